# Optimizing an MI355X kernel written in HIP

```python
import jax, jax.numpy as jnp
from jax import lax
import numpy as np

D_MODEL = 1024
BATCH = 2
SEQ = 8192
DEPTH = 1

D_MIX = D_MODEL
HEAD_DIM = 64
MLSTM_HEADS = (D_MIX // 2) // HEAD_DIM
MOBA_HEADS = (D_MIX // 2) // HEAD_DIM
MLSTM_WIDTH = MLSTM_HEADS * HEAD_DIM
MOBA_WIDTH = MOBA_HEADS * HEAD_DIM
MLSTM_CHUNK = 128
CONV_WIDTH = 4
MOBA_BLOCK = 256
MOBA_TOPK = 3
MOBA_Q_CHUNK = 64
N_EXPERTS = 32
TOP_K = 4
D_FF = D_MODEL
SWIGLU_LIMIT = 7.0
SWIGLU_ALPHA = 1.702
PLE_DIM = 256
RMS_EPS = 1e-6
PROJ_COLS = 4 * MLSTM_WIDTH + 2 * MLSTM_HEADS + 3 * MOBA_WIDTH

kernel_name = "hymba_mlstm_moba_moe_block"


def rmsnorm(x, g):
    xf = x.astype(jnp.float32)
    y = xf * lax.rsqrt(jnp.mean(xf * xf, axis=-1, keepdims=True) + RMS_EPS)
    return (y * g.astype(jnp.float32)).astype(x.dtype)


def alibi_slopes(n_heads):
    return jnp.exp2(-8.0 * jnp.arange(1, n_heads + 1, dtype=jnp.float32) / n_heads)


def causal_conv_silu(u, w, b):
    K = w.shape[0]
    S = u.shape[1]
    up = jnp.pad(u, ((0, 0), (K - 1, 0), (0, 0)))
    y = b + up[:, 0:S] * w[0]
    for j in range(1, K):
        y = y + up[:, j:j + S] * w[j]
    return jax.nn.silu(y)


def mlstm_chunkwise(q, k, v, i_pre, f_pre):
    B, H, S, Dh = q.shape
    L = MLSTM_CHUNK
    NC = S // L
    lf = jax.nn.log_sigmoid(f_pre.astype(jnp.float32))

    def to_chunks(a):
        a = a.astype(jnp.float32)
        return jnp.moveaxis(a.reshape(a.shape[:2] + (NC, L) + a.shape[3:]), 2, 0)

    xs = (to_chunks(q), to_chunks(k), to_chunks(v), to_chunks(i_pre), to_chunks(lf))
    causal = jnp.tril(jnp.ones((L, L), dtype=bool))

    def step(carry, inp):
        C, n, m = carry
        q_, k_, v_, i_, f_ = inp
        b = jnp.cumsum(f_, axis=-1)
        logD = b[..., :, None] - b[..., None, :] + i_[..., None, :]
        logD = jnp.where(causal, logD, -jnp.inf)
        inter = b + m[..., None]
        m_t = jnp.maximum(inter, jnp.max(logD, axis=-1))
        Dm = jnp.exp(logD - m_t[..., None])
        sc_inter = jnp.exp(inter - m_t)
        s = jnp.einsum('bhtd,bhsd->bhts', q_, k_) * Dm
        num = jnp.einsum('bhts,bhsd->bhtd', s, v_) + sc_inter[..., None] * jnp.einsum('bhvk,bhtk->bhtv', C, q_)
        den = jnp.sum(s, axis=-1) + sc_inter * jnp.einsum('bhk,bhtk->bht', n, q_)
        h = num / jnp.maximum(jnp.abs(den), jnp.exp(-m_t))[..., None]
        bL = b[..., -1]
        logw = bL[..., None] - b + i_
        m_new = jnp.maximum(bL + m, jnp.max(logw, axis=-1))
        w = jnp.exp(logw - m_new[..., None])
        decay = jnp.exp(bL + m - m_new)
        C_new = decay[..., None, None] * C + jnp.einsum('bhs,bhsv,bhsk->bhvk', w, v_, k_)
        n_new = decay[..., None] * n + jnp.einsum('bhs,bhsk->bhk', w, k_)
        return (C_new, n_new, m_new), h

    init = (jnp.zeros((B, H, Dh, Dh), jnp.float32), jnp.zeros((B, H, Dh), jnp.float32),
            jnp.zeros((B, H), jnp.float32))
    _, hs = lax.scan(step, init, xs)
    return jnp.moveaxis(hs, 0, 2).reshape(B, H, S, Dh)


def moba_attention(q, k, v):
    B, H, S, Dh = q.shape
    BS = MOBA_BLOCK
    Qc = MOBA_Q_CHUNK
    S_pad = -(-S // BS) * BS
    q = q.astype(jnp.float32)
    pad = ((0, 0), (0, 0), (0, S_pad - S), (0, 0))
    k = jnp.pad(k.astype(jnp.float32), pad)
    v = jnp.pad(v.astype(jnp.float32), pad)
    NB = S_pad // BS
    n_sel = min(MOBA_TOPK, NB)
    kb = k.reshape(B, H, NB, BS, Dh)
    vb = v.reshape(B, H, NB, BS, Dh)
    kmean = jnp.mean(kb, axis=3)
    slopes = alibi_slopes(H)
    blk_ids = jnp.arange(NB)
    in_blk = jnp.arange(BS)
    gather = jax.vmap(jax.vmap(lambda blocks, idx: blocks[idx]))

    def one_chunk(c):
        t0 = c * Qc
        qc = lax.dynamic_slice_in_dim(q, t0, Qc, axis=2)
        pos_q = t0 + jnp.arange(Qc)
        own = t0 // BS
        gate = jnp.einsum('bhqd,bhnd->bhqn', qc, kmean)
        gate = jnp.where(blk_ids < own, gate, -jnp.inf)
        _, sel = lax.top_k(gate, n_sel)
        sel_valid = sel < own
        ks = gather(kb, sel)
        vs = gather(vb, sel)
        s_sel = jnp.einsum('bhqd,bhqjkd->bhqjk', qc, ks)
        pos_sel = sel[..., None] * BS + in_blk
        dist_sel = (pos_q[:, None, None] - pos_sel).astype(jnp.float32)
        s_sel = s_sel - slopes[:, None, None, None] * dist_sel
        s_sel = jnp.where(sel_valid[..., None], s_sel, -jnp.inf)
        k_own = lax.dynamic_index_in_dim(kb, own, axis=2, keepdims=False)
        v_own = lax.dynamic_index_in_dim(vb, own, axis=2, keepdims=False)
        s_own = jnp.einsum('bhqd,bhkd->bhqk', qc, k_own)
        dist_own = pos_q[:, None] - (own * BS + in_blk)[None, :]
        s_own = s_own - slopes[:, None, None] * dist_own.astype(jnp.float32)
        s_own = jnp.where(dist_own >= 0, s_own, -jnp.inf)
        scores = jnp.concatenate([s_sel.reshape(B, H, Qc, n_sel * BS), s_own], axis=-1)
        probs = jax.nn.softmax(scores, axis=-1)
        p_sel = probs[..., :n_sel * BS].reshape(B, H, Qc, n_sel, BS)
        p_own = probs[..., n_sel * BS:]
        return (jnp.einsum('bhqjk,bhqjkd->bhqd', p_sel, vs)
                + jnp.einsum('bhqk,bhkd->bhqd', p_own, v_own))

    outs = lax.map(one_chunk, jnp.arange(S // Qc))
    return jnp.moveaxis(outs, 0, 2).reshape(B, H, S, Dh)


def moe_ffn(h, w_router, b_router, w_gu, b_gu, w_dn, b_dn):
    B, S, D = h.shape
    t = h.reshape(B * S, D)
    logits = (t @ w_router + b_router).astype(jnp.float32)
    top_vals, top_idx = lax.top_k(logits, TOP_K)
    wts = jax.nn.softmax(top_vals, axis=-1)
    gates = jnp.sum(jax.nn.one_hot(top_idx, N_EXPERTS, dtype=jnp.float32) * wts[..., None], axis=1)
    y = jnp.zeros((B * S, D), jnp.float32)
    for e in range(N_EXPERTS):
        hu = t @ w_gu[e] + b_gu[e]
        glu = jnp.minimum(hu[:, :D_FF], SWIGLU_LIMIT)
        lin = jnp.clip(hu[:, D_FF:], -SWIGLU_LIMIT, SWIGLU_LIMIT)
        act = glu * jax.nn.sigmoid(SWIGLU_ALPHA * glu) * (lin + 1.0)
        y = y + gates[:, e:e + 1] * (act @ w_dn[e] + b_dn[e])
    return y.reshape(B, S, D)


def setup_inputs(seed: int = 0) -> dict:
    key = jax.random.key(seed)
    ks = jax.random.split(key, 24)
    L = DEPTH

    def nrm(k, shape, scale):
        return jax.random.normal(k, shape, jnp.float32) * scale

    return {
        "x": nrm(ks[0], (BATCH, SEQ, D_MODEL), 1.0),
        "p": nrm(ks[1], (DEPTH, BATCH, SEQ, PLE_DIM), 1.0),
        "mix_norm_g": 1.0 + nrm(ks[2], (L, D_MODEL), 0.02),
        "w_in": nrm(ks[3], (L, D_MODEL, PROJ_COLS), D_MODEL ** -0.5),
        "conv_w": nrm(ks[4], (L, CONV_WIDTH, 2 * MLSTM_WIDTH), CONV_WIDTH ** -0.5),
        "conv_b": nrm(ks[5], (L, 2 * MLSTM_WIDTH), 0.02),
        "igate_b": nrm(ks[6], (L, MLSTM_HEADS), 0.1),
        "fgate_b": jnp.linspace(3.0, 6.0, MLSTM_HEADS, dtype=jnp.float32) + nrm(ks[7], (L, MLSTM_HEADS), 0.1),
        "mlstm_head_g": 1.0 + nrm(ks[8], (L, MLSTM_HEADS, HEAD_DIM), 0.02),
        "q_norm_g": 1.0 + nrm(ks[9], (L, HEAD_DIM), 0.02),
        "k_norm_g": 1.0 + nrm(ks[10], (L, HEAD_DIM), 0.02),
        "w_out": nrm(ks[11], (L, D_MIX, D_MODEL), D_MIX ** -0.5),
        "ffn_norm_g": 1.0 + nrm(ks[12], (L, D_MODEL), 0.02),
        "w_router": nrm(ks[13], (L, D_MODEL, N_EXPERTS), D_MODEL ** -0.5),
        "b_router": nrm(ks[14], (L, N_EXPERTS), 0.01),
        "w_gate_up": nrm(ks[15], (L, N_EXPERTS, D_MODEL, 2 * D_FF), D_MODEL ** -0.5),
        "b_gate_up": nrm(ks[16], (L, N_EXPERTS, 2 * D_FF), 0.02),
        "w_down": nrm(ks[17], (L, N_EXPERTS, D_FF, D_MODEL), D_FF ** -0.5),
        "b_down": nrm(ks[18], (L, N_EXPERTS, D_MODEL), 0.02),
        "ple_norm_g": 1.0 + nrm(ks[19], (L, D_MODEL), 0.02),
        "w_ple_gate": nrm(ks[20], (L, D_MODEL, D_MODEL), D_MODEL ** -0.5),
        "w_ple_proj": nrm(ks[21], (L, PLE_DIM, D_MODEL), PLE_DIM ** -0.5),
    }


def reference(x, p, mix_norm_g, w_in, conv_w, conv_b, igate_b, fgate_b, mlstm_head_g,
              q_norm_g, k_norm_g, w_out, ffn_norm_g, w_router, b_router, w_gate_up,
              b_gate_up, w_down, b_down, ple_norm_g, w_ple_gate, w_ple_proj):
    B, S, _ = x.shape
    Wm, Hm, Wb, Hb = MLSTM_WIDTH, MLSTM_HEADS, MOBA_WIDTH, MOBA_HEADS
    splits = [2 * Wm, 3 * Wm, 4 * Wm, 4 * Wm + Hm, 4 * Wm + 2 * Hm,
              4 * Wm + 2 * Hm + Wb, 4 * Wm + 2 * Hm + 2 * Wb]

    def heads(a, n):
        return a.reshape(B, S, n, HEAD_DIM).transpose(0, 2, 1, 3)

    scale = HEAD_DIM ** -0.5
    for l in range(DEPTH):
        h = rmsnorm(x, mix_norm_g[l])
        u = h @ w_in[l]
        ml_qk, ml_v, ml_o, ml_i, ml_f, mb_q, mb_k, mb_v = jnp.split(u, splits, axis=-1)

        ml_qk = causal_conv_silu(ml_qk, conv_w[l], conv_b[l])
        q_m = heads(ml_qk[..., :Wm], Hm) * scale
        k_m = heads(ml_qk[..., Wm:], Hm)
        v_m = heads(ml_v, Hm)
        i_pre = (ml_i + igate_b[l]).transpose(0, 2, 1)
        f_pre = (ml_f + fgate_b[l]).transpose(0, 2, 1)
        h_m = mlstm_chunkwise(q_m, k_m, v_m, i_pre, f_pre)
        h_m = rmsnorm(h_m, mlstm_head_g[l][:, None, :])
        h_m = h_m.transpose(0, 2, 1, 3).reshape(B, S, Wm) * jax.nn.sigmoid(ml_o.astype(jnp.float32))

        q_b = rmsnorm(heads(mb_q, Hb), q_norm_g[l]) * scale
        k_b = rmsnorm(heads(mb_k, Hb), k_norm_g[l])
        v_b = heads(mb_v, Hb)
        h_b = moba_attention(q_b, k_b, v_b).transpose(0, 2, 1, 3).reshape(B, S, Wb)

        mix = jnp.concatenate([h_m, h_b], axis=-1).astype(x.dtype) @ w_out[l]
        x = x + mix.astype(x.dtype)

        y = moe_ffn(rmsnorm(x, ffn_norm_g[l]), w_router[l], b_router[l], w_gate_up[l],
                    b_gate_up[l], w_down[l], b_down[l])
        x = x + y.astype(x.dtype)

        g = jax.nn.sigmoid((rmsnorm(x, ple_norm_g[l]) @ w_ple_gate[l]).astype(jnp.float32))
        x = x + (g * (p[l] @ w_ple_proj[l]).astype(jnp.float32)).astype(x.dtype)
    return x
```

```cpp
#include <hip/hip_runtime.h>
#include <cstdio>
#include <cstdint>

#ifndef MK_PER_PHASE
#define MK_PER_PHASE 1
#endif

#define GAS __attribute__((address_space(1)))
#define LAS __attribute__((address_space(3)))
typedef unsigned short bf16;
typedef unsigned v4u __attribute__((ext_vector_type(4)));
typedef unsigned v2u __attribute__((ext_vector_type(2)));
typedef float f32x4 __attribute__((ext_vector_type(4)));
typedef short bf16x8 __attribute__((ext_vector_type(8)));
typedef GAS unsigned gu32;
#define RLX_AGENT __ATOMIC_RELAXED, __HIP_MEMORY_SCOPE_AGENT
#define LDS_WAIT() asm volatile("s_waitcnt lgkmcnt(0)" ::: "memory")
#define VM_WAIT() asm volatile("s_waitcnt vmcnt(0)" ::: "memory")

constexpr int BATCH = 2, SEQ = 8192, D = 1024, M = BATCH * SEQ;
constexpr int PROJ = 3600, NU = 3584;
constexpr int HD = 64, NH = 8, WM = 512;
constexpr int LCH = 128, NCH = SEQ / LCH;
constexpr int MBS = 256, NBK = SEQ / MBS;
constexpr int NPAIR = NBK * (NBK - 1) / 2;
constexpr int NE = 32, TOPK = 4, FF = 1024, PLE = 256;
constexpr int MAXROWS = M * TOPK + NE * 256, MAXTILES = MAXROWS / 256;
constexpr float RMS_EPS = 1e-6f;
constexpr float SW_LIMIT = 7.0f, SW_ALPHA = 1.702f;
constexpr int UQM = 0, UKM = 512, UVM = 1024, UOM = 1536, UQB = 2048, UKB = 2560, UVB = 3072;
constexpr int NBH = BATCH * NH;

constexpr size_t MiB = 1u << 20;
constexpr size_t WS_CTL = 0, CTL_ZERO_BYTES = 1 * MiB;
constexpr size_t WS_WIN = 2 * MiB;
constexpr size_t WS_WOUT = 10 * MiB;
constexpr size_t WS_WPG = 12 * MiB;
constexpr size_t WS_WPP = 14 * MiB;
constexpr size_t WS_WR = 15 * MiB;
constexpr size_t WS_WGU = 16 * MiB;
constexpr size_t WS_WDN = 144 * MiB;
constexpr size_t WS_XN = 208 * MiB;
constexpr size_t WS_PB = 240 * MiB;
constexpr size_t WS_GATES = 248 * MiB;
constexpr size_t WS_SA = 249 * MiB;
constexpr size_t WS_SMX = WS_SA + 512 * 1024;
constexpr size_t WS_SB = WS_SMX + 512 * 1024;
constexpr size_t WS_SW = WS_SB + 512 * 1024;
constexpr size_t WS_SMALL = 251 * MiB;
constexpr size_t WS_DEC = WS_SMALL;
constexpr size_t WS_MC = WS_DEC + 4096;
constexpr size_t WS_KMEAN = WS_MC + 4096;
constexpr size_t WS_MCNT = WS_KMEAN + 131072;
constexpr size_t WS_SELE = 252 * MiB;
constexpr size_t WS_SELW = WS_SELE + 262144;
constexpr size_t WS_RSTD = WS_SELW + 262144;
constexpr size_t WS_HIST = WS_RSTD + 65536;
constexpr size_t WS_POS = WS_HIST + 32768;
constexpr size_t WS_ROWTOK = WS_POS + 262144;
constexpr size_t WS_ROWGATE = WS_ROWTOK + 294912;
constexpr size_t WS_ROWRSTD = WS_ROWGATE + 294912;
constexpr size_t WS_TILEE = WS_ROWRSTD + 294912;
constexpr size_t WS_SS = 254 * MiB;
constexpr size_t WS_DN = 255 * MiB;
constexpr size_t WS_NS = WS_DN + 262144;
constexpr size_t WS_U = 260 * MiB;
constexpr size_t WS_QM = 372 * MiB;
constexpr size_t WS_KM = 388 * MiB;
constexpr size_t WS_QN = 404 * MiB;
constexpr size_t WS_KN = 420 * MiB;
constexpr size_t WS_VT = 436 * MiB;
constexpr size_t WS_MIX = 452 * MiB;
constexpr size_t WS_X1 = 484 * MiB;
constexpr size_t WS_MLIST = 548 * MiB;
constexpr size_t WS_OP = 556 * MiB;
constexpr size_t WS_LP = 652 * MiB;
constexpr size_t WS_DC = 654 * MiB;
constexpr size_t WS_CS = 670 * MiB;
constexpr size_t WS_ACT = 688 * MiB;
constexpr size_t WS_YS = 260 * MiB;
constexpr size_t WS_END = 832 * MiB;
static_assert(WS_ACT + (size_t)MAXROWS * 1024 * 2 <= WS_END && WS_YS + (size_t)MAXROWS * 1024 * 2 <= WS_QN, "ws map");
constexpr int CW_BAR = 4096;

constexpr int RING_BYTES = 131072;
constexpr int MISC_OFF = RING_BYTES + 320;
constexpr int LDS_BYTES = 147456;
constexpr int NWAVES = 8, NTHR = 512;

__device__ __forceinline__ unsigned f2bf(float f) { unsigned u = __builtin_bit_cast(unsigned, f); return (u + 0x7fffu + ((u >> 16) & 1u)) >> 16; }
__device__ __forceinline__ unsigned pk2(float lo, float hi) { return f2bf(lo) | (f2bf(hi) << 16); }
__device__ __forceinline__ float bf2f(unsigned short b) { return __builtin_bit_cast(float, (unsigned)b << 16); }
__device__ __forceinline__ float bflo(unsigned w) { return __builtin_bit_cast(float, w << 16); }
__device__ __forceinline__ float bfhi(unsigned w) { return __builtin_bit_cast(float, w & 0xffff0000u); }
__device__ __forceinline__ float sigmoidf_(float x) { return 1.0f / (1.0f + __expf(-x)); }

#define XB_TMO      128
#define XB_XCNT(j)  (256  + 64 * (j))
#define XB_XSUB(j)  (1280 + 64 * (j))
#define XB_XGEN(j)  (2304 + 64 * (j))
#define XB_TOP      3328
#define XB_TOPGEN   3392
#define XCD_BAR_WORDS 3456
#define XB_SPIN_CAP (1u << 18)
__device__ __forceinline__ unsigned xb_ld(unsigned* p)              { return __hip_atomic_load(p, __ATOMIC_RELAXED, __HIP_MEMORY_SCOPE_AGENT); }
__device__ __forceinline__ unsigned xb_add(unsigned* p, unsigned v) { return __hip_atomic_fetch_add(p, v, __ATOMIC_RELAXED, __HIP_MEMORY_SCOPE_AGENT); }
__device__ __forceinline__ unsigned xb_xcc_id() { return (unsigned)__builtin_amdgcn_s_getreg((3 << 11) | 20) & 0xFu; }
#define XB_SPIN(cond, bar) do { unsigned _sp = 0; while (cond) { __builtin_amdgcn_s_sleep(1); \
    if ((++_sp & 255u) == 0u) { if (xb_ld(&(bar)[XB_TMO])) break; if (_sp > XB_SPIN_CAP) { atomicAdd(&(bar)[XB_TMO], 1u); break; } } } } while (0)
struct XcdBarrier { unsigned* bar; unsigned x; volatile LAS unsigned* st; };
__device__ __forceinline__ XcdBarrier xcd_barrier_post(unsigned* bar, volatile LAS unsigned* st) {
    XcdBarrier b; b.bar = bar; b.x = xb_xcc_id(); b.st = st;
    if (threadIdx.x == 0) (void)xb_add(&bar[XB_XCNT(b.x)], 1u);
    return b;
}
__device__ __forceinline__ void xcd_barrier_complete(unsigned* bar, unsigned x, unsigned& nloc, unsigned& nx) {
    const unsigned G = gridDim.x * gridDim.y * gridDim.z;
    unsigned sum, cnt, mine, sp = 0u;
    for (;;) {
        sum = 0u; cnt = 0u; mine = 0u;
#pragma unroll
        for (unsigned j = 0; j < 16; ++j) { const unsigned c = xb_ld(&bar[XB_XCNT(j)]); sum += c; cnt += (c > 0u) ? 1u : 0u; mine = (j == x) ? c : mine; }
        if (sum == G) break;
        __builtin_amdgcn_s_sleep(1);
        if ((++sp & 255u) == 0u) { if (xb_ld(&bar[XB_TMO])) break; if (sp > XB_SPIN_CAP) { atomicAdd(&bar[XB_TMO], 1u); break; } }
    }
    nloc = mine > 0u ? mine : 1u; nx = cnt > 0u ? cnt : 1u;
}
__device__ __forceinline__ void xcd_barrier(const XcdBarrier& b) {
    asm volatile("s_waitcnt vmcnt(0)" ::: "memory");
    __syncthreads();
    if (threadIdx.x == 0) {
        unsigned* bar = b.bar;
        __builtin_amdgcn_s_waitcnt(0);
        unsigned nloc = b.st[0], nx = b.st[1];
        if (nloc == 0u) { xcd_barrier_complete(bar, b.x, nloc, nx); b.st[0] = nloc; b.st[1] = nx; }
        const unsigned old = xb_add(&bar[XB_XSUB(b.x)], 1u);
        const unsigned gen = old / nloc;
        if (old + 1u == (gen + 1u) * nloc) {
            __builtin_amdgcn_fence(__ATOMIC_RELEASE, "agent");
            asm volatile("s_waitcnt vmcnt(0)" ::: "memory");
            const unsigned og = xb_add(&bar[XB_TOP], 1u);
            const unsigned tg = og / nx;
            if (og + 1u == (tg + 1u) * nx) xb_add(&bar[XB_TOPGEN], 1u);
            else XB_SPIN(xb_ld(&bar[XB_TOPGEN]) == tg, bar);
            __builtin_amdgcn_fence(__ATOMIC_ACQUIRE, "agent");
            xb_add(&bar[XB_XGEN(b.x)], 1u);
            asm volatile("s_waitcnt vmcnt(0)" ::: "memory");
        } else {
            XB_SPIN(xb_ld(&bar[XB_XGEN(b.x)]) == gen, bar);
            __builtin_amdgcn_fence(__ATOMIC_ACQUIRE, "agent");
            asm volatile("s_waitcnt vmcnt(0)" ::: "memory");
        }
    }
    __syncthreads();
}

struct Args { const float* in[22]; float* out; unsigned char* ws; int ph_lo, ph_hi, li, pad; };
struct Frame {
    LAS unsigned char* lds; volatile LAS unsigned* MISC; gu32* ctl;
    int tid, lane, wave, G, bid;
    const float *x, *p, *mix_g, *w_in, *conv_w, *conv_b, *ig_b, *fg_b, *head_g, *qn_g, *kn_g, *w_out, *ffn_g, *w_r, *b_r, *w_gu, *b_gu, *w_dn, *b_dn, *ple_g, *w_pg, *w_pp;
    float* out; unsigned char* ws;
};
template <class T> __device__ __forceinline__ T* wsp(const Frame& F, size_t off) { return (T*)(F.ws + off); }

__device__ __forceinline__ float wave_sum(float v) {
#pragma unroll
    for (int o = 1; o < 64; o <<= 1) v += __shfl_xor(v, o);
    return v;
}
__device__ __forceinline__ float wave_max(float v) {
#pragma unroll
    for (int o = 1; o < 64; o <<= 1) v = fmaxf(v, __shfl_xor(v, o));
    return v;
}

struct Unit { int pm, pn; };
struct StaticOrder {
    int nM, nN, G, c;
    __device__ __forceinline__ bool next(int i, Unit& u) const {
        const int L = i * G + c; if (L >= nM * nN) return false;
        const int grp = L / (8 * nN), r = L % (8 * nN); u.pm = grp * 8 + (r & 7); u.pn = r >> 3; return true;
    }
};
struct GroupedOrder {
    const int* tile_e; int NT, G, c;
    __device__ __forceinline__ bool next(int i, Unit& u) const {
        const int ntile = tile_e[MAXTILES]; const int L = i * G + c; if (L >= ntile * NT) return false;
        const int t = L / NT, n = L % NT; u.pm = t; u.pn = tile_e[t] * NT + n; return true;
    }
};
__device__ __forceinline__ int perm32(int rho) { const int n = rho >> 4, i = rho & 15; return 8 * (i >> 2) + 4 * n + (i & 3); }

template <class Sched, class Epi>
__device__ __forceinline__ void sgemm_phase(const Frame& F, const bf16* A, const int* arow, int lda, const bf16* Bt, int K, const Sched& S, const Epi& E) {
    const int wid = F.wave, lane = F.lane, wr = wid >> 2, wc = wid & 3, fr = lane & 15, fq = lane >> 4;
    Unit u;
    for (int i = 0; S.next(i, u); ++i) {
        for (int ai = 0; ai < 2; ++ai) {
            f32x4 acc[2][4][2];
#pragma unroll
            for (int bj = 0; bj < 2; ++bj)
#pragma unroll
                for (int m = 0; m < 4; ++m)
#pragma unroll
                    for (int n = 0; n < 2; ++n) acc[bj][m][n] = (f32x4){0.f, 0.f, 0.f, 0.f};
            const bf16* ap[4]; const bf16* bp[2][2];
#pragma unroll
            for (int m = 0; m < 4; ++m) { const int r = u.pm * 256 + ai * 128 + wr * 64 + m * 16 + fr; const int src = arow ? arow[r] : r; ap[m] = A + (size_t)src * lda + fq * 8; }
#pragma unroll
            for (int bj = 0; bj < 2; ++bj)
#pragma unroll
                for (int n = 0; n < 2; ++n) bp[bj][n] = Bt + (size_t)(u.pn * 256 + bj * 128 + wc * 32 + perm32(16 * n + fr)) * K + fq * 8;
            for (int k = 0; k < K; k += 32) {
                bf16x8 af[4], bfr[2][2];
#pragma unroll
                for (int m = 0; m < 4; ++m) af[m] = *(const bf16x8*)(ap[m] + k);
#pragma unroll
                for (int bj = 0; bj < 2; ++bj)
#pragma unroll
                    for (int n = 0; n < 2; ++n) bfr[bj][n] = *(const bf16x8*)(bp[bj][n] + k);
#pragma unroll
                for (int bj = 0; bj < 2; ++bj)
#pragma unroll
                    for (int m = 0; m < 4; ++m)
#pragma unroll
                        for (int n = 0; n < 2; ++n) acc[bj][m][n] = __builtin_amdgcn_mfma_f32_16x16x32_bf16(bfr[bj][n], af[m], acc[bj][m][n], 0, 0, 0);
            }
#pragma unroll
            for (int m = 0; m < 4; ++m) {
                float lo[8], hi[8];
#pragma unroll
                for (int j = 0; j < 4; ++j) { lo[j] = acc[0][m][0][j]; lo[4 + j] = acc[0][m][1][j]; hi[j] = acc[1][m][0][j]; hi[4 + j] = acc[1][m][1][j]; }
                E(u, ai * 128 + wr * 64 + m * 16 + fr, wc * 32 + fq * 8, lo, hi);
            }
        }
    }
}
__device__ __forceinline__ void store8bf(bf16* p, const float (&v)[8]) { v4u w; w.x = pk2(v[0], v[1]); w.y = pk2(v[2], v[3]); w.z = pk2(v[4], v[5]); w.w = pk2(v[6], v[7]); *(v4u*)p = w; }

struct EpiStoreBf16 { bf16* O; int ldc;
    __device__ __forceinline__ void operator()(const Unit& u, int r, int c, const float (&lo)[8], const float (&hi)[8]) const {
        bf16* o = O + (size_t)(u.pm * 256 + r) * ldc + u.pn * 256 + c; store8bf(o, lo); store8bf(o + 128, hi); } };
struct EpiOutProj { const float* x; const float* g; float* X1; bf16* T1; float* SS;
    __device__ __forceinline__ void operator()(const Unit& u, int r, int c, const float (&lo)[8], const float (&hi)[8]) const {
        const size_t row = (size_t)u.pm * 256 + r; const int col = u.pn * 256 + c; float ss = 0.f;
#pragma unroll
        for (int h = 0; h < 2; ++h) { const float* v = h ? hi : lo; const int cc = col + h * 128; float o[8], t[8];
#pragma unroll
            for (int j = 0; j < 8; ++j) { o[j] = x[row * D + cc + j] + v[j]; ss += o[j] * o[j]; t[j] = o[j] * g[cc + j]; }
            *(f32x4*)(X1 + row * D + cc) = (f32x4){o[0], o[1], o[2], o[3]}; *(f32x4*)(X1 + row * D + cc + 4) = (f32x4){o[4], o[5], o[6], o[7]};
            store8bf(T1 + row * D + cc, t); }
        ss += __shfl_xor(ss, 16); ss += __shfl_xor(ss, 32);
        if ((threadIdx.x & 63) < 16) SS[row * 16 + u.pn * 4 + (c >> 5)] = ss; } };
struct EpiGateUp { const int* tile_e; const float* rowrstd; const float* b_gu; bf16* ACT;
    __device__ __forceinline__ void operator()(const Unit& u, int r, int c, const float (&lo)[8], const float (&hi)[8]) const {
        const int e = u.pn >> 3, nt = u.pn & 7; const size_t row = (size_t)u.pm * 256 + r; const float rs = rowrstd[row];
        const float* bg = b_gu + (size_t)e * 2048 + nt * 128 + c; float a[8];
#pragma unroll
        for (int j = 0; j < 8; ++j) { float glu = lo[j] * rs + bg[j], lin = hi[j] * rs + bg[1024 + j];
            glu = fminf(glu, SW_LIMIT); lin = fminf(fmaxf(lin, -SW_LIMIT), SW_LIMIT);
            a[j] = glu * sigmoidf_(SW_ALPHA * glu) * (lin + 1.0f); }
        store8bf(ACT + row * FF + nt * 128 + c, a); } };
struct EpiDown { const float* rowgate; const float* b_dn; bf16* YS;
    __device__ __forceinline__ void operator()(const Unit& u, int r, int c, const float (&lo)[8], const float (&hi)[8]) const {
        const int e = u.pn >> 2, nt = u.pn & 3; const size_t row = (size_t)u.pm * 256 + r; const float gt = rowgate[row];
        const float* bd = b_dn + (size_t)e * 1024 + nt * 256 + c; float a[8], b[8];
#pragma unroll
        for (int j = 0; j < 8; ++j) { a[j] = (lo[j] + bd[j]) * gt; b[j] = (hi[j] + bd[128 + j]) * gt; }
        bf16* o = YS + row * D + nt * 256 + c; store8bf(o, a); store8bf(o + 128, b); } };
struct EpiPle { const bf16* PE; float* out;
    __device__ __forceinline__ void operator()(const Unit& u, int r, int c, const float (&lo)[8], const float (&hi)[8]) const {
        const size_t row = (size_t)u.pm * 256 + r; const int col = u.pn * 256 + c;
#pragma unroll
        for (int h = 0; h < 2; ++h) { const float* v = h ? hi : lo; const int cc = col + h * 128; const v4u pe = *(const v4u*)(PE + row * D + cc);
            f32x4 x0 = *(const f32x4*)(out + row * D + cc), x1 = *(const f32x4*)(out + row * D + cc + 4);
            x0[0] += sigmoidf_(v[0]) * bflo(pe.x); x0[1] += sigmoidf_(v[1]) * bfhi(pe.x); x0[2] += sigmoidf_(v[2]) * bflo(pe.y); x0[3] += sigmoidf_(v[3]) * bfhi(pe.y);
            x1[0] += sigmoidf_(v[4]) * bflo(pe.z); x1[1] += sigmoidf_(v[5]) * bfhi(pe.z); x1[2] += sigmoidf_(v[6]) * bflo(pe.w); x1[3] += sigmoidf_(v[7]) * bfhi(pe.w);
            *(f32x4*)(out + row * D + cc) = x0; *(f32x4*)(out + row * D + cc + 4) = x1; } } };

__device__ __forceinline__ void transpose_tile(const float* src, int ldw, bf16* dst, int K, LAS float* scr, int lane) {
#pragma unroll 8
    for (int i = 0; i < 32; ++i) { const int kk = 2 * i + (lane >> 5); scr[kk * 33 + (lane & 31)] = src[(size_t)kk * ldw + (lane & 31)]; }
    LDS_WAIT(); asm volatile("" ::: "memory");
    const int c = lane & 7;
#pragma unroll
    for (int j = 0; j < 4; ++j) { const int n = (lane >> 3) + 8 * j; const LAS float* s = scr + (8 * c) * 33 + n;
        v4u o; o.x = pk2(s[0 * 33], s[1 * 33]); o.y = pk2(s[2 * 33], s[3 * 33]); o.z = pk2(s[4 * 33], s[5 * 33]); o.w = pk2(s[6 * 33], s[7 * 33]);
        *(v4u*)(dst + (size_t)n * K + 8 * c) = o; }
    LDS_WAIT(); asm volatile("" ::: "memory");
}
__device__ __forceinline__ void p0_prologue(Frame& F) {
    LAS float* scr = (LAS float*)(F.lds + F.wave * 16384);
    const int gw = F.bid * NWAVES + F.wave, NGW = F.G * NWAVES, lane = F.lane;
    constexpr int I_IN = 16 * (NU / 32), I_SQ = 16 * 32, I_PP = 4 * 32, I_R = 16, I_GU = 16 * 64, I_DN = 16 * 32;
    constexpr int NITEMS = I_IN + 2 * I_SQ + I_PP + I_R + NE * I_GU + NE * I_DN;
    for (int it = gw; it < NITEMS; it += NGW) {
        int r = it;
        if (r < I_IN) { const int kb = r / (NU / 32), nb = r % (NU / 32), n0 = 32 * nb, sc = n0 < 2048 ? n0 : n0 + 16;
            transpose_tile(F.w_in + (size_t)(64 * kb) * PROJ + sc, PROJ, wsp<bf16>(F, WS_WIN) + (size_t)n0 * D + 64 * kb, D, scr, lane); continue; } r -= I_IN;
        if (r < I_SQ) { const int kb = r / 32, n0 = 32 * (r % 32); transpose_tile(F.w_out + (size_t)(64 * kb) * D + n0, D, wsp<bf16>(F, WS_WOUT) + (size_t)n0 * D + 64 * kb, D, scr, lane); continue; } r -= I_SQ;
        if (r < I_SQ) { const int kb = r / 32, n0 = 32 * (r % 32); transpose_tile(F.w_pg + (size_t)(64 * kb) * D + n0, D, wsp<bf16>(F, WS_WPG) + (size_t)n0 * D + 64 * kb, D, scr, lane); continue; } r -= I_SQ;
        if (r < I_PP) { const int kb = r / 32, n0 = 32 * (r % 32); transpose_tile(F.w_pp + (size_t)(64 * kb) * D + n0, D, wsp<bf16>(F, WS_WPP) + (size_t)n0 * PLE + 64 * kb, PLE, scr, lane); continue; } r -= I_PP;
        if (r < I_R) { const int kb = r; transpose_tile(F.w_r + (size_t)(64 * kb) * NE, NE, wsp<bf16>(F, WS_WR) + 64 * kb, D, scr, lane); continue; } r -= I_R;
        if (r < NE * I_GU) { const int e = r / I_GU, q = r % I_GU, kb = q / 64, n0 = 32 * (q % 64), pn = n0 >> 8, c = n0 & 255;
            const int sc = c < 128 ? pn * 128 + c : 1024 + pn * 128 + (c - 128);
            transpose_tile(F.w_gu + ((size_t)e * D + 64 * kb) * 2048 + sc, 2048, wsp<bf16>(F, WS_WGU) + ((size_t)e * 2048 + n0) * D + 64 * kb, D, scr, lane); continue; } r -= NE * I_GU;
        { const int e = r / I_DN, q = r % I_DN, kb = q / 32, n0 = 32 * (q % 32);
            transpose_tile(F.w_dn + ((size_t)e * FF + 64 * kb) * D + n0, D, wsp<bf16>(F, WS_WDN) + ((size_t)e * D + n0) * FF + 64 * kb, FF, scr, lane); }
    }
    bf16* XN = wsp<bf16>(F, WS_XN); float* GT = wsp<float>(F, WS_GATES);
    for (int m = gw; m < M; m += NGW) {
        const f32x4* xr = (const f32x4*)(F.x + (size_t)m * D) + lane; const f32x4* gr = (const f32x4*)F.mix_g + lane;
        f32x4 v[4]; float s = 0.f;
#pragma unroll
        for (int j = 0; j < 4; ++j) { v[j] = xr[64 * j]; s += (v[j].x * v[j].x + v[j].y * v[j].y) + (v[j].z * v[j].z + v[j].w * v[j].w); }
        const float rstd = 1.0f / sqrtf(wave_sum(s) * (1.0f / D) + RMS_EPS);
        float ga[16];
#pragma unroll
        for (int c = 0; c < 16; ++c) ga[c] = 0.f;
#pragma unroll
        for (int j = 0; j < 4; ++j) { const f32x4 g = gr[64 * j]; v[j] = v[j] * rstd * g;
            *(v2u*)(XN + (size_t)m * D + 256 * j + 4 * lane) = (v2u){pk2(v[j].x, v[j].y), pk2(v[j].z, v[j].w)};
#pragma unroll
            for (int e = 0; e < 4; ++e) { const int k = 256 * j + 4 * lane + e; const f32x4* wg = (const f32x4*)(F.w_in + (size_t)k * PROJ + 2048);
#pragma unroll
                for (int q = 0; q < 4; ++q) { const f32x4 w = wg[q]; ga[4 * q + 0] += v[j][e] * w.x; ga[4 * q + 1] += v[j][e] * w.y; ga[4 * q + 2] += v[j][e] * w.z; ga[4 * q + 3] += v[j][e] * w.w; } } }
#pragma unroll
        for (int c = 0; c < 16; ++c) ga[c] = wave_sum(ga[c]);
        if (lane < 16) { float val = 0.f;
#pragma unroll
            for (int c = 0; c < 16; ++c) val = (lane == c) ? ga[c] : val;
            GT[(size_t)m * 16 + lane] = val + (lane < 8 ? F.ig_b[lane] : F.fg_b[lane - 8]); }
    }
    bf16* PB = wsp<bf16>(F, WS_PB);
    for (size_t i = (size_t)F.bid * NTHR + F.tid; i < (size_t)M * PLE / 4; i += (size_t)F.G * NTHR) { const f32x4 v = ((const f32x4*)F.p)[i]; *(v2u*)(PB + 4 * i) = (v2u){pk2(v.x, v.y), pk2(v.z, v.w)}; }
}

__device__ __forceinline__ float logsigmoidf_(float f) { return f >= 0.f ? -log1pf(__expf(-f)) : f - log1pf(__expf(f)); }
__device__ __forceinline__ void p_prep(Frame& F) {
    const bf16* U = wsp<bf16>(F, WS_U);
    { bf16* QM = wsp<bf16>(F, WS_QM); bf16* KM = wsp<bf16>(F, WS_KM);
      for (size_t i = (size_t)F.bid * NTHR + F.tid; i < (size_t)M * 256; i += (size_t)F.G * NTHR) {
          const int m = (int)(i >> 8), ch = (int)(i & 255) * 4, t = m & (SEQ - 1);
          float y[4];
#pragma unroll
          for (int e = 0; e < 4; ++e) y[e] = F.conv_b[ch + e];
#pragma unroll
          for (int j = 0; j < 4; ++j) { const int tt = t - 3 + j; if (tt >= 0) { const v2u w = *(const v2u*)(U + (size_t)(m - 3 + j) * NU + ch); const float* cw = F.conv_w + j * 1024 + ch;
              y[0] += bflo(w.x) * cw[0]; y[1] += bfhi(w.x) * cw[1]; y[2] += bflo(w.y) * cw[2]; y[3] += bfhi(w.y) * cw[3]; } }
          const float sc = ch < 512 ? 0.125f : 1.0f;
#pragma unroll
          for (int e = 0; e < 4; ++e) y[e] = y[e] * sigmoidf_(y[e]) * sc;
          bf16* o = ch < 512 ? QM + (size_t)m * WM + ch : KM + (size_t)m * WM + (ch - 512);
          *(v2u*)o = (v2u){pk2(y[0], y[1]), pk2(y[2], y[3])}; } }
    { bf16* KN = wsp<bf16>(F, WS_KN); bf16* VT = wsp<bf16>(F, WS_VT); float* KMEAN = wsp<float>(F, WS_KMEAN);
      LAS float* red = (LAS float*)F.lds;
      for (int un = F.bid; un < NBH * NBK; un += F.G) {
          const int bh = un / NBK, j = un % NBK, b = bh / NH, h = bh % NH;
          const float gk = F.kn_g[F.lane]; float acc = 0.f;
          for (int kk = F.wave; kk < MBS; kk += NWAVES) {
              const size_t m = (size_t)b * SEQ + j * MBS + kk;
              const float v = bf2f(U[m * NU + UKB + h * HD + F.lane]);
              const float rstd = 1.0f / sqrtf(wave_sum(v * v) * (1.0f / HD) + RMS_EPS);
              const float kn = v * rstd * gk; acc += kn;
              KN[m * WM + h * HD + F.lane] = (bf16)f2bf(kn);
          }
          red[F.wave * 64 + F.lane] = acc; __syncthreads();
          if (F.wave == 0) { float s = 0.f;
#pragma unroll
              for (int w = 0; w < NWAVES; ++w) s += red[w * 64 + F.lane];
              KMEAN[(size_t)un * HD + F.lane] = s * (1.0f / MBS); }
          __syncthreads();
          for (int e = F.tid; e < HD * MBS; e += NTHR) { const int d = e >> 8, s = e & 255; const size_t m = (size_t)b * SEQ + j * MBS + s;
              VT[((size_t)bh * HD + d) * SEQ + j * MBS + s] = U[m * NU + UVB + h * HD + d]; }
      } }
    { const float* GT = wsp<float>(F, WS_GATES); float* SA = wsp<float>(F, WS_SA); float* SMX = wsp<float>(F, WS_SMX); float* SB = wsp<float>(F, WS_SB); float* SW = wsp<float>(F, WS_SW);
      float* DEC = wsp<float>(F, WS_DEC); float* MC = wsp<float>(F, WS_MC);
      LAS float* sbl = (LAS float*)(F.lds + 4096); LAS float* sA = sbl + 64; LAS float* sm = sA + 64;
      for (int bh = F.bid; bh < NBH; bh += F.G) {
          const int b = bh / NH, h = bh % NH;
          __syncthreads();
          for (int c = F.wave; c < NCH; c += NWAVES) {
              const size_t m0 = (size_t)b * SEQ + c * LCH + 2 * F.lane;
              const float i0 = GT[m0 * 16 + h], i1 = GT[(m0 + 1) * 16 + h];
              const float l0 = logsigmoidf_(GT[m0 * 16 + 8 + h]), l1 = logsigmoidf_(GT[(m0 + 1) * 16 + 8 + h]);
              float s = l0 + l1, inc = s;
#pragma unroll
              for (int o = 1; o < 64; o <<= 1) { const float t = __shfl_up(inc, o); if (F.lane >= o) inc += t; }
              const float b0 = (inc - s) + l0, b1 = inc;
              const float a0 = i0 - b0, a1 = i1 - b1;
              float mx = fmaxf(a0, a1), pm = mx;
#pragma unroll
              for (int o = 1; o < 64; o <<= 1) { const float t = __shfl_up(pm, o); if (F.lane >= o) pm = fmaxf(pm, t); }
              float ex = __shfl_up(pm, 1); if (F.lane == 0) ex = -INFINITY;
              const float cm0 = fmaxf(ex, a0), cm1 = fmaxf(cm0, a1);
              const size_t o0 = (size_t)bh * SEQ + c * LCH + 2 * F.lane;
              SA[o0] = a0; SA[o0 + 1] = a1; SB[o0] = b0; SB[o0 + 1] = b1; SMX[o0] = cm0; SMX[o0 + 1] = cm1;
              if (F.lane == 63) { sbl[c] = b1; sA[c] = cm1; }
          }
          __syncthreads();
          if (F.tid == 0) { float m = 0.f; for (int c = 0; c < NCH; ++c) { sm[c] = m; m = sbl[c] + fmaxf(m, sA[c]); } sm[NCH] = m; }
          VM_WAIT(); __syncthreads();
          for (int c = F.wave; c < NCH; c += NWAVES) {
              const float mc = sm[c], mn = sm[c + 1], bL = sbl[c];
              const size_t o0 = (size_t)bh * SEQ + c * LCH + 2 * F.lane;
              const float a0 = SA[o0], a1 = SA[o0 + 1], c0 = SMX[o0], c1 = SMX[o0 + 1];
              SMX[o0] = fmaxf(mc, c0); SMX[o0 + 1] = fmaxf(mc, c1);
              SW[o0] = __expf(bL + a0 - mn); SW[o0 + 1] = __expf(bL + a1 - mn);
              if (F.lane == 0) { DEC[bh * NCH + c] = __expf(bL + mc - mn); MC[bh * NCH + c] = mc; }
          }
      } }
}

__device__ __forceinline__ int pair_idx(int i, int j) { return i * (i - 1) / 2 + j; }
__device__ __forceinline__ void p_route(Frame& F) {
    const bf16* U = wsp<bf16>(F, WS_U); bf16* QN = wsp<bf16>(F, WS_QN); const float* KMEAN = wsp<float>(F, WS_KMEAN);
    int* MLIST = wsp<int>(F, WS_MLIST); int* MCNT = wsp<int>(F, WS_MCNT);
    LAS float* skm = (LAS float*)F.lds;
    LAS int* ssel = (LAS int*)(F.lds + 8192);
    LAS int* wtot = (LAS int*)(F.lds + 8192 + 3072);
    for (int un = F.bid; un < NBH * NBK; un += F.G) {
        const int bh = un / NBK, i = un % NBK, b = bh / NH, h = bh % NH;
        __syncthreads();
        for (int e = F.tid; e < NBK * HD; e += NTHR) skm[e] = KMEAN[(size_t)bh * NBK * HD + e];
        __syncthreads();
        int s0 = -1, s1 = -1, s2 = -1;
        if (F.tid < MBS) {
            const size_t m = (size_t)b * SEQ + i * MBS + F.tid;
            float q[HD]; float ss = 0.f;
#pragma unroll
            for (int d8 = 0; d8 < 8; ++d8) { const v4u w = *(const v4u*)(U + m * NU + UQB + h * HD + 8 * d8);
                q[8 * d8 + 0] = bflo(w.x); q[8 * d8 + 1] = bfhi(w.x); q[8 * d8 + 2] = bflo(w.y); q[8 * d8 + 3] = bfhi(w.y);
                q[8 * d8 + 4] = bflo(w.z); q[8 * d8 + 5] = bfhi(w.z); q[8 * d8 + 6] = bflo(w.w); q[8 * d8 + 7] = bfhi(w.w); }
#pragma unroll
            for (int d = 0; d < HD; ++d) ss += q[d] * q[d];
            const float rstd = 1.0f / sqrtf(ss * (1.0f / HD) + RMS_EPS);
#pragma unroll
            for (int d = 0; d < HD; ++d) q[d] = q[d] * rstd * F.qn_g[d] * 0.125f;
#pragma unroll
            for (int d8 = 0; d8 < 8; ++d8) { v4u w; w.x = pk2(q[8 * d8], q[8 * d8 + 1]); w.y = pk2(q[8 * d8 + 2], q[8 * d8 + 3]); w.z = pk2(q[8 * d8 + 4], q[8 * d8 + 5]); w.w = pk2(q[8 * d8 + 6], q[8 * d8 + 7]);
                *(v4u*)(QN + m * WM + h * HD + 8 * d8) = w; }
            float v0 = -INFINITY, v1 = -INFINITY, v2 = -INFINITY;
            for (int j = 0; j < i; ++j) {
                float g = 0.f;
#pragma unroll
                for (int d = 0; d < HD; ++d) g += q[d] * skm[j * HD + d];
                if (g > v0) { v2 = v1; s2 = s1; v1 = v0; s1 = s0; v0 = g; s0 = j; }
                else if (g > v1) { v2 = v1; s2 = s1; v1 = g; s1 = j; }
                else if (g > v2) { v2 = g; s2 = j; }
            }
            ssel[F.tid * 3 + 0] = s0; ssel[F.tid * 3 + 1] = s1; ssel[F.tid * 3 + 2] = s2;
        }
        if (F.wave < 4) { for (int j = 0; j < i; ++j) { const bool f = (s0 == j) || (s1 == j) || (s2 == j); const unsigned long long mk = __ballot(f); if (F.lane == 0) wtot[j * 4 + F.wave] = __popcll(mk); } }
        __syncthreads();
        if (F.wave < 4) { for (int j = 0; j < i; ++j) { const bool f = (s0 == j) || (s1 == j) || (s2 == j); const unsigned long long mk = __ballot(f);
                int base = 0; for (int w = 0; w < F.wave; ++w) base += wtot[j * 4 + w];
                if (f) { const int pos = base + __popcll(mk & ((1ull << F.lane) - 1ull)); const int slot = (s0 == j) ? 0 : ((s1 == j) ? 1 : 2);
                    MLIST[((size_t)bh * NPAIR + pair_idx(i, j)) * MBS + pos] = F.tid | (slot << 8); } } }
        if (F.tid < i) MCNT[bh * NPAIR + pair_idx(i, F.tid)] = wtot[F.tid * 4] + wtot[F.tid * 4 + 1] + wtot[F.tid * 4 + 2] + wtot[F.tid * 4 + 3];
    }
}

__device__ __forceinline__ float moba_m0(const Frame& F) { return 8.0f * wave_max(fabsf(F.qn_g[F.lane])) * wave_max(fabsf(F.kn_g[F.lane])); }

__device__ __forceinline__ void p_mix_a(Frame& F) {
    const bf16* U = wsp<bf16>(F, WS_U); const bf16* QN = wsp<bf16>(F, WS_QN); const bf16* KN = wsp<bf16>(F, WS_KN);
    const int* MLIST = wsp<int>(F, WS_MLIST); const int* MCNT = wsp<int>(F, WS_MCNT);
    float* OP = wsp<float>(F, WS_OP); float* LP = wsp<float>(F, WS_LP);
    const float m0 = moba_m0(F);
    LAS float* sq = (LAS float*)(F.lds + F.wave * 2048);
    LAS float* sp = sq + 64;
    for (int un = F.bid; un < NBH * NPAIR; un += F.G) {
        const int bh = un / NPAIR, pr = un % NPAIR, b = bh / NH, h = bh % NH;
        int i = 1; while ((i + 1) * i / 2 <= pr) ++i;
        const int j = pr - i * (i - 1) / 2;
        const int cnt = MCNT[un]; const float slope = exp2f(-(float)(h + 1));
        for (int en = F.wave; en < cnt; en += NWAVES) {
            const int ent = MLIST[(size_t)un * MBS + en]; const int qo = ent & 255, slot = ent >> 8;
            const int tq = i * MBS + qo; const size_t mq = (size_t)b * SEQ + tq;
            sq[F.lane] = bf2f(QN[mq * WM + h * HD + F.lane]);
            LDS_WAIT(); asm volatile("" ::: "memory");
            float l = 0.f;
#pragma unroll
            for (int u4 = 0; u4 < 4; ++u4) { const int kk = F.lane + 64 * u4; const int tk = j * MBS + kk; const size_t mk = (size_t)b * SEQ + tk;
                float s = 0.f;
#pragma unroll
                for (int d8 = 0; d8 < 8; ++d8) { const v4u w = *(const v4u*)(KN + mk * WM + h * HD + 8 * d8);
                    s += sq[8 * d8] * bflo(w.x) + sq[8 * d8 + 1] * bfhi(w.x) + sq[8 * d8 + 2] * bflo(w.y) + sq[8 * d8 + 3] * bfhi(w.y)
                       + sq[8 * d8 + 4] * bflo(w.z) + sq[8 * d8 + 5] * bfhi(w.z) + sq[8 * d8 + 6] * bflo(w.w) + sq[8 * d8 + 7] * bfhi(w.w); }
                const float pv = __expf(s - slope * (float)(tq - tk) - m0);
                sp[kk] = pv; l += pv; }
            l = wave_sum(l);
            LDS_WAIT(); asm volatile("" ::: "memory");
            float o = 0.f;
            for (int kk = 0; kk < MBS; ++kk) { const size_t mk = (size_t)b * SEQ + j * MBS + kk; o += sp[kk] * bf2f(U[mk * NU + UVB + h * HD + F.lane]); }
            OP[((mq * NH + h) * 3 + slot) * HD + F.lane] = o;
            if (F.lane == 0) LP[(mq * NH + h) * 3 + slot] = l;
            LDS_WAIT(); asm volatile("" ::: "memory");
        }
    }
    { const bf16* KM = wsp<bf16>(F, WS_KM); const float* SW = wsp<float>(F, WS_SW); float* DC = wsp<float>(F, WS_DC); float* DN = wsp<float>(F, WS_DN);
      LAS float* sk = (LAS float*)(F.lds + 16384);
      LAS float* sv = sk + LCH * HD;
      for (int un = F.bid; un < NBH * NCH; un += F.G) {
          const int bh = un / NCH, c = un % NCH, b = bh / NH, h = bh % NH;
          __syncthreads();
          for (int e = F.tid; e < LCH * HD; e += NTHR) { const int s = e >> 6, d = e & 63; const size_t m = (size_t)b * SEQ + c * LCH + s;
              const float w = SW[(size_t)bh * SEQ + c * LCH + s];
              sk[e] = bf2f(KM[m * WM + h * HD + d]); sv[e] = w * bf2f(U[m * NU + UVM + h * HD + d]); }
          __syncthreads();
          { const int v = F.tid >> 3, k0 = (F.tid & 7) * 8; float acc[8];
#pragma unroll
            for (int e = 0; e < 8; ++e) acc[e] = 0.f;
            for (int s = 0; s < LCH; ++s) { const float wv = sv[s * HD + v];
#pragma unroll
                for (int e = 0; e < 8; ++e) acc[e] += wv * sk[s * HD + k0 + e]; }
#pragma unroll
            for (int e = 0; e < 8; ++e) DC[(size_t)un * 4096 + v * HD + k0 + e] = acc[e]; }
          if (F.tid < HD) { float a = 0.f; for (int s = 0; s < LCH; ++s) a += SW[(size_t)bh * SEQ + c * LCH + s] * sk[s * HD + F.tid]; DN[(size_t)un * HD + F.tid] = a; }
      } }
}

__device__ __forceinline__ void p_mix_b(Frame& F) {
    { const float* DC = wsp<float>(F, WS_DC); const float* DN = wsp<float>(F, WS_DN); float* CS = wsp<float>(F, WS_CS); float* NS = wsp<float>(F, WS_NS); const float* DEC = wsp<float>(F, WS_DEC);
      for (int e = F.bid * NTHR + F.tid; e < NBH * (4096 + HD); e += F.G * NTHR) {
          const int bh = e / (4096 + HD), r = e % (4096 + HD);
          float st = 0.f;
          if (r < 4096) { for (int c = 0; c < NCH; ++c) { const size_t o = ((size_t)bh * NCH + c) * 4096 + r; CS[o] = st; st = DEC[bh * NCH + c] * st + DC[o]; } }
          else { const int k = r - 4096; for (int c = 0; c < NCH; ++c) { const size_t o = ((size_t)bh * NCH + c) * HD + k; NS[o] = st; st = DEC[bh * NCH + c] * st + DN[o]; } }
      } }
    const bf16* U = wsp<bf16>(F, WS_U); const bf16* QN = wsp<bf16>(F, WS_QN); const bf16* KN = wsp<bf16>(F, WS_KN);
    const float* OP = wsp<float>(F, WS_OP); const float* LP = wsp<float>(F, WS_LP); bf16* MIX = wsp<bf16>(F, WS_MIX);
    const float m0 = moba_m0(F);
    LAS float* sq = (LAS float*)(F.lds + F.wave * 2048); LAS float* sp = sq + 64;
    const int gw = F.bid * NWAVES + F.wave, NGW = F.G * NWAVES;
    for (int it = gw; it < M * NH; it += NGW) {
        const int mq = it / NH, h = it % NH, b = mq / SEQ, tq = mq % SEQ, i = tq / MBS, qo = tq % MBS;
        const float slope = exp2f(-(float)(h + 1));
        sq[F.lane] = bf2f(QN[(size_t)mq * WM + h * HD + F.lane]);
        LDS_WAIT(); asm volatile("" ::: "memory");
        float l = 0.f;
#pragma unroll
        for (int u4 = 0; u4 < 4; ++u4) { const int kk = F.lane + 64 * u4; float pv = 0.f;
            if (kk <= qo) { const size_t mk = (size_t)b * SEQ + i * MBS + kk; float s = 0.f;
#pragma unroll
                for (int d8 = 0; d8 < 8; ++d8) { const v4u w = *(const v4u*)(KN + mk * WM + h * HD + 8 * d8);
                    s += sq[8 * d8] * bflo(w.x) + sq[8 * d8 + 1] * bfhi(w.x) + sq[8 * d8 + 2] * bflo(w.y) + sq[8 * d8 + 3] * bfhi(w.y)
                       + sq[8 * d8 + 4] * bflo(w.z) + sq[8 * d8 + 5] * bfhi(w.z) + sq[8 * d8 + 6] * bflo(w.w) + sq[8 * d8 + 7] * bfhi(w.w); }
                pv = __expf(s - slope * (float)(qo - kk) - m0); }
            sp[kk] = pv; l += pv; }
        l = wave_sum(l);
        LDS_WAIT(); asm volatile("" ::: "memory");
        float o = 0.f;
        for (int kk = 0; kk <= qo; ++kk) { const size_t mk = (size_t)b * SEQ + i * MBS + kk; o += sp[kk] * bf2f(U[mk * NU + UVB + h * HD + F.lane]); }
        const int nsel = i < 3 ? i : 3;
        for (int sl = 0; sl < nsel; ++sl) { o += OP[(((size_t)mq * NH + h) * 3 + sl) * HD + F.lane]; l += LP[((size_t)mq * NH + h) * 3 + sl]; }
        MIX[(size_t)mq * D + WM + h * HD + F.lane] = (bf16)f2bf(o / l);
        LDS_WAIT(); asm volatile("" ::: "memory");
    }
}

__device__ __forceinline__ void p_mix_c(Frame& F) {
    const bf16* U = wsp<bf16>(F, WS_U); const bf16* QM = wsp<bf16>(F, WS_QM); const bf16* KM = wsp<bf16>(F, WS_KM);
    const float* SA = wsp<float>(F, WS_SA); const float* SMX = wsp<float>(F, WS_SMX); const float* SB = wsp<float>(F, WS_SB);
    const float* CS = wsp<float>(F, WS_CS); const float* NS = wsp<float>(F, WS_NS); const float* MC = wsp<float>(F, WS_MC); bf16* MIX = wsp<bf16>(F, WS_MIX);
    LAS float* sq = (LAS float*)F.lds;
    LAS float* sk = sq + LCH * HD;
    LAS float* ssp = sk + LCH * HD;
    for (int un = F.bid; un < NBH * NCH; un += F.G) {
        const int bh = un / NCH, c = un % NCH, b = bh / NH, h = bh % NH;
        __syncthreads();
        for (int e = F.tid; e < LCH * HD; e += NTHR) { const int s = e >> 6, d = e & 63; const size_t m = (size_t)b * SEQ + c * LCH + s;
            sq[e] = bf2f(QM[m * WM + h * HD + d]); sk[e] = bf2f(KM[m * WM + h * HD + d]); }
        __syncthreads();
        const int t = F.tid >> 2, sub = F.tid & 3; const size_t gt = (size_t)bh * SEQ + c * LCH + t;
        const float mx = SMX[gt];
        for (int s = sub; s <= t; s += 4) { float dt = 0.f;
#pragma unroll 16
            for (int d = 0; d < HD; ++d) dt += sq[t * HD + d] * sk[s * HD + d];
            ssp[t * LCH + s] = dt * __expf(SA[(size_t)bh * SEQ + c * LCH + s] - mx); }
        __syncthreads();
        const float mc = MC[un]; const float sc = __expf(mc - mx);
        const int v0 = sub * 16; float num[16]; float den = 0.f;
#pragma unroll
        for (int e = 0; e < 16; ++e) num[e] = 0.f;
#pragma unroll 1
        for (int s = 0; s <= t; ++s) { const float pw = ssp[t * LCH + s]; den += pw; const size_t m = (size_t)b * SEQ + c * LCH + s;
            const v4u w0 = *(const v4u*)(U + m * NU + UVM + h * HD + v0), w1 = *(const v4u*)(U + m * NU + UVM + h * HD + v0 + 8);
            num[0] += pw * bflo(w0.x); num[1] += pw * bfhi(w0.x); num[2] += pw * bflo(w0.y); num[3] += pw * bfhi(w0.y);
            num[4] += pw * bflo(w0.z); num[5] += pw * bfhi(w0.z); num[6] += pw * bflo(w0.w); num[7] += pw * bfhi(w0.w);
            num[8] += pw * bflo(w1.x); num[9] += pw * bfhi(w1.x); num[10] += pw * bflo(w1.y); num[11] += pw * bfhi(w1.y);
            num[12] += pw * bflo(w1.z); num[13] += pw * bfhi(w1.z); num[14] += pw * bflo(w1.w); num[15] += pw * bfhi(w1.w); }
        float qn = 0.f;
        for (int k = 0; k < HD; ++k) qn += NS[(size_t)un * HD + k] * sq[t * HD + k];
        den += sc * qn;
        { float cq[16];
#pragma unroll
          for (int e = 0; e < 16; ++e) cq[e] = 0.f;
#pragma unroll 1
          for (int k = 0; k < HD; k += 4) { const f32x4 qv = *(const LAS f32x4*)(sq + t * HD + k);
#pragma unroll
              for (int e = 0; e < 16; ++e) { const f32x4 cv = *(const f32x4*)(CS + (size_t)un * 4096 + (v0 + e) * HD + k); cq[e] += (cv.x * qv.x + cv.y * qv.y) + (cv.z * qv.z + cv.w * qv.w); } }
#pragma unroll
          for (int e = 0; e < 16; ++e) num[e] += sc * cq[e]; }
        const float dn = fmaxf(fabsf(den), __expf(-(SB[gt] + mx)));
        float ss = 0.f;
#pragma unroll
        for (int e = 0; e < 16; ++e) { num[e] = num[e] / dn; ss += num[e] * num[e]; }
        ss += __shfl_xor(ss, 1); ss += __shfl_xor(ss, 2);
        const float rstd = 1.0f / sqrtf(ss * (1.0f / HD) + RMS_EPS);
        const size_t m = (size_t)b * SEQ + c * LCH + t; float o[16];
#pragma unroll
        for (int e = 0; e < 16; ++e) { const float og = bf2f(U[m * NU + UOM + h * HD + v0 + e]); o[e] = num[e] * rstd * F.head_g[h * HD + v0 + e] * sigmoidf_(og); }
        v4u w0, w1; w0.x = pk2(o[0], o[1]); w0.y = pk2(o[2], o[3]); w0.z = pk2(o[4], o[5]); w0.w = pk2(o[6], o[7]); w1.x = pk2(o[8], o[9]); w1.y = pk2(o[10], o[11]); w1.z = pk2(o[12], o[13]); w1.w = pk2(o[14], o[15]);
        *(v4u*)(MIX + m * D + h * HD + v0) = w0; *(v4u*)(MIX + m * D + h * HD + v0 + 8) = w1;
    }
}

__device__ __forceinline__ void p_router(Frame& F) {
    const bf16* T1 = wsp<bf16>(F, WS_XN); const bf16* WR = wsp<bf16>(F, WS_WR); const float* SS = wsp<float>(F, WS_SS);
    int* SELE = wsp<int>(F, WS_SELE); float* SELW = wsp<float>(F, WS_SELW); float* RSTD = wsp<float>(F, WS_RSTD); int* HIST = wsp<int>(F, WS_HIST);
    LAS int* sh = (LAS int*)F.lds;
    for (int ch = F.bid; ch < 256; ch += F.G) {
        __syncthreads();
        if (F.tid < NE) sh[F.tid] = 0;
        __syncthreads();
        for (int tt = F.wave; tt < 64; tt += NWAVES) {
            const size_t m = (size_t)ch * 64 + tt;
            float ss = 0.f;
#pragma unroll
            for (int q = 0; q < 16; ++q) ss += SS[m * 16 + q];
            const float rstd = 1.0f / sqrtf(ss * (1.0f / D) + RMS_EPS);
            float tv[16];
            { const v4u w0 = *(const v4u*)(T1 + m * D + 16 * F.lane), w1 = *(const v4u*)(T1 + m * D + 16 * F.lane + 8);
              tv[0] = bflo(w0.x); tv[1] = bfhi(w0.x); tv[2] = bflo(w0.y); tv[3] = bfhi(w0.y); tv[4] = bflo(w0.z); tv[5] = bfhi(w0.z); tv[6] = bflo(w0.w); tv[7] = bfhi(w0.w);
              tv[8] = bflo(w1.x); tv[9] = bfhi(w1.x); tv[10] = bflo(w1.y); tv[11] = bfhi(w1.y); tv[12] = bflo(w1.z); tv[13] = bfhi(w1.z); tv[14] = bflo(w1.w); tv[15] = bfhi(w1.w); }
            float mylogit = 0.f;
            for (int e = 0; e < NE; ++e) { const v4u w0 = *(const v4u*)(WR + (size_t)e * D + 16 * F.lane), w1 = *(const v4u*)(WR + (size_t)e * D + 16 * F.lane + 8);
                float a = tv[0] * bflo(w0.x) + tv[1] * bfhi(w0.x) + tv[2] * bflo(w0.y) + tv[3] * bfhi(w0.y) + tv[4] * bflo(w0.z) + tv[5] * bfhi(w0.z) + tv[6] * bflo(w0.w) + tv[7] * bfhi(w0.w)
                        + tv[8] * bflo(w1.x) + tv[9] * bfhi(w1.x) + tv[10] * bflo(w1.y) + tv[11] * bfhi(w1.y) + tv[12] * bflo(w1.z) + tv[13] * bfhi(w1.z) + tv[14] * bflo(w1.w) + tv[15] * bfhi(w1.w);
                a = wave_sum(a); if (F.lane == e) mylogit = a * rstd + F.b_r[e]; }
            float v = F.lane < NE ? mylogit : -INFINITY; int se[4]; float sv[4];
#pragma unroll
            for (int k = 0; k < 4; ++k) { const float mxv = wave_max(v); const unsigned long long mk = __ballot(v == mxv); const int idx = __ffsll((long long)mk) - 1; se[k] = idx; sv[k] = mxv; if (F.lane == idx) v = -INFINITY; }
            const float e0 = 1.0f, e1 = __expf(sv[1] - sv[0]), e2 = __expf(sv[2] - sv[0]), e3 = __expf(sv[3] - sv[0]); const float inv = 1.0f / (e0 + e1 + e2 + e3);
            if (F.lane == 0) { SELE[m * 4 + 0] = se[0]; SELE[m * 4 + 1] = se[1]; SELE[m * 4 + 2] = se[2]; SELE[m * 4 + 3] = se[3];
                SELW[m * 4 + 0] = e0 * inv; SELW[m * 4 + 1] = e1 * inv; SELW[m * 4 + 2] = e2 * inv; SELW[m * 4 + 3] = e3 * inv; RSTD[m] = rstd;
                atomicAdd((int*)&sh[se[0]], 1); atomicAdd((int*)&sh[se[1]], 1); atomicAdd((int*)&sh[se[2]], 1); atomicAdd((int*)&sh[se[3]], 1); }
        }
        __syncthreads();
        if (F.tid < NE) HIST[ch * NE + F.tid] = sh[F.tid];
    }
}
__device__ __forceinline__ void p_lists(Frame& F) {
    const int* SELE = wsp<int>(F, WS_SELE); const float* SELW = wsp<float>(F, WS_SELW); const float* RSTD = wsp<float>(F, WS_RSTD); const int* HIST = wsp<int>(F, WS_HIST);
    int* POS = wsp<int>(F, WS_POS); int* ROWTOK = wsp<int>(F, WS_ROWTOK); float* ROWGATE = wsp<float>(F, WS_ROWGATE); float* ROWRSTD = wsp<float>(F, WS_ROWRSTD); int* TILEE = wsp<int>(F, WS_TILEE);
    LAS int* stot = (LAS int*)F.lds;
    LAS int* soff = stot + 32;
    LAS int* sbase = soff + 40;
    for (int ch = F.bid; ch < 256; ch += F.G) {
        __syncthreads();
        if (F.tid < NE) { int tot = 0, before = 0; for (int w = 0; w < 256; ++w) { const int hv = HIST[w * NE + F.tid]; if (w < ch) before += hv; tot += hv; } stot[F.tid] = tot; sbase[F.tid] = before; }
        __syncthreads();
        if (F.tid == 0) { int o = 0; for (int e = 0; e < NE; ++e) { soff[e] = o; o += (stot[e] + 255) & ~255; } soff[NE] = o; }
        __syncthreads();
        if (F.wave == 0) {
            const size_t m = (size_t)ch * 64 + F.lane; int se[4]; float sw[4];
#pragma unroll
            for (int k = 0; k < 4; ++k) { se[k] = SELE[m * 4 + k]; sw[k] = SELW[m * 4 + k]; }
            const float rs = RSTD[m]; int pos[4] = {0, 0, 0, 0};
            for (int e = 0; e < NE; ++e) { const unsigned long long mk = __ballot(se[0] == e || se[1] == e || se[2] == e || se[3] == e);
                const int rank = __popcll(mk & ((1ull << F.lane) - 1ull)); const int pp = soff[e] + sbase[e] + rank;
#pragma unroll
                for (int k = 0; k < 4; ++k) if (se[k] == e) pos[k] = pp; }
#pragma unroll
            for (int k = 0; k < 4; ++k) { POS[m * 4 + k] = pos[k]; ROWTOK[pos[k]] = (int)m; ROWGATE[pos[k]] = sw[k]; ROWRSTD[pos[k]] = rs; }
        }
        if (ch < NE) { const int e = ch; for (int r = soff[e] + stot[e] + F.tid; r < soff[e + 1]; r += NTHR) { ROWTOK[r] = 0; ROWGATE[r] = 0.f; ROWRSTD[r] = 0.f; } }
        if (ch == 0) { const int nt = soff[NE] >> 8; for (int t = F.tid; t < nt; t += NTHR) { int e = 0; while (soff[e + 1] <= t * 256) ++e; TILEE[t] = e; } if (F.tid == 0) TILEE[MAXTILES] = nt; }
    }
}
__device__ __forceinline__ void p_combine(Frame& F) {
    const float* X1 = wsp<float>(F, WS_X1); const bf16* YS = wsp<bf16>(F, WS_YS); const int* POS = wsp<int>(F, WS_POS); bf16* XN = wsp<bf16>(F, WS_XN);
    const int gw = F.bid * NWAVES + F.wave, NGW = F.G * NWAVES, lane = F.lane;
    for (int m = gw; m < M; m += NGW) {
        f32x4 v[4]; float s = 0.f; int ps[4];
#pragma unroll
        for (int k = 0; k < 4; ++k) ps[k] = POS[(size_t)m * 4 + k];
#pragma unroll
        for (int j = 0; j < 4; ++j) { v[j] = *((const f32x4*)(X1 + (size_t)m * D) + lane + 64 * j);
#pragma unroll
            for (int k = 0; k < 4; ++k) { const v2u w = *(const v2u*)(YS + (size_t)ps[k] * D + 256 * j + 4 * lane); v[j].x += bflo(w.x); v[j].y += bfhi(w.x); v[j].z += bflo(w.y); v[j].w += bfhi(w.y); }
            s += (v[j].x * v[j].x + v[j].y * v[j].y) + (v[j].z * v[j].z + v[j].w * v[j].w);
            *((f32x4*)(F.out + (size_t)m * D) + lane + 64 * j) = v[j]; }
        const float rstd = 1.0f / sqrtf(wave_sum(s) * (1.0f / D) + RMS_EPS);
#pragma unroll
        for (int j = 0; j < 4; ++j) { const f32x4 g = *((const f32x4*)F.ple_g + lane + 64 * j); const f32x4 o = v[j] * rstd * g;
            *(v2u*)(XN + (size_t)m * D + 256 * j + 4 * lane) = (v2u){pk2(o.x, o.y), pk2(o.z, o.w)}; }
    }
}

enum { PH_PRO = 0, PH_INPROJ, PH_PREP, PH_ROUTE, PH_MIXA, PH_MIXB, PH_MIXC, PH_OUTPROJ, PH_ROUTER, PH_LISTS, PH_GU, PH_DN, PH_COMB, PH_PLE, NPH };

__global__ void __launch_bounds__(NTHR, 2) fwd(Args args) {
    extern __shared__ __attribute__((aligned(16))) unsigned char lds[];
    Frame F;
    F.lds = (LAS unsigned char*)lds; F.MISC = (volatile LAS unsigned*)(F.lds + MISC_OFF);
    F.tid = threadIdx.x; F.lane = F.tid & 63; F.wave = __builtin_amdgcn_readfirstlane(F.tid >> 6); F.G = gridDim.x; F.bid = blockIdx.x;
    F.ws = args.ws; F.ctl = (gu32*)(args.ws + WS_CTL); F.out = args.out;
    F.x = args.in[0]; F.p = args.in[1]; F.mix_g = args.in[2]; F.w_in = args.in[3]; F.conv_w = args.in[4]; F.conv_b = args.in[5]; F.ig_b = args.in[6]; F.fg_b = args.in[7];
    F.head_g = args.in[8]; F.qn_g = args.in[9]; F.kn_g = args.in[10]; F.w_out = args.in[11]; F.ffn_g = args.in[12]; F.w_r = args.in[13]; F.b_r = args.in[14];
    F.w_gu = args.in[15]; F.b_gu = args.in[16]; F.w_dn = args.in[17]; F.b_dn = args.in[18]; F.ple_g = args.in[19]; F.w_pg = args.in[20]; F.w_pp = args.in[21];
    for (int u = F.tid; u < (LDS_BYTES - RING_BYTES) / 4; u += NTHR) ((LAS unsigned*)(F.lds + RING_BYTES))[u] = 0u;
    __syncthreads();
    XcdBarrier bar; bar.bar = (unsigned*)(F.ctl + CW_BAR); bar.x = 0; bar.st = nullptr;
    if (!MK_PER_PHASE) bar = xcd_barrier_post((unsigned*)(F.ctl + CW_BAR), F.MISC + 8);
    const int lo = args.ph_lo, hi = args.ph_hi;
#ifdef ONLY
#define IN(k) ((k) == ONLY)
#else
#define IN(k) (lo <= (k) && (k) < hi)
#endif
#define SEAM(k) do { if (IN(k) && IN((k) + 1)) xcd_barrier(bar); } while (0)

    if (IN(PH_PRO)) { p0_prologue(F); } SEAM(PH_PRO);
    if (IN(PH_INPROJ)) { StaticOrder S{M / 256, NU / 256, F.G, F.bid}; EpiStoreBf16 E{wsp<bf16>(F, WS_U), NU};
        sgemm_phase(F, wsp<bf16>(F, WS_XN), nullptr, D, wsp<bf16>(F, WS_WIN), D, S, E); } SEAM(PH_INPROJ);
    if (IN(PH_PREP)) { p_prep(F); } SEAM(PH_PREP);
    if (IN(PH_ROUTE)) { p_route(F); } SEAM(PH_ROUTE);
    if (IN(PH_MIXA)) { p_mix_a(F); } SEAM(PH_MIXA);
    if (IN(PH_MIXB)) { p_mix_b(F); } SEAM(PH_MIXB);
    if (IN(PH_MIXC)) { p_mix_c(F); } SEAM(PH_MIXC);
    if (IN(PH_OUTPROJ)) { StaticOrder S{M / 256, D / 256, F.G, F.bid}; EpiOutProj E{F.x, F.ffn_g, wsp<float>(F, WS_X1), wsp<bf16>(F, WS_XN), wsp<float>(F, WS_SS)};
        sgemm_phase(F, wsp<bf16>(F, WS_MIX), nullptr, D, wsp<bf16>(F, WS_WOUT), D, S, E); } SEAM(PH_OUTPROJ);
    if (IN(PH_ROUTER)) { p_router(F); } SEAM(PH_ROUTER);
    if (IN(PH_LISTS)) { p_lists(F); } SEAM(PH_LISTS);
    if (IN(PH_GU)) { GroupedOrder S{wsp<int>(F, WS_TILEE), 8, F.G, F.bid}; EpiGateUp E{wsp<int>(F, WS_TILEE), wsp<float>(F, WS_ROWRSTD), F.b_gu, wsp<bf16>(F, WS_ACT)};
        sgemm_phase(F, wsp<bf16>(F, WS_XN), wsp<int>(F, WS_ROWTOK), D, wsp<bf16>(F, WS_WGU), D, S, E); } SEAM(PH_GU);
    if (IN(PH_DN)) { GroupedOrder S{wsp<int>(F, WS_TILEE), 4, F.G, F.bid}; EpiDown E{wsp<float>(F, WS_ROWGATE), F.b_dn, wsp<bf16>(F, WS_YS)};
        sgemm_phase(F, wsp<bf16>(F, WS_ACT), nullptr, FF, wsp<bf16>(F, WS_WDN), FF, S, E); } SEAM(PH_DN);
    if (IN(PH_COMB)) { p_combine(F); } SEAM(PH_COMB);
    if (IN(PH_PLE)) { StaticOrder S{M / 256, D / 256, F.G, F.bid};
        { EpiStoreBf16 E{wsp<bf16>(F, WS_MIX), D}; sgemm_phase(F, wsp<bf16>(F, WS_PB), nullptr, PLE, wsp<bf16>(F, WS_WPP), PLE, S, E); }
        { EpiPle E{wsp<bf16>(F, WS_MIX), F.out}; sgemm_phase(F, wsp<bf16>(F, WS_XN), nullptr, D, wsp<bf16>(F, WS_WPG), D, S, E); } }
#undef IN
#undef SEAM
}

extern "C" void kernel_launch(void* const* d_in, const int* in_sizes, int n_in, void* d_out, int out_size, void* d_ws, size_t ws_size, hipStream_t stream) {
    static int grid = 0;
    if (grid == 0) {
        if (n_in != 22 || out_size != M * D || ws_size < WS_END) { fprintf(stderr, "kernel_launch: unexpected problem (n_in %d, out %d, ws %zu); nothing launched\n", n_in, out_size, ws_size); grid = -1; return; }
        int dev = 0, cus = 0, per_cu = 0;
        if (hipGetDevice(&dev) != hipSuccess || hipDeviceGetAttribute(&cus, hipDeviceAttributeMultiprocessorCount, dev) != hipSuccess) { grid = -1; return; }
        if (hipFuncSetAttribute((const void*)fwd, hipFuncAttributeMaxDynamicSharedMemorySize, LDS_BYTES) != hipSuccess) { fprintf(stderr, "kernel_launch: hipFuncSetAttribute failed\n"); grid = -1; return; }
        if (hipOccupancyMaxActiveBlocksPerMultiprocessor(&per_cu, (const void*)fwd, NTHR, LDS_BYTES) != hipSuccess || per_cu < 1) fprintf(stderr, "kernel_launch: occupancy query says %d\n", per_cu);
        (void)hipGetLastError();
        grid = cus;
    }
    if (grid < 0) return;
    if (hipMemsetAsync((char*)d_ws + WS_CTL, 0, CTL_ZERO_BYTES, stream) != hipSuccess) return;
    Args a{};
    for (int i = 0; i < 22; ++i) a.in[i] = (const float*)d_in[i];
    a.out = (float*)d_out; a.ws = (unsigned char*)d_ws; a.li = 0; a.pad = 0;
#if MK_PER_PHASE
    for (int ph = 0; ph < NPH; ++ph) { a.ph_lo = ph; a.ph_hi = ph + 1; hipLaunchKernelGGL(fwd, dim3(grid), dim3(NTHR), LDS_BYTES, stream, a); }
#else
    a.ph_lo = 0; a.ph_hi = NPH; hipLaunchKernelGGL(fwd, dim3(grid), dim3(NTHR), LDS_BYTES, stream, a);
#endif
}
```

```cpp
#include <hip/hip_runtime.h>
#include <cstdio>
#include <cstdint>

#ifndef MK_PER_PHASE
#define MK_PER_PHASE 0
#endif

#define GAS __attribute__((address_space(1)))
#define LAS __attribute__((address_space(3)))
typedef unsigned short bf16;
typedef unsigned v4u __attribute__((ext_vector_type(4)));
typedef unsigned v2u __attribute__((ext_vector_type(2)));
typedef float f32x4 __attribute__((ext_vector_type(4)));
typedef short bf16x8 __attribute__((ext_vector_type(8)));
typedef GAS unsigned gu32;
#define RLX_AGENT __ATOMIC_RELAXED, __HIP_MEMORY_SCOPE_AGENT
#define LDS_WAIT() asm volatile("s_waitcnt lgkmcnt(0)" ::: "memory")
#define VM_WAIT() asm volatile("s_waitcnt vmcnt(0)" ::: "memory")

constexpr int BATCH = 2, SEQ = 8192, D = 1024, M = BATCH * SEQ;
constexpr int PROJ = 3600, NU = 3584;
constexpr int HD = 64, NH = 8, WM = 512;
constexpr int LCH = 128, NCH = SEQ / LCH;
constexpr int MBS = 256, NBK = SEQ / MBS;
constexpr int NPAIR = NBK * (NBK - 1) / 2;
constexpr int NE = 32, TOPK = 4, FF = 1024, PLE = 256;
constexpr int MAXROWS = M * TOPK + NE * 256, MAXTILES = MAXROWS / 256;
constexpr float RMS_EPS = 1e-6f;
constexpr float SW_LIMIT = 7.0f, SW_ALPHA = 1.702f;
constexpr int UQM = 0, UKM = 512, UVM = 1024, UOM = 1536, UQB = 2048, UKB = 2560, UVB = 3072;
constexpr int NBH = BATCH * NH;

constexpr size_t MiB = 1u << 20;
constexpr size_t WS_CTL = 0, CTL_ZERO_BYTES = 1 * MiB;
constexpr size_t WS_WIN = 2 * MiB;
constexpr size_t WS_WOUT = 10 * MiB;
constexpr size_t WS_WPG = 12 * MiB;
constexpr size_t WS_WPP = 14 * MiB;
constexpr size_t WS_WR = 15 * MiB;
constexpr size_t WS_WGU = 16 * MiB;
constexpr size_t WS_WDN = 144 * MiB;
constexpr size_t WS_XN = 208 * MiB;
constexpr size_t WS_PB = 240 * MiB;
constexpr size_t WS_GATES = 248 * MiB;
constexpr size_t WS_SA = 249 * MiB;
constexpr size_t WS_SMX = WS_SA + 512 * 1024;
constexpr size_t WS_SB = WS_SMX + 512 * 1024;
constexpr size_t WS_SW = WS_SB + 512 * 1024;
constexpr size_t WS_SMALL = 251 * MiB;
constexpr size_t WS_DEC = WS_SMALL;
constexpr size_t WS_MC = WS_DEC + 4096;
constexpr size_t WS_KMEAN = WS_MC + 4096;
constexpr size_t WS_MCNT = WS_KMEAN + 131072;
constexpr size_t WS_SELE = 252 * MiB;
constexpr size_t WS_SELW = WS_SELE + 262144;
constexpr size_t WS_RSTD = WS_SELW + 262144;
constexpr size_t WS_HIST = WS_RSTD + 65536;
constexpr size_t WS_POS = WS_HIST + 32768;
constexpr size_t WS_ROWTOK = WS_POS + 262144;
constexpr size_t WS_ROWGATE = WS_ROWTOK + 294912;
constexpr size_t WS_ROWRSTD = WS_ROWGATE + 294912;
constexpr size_t WS_TILEE = WS_ROWRSTD + 294912;
constexpr size_t WS_SS = 254 * MiB;
constexpr size_t WS_DN = 255 * MiB;
constexpr size_t WS_NS = WS_DN + 262144;
constexpr size_t WS_U = 260 * MiB;
constexpr size_t WS_QM = 372 * MiB;
constexpr size_t WS_KM = 388 * MiB;
constexpr size_t WS_QN = 404 * MiB;
constexpr size_t WS_KN = 420 * MiB;
constexpr size_t WS_VT = 436 * MiB;
constexpr size_t WS_MIX = 452 * MiB;
constexpr size_t WS_X1 = 484 * MiB;
constexpr size_t WS_MLIST = 548 * MiB;
constexpr size_t WS_OP = 556 * MiB;
constexpr size_t WS_LP = 652 * MiB;
constexpr size_t WS_DC = 654 * MiB;
constexpr size_t WS_CS = 670 * MiB;
constexpr size_t WS_ACT = 688 * MiB;
constexpr size_t WS_YS = 260 * MiB;
constexpr size_t WS_END = 832 * MiB;
static_assert(WS_ACT + (size_t)MAXROWS * 1024 * 2 <= WS_END && WS_YS + (size_t)MAXROWS * 1024 * 2 <= WS_QN, "ws map");
constexpr int CW_BAR = 4096;

constexpr int RING_BYTES = 131072;
constexpr int MISC_OFF = RING_BYTES + 320;
constexpr int LDS_BYTES = 147456;
constexpr int NWAVES = 8, NTHR = 512;

__device__ __forceinline__ unsigned f2bf(float f) { unsigned u = __builtin_bit_cast(unsigned, f); return (u + 0x7fffu + ((u >> 16) & 1u)) >> 16; }
__device__ __forceinline__ unsigned pk2(float lo, float hi) { return f2bf(lo) | (f2bf(hi) << 16); }
__device__ __forceinline__ float bf2f(unsigned short b) { return __builtin_bit_cast(float, (unsigned)b << 16); }
__device__ __forceinline__ float bflo(unsigned w) { return __builtin_bit_cast(float, w << 16); }
__device__ __forceinline__ float bfhi(unsigned w) { return __builtin_bit_cast(float, w & 0xffff0000u); }
__device__ __forceinline__ float sigmoidf_(float x) { return 1.0f / (1.0f + __expf(-x)); }

#define XB_TMO      128
#define XB_XCNT(j)  (256  + 64 * (j))
#define XB_XSUB(j)  (1280 + 64 * (j))
#define XB_XGEN(j)  (2304 + 64 * (j))
#define XB_TOP      3328
#define XB_TOPGEN   3392
#define XCD_BAR_WORDS 3456
#define XB_SPIN_CAP (1u << 18)
__device__ __forceinline__ unsigned xb_ld(unsigned* p)              { return __hip_atomic_load(p, __ATOMIC_RELAXED, __HIP_MEMORY_SCOPE_AGENT); }
__device__ __forceinline__ unsigned xb_add(unsigned* p, unsigned v) { return __hip_atomic_fetch_add(p, v, __ATOMIC_RELAXED, __HIP_MEMORY_SCOPE_AGENT); }
__device__ __forceinline__ unsigned xb_xcc_id() { return (unsigned)__builtin_amdgcn_s_getreg((3 << 11) | 20) & 0xFu; }
#define XB_SPIN(cond, bar) do { unsigned _sp = 0; while (cond) { __builtin_amdgcn_s_sleep(1); \
    if ((++_sp & 255u) == 0u) { if (xb_ld(&(bar)[XB_TMO])) break; if (_sp > XB_SPIN_CAP) { atomicAdd(&(bar)[XB_TMO], 1u); break; } } } } while (0)
struct XcdBarrier { unsigned* bar; unsigned x; volatile LAS unsigned* st; };
__device__ __forceinline__ XcdBarrier xcd_barrier_post(unsigned* bar, volatile LAS unsigned* st) {
    XcdBarrier b; b.bar = bar; b.x = xb_xcc_id(); b.st = st;
    if (threadIdx.x == 0) (void)xb_add(&bar[XB_XCNT(b.x)], 1u);
    return b;
}
__device__ __forceinline__ void xcd_barrier_complete(unsigned* bar, unsigned x, unsigned& nloc, unsigned& nx) {
    const unsigned G = gridDim.x * gridDim.y * gridDim.z;
    unsigned sum, cnt, mine, sp = 0u;
    for (;;) {
        sum = 0u; cnt = 0u; mine = 0u;
#pragma unroll
        for (unsigned j = 0; j < 16; ++j) { const unsigned c = xb_ld(&bar[XB_XCNT(j)]); sum += c; cnt += (c > 0u) ? 1u : 0u; mine = (j == x) ? c : mine; }
        if (sum == G) break;
        __builtin_amdgcn_s_sleep(1);
        if ((++sp & 255u) == 0u) { if (xb_ld(&bar[XB_TMO])) break; if (sp > XB_SPIN_CAP) { atomicAdd(&bar[XB_TMO], 1u); break; } }
    }
    nloc = mine > 0u ? mine : 1u; nx = cnt > 0u ? cnt : 1u;
}
__device__ __forceinline__ void xcd_barrier(const XcdBarrier& b) {
    asm volatile("s_waitcnt vmcnt(0)" ::: "memory");
    __syncthreads();
    if (threadIdx.x == 0) {
        unsigned* bar = b.bar;
        __builtin_amdgcn_s_waitcnt(0);
        unsigned nloc = b.st[0], nx = b.st[1];
        if (nloc == 0u) { xcd_barrier_complete(bar, b.x, nloc, nx); b.st[0] = nloc; b.st[1] = nx; }
        const unsigned old = xb_add(&bar[XB_XSUB(b.x)], 1u);
        const unsigned gen = old / nloc;
        if (old + 1u == (gen + 1u) * nloc) {
            __builtin_amdgcn_fence(__ATOMIC_RELEASE, "agent");
            asm volatile("s_waitcnt vmcnt(0)" ::: "memory");
            const unsigned og = xb_add(&bar[XB_TOP], 1u);
            const unsigned tg = og / nx;
            if (og + 1u == (tg + 1u) * nx) xb_add(&bar[XB_TOPGEN], 1u);
            else XB_SPIN(xb_ld(&bar[XB_TOPGEN]) == tg, bar);
            __builtin_amdgcn_fence(__ATOMIC_ACQUIRE, "agent");
            xb_add(&bar[XB_XGEN(b.x)], 1u);
            asm volatile("s_waitcnt vmcnt(0)" ::: "memory");
        } else {
            XB_SPIN(xb_ld(&bar[XB_XGEN(b.x)]) == gen, bar);
            __builtin_amdgcn_fence(__ATOMIC_ACQUIRE, "agent");
            asm volatile("s_waitcnt vmcnt(0)" ::: "memory");
        }
    }
    __syncthreads();
}

struct Args { const float* in[22]; float* out; unsigned char* ws; int ph_lo, ph_hi, li, pad; };
struct Frame {
    LAS unsigned char* lds; volatile LAS unsigned* MISC; gu32* ctl;
    int tid, lane, wave, G, bid;
    const float *x, *p, *mix_g, *w_in, *conv_w, *conv_b, *ig_b, *fg_b, *head_g, *qn_g, *kn_g, *w_out, *ffn_g, *w_r, *b_r, *w_gu, *b_gu, *w_dn, *b_dn, *ple_g, *w_pg, *w_pp;
    float* out; unsigned char* ws;
};
template <class T> __device__ __forceinline__ T* wsp(const Frame& F, size_t off) { return (T*)(F.ws + off); }

__device__ __forceinline__ float wave_sum(float v) {
#pragma unroll
    for (int o = 1; o < 64; o <<= 1) v += __shfl_xor(v, o);
    return v;
}
__device__ __forceinline__ float wave_max(float v) {
#pragma unroll
    for (int o = 1; o < 64; o <<= 1) v = fmaxf(v, __shfl_xor(v, o));
    return v;
}

struct Unit { int pm, pn; };
struct StaticOrder {
    int nM, nN, G, c;
    __device__ __forceinline__ bool next(int i, Unit& u) const {
        const int L = i * G + c; if (L >= nM * nN) return false;
        const int grp = L / (8 * nN), r = L % (8 * nN); u.pm = grp * 8 + (r & 7); u.pn = r >> 3; return true;
    }
};
struct GroupedOrder {
    const int* tile_e; int NT, G, c;
    __device__ __forceinline__ bool next(int i, Unit& u) const {
        const int ntile = tile_e[MAXTILES]; const int L = i * G + c; if (L >= ntile * NT) return false;
        const int t = L / NT, n = L % NT; u.pm = t; u.pn = tile_e[t] * NT + n; return true;
    }
};
__device__ __forceinline__ int perm32(int rho) { const int n = rho >> 4, i = rho & 15; return 8 * (i >> 2) + 4 * n + (i & 3); }

template <class Sched, class Epi>
__device__ __forceinline__ void sgemm_phase(const Frame& F, const bf16* A, const int* arow, int lda, const bf16* Bt, int K, const Sched& S, const Epi& E) {
    const int wid = F.wave, lane = F.lane, wr = wid >> 2, wc = wid & 3, fr = lane & 15, fq = lane >> 4;
    Unit u;
    for (int i = 0; S.next(i, u); ++i) {
        for (int ai = 0; ai < 2; ++ai) {
            f32x4 acc[2][4][2];
#pragma unroll
            for (int bj = 0; bj < 2; ++bj)
#pragma unroll
                for (int m = 0; m < 4; ++m)
#pragma unroll
                    for (int n = 0; n < 2; ++n) acc[bj][m][n] = (f32x4){0.f, 0.f, 0.f, 0.f};
            const bf16* ap[4]; const bf16* bp[2][2];
#pragma unroll
            for (int m = 0; m < 4; ++m) { const int r = u.pm * 256 + ai * 128 + wr * 64 + m * 16 + fr; const int src = arow ? arow[r] : r; ap[m] = A + (size_t)src * lda + fq * 8; }
#pragma unroll
            for (int bj = 0; bj < 2; ++bj)
#pragma unroll
                for (int n = 0; n < 2; ++n) bp[bj][n] = Bt + (size_t)(u.pn * 256 + bj * 128 + wc * 32 + perm32(16 * n + fr)) * K + fq * 8;
            for (int k = 0; k < K; k += 32) {
                bf16x8 af[4], bfr[2][2];
#pragma unroll
                for (int m = 0; m < 4; ++m) af[m] = *(const bf16x8*)(ap[m] + k);
#pragma unroll
                for (int bj = 0; bj < 2; ++bj)
#pragma unroll
                    for (int n = 0; n < 2; ++n) bfr[bj][n] = *(const bf16x8*)(bp[bj][n] + k);
#pragma unroll
                for (int bj = 0; bj < 2; ++bj)
#pragma unroll
                    for (int m = 0; m < 4; ++m)
#pragma unroll
                        for (int n = 0; n < 2; ++n) acc[bj][m][n] = __builtin_amdgcn_mfma_f32_16x16x32_bf16(bfr[bj][n], af[m], acc[bj][m][n], 0, 0, 0);
            }
#pragma unroll
            for (int m = 0; m < 4; ++m) {
                float lo[8], hi[8];
#pragma unroll
                for (int j = 0; j < 4; ++j) { lo[j] = acc[0][m][0][j]; lo[4 + j] = acc[0][m][1][j]; hi[j] = acc[1][m][0][j]; hi[4 + j] = acc[1][m][1][j]; }
                E(u, ai * 128 + wr * 64 + m * 16 + fr, wc * 32 + fq * 8, lo, hi);
            }
        }
    }
}
__device__ __forceinline__ void store8bf(bf16* p, const float (&v)[8]) { v4u w; w.x = pk2(v[0], v[1]); w.y = pk2(v[2], v[3]); w.z = pk2(v[4], v[5]); w.w = pk2(v[6], v[7]); *(v4u*)p = w; }

struct EpiStoreBf16 { bf16* O; int ldc;
    __device__ __forceinline__ void operator()(const Unit& u, int r, int c, const float (&lo)[8], const float (&hi)[8]) const {
        bf16* o = O + (size_t)(u.pm * 256 + r) * ldc + u.pn * 256 + c; store8bf(o, lo); store8bf(o + 128, hi); } };
struct EpiOutProj { const float* x; const float* g; float* X1; bf16* T1; float* SS;
    __device__ __forceinline__ void operator()(const Unit& u, int r, int c, const float (&lo)[8], const float (&hi)[8]) const {
        const size_t row = (size_t)u.pm * 256 + r; const int col = u.pn * 256 + c; float ss = 0.f;
#pragma unroll
        for (int h = 0; h < 2; ++h) { const float* v = h ? hi : lo; const int cc = col + h * 128; float o[8], t[8];
#pragma unroll
            for (int j = 0; j < 8; ++j) { o[j] = x[row * D + cc + j] + v[j]; ss += o[j] * o[j]; t[j] = o[j] * g[cc + j]; }
            *(f32x4*)(X1 + row * D + cc) = (f32x4){o[0], o[1], o[2], o[3]}; *(f32x4*)(X1 + row * D + cc + 4) = (f32x4){o[4], o[5], o[6], o[7]};
            store8bf(T1 + row * D + cc, t); }
        ss += __shfl_xor(ss, 16); ss += __shfl_xor(ss, 32);
        if ((threadIdx.x & 63) < 16) SS[row * 16 + u.pn * 4 + (c >> 5)] = ss; } };
struct EpiGateUp { const int* tile_e; const float* rowrstd; const float* b_gu; bf16* ACT;
    __device__ __forceinline__ void operator()(const Unit& u, int r, int c, const float (&lo)[8], const float (&hi)[8]) const {
        const int e = u.pn >> 3, nt = u.pn & 7; const size_t row = (size_t)u.pm * 256 + r; const float rs = rowrstd[row];
        const float* bg = b_gu + (size_t)e * 2048 + nt * 128 + c; float a[8];
#pragma unroll
        for (int j = 0; j < 8; ++j) { float glu = lo[j] * rs + bg[j], lin = hi[j] * rs + bg[1024 + j];
            glu = fminf(glu, SW_LIMIT); lin = fminf(fmaxf(lin, -SW_LIMIT), SW_LIMIT);
            a[j] = glu * sigmoidf_(SW_ALPHA * glu) * (lin + 1.0f); }
        store8bf(ACT + row * FF + nt * 128 + c, a); } };
struct EpiDown { const float* rowgate; const float* b_dn; bf16* YS;
    __device__ __forceinline__ void operator()(const Unit& u, int r, int c, const float (&lo)[8], const float (&hi)[8]) const {
        const int e = u.pn >> 2, nt = u.pn & 3; const size_t row = (size_t)u.pm * 256 + r; const float gt = rowgate[row];
        const float* bd = b_dn + (size_t)e * 1024 + nt * 256 + c; float a[8], b[8];
#pragma unroll
        for (int j = 0; j < 8; ++j) { a[j] = (lo[j] + bd[j]) * gt; b[j] = (hi[j] + bd[128 + j]) * gt; }
        bf16* o = YS + row * D + nt * 256 + c; store8bf(o, a); store8bf(o + 128, b); } };
struct EpiPle { const bf16* PE; float* out;
    __device__ __forceinline__ void operator()(const Unit& u, int r, int c, const float (&lo)[8], const float (&hi)[8]) const {
        const size_t row = (size_t)u.pm * 256 + r; const int col = u.pn * 256 + c;
#pragma unroll
        for (int h = 0; h < 2; ++h) { const float* v = h ? hi : lo; const int cc = col + h * 128; const v4u pe = *(const v4u*)(PE + row * D + cc);
            f32x4 x0 = *(const f32x4*)(out + row * D + cc), x1 = *(const f32x4*)(out + row * D + cc + 4);
            x0[0] += sigmoidf_(v[0]) * bflo(pe.x); x0[1] += sigmoidf_(v[1]) * bfhi(pe.x); x0[2] += sigmoidf_(v[2]) * bflo(pe.y); x0[3] += sigmoidf_(v[3]) * bfhi(pe.y);
            x1[0] += sigmoidf_(v[4]) * bflo(pe.z); x1[1] += sigmoidf_(v[5]) * bfhi(pe.z); x1[2] += sigmoidf_(v[6]) * bflo(pe.w); x1[3] += sigmoidf_(v[7]) * bfhi(pe.w);
            *(f32x4*)(out + row * D + cc) = x0; *(f32x4*)(out + row * D + cc + 4) = x1; } } };

__device__ __forceinline__ void transpose_tile(const float* src, int ldw, bf16* dst, int K, LAS float* scr, int lane) {
#pragma unroll 8
    for (int i = 0; i < 32; ++i) { const int kk = 2 * i + (lane >> 5); scr[kk * 33 + (lane & 31)] = src[(size_t)kk * ldw + (lane & 31)]; }
    LDS_WAIT(); asm volatile("" ::: "memory");
    const int c = lane & 7;
#pragma unroll
    for (int j = 0; j < 4; ++j) { const int n = (lane >> 3) + 8 * j; const LAS float* s = scr + (8 * c) * 33 + n;
        v4u o; o.x = pk2(s[0 * 33], s[1 * 33]); o.y = pk2(s[2 * 33], s[3 * 33]); o.z = pk2(s[4 * 33], s[5 * 33]); o.w = pk2(s[6 * 33], s[7 * 33]);
        *(v4u*)(dst + (size_t)n * K + 8 * c) = o; }
    LDS_WAIT(); asm volatile("" ::: "memory");
}
__device__ __forceinline__ void p0_prologue(Frame& F) {
    LAS float* scr = (LAS float*)(F.lds + F.wave * 16384);
    const int gw = F.bid * NWAVES + F.wave, NGW = F.G * NWAVES, lane = F.lane;
    constexpr int I_IN = 16 * (NU / 32), I_SQ = 16 * 32, I_PP = 4 * 32, I_R = 16, I_GU = 16 * 64, I_DN = 16 * 32;
    constexpr int NITEMS = I_IN + 2 * I_SQ + I_PP + I_R + NE * I_GU + NE * I_DN;
    for (int it = gw; it < NITEMS; it += NGW) {
        int r = it;
        if (r < I_IN) { const int kb = r / (NU / 32), nb = r % (NU / 32), n0 = 32 * nb, sc = n0 < 2048 ? n0 : n0 + 16;
            transpose_tile(F.w_in + (size_t)(64 * kb) * PROJ + sc, PROJ, wsp<bf16>(F, WS_WIN) + (size_t)n0 * D + 64 * kb, D, scr, lane); continue; } r -= I_IN;
        if (r < I_SQ) { const int kb = r / 32, n0 = 32 * (r % 32); transpose_tile(F.w_out + (size_t)(64 * kb) * D + n0, D, wsp<bf16>(F, WS_WOUT) + (size_t)n0 * D + 64 * kb, D, scr, lane); continue; } r -= I_SQ;
        if (r < I_SQ) { const int kb = r / 32, n0 = 32 * (r % 32); transpose_tile(F.w_pg + (size_t)(64 * kb) * D + n0, D, wsp<bf16>(F, WS_WPG) + (size_t)n0 * D + 64 * kb, D, scr, lane); continue; } r -= I_SQ;
        if (r < I_PP) { const int kb = r / 32, n0 = 32 * (r % 32); transpose_tile(F.w_pp + (size_t)(64 * kb) * D + n0, D, wsp<bf16>(F, WS_WPP) + (size_t)n0 * PLE + 64 * kb, PLE, scr, lane); continue; } r -= I_PP;
        if (r < I_R) { const int kb = r; transpose_tile(F.w_r + (size_t)(64 * kb) * NE, NE, wsp<bf16>(F, WS_WR) + 64 * kb, D, scr, lane); continue; } r -= I_R;
        if (r < NE * I_GU) { const int e = r / I_GU, q = r % I_GU, kb = q / 64, n0 = 32 * (q % 64), pn = n0 >> 8, c = n0 & 255;
            const int sc = c < 128 ? pn * 128 + c : 1024 + pn * 128 + (c - 128);
            transpose_tile(F.w_gu + ((size_t)e * D + 64 * kb) * 2048 + sc, 2048, wsp<bf16>(F, WS_WGU) + ((size_t)e * 2048 + n0) * D + 64 * kb, D, scr, lane); continue; } r -= NE * I_GU;
        { const int e = r / I_DN, q = r % I_DN, kb = q / 32, n0 = 32 * (q % 32);
            transpose_tile(F.w_dn + ((size_t)e * FF + 64 * kb) * D + n0, D, wsp<bf16>(F, WS_WDN) + ((size_t)e * D + n0) * FF + 64 * kb, FF, scr, lane); }
    }
    bf16* XN = wsp<bf16>(F, WS_XN); float* GT = wsp<float>(F, WS_GATES);
    for (int m = gw; m < M; m += NGW) {
        const f32x4* xr = (const f32x4*)(F.x + (size_t)m * D) + lane; const f32x4* gr = (const f32x4*)F.mix_g + lane;
        f32x4 v[4]; float s = 0.f;
#pragma unroll
        for (int j = 0; j < 4; ++j) { v[j] = xr[64 * j]; s += (v[j].x * v[j].x + v[j].y * v[j].y) + (v[j].z * v[j].z + v[j].w * v[j].w); }
        const float rstd = 1.0f / sqrtf(wave_sum(s) * (1.0f / D) + RMS_EPS);
        float ga[16];
#pragma unroll
        for (int c = 0; c < 16; ++c) ga[c] = 0.f;
#pragma unroll
        for (int j = 0; j < 4; ++j) { const f32x4 g = gr[64 * j]; v[j] = v[j] * rstd * g;
            *(v2u*)(XN + (size_t)m * D + 256 * j + 4 * lane) = (v2u){pk2(v[j].x, v[j].y), pk2(v[j].z, v[j].w)};
#pragma unroll
            for (int e = 0; e < 4; ++e) { const int k = 256 * j + 4 * lane + e; const f32x4* wg = (const f32x4*)(F.w_in + (size_t)k * PROJ + 2048);
#pragma unroll
                for (int q = 0; q < 4; ++q) { const f32x4 w = wg[q]; ga[4 * q + 0] += v[j][e] * w.x; ga[4 * q + 1] += v[j][e] * w.y; ga[4 * q + 2] += v[j][e] * w.z; ga[4 * q + 3] += v[j][e] * w.w; } } }
#pragma unroll
        for (int c = 0; c < 16; ++c) ga[c] = wave_sum(ga[c]);
        if (lane < 16) { float val = 0.f;
#pragma unroll
            for (int c = 0; c < 16; ++c) val = (lane == c) ? ga[c] : val;
            GT[(size_t)m * 16 + lane] = val + (lane < 8 ? F.ig_b[lane] : F.fg_b[lane - 8]); }
    }
    bf16* PB = wsp<bf16>(F, WS_PB);
    for (size_t i = (size_t)F.bid * NTHR + F.tid; i < (size_t)M * PLE / 4; i += (size_t)F.G * NTHR) { const f32x4 v = ((const f32x4*)F.p)[i]; *(v2u*)(PB + 4 * i) = (v2u){pk2(v.x, v.y), pk2(v.z, v.w)}; }
}

__device__ __forceinline__ float logsigmoidf_(float f) { return f >= 0.f ? -log1pf(__expf(-f)) : f - log1pf(__expf(f)); }
__device__ __forceinline__ void p_prep(Frame& F) {
    const bf16* U = wsp<bf16>(F, WS_U);
    { bf16* QM = wsp<bf16>(F, WS_QM); bf16* KM = wsp<bf16>(F, WS_KM);
      for (size_t i = (size_t)F.bid * NTHR + F.tid; i < (size_t)M * 256; i += (size_t)F.G * NTHR) {
          const int m = (int)(i >> 8), ch = (int)(i & 255) * 4, t = m & (SEQ - 1);
          float y[4];
#pragma unroll
          for (int e = 0; e < 4; ++e) y[e] = F.conv_b[ch + e];
#pragma unroll
          for (int j = 0; j < 4; ++j) { const int tt = t - 3 + j; if (tt >= 0) { const v2u w = *(const v2u*)(U + (size_t)(m - 3 + j) * NU + ch); const float* cw = F.conv_w + j * 1024 + ch;
              y[0] += bflo(w.x) * cw[0]; y[1] += bfhi(w.x) * cw[1]; y[2] += bflo(w.y) * cw[2]; y[3] += bfhi(w.y) * cw[3]; } }
          const float sc = ch < 512 ? 0.125f : 1.0f;
#pragma unroll
          for (int e = 0; e < 4; ++e) y[e] = y[e] * sigmoidf_(y[e]) * sc;
          bf16* o = ch < 512 ? QM + (size_t)m * WM + ch : KM + (size_t)m * WM + (ch - 512);
          *(v2u*)o = (v2u){pk2(y[0], y[1]), pk2(y[2], y[3])}; } }
    { bf16* KN = wsp<bf16>(F, WS_KN); bf16* VT = wsp<bf16>(F, WS_VT); float* KMEAN = wsp<float>(F, WS_KMEAN);
      LAS float* red = (LAS float*)F.lds;
      for (int un = F.bid; un < NBH * NBK; un += F.G) {
          const int bh = un / NBK, j = un % NBK, b = bh / NH, h = bh % NH;
          const float gk = F.kn_g[F.lane]; float acc = 0.f;
          for (int kk = F.wave; kk < MBS; kk += NWAVES) {
              const size_t m = (size_t)b * SEQ + j * MBS + kk;
              const float v = bf2f(U[m * NU + UKB + h * HD + F.lane]);
              const float rstd = 1.0f / sqrtf(wave_sum(v * v) * (1.0f / HD) + RMS_EPS);
              const float kn = v * rstd * gk; acc += kn;
              KN[m * WM + h * HD + F.lane] = (bf16)f2bf(kn);
          }
          red[F.wave * 64 + F.lane] = acc; __syncthreads();
          if (F.wave == 0) { float s = 0.f;
#pragma unroll
              for (int w = 0; w < NWAVES; ++w) s += red[w * 64 + F.lane];
              KMEAN[(size_t)un * HD + F.lane] = s * (1.0f / MBS); }
          __syncthreads();
          for (int e = F.tid; e < HD * MBS; e += NTHR) { const int d = e >> 8, s = e & 255; const size_t m = (size_t)b * SEQ + j * MBS + s;
              VT[((size_t)bh * HD + d) * SEQ + j * MBS + s] = U[m * NU + UVB + h * HD + d]; }
      } }
    { const float* GT = wsp<float>(F, WS_GATES); float* SA = wsp<float>(F, WS_SA); float* SMX = wsp<float>(F, WS_SMX); float* SB = wsp<float>(F, WS_SB); float* SW = wsp<float>(F, WS_SW);
      float* DEC = wsp<float>(F, WS_DEC); float* MC = wsp<float>(F, WS_MC);
      LAS float* sbl = (LAS float*)(F.lds + 4096); LAS float* sA = sbl + 64; LAS float* sm = sA + 64;
      for (int bh = F.bid; bh < NBH; bh += F.G) {
          const int b = bh / NH, h = bh % NH;
          __syncthreads();
          for (int c = F.wave; c < NCH; c += NWAVES) {
              const size_t m0 = (size_t)b * SEQ + c * LCH + 2 * F.lane;
              const float i0 = GT[m0 * 16 + h], i1 = GT[(m0 + 1) * 16 + h];
              const float l0 = logsigmoidf_(GT[m0 * 16 + 8 + h]), l1 = logsigmoidf_(GT[(m0 + 1) * 16 + 8 + h]);
              float s = l0 + l1, inc = s;
#pragma unroll
              for (int o = 1; o < 64; o <<= 1) { const float t = __shfl_up(inc, o); if (F.lane >= o) inc += t; }
              const float b0 = (inc - s) + l0, b1 = inc;
              const float a0 = i0 - b0, a1 = i1 - b1;
              float mx = fmaxf(a0, a1), pm = mx;
#pragma unroll
              for (int o = 1; o < 64; o <<= 1) { const float t = __shfl_up(pm, o); if (F.lane >= o) pm = fmaxf(pm, t); }
              float ex = __shfl_up(pm, 1); if (F.lane == 0) ex = -INFINITY;
              const float cm0 = fmaxf(ex, a0), cm1 = fmaxf(cm0, a1);
              const size_t o0 = (size_t)bh * SEQ + c * LCH + 2 * F.lane;
              SA[o0] = a0; SA[o0 + 1] = a1; SB[o0] = b0; SB[o0 + 1] = b1; SMX[o0] = cm0; SMX[o0 + 1] = cm1;
              if (F.lane == 63) { sbl[c] = b1; sA[c] = cm1; }
          }
          __syncthreads();
          if (F.tid == 0) { float m = 0.f; for (int c = 0; c < NCH; ++c) { sm[c] = m; m = sbl[c] + fmaxf(m, sA[c]); } sm[NCH] = m; }
          VM_WAIT(); __syncthreads();
          for (int c = F.wave; c < NCH; c += NWAVES) {
              const float mc = sm[c], mn = sm[c + 1], bL = sbl[c];
              const size_t o0 = (size_t)bh * SEQ + c * LCH + 2 * F.lane;
              const float a0 = SA[o0], a1 = SA[o0 + 1], c0 = SMX[o0], c1 = SMX[o0 + 1];
              SMX[o0] = fmaxf(mc, c0); SMX[o0 + 1] = fmaxf(mc, c1);
              SW[o0] = __expf(bL + a0 - mn); SW[o0 + 1] = __expf(bL + a1 - mn);
              if (F.lane == 0) { DEC[bh * NCH + c] = __expf(bL + mc - mn); MC[bh * NCH + c] = mc; }
          }
      } }
}

__device__ __forceinline__ int pair_idx(int i, int j) { return i * (i - 1) / 2 + j; }
__device__ __forceinline__ void p_route(Frame& F) {
    const bf16* U = wsp<bf16>(F, WS_U); bf16* QN = wsp<bf16>(F, WS_QN); const float* KMEAN = wsp<float>(F, WS_KMEAN);
    int* MLIST = wsp<int>(F, WS_MLIST); int* MCNT = wsp<int>(F, WS_MCNT);
    LAS float* skm = (LAS float*)F.lds;
    LAS int* ssel = (LAS int*)(F.lds + 8192);
    LAS int* wtot = (LAS int*)(F.lds + 8192 + 3072);
    for (int un = F.bid; un < NBH * NBK; un += F.G) {
        const int bh = un / NBK, i = un % NBK, b = bh / NH, h = bh % NH;
        __syncthreads();
        for (int e = F.tid; e < NBK * HD; e += NTHR) skm[e] = KMEAN[(size_t)bh * NBK * HD + e];
        __syncthreads();
        int s0 = -1, s1 = -1, s2 = -1;
        if (F.tid < MBS) {
            const size_t m = (size_t)b * SEQ + i * MBS + F.tid;
            float q[HD]; float ss = 0.f;
#pragma unroll
            for (int d8 = 0; d8 < 8; ++d8) { const v4u w = *(const v4u*)(U + m * NU + UQB + h * HD + 8 * d8);
                q[8 * d8 + 0] = bflo(w.x); q[8 * d8 + 1] = bfhi(w.x); q[8 * d8 + 2] = bflo(w.y); q[8 * d8 + 3] = bfhi(w.y);
                q[8 * d8 + 4] = bflo(w.z); q[8 * d8 + 5] = bfhi(w.z); q[8 * d8 + 6] = bflo(w.w); q[8 * d8 + 7] = bfhi(w.w); }
#pragma unroll
            for (int d = 0; d < HD; ++d) ss += q[d] * q[d];
            const float rstd = 1.0f / sqrtf(ss * (1.0f / HD) + RMS_EPS);
#pragma unroll
            for (int d = 0; d < HD; ++d) q[d] = q[d] * rstd * F.qn_g[d] * 0.125f;
#pragma unroll
            for (int d8 = 0; d8 < 8; ++d8) { v4u w; w.x = pk2(q[8 * d8], q[8 * d8 + 1]); w.y = pk2(q[8 * d8 + 2], q[8 * d8 + 3]); w.z = pk2(q[8 * d8 + 4], q[8 * d8 + 5]); w.w = pk2(q[8 * d8 + 6], q[8 * d8 + 7]);
                *(v4u*)(QN + m * WM + h * HD + 8 * d8) = w; }
            float v0 = -INFINITY, v1 = -INFINITY, v2 = -INFINITY;
            for (int j = 0; j < i; ++j) {
                float g = 0.f;
#pragma unroll
                for (int d = 0; d < HD; ++d) g += q[d] * skm[j * HD + d];
                if (g > v0) { v2 = v1; s2 = s1; v1 = v0; s1 = s0; v0 = g; s0 = j; }
                else if (g > v1) { v2 = v1; s2 = s1; v1 = g; s1 = j; }
                else if (g > v2) { v2 = g; s2 = j; }
            }
            ssel[F.tid * 3 + 0] = s0; ssel[F.tid * 3 + 1] = s1; ssel[F.tid * 3 + 2] = s2;
        }
        if (F.wave < 4) { for (int j = 0; j < i; ++j) { const bool f = (s0 == j) || (s1 == j) || (s2 == j); const unsigned long long mk = __ballot(f); if (F.lane == 0) wtot[j * 4 + F.wave] = __popcll(mk); } }
        __syncthreads();
        if (F.wave < 4) { for (int j = 0; j < i; ++j) { const bool f = (s0 == j) || (s1 == j) || (s2 == j); const unsigned long long mk = __ballot(f);
                int base = 0; for (int w = 0; w < F.wave; ++w) base += wtot[j * 4 + w];
                if (f) { const int pos = base + __popcll(mk & ((1ull << F.lane) - 1ull)); const int slot = (s0 == j) ? 0 : ((s1 == j) ? 1 : 2);
                    MLIST[((size_t)bh * NPAIR + pair_idx(i, j)) * MBS + pos] = F.tid | (slot << 8); } } }
        if (F.tid < i) MCNT[bh * NPAIR + pair_idx(i, F.tid)] = wtot[F.tid * 4] + wtot[F.tid * 4 + 1] + wtot[F.tid * 4 + 2] + wtot[F.tid * 4 + 3];
    }
}

__device__ __forceinline__ float moba_m0(const Frame& F) { return 8.0f * wave_max(fabsf(F.qn_g[F.lane])) * wave_max(fabsf(F.kn_g[F.lane])); }

__device__ __forceinline__ void p_mix_a(Frame& F) {
    const bf16* U = wsp<bf16>(F, WS_U); const bf16* QN = wsp<bf16>(F, WS_QN); const bf16* KN = wsp<bf16>(F, WS_KN);
    const int* MLIST = wsp<int>(F, WS_MLIST); const int* MCNT = wsp<int>(F, WS_MCNT);
    float* OP = wsp<float>(F, WS_OP); float* LP = wsp<float>(F, WS_LP);
    const float m0 = moba_m0(F);
    LAS float* sq = (LAS float*)(F.lds + F.wave * 2048);
    LAS float* sp = sq + 64;
    for (int un = F.bid; un < NBH * NPAIR; un += F.G) {
        const int bh = un / NPAIR, pr = un % NPAIR, b = bh / NH, h = bh % NH;
        int i = 1; while ((i + 1) * i / 2 <= pr) ++i;
        const int j = pr - i * (i - 1) / 2;
        const int cnt = MCNT[un]; const float slope = exp2f(-(float)(h + 1));
        for (int en = F.wave; en < cnt; en += NWAVES) {
            const int ent = MLIST[(size_t)un * MBS + en]; const int qo = ent & 255, slot = ent >> 8;
            const int tq = i * MBS + qo; const size_t mq = (size_t)b * SEQ + tq;
            sq[F.lane] = bf2f(QN[mq * WM + h * HD + F.lane]);
            LDS_WAIT(); asm volatile("" ::: "memory");
            float l = 0.f;
#pragma unroll
            for (int u4 = 0; u4 < 4; ++u4) { const int kk = F.lane + 64 * u4; const int tk = j * MBS + kk; const size_t mk = (size_t)b * SEQ + tk;
                float s = 0.f;
#pragma unroll
                for (int d8 = 0; d8 < 8; ++d8) { const v4u w = *(const v4u*)(KN + mk * WM + h * HD + 8 * d8);
                    s += sq[8 * d8] * bflo(w.x) + sq[8 * d8 + 1] * bfhi(w.x) + sq[8 * d8 + 2] * bflo(w.y) + sq[8 * d8 + 3] * bfhi(w.y)
                       + sq[8 * d8 + 4] * bflo(w.z) + sq[8 * d8 + 5] * bfhi(w.z) + sq[8 * d8 + 6] * bflo(w.w) + sq[8 * d8 + 7] * bfhi(w.w); }
                const float pv = __expf(s - slope * (float)(tq - tk) - m0);
                sp[kk] = pv; l += pv; }
            l = wave_sum(l);
            LDS_WAIT(); asm volatile("" ::: "memory");
            float o = 0.f;
            for (int kk = 0; kk < MBS; ++kk) { const size_t mk = (size_t)b * SEQ + j * MBS + kk; o += sp[kk] * bf2f(U[mk * NU + UVB + h * HD + F.lane]); }
            OP[((mq * NH + h) * 3 + slot) * HD + F.lane] = o;
            if (F.lane == 0) LP[(mq * NH + h) * 3 + slot] = l;
            LDS_WAIT(); asm volatile("" ::: "memory");
        }
    }
    { const bf16* KM = wsp<bf16>(F, WS_KM); const float* SW = wsp<float>(F, WS_SW); float* DC = wsp<float>(F, WS_DC); float* DN = wsp<float>(F, WS_DN);
      LAS float* sk = (LAS float*)(F.lds + 16384);
      LAS float* sv = sk + LCH * HD;
      for (int un = F.bid; un < NBH * NCH; un += F.G) {
          const int bh = un / NCH, c = un % NCH, b = bh / NH, h = bh % NH;
          __syncthreads();
          for (int e = F.tid; e < LCH * HD; e += NTHR) { const int s = e >> 6, d = e & 63; const size_t m = (size_t)b * SEQ + c * LCH + s;
              const float w = SW[(size_t)bh * SEQ + c * LCH + s];
              sk[e] = bf2f(KM[m * WM + h * HD + d]); sv[e] = w * bf2f(U[m * NU + UVM + h * HD + d]); }
          __syncthreads();
          { const int v = F.tid >> 3, k0 = (F.tid & 7) * 8; float acc[8];
#pragma unroll
            for (int e = 0; e < 8; ++e) acc[e] = 0.f;
            for (int s = 0; s < LCH; ++s) { const float wv = sv[s * HD + v];
#pragma unroll
                for (int e = 0; e < 8; ++e) acc[e] += wv * sk[s * HD + k0 + e]; }
#pragma unroll
            for (int e = 0; e < 8; ++e) DC[(size_t)un * 4096 + v * HD + k0 + e] = acc[e]; }
          if (F.tid < HD) { float a = 0.f; for (int s = 0; s < LCH; ++s) a += SW[(size_t)bh * SEQ + c * LCH + s] * sk[s * HD + F.tid]; DN[(size_t)un * HD + F.tid] = a; }
      } }
}

__device__ __forceinline__ void p_mix_b(Frame& F) {
    { const float* DC = wsp<float>(F, WS_DC); const float* DN = wsp<float>(F, WS_DN); float* CS = wsp<float>(F, WS_CS); float* NS = wsp<float>(F, WS_NS); const float* DEC = wsp<float>(F, WS_DEC);
      for (int e = F.bid * NTHR + F.tid; e < NBH * (4096 + HD); e += F.G * NTHR) {
          const int bh = e / (4096 + HD), r = e % (4096 + HD);
          float st = 0.f;
          if (r < 4096) { for (int c = 0; c < NCH; ++c) { const size_t o = ((size_t)bh * NCH + c) * 4096 + r; CS[o] = st; st = DEC[bh * NCH + c] * st + DC[o]; } }
          else { const int k = r - 4096; for (int c = 0; c < NCH; ++c) { const size_t o = ((size_t)bh * NCH + c) * HD + k; NS[o] = st; st = DEC[bh * NCH + c] * st + DN[o]; } }
      } }
    const bf16* U = wsp<bf16>(F, WS_U); const bf16* QN = wsp<bf16>(F, WS_QN); const bf16* KN = wsp<bf16>(F, WS_KN);
    const float* OP = wsp<float>(F, WS_OP); const float* LP = wsp<float>(F, WS_LP); bf16* MIX = wsp<bf16>(F, WS_MIX);
    const float m0 = moba_m0(F);
    LAS float* sq = (LAS float*)(F.lds + F.wave * 2048); LAS float* sp = sq + 64;
    const int gw = F.bid * NWAVES + F.wave, NGW = F.G * NWAVES;
    for (int it = gw; it < M * NH; it += NGW) {
        const int mq = it / NH, h = it % NH, b = mq / SEQ, tq = mq % SEQ, i = tq / MBS, qo = tq % MBS;
        const float slope = exp2f(-(float)(h + 1));
        sq[F.lane] = bf2f(QN[(size_t)mq * WM + h * HD + F.lane]);
        LDS_WAIT(); asm volatile("" ::: "memory");
        float l = 0.f;
#pragma unroll
        for (int u4 = 0; u4 < 4; ++u4) { const int kk = F.lane + 64 * u4; float pv = 0.f;
            if (kk <= qo) { const size_t mk = (size_t)b * SEQ + i * MBS + kk; float s = 0.f;
#pragma unroll
                for (int d8 = 0; d8 < 8; ++d8) { const v4u w = *(const v4u*)(KN + mk * WM + h * HD + 8 * d8);
                    s += sq[8 * d8] * bflo(w.x) + sq[8 * d8 + 1] * bfhi(w.x) + sq[8 * d8 + 2] * bflo(w.y) + sq[8 * d8 + 3] * bfhi(w.y)
                       + sq[8 * d8 + 4] * bflo(w.z) + sq[8 * d8 + 5] * bfhi(w.z) + sq[8 * d8 + 6] * bflo(w.w) + sq[8 * d8 + 7] * bfhi(w.w); }
                pv = __expf(s - slope * (float)(qo - kk) - m0); }
            sp[kk] = pv; l += pv; }
        l = wave_sum(l);
        LDS_WAIT(); asm volatile("" ::: "memory");
        float o = 0.f;
        for (int kk = 0; kk <= qo; ++kk) { const size_t mk = (size_t)b * SEQ + i * MBS + kk; o += sp[kk] * bf2f(U[mk * NU + UVB + h * HD + F.lane]); }
        const int nsel = i < 3 ? i : 3;
        for (int sl = 0; sl < nsel; ++sl) { o += OP[(((size_t)mq * NH + h) * 3 + sl) * HD + F.lane]; l += LP[((size_t)mq * NH + h) * 3 + sl]; }
        MIX[(size_t)mq * D + WM + h * HD + F.lane] = (bf16)f2bf(o / l);
        LDS_WAIT(); asm volatile("" ::: "memory");
    }
}

__device__ __forceinline__ void p_mix_c(Frame& F) {
    const bf16* U = wsp<bf16>(F, WS_U); const bf16* QM = wsp<bf16>(F, WS_QM); const bf16* KM = wsp<bf16>(F, WS_KM);
    const float* SA = wsp<float>(F, WS_SA); const float* SMX = wsp<float>(F, WS_SMX); const float* SB = wsp<float>(F, WS_SB);
    const float* CS = wsp<float>(F, WS_CS); const float* NS = wsp<float>(F, WS_NS); const float* MC = wsp<float>(F, WS_MC); bf16* MIX = wsp<bf16>(F, WS_MIX);
    LAS float* sq = (LAS float*)F.lds;
    LAS float* sk = sq + LCH * HD;
    LAS float* ssp = sk + LCH * HD;
    for (int un = F.bid; un < NBH * NCH; un += F.G) {
        const int bh = un / NCH, c = un % NCH, b = bh / NH, h = bh % NH;
        __syncthreads();
        for (int e = F.tid; e < LCH * HD; e += NTHR) { const int s = e >> 6, d = e & 63; const size_t m = (size_t)b * SEQ + c * LCH + s;
            sq[e] = bf2f(QM[m * WM + h * HD + d]); sk[e] = bf2f(KM[m * WM + h * HD + d]); }
        __syncthreads();
        const int t = F.tid >> 2, sub = F.tid & 3; const size_t gt = (size_t)bh * SEQ + c * LCH + t;
        const float mx = SMX[gt];
        for (int s = sub; s <= t; s += 4) { float dt = 0.f;
#pragma unroll 16
            for (int d = 0; d < HD; ++d) dt += sq[t * HD + d] * sk[s * HD + d];
            ssp[t * LCH + s] = dt * __expf(SA[(size_t)bh * SEQ + c * LCH + s] - mx); }
        __syncthreads();
        const float mc = MC[un]; const float sc = __expf(mc - mx);
        const int v0 = sub * 16; float num[16]; float den = 0.f;
#pragma unroll
        for (int e = 0; e < 16; ++e) num[e] = 0.f;
#pragma unroll 1
        for (int s = 0; s <= t; ++s) { const float pw = ssp[t * LCH + s]; den += pw; const size_t m = (size_t)b * SEQ + c * LCH + s;
            const v4u w0 = *(const v4u*)(U + m * NU + UVM + h * HD + v0), w1 = *(const v4u*)(U + m * NU + UVM + h * HD + v0 + 8);
            num[0] += pw * bflo(w0.x); num[1] += pw * bfhi(w0.x); num[2] += pw * bflo(w0.y); num[3] += pw * bfhi(w0.y);
            num[4] += pw * bflo(w0.z); num[5] += pw * bfhi(w0.z); num[6] += pw * bflo(w0.w); num[7] += pw * bfhi(w0.w);
            num[8] += pw * bflo(w1.x); num[9] += pw * bfhi(w1.x); num[10] += pw * bflo(w1.y); num[11] += pw * bfhi(w1.y);
            num[12] += pw * bflo(w1.z); num[13] += pw * bfhi(w1.z); num[14] += pw * bflo(w1.w); num[15] += pw * bfhi(w1.w); }
        float qn = 0.f;
        for (int k = 0; k < HD; ++k) qn += NS[(size_t)un * HD + k] * sq[t * HD + k];
        den += sc * qn;
        { float cq[16];
#pragma unroll
          for (int e = 0; e < 16; ++e) cq[e] = 0.f;
#pragma unroll 1
          for (int k = 0; k < HD; k += 4) { const f32x4 qv = *(const LAS f32x4*)(sq + t * HD + k);
#pragma unroll
              for (int e = 0; e < 16; ++e) { const f32x4 cv = *(const f32x4*)(CS + (size_t)un * 4096 + (v0 + e) * HD + k); cq[e] += (cv.x * qv.x + cv.y * qv.y) + (cv.z * qv.z + cv.w * qv.w); } }
#pragma unroll
          for (int e = 0; e < 16; ++e) num[e] += sc * cq[e]; }
        const float dn = fmaxf(fabsf(den), __expf(-(SB[gt] + mx)));
        float ss = 0.f;
#pragma unroll
        for (int e = 0; e < 16; ++e) { num[e] = num[e] / dn; ss += num[e] * num[e]; }
        ss += __shfl_xor(ss, 1); ss += __shfl_xor(ss, 2);
        const float rstd = 1.0f / sqrtf(ss * (1.0f / HD) + RMS_EPS);
        const size_t m = (size_t)b * SEQ + c * LCH + t; float o[16];
#pragma unroll
        for (int e = 0; e < 16; ++e) { const float og = bf2f(U[m * NU + UOM + h * HD + v0 + e]); o[e] = num[e] * rstd * F.head_g[h * HD + v0 + e] * sigmoidf_(og); }
        v4u w0, w1; w0.x = pk2(o[0], o[1]); w0.y = pk2(o[2], o[3]); w0.z = pk2(o[4], o[5]); w0.w = pk2(o[6], o[7]); w1.x = pk2(o[8], o[9]); w1.y = pk2(o[10], o[11]); w1.z = pk2(o[12], o[13]); w1.w = pk2(o[14], o[15]);
        *(v4u*)(MIX + m * D + h * HD + v0) = w0; *(v4u*)(MIX + m * D + h * HD + v0 + 8) = w1;
    }
}

__device__ __forceinline__ void p_router(Frame& F) {
    const bf16* T1 = wsp<bf16>(F, WS_XN); const bf16* WR = wsp<bf16>(F, WS_WR); const float* SS = wsp<float>(F, WS_SS);
    int* SELE = wsp<int>(F, WS_SELE); float* SELW = wsp<float>(F, WS_SELW); float* RSTD = wsp<float>(F, WS_RSTD); int* HIST = wsp<int>(F, WS_HIST);
    LAS int* sh = (LAS int*)F.lds;
    for (int ch = F.bid; ch < 256; ch += F.G) {
        __syncthreads();
        if (F.tid < NE) sh[F.tid] = 0;
        __syncthreads();
        for (int tt = F.wave; tt < 64; tt += NWAVES) {
            const size_t m = (size_t)ch * 64 + tt;
            float ss = 0.f;
#pragma unroll
            for (int q = 0; q < 16; ++q) ss += SS[m * 16 + q];
            const float rstd = 1.0f / sqrtf(ss * (1.0f / D) + RMS_EPS);
            float tv[16];
            { const v4u w0 = *(const v4u*)(T1 + m * D + 16 * F.lane), w1 = *(const v4u*)(T1 + m * D + 16 * F.lane + 8);
              tv[0] = bflo(w0.x); tv[1] = bfhi(w0.x); tv[2] = bflo(w0.y); tv[3] = bfhi(w0.y); tv[4] = bflo(w0.z); tv[5] = bfhi(w0.z); tv[6] = bflo(w0.w); tv[7] = bfhi(w0.w);
              tv[8] = bflo(w1.x); tv[9] = bfhi(w1.x); tv[10] = bflo(w1.y); tv[11] = bfhi(w1.y); tv[12] = bflo(w1.z); tv[13] = bfhi(w1.z); tv[14] = bflo(w1.w); tv[15] = bfhi(w1.w); }
            float mylogit = 0.f;
            for (int e = 0; e < NE; ++e) { const v4u w0 = *(const v4u*)(WR + (size_t)e * D + 16 * F.lane), w1 = *(const v4u*)(WR + (size_t)e * D + 16 * F.lane + 8);
                float a = tv[0] * bflo(w0.x) + tv[1] * bfhi(w0.x) + tv[2] * bflo(w0.y) + tv[3] * bfhi(w0.y) + tv[4] * bflo(w0.z) + tv[5] * bfhi(w0.z) + tv[6] * bflo(w0.w) + tv[7] * bfhi(w0.w)
                        + tv[8] * bflo(w1.x) + tv[9] * bfhi(w1.x) + tv[10] * bflo(w1.y) + tv[11] * bfhi(w1.y) + tv[12] * bflo(w1.z) + tv[13] * bfhi(w1.z) + tv[14] * bflo(w1.w) + tv[15] * bfhi(w1.w);
                a = wave_sum(a); if (F.lane == e) mylogit = a * rstd + F.b_r[e]; }
            float v = F.lane < NE ? mylogit : -INFINITY; int se[4]; float sv[4];
#pragma unroll
            for (int k = 0; k < 4; ++k) { const float mxv = wave_max(v); const unsigned long long mk = __ballot(v == mxv); const int idx = __ffsll((long long)mk) - 1; se[k] = idx; sv[k] = mxv; if (F.lane == idx) v = -INFINITY; }
            const float e0 = 1.0f, e1 = __expf(sv[1] - sv[0]), e2 = __expf(sv[2] - sv[0]), e3 = __expf(sv[3] - sv[0]); const float inv = 1.0f / (e0 + e1 + e2 + e3);
            if (F.lane == 0) { SELE[m * 4 + 0] = se[0]; SELE[m * 4 + 1] = se[1]; SELE[m * 4 + 2] = se[2]; SELE[m * 4 + 3] = se[3];
                SELW[m * 4 + 0] = e0 * inv; SELW[m * 4 + 1] = e1 * inv; SELW[m * 4 + 2] = e2 * inv; SELW[m * 4 + 3] = e3 * inv; RSTD[m] = rstd;
                atomicAdd((int*)&sh[se[0]], 1); atomicAdd((int*)&sh[se[1]], 1); atomicAdd((int*)&sh[se[2]], 1); atomicAdd((int*)&sh[se[3]], 1); }
        }
        __syncthreads();
        if (F.tid < NE) HIST[ch * NE + F.tid] = sh[F.tid];
    }
}
__device__ __forceinline__ void p_lists(Frame& F) {
    const int* SELE = wsp<int>(F, WS_SELE); const float* SELW = wsp<float>(F, WS_SELW); const float* RSTD = wsp<float>(F, WS_RSTD); const int* HIST = wsp<int>(F, WS_HIST);
    int* POS = wsp<int>(F, WS_POS); int* ROWTOK = wsp<int>(F, WS_ROWTOK); float* ROWGATE = wsp<float>(F, WS_ROWGATE); float* ROWRSTD = wsp<float>(F, WS_ROWRSTD); int* TILEE = wsp<int>(F, WS_TILEE);
    LAS int* stot = (LAS int*)F.lds;
    LAS int* soff = stot + 32;
    LAS int* sbase = soff + 40;
    for (int ch = F.bid; ch < 256; ch += F.G) {
        __syncthreads();
        if (F.tid < NE) { int tot = 0, before = 0; for (int w = 0; w < 256; ++w) { const int hv = HIST[w * NE + F.tid]; if (w < ch) before += hv; tot += hv; } stot[F.tid] = tot; sbase[F.tid] = before; }
        __syncthreads();
        if (F.tid == 0) { int o = 0; for (int e = 0; e < NE; ++e) { soff[e] = o; o += (stot[e] + 255) & ~255; } soff[NE] = o; }
        __syncthreads();
        if (F.wave == 0) {
            const size_t m = (size_t)ch * 64 + F.lane; int se[4]; float sw[4];
#pragma unroll
            for (int k = 0; k < 4; ++k) { se[k] = SELE[m * 4 + k]; sw[k] = SELW[m * 4 + k]; }
            const float rs = RSTD[m]; int pos[4] = {0, 0, 0, 0};
            for (int e = 0; e < NE; ++e) { const unsigned long long mk = __ballot(se[0] == e || se[1] == e || se[2] == e || se[3] == e);
                const int rank = __popcll(mk & ((1ull << F.lane) - 1ull)); const int pp = soff[e] + sbase[e] + rank;
#pragma unroll
                for (int k = 0; k < 4; ++k) if (se[k] == e) pos[k] = pp; }
#pragma unroll
            for (int k = 0; k < 4; ++k) { POS[m * 4 + k] = pos[k]; ROWTOK[pos[k]] = (int)m; ROWGATE[pos[k]] = sw[k]; ROWRSTD[pos[k]] = rs; }
        }
        if (ch < NE) { const int e = ch; for (int r = soff[e] + stot[e] + F.tid; r < soff[e + 1]; r += NTHR) { ROWTOK[r] = 0; ROWGATE[r] = 0.f; ROWRSTD[r] = 0.f; } }
        if (ch == 0) { const int nt = soff[NE] >> 8; for (int t = F.tid; t < nt; t += NTHR) { int e = 0; while (soff[e + 1] <= t * 256) ++e; TILEE[t] = e; } if (F.tid == 0) TILEE[MAXTILES] = nt; }
    }
}
__device__ __forceinline__ void p_combine(Frame& F) {
    const float* X1 = wsp<float>(F, WS_X1); const bf16* YS = wsp<bf16>(F, WS_YS); const int* POS = wsp<int>(F, WS_POS); bf16* XN = wsp<bf16>(F, WS_XN);
    const int gw = F.bid * NWAVES + F.wave, NGW = F.G * NWAVES, lane = F.lane;
    for (int m = gw; m < M; m += NGW) {
        f32x4 v[4]; float s = 0.f; int ps[4];
#pragma unroll
        for (int k = 0; k < 4; ++k) ps[k] = POS[(size_t)m * 4 + k];
#pragma unroll
        for (int j = 0; j < 4; ++j) { v[j] = *((const f32x4*)(X1 + (size_t)m * D) + lane + 64 * j);
#pragma unroll
            for (int k = 0; k < 4; ++k) { const v2u w = *(const v2u*)(YS + (size_t)ps[k] * D + 256 * j + 4 * lane); v[j].x += bflo(w.x); v[j].y += bfhi(w.x); v[j].z += bflo(w.y); v[j].w += bfhi(w.y); }
            s += (v[j].x * v[j].x + v[j].y * v[j].y) + (v[j].z * v[j].z + v[j].w * v[j].w);
            *((f32x4*)(F.out + (size_t)m * D) + lane + 64 * j) = v[j]; }
        const float rstd = 1.0f / sqrtf(wave_sum(s) * (1.0f / D) + RMS_EPS);
#pragma unroll
        for (int j = 0; j < 4; ++j) { const f32x4 g = *((const f32x4*)F.ple_g + lane + 64 * j); const f32x4 o = v[j] * rstd * g;
            *(v2u*)(XN + (size_t)m * D + 256 * j + 4 * lane) = (v2u){pk2(o.x, o.y), pk2(o.z, o.w)}; }
    }
}

enum { PH_PRO = 0, PH_INPROJ, PH_PREP, PH_ROUTE, PH_MIXA, PH_MIXB, PH_MIXC, PH_OUTPROJ, PH_ROUTER, PH_LISTS, PH_GU, PH_DN, PH_COMB, PH_PLE, NPH };

__global__ void __launch_bounds__(NTHR, 2) fwd(Args args) {
    extern __shared__ __attribute__((aligned(16))) unsigned char lds[];
    Frame F;
    F.lds = (LAS unsigned char*)lds; F.MISC = (volatile LAS unsigned*)(F.lds + MISC_OFF);
    F.tid = threadIdx.x; F.lane = F.tid & 63; F.wave = __builtin_amdgcn_readfirstlane(F.tid >> 6); F.G = gridDim.x; F.bid = blockIdx.x;
    F.ws = args.ws; F.ctl = (gu32*)(args.ws + WS_CTL); F.out = args.out;
    F.x = args.in[0]; F.p = args.in[1]; F.mix_g = args.in[2]; F.w_in = args.in[3]; F.conv_w = args.in[4]; F.conv_b = args.in[5]; F.ig_b = args.in[6]; F.fg_b = args.in[7];
    F.head_g = args.in[8]; F.qn_g = args.in[9]; F.kn_g = args.in[10]; F.w_out = args.in[11]; F.ffn_g = args.in[12]; F.w_r = args.in[13]; F.b_r = args.in[14];
    F.w_gu = args.in[15]; F.b_gu = args.in[16]; F.w_dn = args.in[17]; F.b_dn = args.in[18]; F.ple_g = args.in[19]; F.w_pg = args.in[20]; F.w_pp = args.in[21];
    for (int u = F.tid; u < (LDS_BYTES - RING_BYTES) / 4; u += NTHR) ((LAS unsigned*)(F.lds + RING_BYTES))[u] = 0u;
    __syncthreads();
    XcdBarrier bar; bar.bar = (unsigned*)(F.ctl + CW_BAR); bar.x = 0; bar.st = nullptr;
    if (!MK_PER_PHASE) bar = xcd_barrier_post((unsigned*)(F.ctl + CW_BAR), F.MISC + 8);
    const int lo = args.ph_lo, hi = args.ph_hi;
#ifdef ONLY
#define IN(k) ((k) == ONLY)
#else
#define IN(k) (lo <= (k) && (k) < hi)
#endif
#define SEAM(k) do { if (IN(k) && IN((k) + 1)) xcd_barrier(bar); } while (0)

    if (IN(PH_PRO)) { p0_prologue(F); } SEAM(PH_PRO);
    if (IN(PH_INPROJ)) { StaticOrder S{M / 256, NU / 256, F.G, F.bid}; EpiStoreBf16 E{wsp<bf16>(F, WS_U), NU};
        sgemm_phase(F, wsp<bf16>(F, WS_XN), nullptr, D, wsp<bf16>(F, WS_WIN), D, S, E); } SEAM(PH_INPROJ);
    if (IN(PH_PREP)) { p_prep(F); } SEAM(PH_PREP);
    if (IN(PH_ROUTE)) { p_route(F); } SEAM(PH_ROUTE);
    if (IN(PH_MIXA)) { p_mix_a(F); } SEAM(PH_MIXA);
    if (IN(PH_MIXB)) { p_mix_b(F); } SEAM(PH_MIXB);
    if (IN(PH_MIXC)) { p_mix_c(F); } SEAM(PH_MIXC);
    if (IN(PH_OUTPROJ)) { StaticOrder S{M / 256, D / 256, F.G, F.bid}; EpiOutProj E{F.x, F.ffn_g, wsp<float>(F, WS_X1), wsp<bf16>(F, WS_XN), wsp<float>(F, WS_SS)};
        sgemm_phase(F, wsp<bf16>(F, WS_MIX), nullptr, D, wsp<bf16>(F, WS_WOUT), D, S, E); } SEAM(PH_OUTPROJ);
    if (IN(PH_ROUTER)) { p_router(F); } SEAM(PH_ROUTER);
    if (IN(PH_LISTS)) { p_lists(F); } SEAM(PH_LISTS);
    if (IN(PH_GU)) { GroupedOrder S{wsp<int>(F, WS_TILEE), 8, F.G, F.bid}; EpiGateUp E{wsp<int>(F, WS_TILEE), wsp<float>(F, WS_ROWRSTD), F.b_gu, wsp<bf16>(F, WS_ACT)};
        sgemm_phase(F, wsp<bf16>(F, WS_XN), wsp<int>(F, WS_ROWTOK), D, wsp<bf16>(F, WS_WGU), D, S, E); } SEAM(PH_GU);
    if (IN(PH_DN)) { GroupedOrder S{wsp<int>(F, WS_TILEE), 4, F.G, F.bid}; EpiDown E{wsp<float>(F, WS_ROWGATE), F.b_dn, wsp<bf16>(F, WS_YS)};
        sgemm_phase(F, wsp<bf16>(F, WS_ACT), nullptr, FF, wsp<bf16>(F, WS_WDN), FF, S, E); } SEAM(PH_DN);
    if (IN(PH_COMB)) { p_combine(F); } SEAM(PH_COMB);
    if (IN(PH_PLE)) { StaticOrder S{M / 256, D / 256, F.G, F.bid};
        { EpiStoreBf16 E{wsp<bf16>(F, WS_MIX), D}; sgemm_phase(F, wsp<bf16>(F, WS_PB), nullptr, PLE, wsp<bf16>(F, WS_WPP), PLE, S, E); }
        { EpiPle E{wsp<bf16>(F, WS_MIX), F.out}; sgemm_phase(F, wsp<bf16>(F, WS_XN), nullptr, D, wsp<bf16>(F, WS_WPG), D, S, E); } }
#undef IN
#undef SEAM
}

extern "C" void kernel_launch(void* const* d_in, const int* in_sizes, int n_in, void* d_out, int out_size, void* d_ws, size_t ws_size, hipStream_t stream) {
    static int grid = 0;
    if (grid == 0) {
        if (n_in != 22 || out_size != M * D || ws_size < WS_END) { fprintf(stderr, "kernel_launch: unexpected problem (n_in %d, out %d, ws %zu); nothing launched\n", n_in, out_size, ws_size); grid = -1; return; }
        int dev = 0, cus = 0, per_cu = 0;
        if (hipGetDevice(&dev) != hipSuccess || hipDeviceGetAttribute(&cus, hipDeviceAttributeMultiprocessorCount, dev) != hipSuccess) { grid = -1; return; }
        if (hipFuncSetAttribute((const void*)fwd, hipFuncAttributeMaxDynamicSharedMemorySize, LDS_BYTES) != hipSuccess) { fprintf(stderr, "kernel_launch: hipFuncSetAttribute failed\n"); grid = -1; return; }
        if (hipOccupancyMaxActiveBlocksPerMultiprocessor(&per_cu, (const void*)fwd, NTHR, LDS_BYTES) != hipSuccess || per_cu < 1) fprintf(stderr, "kernel_launch: occupancy query says %d\n", per_cu);
        (void)hipGetLastError();
        grid = cus;
    }
    if (grid < 0) return;
    if (hipMemsetAsync((char*)d_ws + WS_CTL, 0, CTL_ZERO_BYTES, stream) != hipSuccess) return;
    Args a{};
    for (int i = 0; i < 22; ++i) a.in[i] = (const float*)d_in[i];
    a.out = (float*)d_out; a.ws = (unsigned char*)d_ws; a.li = 0; a.pad = 0;
#if MK_PER_PHASE
    for (int ph = 0; ph < NPH; ++ph) { a.ph_lo = ph; a.ph_hi = ph + 1; hipLaunchKernelGGL(fwd, dim3(grid), dim3(NTHR), LDS_BYTES, stream, a); }
#else
    a.ph_lo = 0; a.ph_hi = NPH; hipLaunchKernelGGL(fwd, dim3(grid), dim3(NTHR), LDS_BYTES, stream, a);
#endif
}
```

```cpp
#include <hip/hip_runtime.h>
#include <cstdio>
#include <cstdint>

#ifndef MK_PER_PHASE
#define MK_PER_PHASE 0
#endif

#define GAS __attribute__((address_space(1)))
#define LAS __attribute__((address_space(3)))
typedef unsigned short bf16;
typedef unsigned v4u __attribute__((ext_vector_type(4)));
typedef unsigned v2u __attribute__((ext_vector_type(2)));
typedef float f32x4 __attribute__((ext_vector_type(4)));
typedef short bf16x8 __attribute__((ext_vector_type(8)));
typedef GAS unsigned gu32;
#define RLX_AGENT __ATOMIC_RELAXED, __HIP_MEMORY_SCOPE_AGENT
#define LDS_WAIT() asm volatile("s_waitcnt lgkmcnt(0)" ::: "memory")
#define VM_WAIT() asm volatile("s_waitcnt vmcnt(0)" ::: "memory")

constexpr int BATCH = 2, SEQ = 8192, D = 1024, M = BATCH * SEQ;
constexpr int PROJ = 3600, NU = 3584;
constexpr int HD = 64, NH = 8, WM = 512;
constexpr int LCH = 128, NCH = SEQ / LCH;
constexpr int MBS = 256, NBK = SEQ / MBS;
constexpr int NPAIR = NBK * (NBK - 1) / 2;
constexpr int NE = 32, TOPK = 4, FF = 1024, PLE = 256;
constexpr int MAXROWS = M * TOPK + NE * 256, MAXTILES = MAXROWS / 256;
constexpr float RMS_EPS = 1e-6f;
constexpr float SW_LIMIT = 7.0f, SW_ALPHA = 1.702f;
constexpr float LOG2E = 1.4426950408889634f;
constexpr int UQM = 0, UKM = 512, UVM = 1024, UOM = 1536, UQB = 2048, UKB = 2560, UVB = 3072;
constexpr int NBH = BATCH * NH;

constexpr size_t MiB = 1u << 20;
constexpr size_t WS_CTL = 0, CTL_ZERO_BYTES = 1 * MiB;
constexpr size_t WS_WIN = 2 * MiB;
constexpr size_t WS_WOUT = 10 * MiB;
constexpr size_t WS_WPG = 12 * MiB;
constexpr size_t WS_WPP = 14 * MiB;
constexpr size_t WS_WR = 15 * MiB;
constexpr size_t WS_WGU = 16 * MiB;
constexpr size_t WS_WDN = 144 * MiB;
constexpr size_t WS_XN = 208 * MiB;
constexpr size_t WS_PB = 240 * MiB;
constexpr size_t WS_GATES = 248 * MiB;
constexpr size_t WS_SA = 249 * MiB;
constexpr size_t WS_SMX = WS_SA + 512 * 1024;
constexpr size_t WS_SB = WS_SMX + 512 * 1024;
constexpr size_t WS_SW = WS_SB + 512 * 1024;
constexpr size_t WS_SMALL = 251 * MiB;
constexpr size_t WS_DEC = WS_SMALL;
constexpr size_t WS_MC = WS_DEC + 4096;
constexpr size_t WS_KMEAN = WS_MC + 4096;
constexpr size_t WS_MCNT = WS_KMEAN + 131072;
constexpr size_t WS_SELE = 252 * MiB;
constexpr size_t WS_SELW = WS_SELE + 262144;
constexpr size_t WS_RSTD = WS_SELW + 262144;
constexpr size_t WS_HIST = WS_RSTD + 65536;
constexpr size_t WS_POS = WS_HIST + 32768;
constexpr size_t WS_ROWTOK = WS_POS + 262144;
constexpr size_t WS_ROWGATE = WS_ROWTOK + 294912;
constexpr size_t WS_ROWRSTD = WS_ROWGATE + 294912;
constexpr size_t WS_TILEE = WS_ROWRSTD + 294912;
constexpr size_t WS_SS = 254 * MiB;
constexpr size_t WS_DN = 255 * MiB;
constexpr size_t WS_NS = WS_DN + 262144;
constexpr size_t WS_U = 260 * MiB;
constexpr size_t WS_QM = 372 * MiB;
constexpr size_t WS_KM = 388 * MiB;
constexpr size_t WS_QN = 404 * MiB;
constexpr size_t WS_KN = 420 * MiB;
constexpr size_t WS_VT = 436 * MiB;
constexpr size_t WS_MIX = 452 * MiB;
constexpr size_t WS_X1 = 484 * MiB;
constexpr size_t WS_MLIST = 548 * MiB;
constexpr size_t WS_OP = 556 * MiB;
constexpr size_t WS_LP = 652 * MiB;
constexpr size_t WS_DC = 654 * MiB;
constexpr size_t WS_CS = 670 * MiB;
constexpr size_t WS_ACT = 688 * MiB;
constexpr size_t WS_YS = 260 * MiB;
constexpr size_t WS_END = 832 * MiB;
static_assert(WS_ACT + (size_t)MAXROWS * 1024 * 2 <= WS_END && WS_YS + (size_t)MAXROWS * 1024 * 2 <= WS_QN, "ws map");
constexpr int CW_BAR = 4096;

constexpr int RING_BYTES = 131072;
constexpr int MISC_OFF = RING_BYTES + 320;
constexpr int LDS_BYTES = 147456;
constexpr int NWAVES = 8, NTHR = 512;

typedef float f32x2_t __attribute__((ext_vector_type(2)));
typedef __bf16 bf16x2_t __attribute__((ext_vector_type(2)));
typedef float f32x16 __attribute__((ext_vector_type(16)));
__device__ __forceinline__ unsigned pk2(float lo, float hi) { f32x2_t v = {lo, hi}; bf16x2_t b = __builtin_convertvector(v, bf16x2_t); return __builtin_bit_cast(unsigned, b); }
__device__ __forceinline__ unsigned f2bf(float f) { return pk2(f, 0.f) & 0xffffu; }
__device__ __forceinline__ float bf2f(unsigned short b) { return __builtin_bit_cast(float, (unsigned)b << 16); }
__device__ __forceinline__ float bflo(unsigned w) { return __builtin_bit_cast(float, w << 16); }
__device__ __forceinline__ float bfhi(unsigned w) { return __builtin_bit_cast(float, w & 0xffff0000u); }
__device__ __forceinline__ float sigmoidf_(float x) { return 1.0f / (1.0f + __expf(-x)); }

#define XB_TMO      128
#define XB_XCNT(j)  (256  + 64 * (j))
#define XB_XSUB(j)  (1280 + 64 * (j))
#define XB_XGEN(j)  (2304 + 64 * (j))
#define XB_TOP      3328
#define XB_TOPGEN   3392
#define XCD_BAR_WORDS 3456
#define XB_SPIN_CAP (1u << 18)
__device__ __forceinline__ unsigned xb_ld(unsigned* p)              { return __hip_atomic_load(p, __ATOMIC_RELAXED, __HIP_MEMORY_SCOPE_AGENT); }
__device__ __forceinline__ unsigned xb_add(unsigned* p, unsigned v) { return __hip_atomic_fetch_add(p, v, __ATOMIC_RELAXED, __HIP_MEMORY_SCOPE_AGENT); }
__device__ __forceinline__ unsigned xb_xcc_id() { return (unsigned)__builtin_amdgcn_s_getreg((3 << 11) | 20) & 0xFu; }
#define XB_SPIN(cond, bar) do { unsigned _sp = 0; while (cond) { __builtin_amdgcn_s_sleep(1); \
    if ((++_sp & 255u) == 0u) { if (xb_ld(&(bar)[XB_TMO])) break; if (_sp > XB_SPIN_CAP) { atomicAdd(&(bar)[XB_TMO], 1u); break; } } } } while (0)
struct XcdBarrier { unsigned* bar; unsigned x; volatile LAS unsigned* st; };
__device__ __forceinline__ XcdBarrier xcd_barrier_post(unsigned* bar, volatile LAS unsigned* st) {
    XcdBarrier b; b.bar = bar; b.x = xb_xcc_id(); b.st = st;
    if (threadIdx.x == 0) (void)xb_add(&bar[XB_XCNT(b.x)], 1u);
    return b;
}
__device__ __forceinline__ void xcd_barrier_complete(unsigned* bar, unsigned x, unsigned& nloc, unsigned& nx) {
    const unsigned G = gridDim.x * gridDim.y * gridDim.z;
    unsigned sum, cnt, mine, sp = 0u;
    for (;;) {
        sum = 0u; cnt = 0u; mine = 0u;
#pragma unroll
        for (unsigned j = 0; j < 16; ++j) { const unsigned c = xb_ld(&bar[XB_XCNT(j)]); sum += c; cnt += (c > 0u) ? 1u : 0u; mine = (j == x) ? c : mine; }
        if (sum == G) break;
        __builtin_amdgcn_s_sleep(1);
        if ((++sp & 255u) == 0u) { if (xb_ld(&bar[XB_TMO])) break; if (sp > XB_SPIN_CAP) { atomicAdd(&bar[XB_TMO], 1u); break; } }
    }
    nloc = mine > 0u ? mine : 1u; nx = cnt > 0u ? cnt : 1u;
}
__device__ __forceinline__ void xcd_barrier(const XcdBarrier& b) {
    asm volatile("s_waitcnt vmcnt(0)" ::: "memory");
    __syncthreads();
    if (threadIdx.x == 0) {
        unsigned* bar = b.bar;
        __builtin_amdgcn_s_waitcnt(0);
        unsigned nloc = b.st[0], nx = b.st[1];
        if (nloc == 0u) { xcd_barrier_complete(bar, b.x, nloc, nx); b.st[0] = nloc; b.st[1] = nx; }
        const unsigned old = xb_add(&bar[XB_XSUB(b.x)], 1u);
        const unsigned gen = old / nloc;
        if (old + 1u == (gen + 1u) * nloc) {
            __builtin_amdgcn_fence(__ATOMIC_RELEASE, "agent");
            asm volatile("s_waitcnt vmcnt(0)" ::: "memory");
            const unsigned og = xb_add(&bar[XB_TOP], 1u);
            const unsigned tg = og / nx;
            if (og + 1u == (tg + 1u) * nx) xb_add(&bar[XB_TOPGEN], 1u);
            else XB_SPIN(xb_ld(&bar[XB_TOPGEN]) == tg, bar);
            __builtin_amdgcn_fence(__ATOMIC_ACQUIRE, "agent");
            xb_add(&bar[XB_XGEN(b.x)], 1u);
            asm volatile("s_waitcnt vmcnt(0)" ::: "memory");
        } else {
            XB_SPIN(xb_ld(&bar[XB_XGEN(b.x)]) == gen, bar);
            __builtin_amdgcn_fence(__ATOMIC_ACQUIRE, "agent");
            asm volatile("s_waitcnt vmcnt(0)" ::: "memory");
        }
    }
    __syncthreads();
}

struct Args { const float* in[22]; float* out; unsigned char* ws; int ph_lo, ph_hi, li, pad; };
struct Frame {
    LAS unsigned char* lds; volatile LAS unsigned* MISC; gu32* ctl;
    int tid, lane, wave, G, bid;
    float* out; unsigned char* ws;
};
template <class T> __device__ __forceinline__ T* wsp(const Frame& F, size_t off) { return (T*)(F.ws + off); }

__device__ __forceinline__ float wave_sum(float v) {
#pragma unroll
    for (int o = 1; o < 64; o <<= 1) v += __shfl_xor(v, o);
    return v;
}
__device__ __forceinline__ float wave_max(float v) {
#pragma unroll
    for (int o = 1; o < 64; o <<= 1) v = fmaxf(v, __shfl_xor(v, o));
    return v;
}

struct Unit { int pm, pn; };
struct StaticOrder {
    int nM, nN, G, c;
    __device__ __forceinline__ bool next(int i, Unit& u) const {
        const int nwg = nM * nN; const int L = i * G + c; if (L >= nwg) return false;
        int wgid = L; { const int q = nwg / 8, r = nwg % 8, xcd = wgid % 8, off = wgid / 8; wgid = (xcd < r ? xcd * (q + 1) : r * (q + 1) + (xcd - r) * q) + off; }
        const int nig = 8 * nN, gid = wgid / nig, fm = gid * 8, gsz = (nM - fm) < 8 ? (nM - fm) : 8;
        u.pm = fm + ((wgid % nig) % gsz); u.pn = (wgid % nig) / gsz; return true;
    }
};
struct GroupedOrder {
    const int* tile_e; int NT, G, c;
    __device__ __forceinline__ bool next(int i, Unit& u) const {
        const int nwg = tile_e[MAXTILES] * NT; const int L0 = i * G + c; if (L0 >= nwg) return false;
        const int q = nwg / 8, r = nwg % 8, xcd = L0 % 8, off = L0 / 8; const int L = (xcd < r ? xcd * (q + 1) : r * (q + 1) + (xcd - r) * q) + off;
        const int t = L / NT, n = L % NT; u.pm = t; u.pn = tile_e[t] * NT + n; return true;
    }
};
__device__ __forceinline__ int perm32(int rho) { const int n = rho >> 4, i = rho & 15; return 8 * (i >> 2) + 4 * n + (i & 3); }

template <class Sched, class Epi>
__device__ __forceinline__ void sgemm_phase(const Frame& F, const bf16* A, const int* arow, int lda, const bf16* Bt, int K, const Sched& S, const Epi& E) {
    const int wid = F.wave, lane = F.lane, wr = wid >> 2, wc = wid & 3, fr = lane & 15, fq = lane >> 4;
    Unit u;
    for (int i = 0; S.next(i, u); ++i) {
        for (int ai = 0; ai < 2; ++ai) {
            f32x4 acc[2][4][2];
#pragma unroll
            for (int bj = 0; bj < 2; ++bj)
#pragma unroll
                for (int m = 0; m < 4; ++m)
#pragma unroll
                    for (int n = 0; n < 2; ++n) acc[bj][m][n] = (f32x4){0.f, 0.f, 0.f, 0.f};
            const bf16* ap[4]; const bf16* bp[2][2];
#pragma unroll
            for (int m = 0; m < 4; ++m) { const int r = u.pm * 256 + ai * 128 + wr * 64 + m * 16 + fr; const int src = arow ? arow[r] : r; ap[m] = A + (size_t)src * lda + fq * 8; }
#pragma unroll
            for (int bj = 0; bj < 2; ++bj)
#pragma unroll
                for (int n = 0; n < 2; ++n) bp[bj][n] = Bt + (size_t)(u.pn * 256 + bj * 128 + wc * 32 + perm32(16 * n + fr)) * K + fq * 8;
            for (int k = 0; k < K; k += 32) {
                bf16x8 af[4], bfr[2][2];
#pragma unroll
                for (int m = 0; m < 4; ++m) af[m] = *(const bf16x8*)(ap[m] + k);
#pragma unroll
                for (int bj = 0; bj < 2; ++bj)
#pragma unroll
                    for (int n = 0; n < 2; ++n) bfr[bj][n] = *(const bf16x8*)(bp[bj][n] + k);
#pragma unroll
                for (int bj = 0; bj < 2; ++bj)
#pragma unroll
                    for (int m = 0; m < 4; ++m)
#pragma unroll
                        for (int n = 0; n < 2; ++n) acc[bj][m][n] = __builtin_amdgcn_mfma_f32_16x16x32_bf16(bfr[bj][n], af[m], acc[bj][m][n], 0, 0, 0);
            }
#pragma unroll
            for (int m = 0; m < 4; ++m) {
                float lo[8], hi[8];
#pragma unroll
                for (int j = 0; j < 4; ++j) { lo[j] = acc[0][m][0][j]; lo[4 + j] = acc[0][m][1][j]; hi[j] = acc[1][m][0][j]; hi[4 + j] = acc[1][m][1][j]; }
                E(u, ai * 128 + wr * 64 + m * 16 + fr, wc * 32 + fq * 8, lo, hi);
            }
        }
    }
}

namespace pg8 {
constexpr int BM = 256, BK = 64, HALF = 128, HTB = HALF * BK * 2, STAGE_BYTES = 8 * HTB;
__device__ __forceinline__ int lds_byte(int r, int c) { const int st = (r >> 4) * 2 + (c >> 5), rr = r & 15, cc = c & 31, ob = rr * 64 + cc * 2; return st * 1024 + (ob ^ (((ob >> 9) & 1) << 5)); }
__device__ __forceinline__ void stage_rc(int b, int& R, int& C) { const int st = b / 1024, sb = b % 1024, swz = sb ^ (((sb >> 9) & 1) << 5); R = (st >> 1) * 16 + swz / 64; C = (st & 1) * 32 + (swz % 64) / 2; }

template <class Epi, class Sched, bool GATHER, bool ALIGN_EPI>
__device__ __forceinline__ void gemm_phase(LAS unsigned char* lds, const bf16* A, const int* arow, const bf16* Bt, const int K, const Sched& S, const Epi& E) {
    const int tid = threadIdx.x, wid = __builtin_amdgcn_readfirstlane(tid >> 6), lane = tid & 63, wr = wid >> 2, wc = wid & 3, fr = lane & 15, fq = lane >> 4;
    const int nt = K / BK;
    int sR[2], sC[2]; unsigned voffB[2], vA[2][2], nvA[2][2];
#pragma unroll
    for (int i = 0; i < 2; ++i) { stage_rc(tid * 16 + i * 8192, sR[i], sC[i]); const int Rb = (sR[i] & ~31) + perm32(sR[i] & 31);
        voffB[i] = (unsigned)(Rb * K + sC[i]) * 2u;
        vA[0][i] = (unsigned)(sR[i] * K + sC[i]) * 2u; vA[1][i] = (unsigned)((sR[i] + HALF) * K + sC[i]) * 2u; nvA[0][i] = vA[0][i]; nvA[1][i] = vA[1][i]; }
    const size_t kstep = (size_t)(BK * 2);
    const size_t hstep = (size_t)HALF * K * 2;
    const size_t tstep = 2 * hstep;
    const unsigned ldsw = (unsigned)wid * 1024u;
    const int aoff = lds_byte(wr * 64 + fr, fq * 8), boff = lds_byte(wc * 32 + fr, fq * 8);
#define PG8_SA(b, h) (((b) * 2 + (h)) * HTB)
#define PG8_SB(b, h) ((4 + (b) * 2 + (h)) * HTB)
#define PG8_STAGE_B(bufoff, gbase) do { _Pragma("unroll") for (int _i = 0; _i < 2; ++_i) \
        __builtin_amdgcn_global_load_lds((const unsigned*)((const char*)(gbase) + voffB[_i]), (LAS unsigned*)(lds + (bufoff) + ldsw + _i * 8192), 16, 0, 0); } while (0)
#define PG8_STAGE_A(bufoff, gbase, h, nx) do { _Pragma("unroll") for (int _i = 0; _i < 2; ++_i) \
        __builtin_amdgcn_global_load_lds((const unsigned*)((const char*)(gbase) + ((GATHER && (nx)) ? nvA[h][_i] : vA[h][_i])), (LAS unsigned*)(lds + (bufoff) + ldsw + _i * 8192), 16, 0, 0); } while (0)
#define PG8_LDA(dst, b, h) do { _Pragma("unroll") for (int m = 0; m < 4; ++m) _Pragma("unroll") for (int k = 0; k < 2; ++k) dst[m][k] = *(const LAS bf16x8*)(lds + PG8_SA(b, h) + aoff + m * 2048 + k * 1024); } while (0)
#define PG8_LDB(dst, b, h) do { _Pragma("unroll") for (int n = 0; n < 2; ++n) _Pragma("unroll") for (int k = 0; k < 2; ++k) dst[n][k] = *(const LAS bf16x8*)(lds + PG8_SB(b, h) + boff + n * 2048 + k * 1024); } while (0)
#define PG8_MMA(ai, bj, At, Bq) do { __builtin_amdgcn_s_setprio(1); _Pragma("unroll") for (int m = 0; m < 4; ++m) _Pragma("unroll") for (int n = 0; n < 2; ++n) _Pragma("unroll") for (int k = 0; k < 2; ++k) \
        acc[ai][bj][m][n] = __builtin_amdgcn_mfma_f32_16x16x32_bf16(Bq[n][k], At[m][k], acc[ai][bj][m][n], 0, 0, 0); __builtin_amdgcn_s_setprio(0); } while (0)
#define PG8_WAIT_V(n) asm volatile("s_waitcnt vmcnt(" #n ")" ::: "memory")
#define PG8_WAIT_L(n) asm volatile("s_waitcnt lgkmcnt(" #n ")" ::: "memory")
#define PG8_BAR __builtin_amdgcn_s_barrier()
#define PG8_SCHED __builtin_amdgcn_sched_barrier(0)
#define PG8_GOFF(dst, u) do { if (GATHER) { _Pragma("unroll") for (int _h = 0; _h < 2; ++_h) _Pragma("unroll") for (int _i = 0; _i < 2; ++_i) \
        dst[_h][_i] = (unsigned)(arow[(u).pm * BM + _h * HALF + sR[_i]] * K + sC[_i]) * 2u; } } while (0)
    Unit cur, nxt; int ui = 0;
    if (!S.next(0, cur)) return;
    PG8_GOFF(vA, cur);
    f32x4 acc[2][2][4][2];
#pragma unroll
    for (int a = 0; a < 2; ++a)
#pragma unroll
        for (int b = 0; b < 2; ++b)
#pragma unroll
            for (int m = 0; m < 4; ++m)
#pragma unroll
                for (int n = 0; n < 2; ++n) acc[a][b][m][n] = (f32x4){0.f, 0.f, 0.f, 0.f};
    bf16x8 At[4][2], B0[2][2], B1[2][2];
    const char* cA = (const char*)A + (GATHER ? (size_t)0 : (size_t)cur.pm * tstep); const char* cB = (const char*)Bt + (size_t)cur.pn * tstep;
    PG8_STAGE_B(PG8_SB(0, 0), cB); PG8_STAGE_B(PG8_SB(0, 1), cB + hstep); PG8_STAGE_A(PG8_SA(0, 0), cA, 0, false); PG8_STAGE_A(PG8_SA(0, 1), cA, 1, false);
    if (wr == 1) PG8_BAR;
    PG8_WAIT_V(2); PG8_BAR;
    PG8_STAGE_B(PG8_SB(1, 0), cB + kstep); PG8_STAGE_A(PG8_SA(1, 0), cA + kstep, 0, false); PG8_STAGE_B(PG8_SB(1, 1), cB + hstep + kstep);
    PG8_WAIT_V(6); PG8_BAR;
    for (;;) {
        const bool has_next = S.next(ui + 1, nxt);
        const char* nA = has_next ? (const char*)A + (GATHER ? (size_t)0 : (size_t)nxt.pm * tstep) : cA; const char* nB = has_next ? (const char*)Bt + (size_t)nxt.pn * tstep : cB;
        if (GATHER) { if (has_next) PG8_GOFF(nvA, nxt); else {
#pragma unroll
            for (int _h = 0; _h < 2; ++_h)
#pragma unroll
                for (int _i = 0; _i < 2; ++_i) nvA[_h][_i] = vA[_h][_i]; } }
        for (int t = 0; t < nt; t += 2) {
            const bool last = (t == nt - 2);
            const char* a1 = cA + (size_t)(t + 1) * kstep;
            const char* a2 = last ? nA : cA + (size_t)(t + 2) * kstep; const char* b2 = last ? nB : cB + (size_t)(t + 2) * kstep;
            const char* a3 = a2 + kstep; const char* b3 = b2 + kstep;
            PG8_LDB(B0, 0, 0); PG8_LDB(B1, 0, 1); PG8_SCHED; PG8_LDA(At, 0, 0); PG8_STAGE_A(PG8_SA(1, 1), a1, 1, false);
            PG8_WAIT_V(8); PG8_WAIT_L(0); PG8_BAR; PG8_MMA(0, 0, At, B0); PG8_MMA(0, 1, At, B1); PG8_BAR; PG8_SCHED;
            PG8_LDA(At, 0, 1); PG8_STAGE_B(PG8_SB(0, 0), b2); PG8_STAGE_B(PG8_SB(0, 1), b2 + hstep); PG8_STAGE_A(PG8_SA(0, 0), a2, 0, last);
            PG8_WAIT_V(8); PG8_WAIT_L(0); PG8_BAR; PG8_MMA(1, 0, At, B0); PG8_MMA(1, 1, At, B1); PG8_BAR; PG8_SCHED;
            PG8_LDB(B0, 1, 0); PG8_LDB(B1, 1, 1); PG8_SCHED; PG8_LDA(At, 1, 0); PG8_STAGE_A(PG8_SA(0, 1), a2, 1, last);
            PG8_WAIT_V(8); PG8_WAIT_L(0); PG8_BAR; PG8_MMA(0, 0, At, B0); PG8_MMA(0, 1, At, B1); PG8_BAR; PG8_SCHED;
            PG8_LDA(At, 1, 1); PG8_STAGE_B(PG8_SB(1, 0), b3); PG8_STAGE_B(PG8_SB(1, 1), b3 + hstep); PG8_STAGE_A(PG8_SA(1, 0), a3, 0, last);
            PG8_WAIT_V(8); PG8_WAIT_L(0); PG8_BAR; PG8_MMA(1, 0, At, B0); PG8_MMA(1, 1, At, B1); PG8_BAR; PG8_SCHED;
        }
        if constexpr (ALIGN_EPI) { if (wr == 0) PG8_BAR; }
        {
#pragma unroll
            for (int ai = 0; ai < 2; ++ai)
#pragma unroll
                for (int m = 0; m < 4; ++m) { float lo[8], hi[8];
#pragma unroll
                    for (int j = 0; j < 4; ++j) { lo[j] = acc[ai][0][m][0][j]; lo[4 + j] = acc[ai][0][m][1][j]; hi[j] = acc[ai][1][m][0][j]; hi[4 + j] = acc[ai][1][m][1][j]; }
                    E(cur, ai * HALF + wr * 64 + m * 16 + fr, wc * 32 + fq * 8, lo, hi); asm volatile("" ::: "memory"); }
        }
        if (!has_next) break;
#pragma unroll
        for (int a = 0; a < 2; ++a)
#pragma unroll
            for (int b = 0; b < 2; ++b)
#pragma unroll
                for (int m = 0; m < 4; ++m)
#pragma unroll
                    for (int n = 0; n < 2; ++n) acc[a][b][m][n] = (f32x4){0.f, 0.f, 0.f, 0.f};
        cur = nxt; cA = nA; cB = nB; ++ui;
        if (GATHER) {
#pragma unroll
            for (int _h = 0; _h < 2; ++_h)
#pragma unroll
                for (int _i = 0; _i < 2; ++_i) vA[_h][_i] = nvA[_h][_i]; }
        if constexpr (ALIGN_EPI) { if (wr == 1) PG8_BAR; }
    }
    PG8_WAIT_V(0);
    if constexpr (!ALIGN_EPI) { if (wr == 0) PG8_BAR; }
    PG8_BAR;
#undef PG8_SA
#undef PG8_SB
#undef PG8_STAGE_A
#undef PG8_STAGE_B
#undef PG8_LDA
#undef PG8_LDB
#undef PG8_MMA
#undef PG8_WAIT_V
#undef PG8_WAIT_L
#undef PG8_BAR
#undef PG8_SCHED
#undef PG8_GOFF
}
}
__device__ __forceinline__ void store8bf(bf16* p, const float (&v)[8]) { v4u w; w.x = pk2(v[0], v[1]); w.y = pk2(v[2], v[3]); w.z = pk2(v[4], v[5]); w.w = pk2(v[6], v[7]); *(v4u*)p = w; }

struct EpiStoreBf16 { bf16* O; int ldc;
    __device__ __forceinline__ void operator()(const Unit& u, int r, int c, const float (&lo)[8], const float (&hi)[8]) const {
        bf16* o = O + (size_t)(u.pm * 256 + r) * ldc + u.pn * 256 + c; store8bf(o, lo); store8bf(o + 128, hi); } };
struct EpiOutProj { const float* x; const float* g; float* X1; bf16* T1; float* SS;
    __device__ __forceinline__ void operator()(const Unit& u, int r, int c, const float (&lo)[8], const float (&hi)[8]) const {
        const size_t row = (size_t)u.pm * 256 + r; const int col = u.pn * 256 + c; float ss = 0.f;
#pragma unroll
        for (int h = 0; h < 2; ++h) { const float* v = h ? hi : lo; const int cc = col + h * 128; float o[8], t[8];
#pragma unroll
            for (int j = 0; j < 8; ++j) { o[j] = x[row * D + cc + j] + v[j]; ss += o[j] * o[j]; t[j] = o[j] * g[cc + j]; }
            *(f32x4*)(X1 + row * D + cc) = (f32x4){o[0], o[1], o[2], o[3]}; *(f32x4*)(X1 + row * D + cc + 4) = (f32x4){o[4], o[5], o[6], o[7]};
            store8bf(T1 + row * D + cc, t); }
        ss += __shfl_xor(ss, 16); ss += __shfl_xor(ss, 32);
        if ((threadIdx.x & 63) < 16) SS[row * 16 + u.pn * 4 + (c >> 5)] = ss; } };
struct EpiGateUp { const int* tile_e; const float* rowrstd; const float* b_gu; bf16* ACT;
    __device__ __forceinline__ void operator()(const Unit& u, int r, int c, const float (&lo)[8], const float (&hi)[8]) const {
        const int e = u.pn >> 3, nt = u.pn & 7; const size_t row = (size_t)u.pm * 256 + r; const float rs = rowrstd[row];
        const float* bg = b_gu + (size_t)e * 2048 + nt * 128 + c; float a[8];
#pragma unroll
        for (int j = 0; j < 8; ++j) { float glu = lo[j] * rs + bg[j], lin = hi[j] * rs + bg[1024 + j];
            glu = fminf(glu, SW_LIMIT); lin = fminf(fmaxf(lin, -SW_LIMIT), SW_LIMIT);
            a[j] = glu * sigmoidf_(SW_ALPHA * glu) * (lin + 1.0f); }
        store8bf(ACT + row * FF + nt * 128 + c, a); } };
struct EpiDown { const float* rowgate; const float* b_dn; bf16* YS;
    __device__ __forceinline__ void operator()(const Unit& u, int r, int c, const float (&lo)[8], const float (&hi)[8]) const {
        const int e = u.pn >> 2, nt = u.pn & 3; const size_t row = (size_t)u.pm * 256 + r; const float gt = rowgate[row];
        const float* bd = b_dn + (size_t)e * 1024 + nt * 256 + c; float a[8], b[8];
#pragma unroll
        for (int j = 0; j < 8; ++j) { a[j] = (lo[j] + bd[j]) * gt; b[j] = (hi[j] + bd[128 + j]) * gt; }
        bf16* o = YS + row * D + nt * 256 + c; store8bf(o, a); store8bf(o + 128, b); } };
struct EpiPle { const bf16* PE; float* out;
    __device__ __forceinline__ void operator()(const Unit& u, int r, int c, const float (&lo)[8], const float (&hi)[8]) const {
        const size_t row = (size_t)u.pm * 256 + r; const int col = u.pn * 256 + c;
#pragma unroll
        for (int h = 0; h < 2; ++h) { const float* v = h ? hi : lo; const int cc = col + h * 128; const v4u pe = *(const v4u*)(PE + row * D + cc);
            f32x4 x0 = *(const f32x4*)(out + row * D + cc), x1 = *(const f32x4*)(out + row * D + cc + 4);
            x0[0] += sigmoidf_(v[0]) * bflo(pe.x); x0[1] += sigmoidf_(v[1]) * bfhi(pe.x); x0[2] += sigmoidf_(v[2]) * bflo(pe.y); x0[3] += sigmoidf_(v[3]) * bfhi(pe.y);
            x1[0] += sigmoidf_(v[4]) * bflo(pe.z); x1[1] += sigmoidf_(v[5]) * bfhi(pe.z); x1[2] += sigmoidf_(v[6]) * bflo(pe.w); x1[3] += sigmoidf_(v[7]) * bfhi(pe.w);
            *(f32x4*)(out + row * D + cc) = x0; *(f32x4*)(out + row * D + cc + 4) = x1; } } };

__device__ __forceinline__ void transpose_tile(const float* src, int ldw, bf16* dst, int K, LAS float* scr, int lane) {
#pragma unroll 8
    for (int i = 0; i < 32; ++i) { const int kk = 2 * i + (lane >> 5); scr[kk * 33 + (lane & 31)] = src[(size_t)kk * ldw + (lane & 31)]; }
    LDS_WAIT(); asm volatile("" ::: "memory");
    const int c = lane & 7;
#pragma unroll
    for (int j = 0; j < 4; ++j) { const int n = (lane >> 3) + 8 * j; const LAS float* s = scr + (8 * c) * 33 + n;
        v4u o; o.x = pk2(s[0 * 33], s[1 * 33]); o.y = pk2(s[2 * 33], s[3 * 33]); o.z = pk2(s[4 * 33], s[5 * 33]); o.w = pk2(s[6 * 33], s[7 * 33]);
        *(v4u*)(dst + (size_t)n * K + 8 * c) = o; }
    LDS_WAIT(); asm volatile("" ::: "memory");
}
__device__ __forceinline__ void p0_prologue(Frame& F, const Args& args) {
    LAS float* scr = (LAS float*)(F.lds + F.wave * 16384);
    const int gw = F.bid * NWAVES + F.wave, NGW = F.G * NWAVES, lane = F.lane;
    constexpr int I_IN = 16 * (NU / 32), I_SQ = 16 * 32, I_PP = 4 * 32, I_R = 16, I_GU = 16 * 64, I_DN = 16 * 32;
    constexpr int NITEMS = I_IN + 2 * I_SQ + I_PP + I_R + NE * I_GU + NE * I_DN;
    for (int it = gw; it < NITEMS; it += NGW) {
        int r = it;
        if (r < I_IN) { const int kb = r / (NU / 32), nb = r % (NU / 32), n0 = 32 * nb, sc = n0 < 2048 ? n0 : n0 + 16;
            transpose_tile(args.in[3] + (size_t)(64 * kb) * PROJ + sc, PROJ, wsp<bf16>(F, WS_WIN) + (size_t)n0 * D + 64 * kb, D, scr, lane); continue; } r -= I_IN;
        if (r < I_SQ) { const int kb = r / 32, n0 = 32 * (r % 32); transpose_tile(args.in[11] + (size_t)(64 * kb) * D + n0, D, wsp<bf16>(F, WS_WOUT) + (size_t)n0 * D + 64 * kb, D, scr, lane); continue; } r -= I_SQ;
        if (r < I_SQ) { const int kb = r / 32, n0 = 32 * (r % 32); transpose_tile(args.in[20] + (size_t)(64 * kb) * D + n0, D, wsp<bf16>(F, WS_WPG) + (size_t)n0 * D + 64 * kb, D, scr, lane); continue; } r -= I_SQ;
        if (r < I_PP) { const int kb = r / 32, n0 = 32 * (r % 32); transpose_tile(args.in[21] + (size_t)(64 * kb) * D + n0, D, wsp<bf16>(F, WS_WPP) + (size_t)n0 * PLE + 64 * kb, PLE, scr, lane); continue; } r -= I_PP;
        if (r < I_R) { const int kb = r; transpose_tile(args.in[13] + (size_t)(64 * kb) * NE, NE, wsp<bf16>(F, WS_WR) + 64 * kb, D, scr, lane); continue; } r -= I_R;
        if (r < NE * I_GU) { const int e = r / I_GU, q = r % I_GU, kb = q / 64, n0 = 32 * (q % 64), pn = n0 >> 8, c = n0 & 255;
            const int sc = c < 128 ? pn * 128 + c : 1024 + pn * 128 + (c - 128);
            transpose_tile(args.in[15] + ((size_t)e * D + 64 * kb) * 2048 + sc, 2048, wsp<bf16>(F, WS_WGU) + ((size_t)e * 2048 + n0) * D + 64 * kb, D, scr, lane); continue; } r -= NE * I_GU;
        { const int e = r / I_DN, q = r % I_DN, kb = q / 32, n0 = 32 * (q % 32);
            transpose_tile(args.in[17] + ((size_t)e * FF + 64 * kb) * D + n0, D, wsp<bf16>(F, WS_WDN) + ((size_t)e * D + n0) * FF + 64 * kb, FF, scr, lane); }
    }
    bf16* XN = wsp<bf16>(F, WS_XN); float* GT = wsp<float>(F, WS_GATES);
    for (int m = gw; m < M; m += NGW) {
        const f32x4* xr = (const f32x4*)(args.in[0] + (size_t)m * D) + lane; const f32x4* gr = (const f32x4*)args.in[2] + lane;
        f32x4 v[4]; float s = 0.f;
#pragma unroll
        for (int j = 0; j < 4; ++j) { v[j] = xr[64 * j]; s += (v[j].x * v[j].x + v[j].y * v[j].y) + (v[j].z * v[j].z + v[j].w * v[j].w); }
        const float rstd = 1.0f / sqrtf(wave_sum(s) * (1.0f / D) + RMS_EPS);
        float ga[16];
#pragma unroll
        for (int c = 0; c < 16; ++c) ga[c] = 0.f;
#pragma unroll
        for (int j = 0; j < 4; ++j) { const f32x4 g = gr[64 * j]; v[j] = v[j] * rstd * g;
            *(v2u*)(XN + (size_t)m * D + 256 * j + 4 * lane) = (v2u){pk2(v[j].x, v[j].y), pk2(v[j].z, v[j].w)};
#pragma unroll
            for (int e = 0; e < 4; ++e) { const int k = 256 * j + 4 * lane + e; const f32x4* wg = (const f32x4*)(args.in[3] + (size_t)k * PROJ + 2048);
#pragma unroll
                for (int q = 0; q < 4; ++q) { const f32x4 w = wg[q]; ga[4 * q + 0] += v[j][e] * w.x; ga[4 * q + 1] += v[j][e] * w.y; ga[4 * q + 2] += v[j][e] * w.z; ga[4 * q + 3] += v[j][e] * w.w; } } }
#pragma unroll
        for (int c = 0; c < 16; ++c) ga[c] = wave_sum(ga[c]);
        if (lane < 16) { float val = 0.f;
#pragma unroll
            for (int c = 0; c < 16; ++c) val = (lane == c) ? ga[c] : val;
            GT[(size_t)m * 16 + lane] = val + (lane < 8 ? args.in[6][lane] : args.in[7][lane - 8]); }
    }
    bf16* PB = wsp<bf16>(F, WS_PB);
    for (size_t i = (size_t)F.bid * NTHR + F.tid; i < (size_t)M * PLE / 4; i += (size_t)F.G * NTHR) { const f32x4 v = ((const f32x4*)args.in[1])[i]; *(v2u*)(PB + 4 * i) = (v2u){pk2(v.x, v.y), pk2(v.z, v.w)}; }
}

__device__ __forceinline__ float logsigmoidf_(float f) { return f >= 0.f ? -log1pf(__expf(-f)) : f - log1pf(__expf(f)); }
__device__ __forceinline__ void p_prep(Frame& F, const Args& args) {
    const bf16* U = wsp<bf16>(F, WS_U);
    { bf16* QM = wsp<bf16>(F, WS_QM); bf16* KM = wsp<bf16>(F, WS_KM);
      for (size_t i = (size_t)F.bid * NTHR + F.tid; i < (size_t)M * 256; i += (size_t)F.G * NTHR) {
          const int m = (int)(i >> 8), ch = (int)(i & 255) * 4, t = m & (SEQ - 1);
          float y[4];
#pragma unroll
          for (int e = 0; e < 4; ++e) y[e] = args.in[5][ch + e];
#pragma unroll
          for (int j = 0; j < 4; ++j) { const int tt = t - 3 + j; if (tt >= 0) { const v2u w = *(const v2u*)(U + (size_t)(m - 3 + j) * NU + ch); const float* cw = args.in[4] + j * 1024 + ch;
              y[0] += bflo(w.x) * cw[0]; y[1] += bfhi(w.x) * cw[1]; y[2] += bflo(w.y) * cw[2]; y[3] += bfhi(w.y) * cw[3]; } }
          const float sc = ch < 512 ? 0.125f : 1.0f;
#pragma unroll
          for (int e = 0; e < 4; ++e) y[e] = y[e] * sigmoidf_(y[e]) * sc;
          bf16* o = ch < 512 ? QM + (size_t)m * WM + ch : KM + (size_t)m * WM + (ch - 512);
          *(v2u*)o = (v2u){pk2(y[0], y[1]), pk2(y[2], y[3])}; } }
    { bf16* KN = wsp<bf16>(F, WS_KN); bf16* VT = wsp<bf16>(F, WS_VT); float* KMEAN = wsp<float>(F, WS_KMEAN);
      LAS float* red = (LAS float*)F.lds;
      for (int un = F.bid; un < NBH * NBK; un += F.G) {
          const int bh = un / NBK, j = un % NBK, b = bh / NH, h = bh % NH;
          const float gk = args.in[10][F.lane]; float acc = 0.f;
          for (int kk = F.wave; kk < MBS; kk += NWAVES) {
              const size_t m = (size_t)b * SEQ + j * MBS + kk;
              const float v = bf2f(U[m * NU + UKB + h * HD + F.lane]);
              const float rstd = 1.0f / sqrtf(wave_sum(v * v) * (1.0f / HD) + RMS_EPS);
              const float kn = v * rstd * gk; acc += kn;
              KN[m * WM + h * HD + F.lane] = (bf16)f2bf(kn);
          }
          red[F.wave * 64 + F.lane] = acc; __syncthreads();
          if (F.wave == 0) { float s = 0.f;
#pragma unroll
              for (int w = 0; w < NWAVES; ++w) s += red[w * 64 + F.lane];
              KMEAN[(size_t)un * HD + F.lane] = s * (1.0f / MBS); }
          __syncthreads();
          for (int e = F.tid; e < HD * MBS; e += NTHR) { const int d = e >> 8, s = e & 255; const size_t m = (size_t)b * SEQ + j * MBS + s;
              VT[((size_t)bh * HD + d) * SEQ + j * MBS + s] = U[m * NU + UVB + h * HD + d]; }
      } }
    { const float* GT = wsp<float>(F, WS_GATES); float* SA = wsp<float>(F, WS_SA); float* SMX = wsp<float>(F, WS_SMX); float* SB = wsp<float>(F, WS_SB); float* SW = wsp<float>(F, WS_SW);
      float* DEC = wsp<float>(F, WS_DEC); float* MC = wsp<float>(F, WS_MC);
      LAS float* sbl = (LAS float*)(F.lds + 4096); LAS float* sA = sbl + 64; LAS float* sm = sA + 64;
      for (int bh = F.bid; bh < NBH; bh += F.G) {
          const int b = bh / NH, h = bh % NH;
          __syncthreads();
          for (int c = F.wave; c < NCH; c += NWAVES) {
              const size_t m0 = (size_t)b * SEQ + c * LCH + 2 * F.lane;
              const float i0 = GT[m0 * 16 + h], i1 = GT[(m0 + 1) * 16 + h];
              const float l0 = logsigmoidf_(GT[m0 * 16 + 8 + h]), l1 = logsigmoidf_(GT[(m0 + 1) * 16 + 8 + h]);
              float s = l0 + l1, inc = s;
#pragma unroll
              for (int o = 1; o < 64; o <<= 1) { const float t = __shfl_up(inc, o); if (F.lane >= o) inc += t; }
              const float b0 = (inc - s) + l0, b1 = inc;
              const float a0 = i0 - b0, a1 = i1 - b1;
              float mx = fmaxf(a0, a1), pm = mx;
#pragma unroll
              for (int o = 1; o < 64; o <<= 1) { const float t = __shfl_up(pm, o); if (F.lane >= o) pm = fmaxf(pm, t); }
              float ex = __shfl_up(pm, 1); if (F.lane == 0) ex = -INFINITY;
              const float cm0 = fmaxf(ex, a0), cm1 = fmaxf(cm0, a1);
              const size_t o0 = (size_t)bh * SEQ + c * LCH + 2 * F.lane;
              SA[o0] = a0; SA[o0 + 1] = a1; SB[o0] = b0; SB[o0 + 1] = b1; SMX[o0] = cm0; SMX[o0 + 1] = cm1;
              if (F.lane == 63) { sbl[c] = b1; sA[c] = cm1; }
          }
          __syncthreads();
          if (F.tid == 0) { float m = 0.f; for (int c = 0; c < NCH; ++c) { sm[c] = m; m = sbl[c] + fmaxf(m, sA[c]); } sm[NCH] = m; }
          VM_WAIT(); __syncthreads();
          for (int c = F.wave; c < NCH; c += NWAVES) {
              const float mc = sm[c], mn = sm[c + 1], bL = sbl[c];
              const size_t o0 = (size_t)bh * SEQ + c * LCH + 2 * F.lane;
              const float a0 = SA[o0], a1 = SA[o0 + 1], c0 = SMX[o0], c1 = SMX[o0 + 1];
              SMX[o0] = fmaxf(mc, c0); SMX[o0 + 1] = fmaxf(mc, c1);
              SW[o0] = __expf(bL + a0 - mn); SW[o0 + 1] = __expf(bL + a1 - mn);
              if (F.lane == 0) { DEC[bh * NCH + c] = __expf(bL + mc - mn); MC[bh * NCH + c] = mc; }
          }
      } }
}

__device__ __forceinline__ int pair_idx(int i, int j) { return i * (i - 1) / 2 + j; }
__device__ __forceinline__ void p_route(Frame& F, const Args& args) {
    const bf16* U = wsp<bf16>(F, WS_U); bf16* QN = wsp<bf16>(F, WS_QN); const float* KMEAN = wsp<float>(F, WS_KMEAN);
    int* MLIST = wsp<int>(F, WS_MLIST); int* MCNT = wsp<int>(F, WS_MCNT);
    LAS float* skm = (LAS float*)F.lds;
    LAS int* ssel = (LAS int*)(F.lds + 8192);
    LAS int* wtot = (LAS int*)(F.lds + 8192 + 3072);
    for (int un = F.bid; un < NBH * NBK; un += F.G) {
        const int bh = un / NBK, i = un % NBK, b = bh / NH, h = bh % NH;
        __syncthreads();
        for (int e = F.tid; e < NBK * HD; e += NTHR) skm[e] = KMEAN[(size_t)bh * NBK * HD + e];
        __syncthreads();
        int s0 = -1, s1 = -1, s2 = -1;
        if (F.tid < MBS) {
            const size_t m = (size_t)b * SEQ + i * MBS + F.tid;
            float q[HD]; float ss = 0.f;
#pragma unroll
            for (int d8 = 0; d8 < 8; ++d8) { const v4u w = *(const v4u*)(U + m * NU + UQB + h * HD + 8 * d8);
                q[8 * d8 + 0] = bflo(w.x); q[8 * d8 + 1] = bfhi(w.x); q[8 * d8 + 2] = bflo(w.y); q[8 * d8 + 3] = bfhi(w.y);
                q[8 * d8 + 4] = bflo(w.z); q[8 * d8 + 5] = bfhi(w.z); q[8 * d8 + 6] = bflo(w.w); q[8 * d8 + 7] = bfhi(w.w); }
#pragma unroll
            for (int d = 0; d < HD; ++d) ss += q[d] * q[d];
            const float rstd = 1.0f / sqrtf(ss * (1.0f / HD) + RMS_EPS);
#pragma unroll
            for (int d = 0; d < HD; ++d) q[d] = q[d] * rstd * args.in[9][d] * 0.125f;
#pragma unroll
            for (int d8 = 0; d8 < 8; ++d8) { v4u w; w.x = pk2(q[8 * d8] * LOG2E, q[8 * d8 + 1] * LOG2E); w.y = pk2(q[8 * d8 + 2] * LOG2E, q[8 * d8 + 3] * LOG2E); w.z = pk2(q[8 * d8 + 4] * LOG2E, q[8 * d8 + 5] * LOG2E); w.w = pk2(q[8 * d8 + 6] * LOG2E, q[8 * d8 + 7] * LOG2E);
                *(v4u*)(QN + m * WM + h * HD + 8 * d8) = w; }
            float v0 = -INFINITY, v1 = -INFINITY, v2 = -INFINITY;
            for (int j = 0; j < i; ++j) {
                float g = 0.f;
#pragma unroll
                for (int d = 0; d < HD; ++d) g += q[d] * skm[j * HD + d];
                if (g > v0) { v2 = v1; s2 = s1; v1 = v0; s1 = s0; v0 = g; s0 = j; }
                else if (g > v1) { v2 = v1; s2 = s1; v1 = g; s1 = j; }
                else if (g > v2) { v2 = g; s2 = j; }
            }
            ssel[F.tid * 3 + 0] = s0; ssel[F.tid * 3 + 1] = s1; ssel[F.tid * 3 + 2] = s2;
        }
        if (F.wave < 4) { for (int j = 0; j < i; ++j) { const bool f = (s0 == j) || (s1 == j) || (s2 == j); const unsigned long long mk = __ballot(f); if (F.lane == 0) wtot[j * 4 + F.wave] = __popcll(mk); } }
        __syncthreads();
        if (F.wave < 4) { for (int j = 0; j < i; ++j) { const bool f = (s0 == j) || (s1 == j) || (s2 == j); const unsigned long long mk = __ballot(f);
                int base = 0; for (int w = 0; w < F.wave; ++w) base += wtot[j * 4 + w];
                if (f) { const int pos = base + __popcll(mk & ((1ull << F.lane) - 1ull)); const int slot = (s0 == j) ? 0 : ((s1 == j) ? 1 : 2);
                    MLIST[((size_t)bh * NPAIR + pair_idx(i, j)) * MBS + pos] = F.tid | (slot << 8); } } }
        if (F.tid < i) MCNT[bh * NPAIR + pair_idx(i, F.tid)] = wtot[F.tid * 4] + wtot[F.tid * 4 + 1] + wtot[F.tid * 4 + 2] + wtot[F.tid * 4 + 3];
    }
}

__device__ __forceinline__ float moba_m0(const Frame& F, const Args& args) { return 8.0f * wave_max(fabsf(args.in[9][F.lane])) * wave_max(fabsf(args.in[10][F.lane])); }


constexpr int MB_VOFF = 32768, MB_VSTR = 520, MB_MISC = MB_VOFF + 64 * MB_VSTR;
__device__ __forceinline__ void moba_load_kv(const Frame& F, int bh, int j) {
    const bf16* KN = wsp<bf16>(F, WS_KN); const bf16* VT = wsp<bf16>(F, WS_VT); const int b = bh / NH, head = bh % NH;
#pragma unroll
    for (int k = 0; k < 4; ++k) { const int p = F.tid + NTHR * k, key = p >> 3, c = p & 7;
        const v4u w = *(const v4u*)(KN + ((size_t)b * SEQ + j * MBS + key) * WM + head * HD + c * 8);
        *(LAS v4u*)(F.lds + key * 128 + ((c ^ ((key >> 1) & 7)) << 4)) = w; }
#pragma unroll
    for (int k = 0; k < 4; ++k) { const int p = F.tid + NTHR * k, d = p >> 5, c = p & 31;
        const v4u w = *(const v4u*)(VT + ((size_t)bh * HD + d) * SEQ + j * MBS + c * 8);
        LAS v2u* dst = (LAS v2u*)(F.lds + MB_VOFF + d * MB_VSTR + c * 16); dst[0] = (v2u){w.x, w.y}; dst[1] = (v2u){w.z, w.w}; }
}
template <bool MASK>
__device__ __forceinline__ void moba_core(LAS const unsigned char* lds, const bf16x8 (&qf)[4], f32x16 (&o)[2], float& l, int nkt, int dkey0, float slope2, float m0l, int q, int h) {
    float br[16];
#pragma unroll
    for (int r = 0; r < 16; ++r) br[r] = slope2 * (float)((r & 3) + 8 * (r >> 2)) - m0l;
#pragma unroll 1
    for (int kt = 0; kt < nkt; ++kt) {
        const float cb = slope2 * (float)(dkey0 + 32 * kt);
        f32x16 s;
#pragma unroll
        for (int r = 0; r < 16; ++r) s[r] = br[r] + cb;
        const int key = 32 * kt + q, sw = (key >> 1) & 7;
#pragma unroll
        for (int s4 = 0; s4 < 4; ++s4) { const bf16x8 kf = *(const LAS bf16x8*)(lds + key * 128 + (((2 * s4 + h) ^ sw) << 4)); s = __builtin_amdgcn_mfma_f32_32x32x16_bf16(kf, qf[s4], s, 0, 0, 0); }
        float p[16];
#pragma unroll
        for (int r = 0; r < 16; ++r) { p[r] = __builtin_amdgcn_exp2f(s[r]); if (MASK && kt == nkt - 1 && ((r & 3) + 8 * (r >> 2) + 4 * h > q)) p[r] = 0.f; l += p[r]; }
        bf16x8 pb[2];
#pragma unroll
        for (int s2 = 0; s2 < 2; ++s2) { v4u w; w.x = pk2(p[8 * s2], p[8 * s2 + 1]); w.y = pk2(p[8 * s2 + 2], p[8 * s2 + 3]); w.z = pk2(p[8 * s2 + 4], p[8 * s2 + 5]); w.w = pk2(p[8 * s2 + 6], p[8 * s2 + 7]); pb[s2] = __builtin_bit_cast(bf16x8, w); }
#pragma unroll
        for (int mt = 0; mt < 2; ++mt)
#pragma unroll
            for (int s2 = 0; s2 < 2; ++s2) { const LAS unsigned char* vp = lds + MB_VOFF + (32 * mt + q) * MB_VSTR + (32 * kt + 16 * s2 + 4 * h) * 2;
                const v2u lo = *(const LAS v2u*)vp, hi = *(const LAS v2u*)(vp + 16); const v4u w = {lo.x, lo.y, hi.x, hi.y};
                o[mt] = __builtin_amdgcn_mfma_f32_32x32x16_bf16(__builtin_bit_cast(bf16x8, w), pb[s2], o[mt], 0, 0, 0); }
    }
}
__device__ __forceinline__ void moba_routed(Frame& F, const Args& args) {
    const bf16* QN = wsp<bf16>(F, WS_QN); const int* MLIST = wsp<int>(F, WS_MLIST); const int* MCNT = wsp<int>(F, WS_MCNT);
    float* OP = wsp<float>(F, WS_OP); float* LP = wsp<float>(F, WS_LP);
    const float m0l = moba_m0(F, args) * LOG2E;
    LAS int* utot = (LAS int*)(F.lds + MB_MISC); LAS int* ustart = utot + 512; LAS int* cpre = ustart + 512;
    constexpr int NQ = NBH * (NBK - 1);
    __syncthreads();
    if (F.tid < NQ) { const int bh = F.tid / (NBK - 1), j = F.tid % (NBK - 1); int t = 0; for (int i = j + 1; i < NBK; ++i) t += MCNT[bh * NPAIR + pair_idx(i, j)]; utot[F.tid] = t; }
    __syncthreads();
    if (F.tid == 0) { int a = 0; for (int qq = 0; qq < NQ; ++qq) { ustart[qq] = a; a += (utot[qq] + 255) >> 8; } ustart[NQ] = a; }
    __syncthreads();
    const int nunits = ustart[NQ];
    const int q = F.lane & 31, h = F.lane >> 5;
    for (int un = F.bid; un < nunits; un += F.G) {
        int lo = 0, hi = NQ;
        while (hi - lo > 1) { const int mid = (lo + hi) >> 1; if (ustart[mid] <= un) lo = mid; else hi = mid; }
        const int qq = lo, chunk = un - ustart[qq], bh = qq / (NBK - 1), j = qq % (NBK - 1), b = bh / NH, head = bh % NH, tot = utot[qq];
        __syncthreads();
        if (F.tid == 0) { int a = 0; for (int i = j + 1; i < NBK; ++i) { cpre[i] = a; a += MCNT[bh * NPAIR + pair_idx(i, j)]; } cpre[NBK] = a; }
        moba_load_kv(F, bh, j);
        __syncthreads();
        const int gr = chunk * 256 + F.wave * 32 + q; const bool valid = gr < tot;
        if (__ballot(valid) != 0ull) {
            const int grc = valid ? gr : chunk * 256;
            int i = j + 1; while (cpre[i + 1] <= grc) ++i;
            const int ent = MLIST[((size_t)bh * NPAIR + pair_idx(i, j)) * MBS + (grc - cpre[i])]; const int qo = ent & 255, slot = ent >> 8;
            const int tq = i * MBS + qo; const size_t mq = (size_t)b * SEQ + tq;
            bf16x8 qf[4];
#pragma unroll
            for (int s4 = 0; s4 < 4; ++s4) qf[s4] = *(const bf16x8*)(QN + mq * WM + head * HD + 16 * s4 + 8 * h);
            f32x16 o[2]; float l = 0.f;
#pragma unroll
            for (int r = 0; r < 16; ++r) { o[0][r] = 0.f; o[1][r] = 0.f; }
            const float slope2 = exp2f(-(float)(head + 1)) * LOG2E;
            moba_core<false>(F.lds, qf, o, l, 8, j * MBS + 4 * h - tq, slope2, m0l, q, h);
            l += __shfl_xor(l, 32);
            if (valid) { float* op = OP + ((mq * NH + head) * 3 + slot) * HD;
#pragma unroll
                for (int mt = 0; mt < 2; ++mt)
#pragma unroll
                    for (int g = 0; g < 4; ++g) *(f32x4*)(op + 32 * mt + 8 * g + 4 * h) = (f32x4){o[mt][4 * g], o[mt][4 * g + 1], o[mt][4 * g + 2], o[mt][4 * g + 3]};
                if (h == 0) LP[(mq * NH + head) * 3 + slot] = l; }
        }
    }
}
__device__ __forceinline__ void moba_own(Frame& F, const Args& args) {
    const bf16* QN = wsp<bf16>(F, WS_QN); const float* OP = wsp<float>(F, WS_OP); const float* LP = wsp<float>(F, WS_LP); bf16* MIX = wsp<bf16>(F, WS_MIX);
    const float m0l = moba_m0(F, args) * LOG2E;
    const int q = F.lane & 31, h = F.lane >> 5;
    for (int un = F.bid; un < NBH * NBK; un += F.G) {
        const int bh = un / NBK, i = un % NBK, b = bh / NH, head = bh % NH;
        __syncthreads();
        moba_load_kv(F, bh, i);
        __syncthreads();
        const int qo = F.wave * 32 + q; const size_t mq = (size_t)b * SEQ + i * MBS + qo;
        bf16x8 qf[4];
#pragma unroll
        for (int s4 = 0; s4 < 4; ++s4) qf[s4] = *(const bf16x8*)(QN + mq * WM + head * HD + 16 * s4 + 8 * h);
        f32x16 o[2]; float l = 0.f;
#pragma unroll
        for (int r = 0; r < 16; ++r) { o[0][r] = 0.f; o[1][r] = 0.f; }
        const float slope2 = exp2f(-(float)(head + 1)) * LOG2E;
        moba_core<true>(F.lds, qf, o, l, F.wave + 1, 4 * h - qo, slope2, m0l, q, h);
        l += __shfl_xor(l, 32);
        const int nsel = i < 3 ? i : 3;
        for (int sl = 0; sl < nsel; ++sl) { const float* op = OP + ((mq * NH + head) * 3 + sl) * HD; l += LP[(mq * NH + head) * 3 + sl];
#pragma unroll
            for (int mt = 0; mt < 2; ++mt)
#pragma unroll
                for (int g = 0; g < 4; ++g) { const f32x4 v = *(const f32x4*)(op + 32 * mt + 8 * g + 4 * h); o[mt][4 * g] += v.x; o[mt][4 * g + 1] += v.y; o[mt][4 * g + 2] += v.z; o[mt][4 * g + 3] += v.w; } }
        const float inv = 1.0f / l;
#pragma unroll
        for (int mt = 0; mt < 2; ++mt)
#pragma unroll
            for (int g = 0; g < 4; ++g) *(v2u*)(MIX + mq * D + WM + head * HD + 32 * mt + 8 * g + 4 * h) = (v2u){pk2(o[mt][4 * g] * inv, o[mt][4 * g + 1] * inv), pk2(o[mt][4 * g + 2] * inv, o[mt][4 * g + 3] * inv)};
    }
}


constexpr int ML_STR = 272;
typedef LAS unsigned short* lds_u16p;
__device__ __forceinline__ void mlstm_state(Frame& F) {
    const bf16* U = wsp<bf16>(F, WS_U); const bf16* KM = wsp<bf16>(F, WS_KM); const float* SW = wsp<float>(F, WS_SW); float* DC = wsp<float>(F, WS_DC); float* DN = wsp<float>(F, WS_DN);
    LAS unsigned char* vt = F.lds; LAS unsigned char* kt = F.lds + 64 * ML_STR; LAS float* sw = (LAS float*)(F.lds + 128 * ML_STR);
    const int l15 = F.lane & 15, kq = F.lane >> 4;
    for (int un = F.bid; un < NBH * NCH; un += F.G) {
        const int bh = un / NCH, c = un % NCH, b = bh / NH, head = bh % NH; const size_t m0 = (size_t)b * SEQ + c * LCH;
        __syncthreads();
        if (F.tid < LCH) sw[F.tid] = SW[(size_t)bh * SEQ + c * LCH + F.tid];
#pragma unroll
        for (int k = 0; k < 2; ++k) { const int p = F.tid + NTHR * k, sidx = p >> 3, cc = p & 7;
            const float w = SW[(size_t)bh * SEQ + c * LCH + sidx];
            const v4u kv = *(const v4u*)(KM + (m0 + sidx) * WM + head * HD + 8 * cc), vv = *(const v4u*)(U + (m0 + sidx) * NU + UVM + head * HD + 8 * cc);
            const unsigned kw[4] = {kv.x, kv.y, kv.z, kv.w}, vw[4] = {vv.x, vv.y, vv.z, vv.w};
#pragma unroll
            for (int e = 0; e < 4; ++e) {
                *(lds_u16p)(kt + (8 * cc + 2 * e) * ML_STR + 2 * sidx) = (unsigned short)(kw[e] & 0xffffu); *(lds_u16p)(kt + (8 * cc + 2 * e + 1) * ML_STR + 2 * sidx) = (unsigned short)(kw[e] >> 16);
                const unsigned pw = pk2(w * bflo(vw[e]), w * bfhi(vw[e]));
                *(lds_u16p)(vt + (8 * cc + 2 * e) * ML_STR + 2 * sidx) = (unsigned short)(pw & 0xffffu); *(lds_u16p)(vt + (8 * cc + 2 * e + 1) * ML_STR + 2 * sidx) = (unsigned short)(pw >> 16); } }
        __syncthreads();
#pragma unroll
        for (int tt = 0; tt < 2; ++tt) { const int tile = 2 * F.wave + tt, mt = tile >> 2, nt = tile & 3; f32x4 acc = {0.f, 0.f, 0.f, 0.f};
#pragma unroll
            for (int ks = 0; ks < 4; ++ks) { const bf16x8 av = *(const LAS bf16x8*)(vt + (16 * mt + l15) * ML_STR + (32 * ks + 8 * kq) * 2), bv = *(const LAS bf16x8*)(kt + (16 * nt + l15) * ML_STR + (32 * ks + 8 * kq) * 2);
                acc = __builtin_amdgcn_mfma_f32_16x16x32_bf16(av, bv, acc, 0, 0, 0); }
#pragma unroll
            for (int r = 0; r < 4; ++r) DC[(size_t)un * 4096 + (16 * mt + 4 * kq + r) * HD + 16 * nt + l15] = acc[r]; }
        if (F.tid < HD) { float a = 0.f;
#pragma unroll 8
            for (int sidx = 0; sidx < LCH; ++sidx) a += sw[sidx] * bf2f(*(lds_u16p)(kt + F.tid * ML_STR + 2 * sidx));
            DN[(size_t)un * HD + F.tid] = a; }
    }
}
__device__ __forceinline__ void mlstm_out(Frame& F, const Args& args) {
    const bf16* U = wsp<bf16>(F, WS_U); const bf16* QM = wsp<bf16>(F, WS_QM); const bf16* KM = wsp<bf16>(F, WS_KM);
    const float* SA = wsp<float>(F, WS_SA); const float* SMX = wsp<float>(F, WS_SMX); const float* SB = wsp<float>(F, WS_SB);
    const float* CS = wsp<float>(F, WS_CS); const float* NS = wsp<float>(F, WS_NS); const float* MC = wsp<float>(F, WS_MC); bf16* MIX = wsp<bf16>(F, WS_MIX);
    LAS unsigned char* sp = F.lds; LAS unsigned char* vt = F.lds + LCH * ML_STR;
    const int l15 = F.lane & 15, kq = F.lane >> 4, w = F.wave, t0 = 16 * w;
    for (int un = F.bid; un < NBH * NCH; un += F.G) {
        const int bh = un / NCH, c = un % NCH, b = bh / NH, head = bh % NH; const size_t m0 = (size_t)b * SEQ + c * LCH; const size_t g0 = (size_t)bh * SEQ + c * LCH;
        __syncthreads();
#pragma unroll
        for (int k = 0; k < 2; ++k) { const int p = F.tid + NTHR * k, sidx = p >> 3, cc = p & 7;
            const v4u vv = *(const v4u*)(U + (m0 + sidx) * NU + UVM + head * HD + 8 * cc); const unsigned vw[4] = {vv.x, vv.y, vv.z, vv.w};
#pragma unroll
            for (int e = 0; e < 4; ++e) { *(lds_u16p)(vt + (8 * cc + 2 * e) * ML_STR + 2 * sidx) = (unsigned short)(vw[e] & 0xffffu); *(lds_u16p)(vt + (8 * cc + 2 * e + 1) * ML_STR + 2 * sidx) = (unsigned short)(vw[e] >> 16); } }
        for (int e = F.tid; e < 16 * LCH; e += NTHR) { const int r = e >> 7, sidx = e & 127; *(lds_u16p)(vt + (64 + r) * ML_STR + 2 * sidx) = (unsigned short)(r == 0 ? 0x3F80u : 0u); }
        bf16x8 qa[2];
#pragma unroll
        for (int ks = 0; ks < 2; ++ks) qa[ks] = *(const bf16x8*)(QM + (m0 + t0 + l15) * WM + head * HD + 32 * ks + 8 * kq);
        float mx[4];
#pragma unroll
        for (int r = 0; r < 4; ++r) mx[r] = SMX[g0 + t0 + 4 * kq + r];
        for (int st = 0; st <= w; ++st) {
            bf16x8 kb[2];
#pragma unroll
            for (int ks = 0; ks < 2; ++ks) kb[ks] = *(const bf16x8*)(KM + (m0 + 16 * st + l15) * WM + head * HD + 32 * ks + 8 * kq);
            const float as = SA[g0 + 16 * st + l15];
            f32x4 acc = {0.f, 0.f, 0.f, 0.f};
            acc = __builtin_amdgcn_mfma_f32_16x16x32_bf16(qa[0], kb[0], acc, 0, 0, 0); acc = __builtin_amdgcn_mfma_f32_16x16x32_bf16(qa[1], kb[1], acc, 0, 0, 0);
#pragma unroll
            for (int r = 0; r < 4; ++r) { float v = acc[r] * __expf(as - mx[r]); if (st == w && l15 > 4 * kq + r) v = 0.f;
                *(lds_u16p)(sp + (t0 + 4 * kq + r) * ML_STR + 2 * (16 * st + l15)) = (unsigned short)f2bf(v); }
        }
        if ((w & 1) == 0) {
#pragma unroll
            for (int r = 0; r < 4; ++r) *(lds_u16p)(sp + (t0 + 4 * kq + r) * ML_STR + 2 * (16 * (w + 1) + l15)) = (unsigned short)0; }
        __syncthreads();
        f32x4 a1[5], a2[5];
#pragma unroll
        for (int nt = 0; nt < 5; ++nt) { a1[nt] = (f32x4){0.f, 0.f, 0.f, 0.f}; a2[nt] = (f32x4){0.f, 0.f, 0.f, 0.f}; }
        const int nks = (w + 2) >> 1;
        for (int ks = 0; ks < nks; ++ks) { const bf16x8 av = *(const LAS bf16x8*)(sp + (t0 + l15) * ML_STR + (32 * ks + 8 * kq) * 2);
#pragma unroll
            for (int nt = 0; nt < 5; ++nt) { const bf16x8 bv = *(const LAS bf16x8*)(vt + (16 * nt + l15) * ML_STR + (32 * ks + 8 * kq) * 2); a1[nt] = __builtin_amdgcn_mfma_f32_16x16x32_bf16(av, bv, a1[nt], 0, 0, 0); } }
#pragma unroll
        for (int ks = 0; ks < 2; ++ks)
#pragma unroll
            for (int nt = 0; nt < 5; ++nt) { f32x4 c0, c1;
                if (nt < 4) { const float* cp = CS + (size_t)un * 4096 + (16 * nt + l15) * HD + 32 * ks + 8 * kq; c0 = *(const f32x4*)cp; c1 = *(const f32x4*)(cp + 4); }
                else { const float* np = NS + (size_t)un * HD + 32 * ks + 8 * kq; c0 = *(const f32x4*)np; c1 = *(const f32x4*)(np + 4); if (l15 != 0) { c0 = (f32x4){0.f, 0.f, 0.f, 0.f}; c1 = c0; } }
                const v4u wv = {pk2(c0.x, c0.y), pk2(c0.z, c0.w), pk2(c1.x, c1.y), pk2(c1.z, c1.w)};
                a2[nt] = __builtin_amdgcn_mfma_f32_16x16x32_bf16(qa[ks], __builtin_bit_cast(bf16x8, wv), a2[nt], 0, 0, 0); }
        const float mc = MC[un];
#pragma unroll
        for (int r = 0; r < 4; ++r) { const int t = t0 + 4 * kq + r; const float sc = __expf(mc - mx[r]);
            float den = a1[4][r] + sc * a2[4][r]; den = __shfl(den, F.lane & 48);
            const float dn = fmaxf(fabsf(den), __expf(-(SB[g0 + t] + mx[r]))); const float inv = 1.0f / dn;
            float hv[4], ss = 0.f;
#pragma unroll
            for (int nt = 0; nt < 4; ++nt) { hv[nt] = (a1[nt][r] + sc * a2[nt][r]) * inv; ss += hv[nt] * hv[nt]; }
            ss += __shfl_xor(ss, 1); ss += __shfl_xor(ss, 2); ss += __shfl_xor(ss, 4); ss += __shfl_xor(ss, 8);
            const float rstd = 1.0f / sqrtf(ss * (1.0f / HD) + RMS_EPS);
#pragma unroll
            for (int nt = 0; nt < 4; ++nt) { const int v = 16 * nt + l15; const float og = bf2f(U[(m0 + t) * NU + UOM + head * HD + v]);
                MIX[(m0 + t) * D + head * HD + v] = (bf16)f2bf(hv[nt] * rstd * args.in[8][head * HD + v] * sigmoidf_(og)); } }
    }
}

__device__ __forceinline__ void p_mix_a(Frame& F, const Args& args) {
    const bf16* U = wsp<bf16>(F, WS_U);
    moba_routed(F, args);
    mlstm_state(F);
}

__device__ __forceinline__ void p_mix_b(Frame& F, const Args& args) {
    { const float* DC = wsp<float>(F, WS_DC); const float* DN = wsp<float>(F, WS_DN); float* CS = wsp<float>(F, WS_CS); float* NS = wsp<float>(F, WS_NS); const float* DEC = wsp<float>(F, WS_DEC);
      for (int e = F.bid * NTHR + F.tid; e < NBH * (4096 + HD); e += F.G * NTHR) {
          const int bh = e / (4096 + HD), r = e % (4096 + HD);
          float st = 0.f;
          if (r < 4096) { for (int c = 0; c < NCH; ++c) { const size_t o = ((size_t)bh * NCH + c) * 4096 + r; CS[o] = st; st = DEC[bh * NCH + c] * st + DC[o]; } }
          else { const int k = r - 4096; for (int c = 0; c < NCH; ++c) { const size_t o = ((size_t)bh * NCH + c) * HD + k; NS[o] = st; st = DEC[bh * NCH + c] * st + DN[o]; } }
      } }
    moba_own(F, args);
}

__device__ __forceinline__ void p_mix_c(Frame& F, const Args& args) { mlstm_out(F, args); }

__device__ __forceinline__ void p_router(Frame& F, const Args& args) {
    const bf16* T1 = wsp<bf16>(F, WS_XN); const bf16* WR = wsp<bf16>(F, WS_WR); const float* SS = wsp<float>(F, WS_SS);
    int* SELE = wsp<int>(F, WS_SELE); float* SELW = wsp<float>(F, WS_SELW); float* RSTD = wsp<float>(F, WS_RSTD); int* HIST = wsp<int>(F, WS_HIST);
    LAS int* sh = (LAS int*)F.lds;
    for (int ch = F.bid; ch < 256; ch += F.G) {
        __syncthreads();
        if (F.tid < NE) sh[F.tid] = 0;
        __syncthreads();
        for (int tt = F.wave; tt < 64; tt += NWAVES) {
            const size_t m = (size_t)ch * 64 + tt;
            float ss = 0.f;
#pragma unroll
            for (int q = 0; q < 16; ++q) ss += SS[m * 16 + q];
            const float rstd = 1.0f / sqrtf(ss * (1.0f / D) + RMS_EPS);
            float tv[16];
            { const v4u w0 = *(const v4u*)(T1 + m * D + 16 * F.lane), w1 = *(const v4u*)(T1 + m * D + 16 * F.lane + 8);
              tv[0] = bflo(w0.x); tv[1] = bfhi(w0.x); tv[2] = bflo(w0.y); tv[3] = bfhi(w0.y); tv[4] = bflo(w0.z); tv[5] = bfhi(w0.z); tv[6] = bflo(w0.w); tv[7] = bfhi(w0.w);
              tv[8] = bflo(w1.x); tv[9] = bfhi(w1.x); tv[10] = bflo(w1.y); tv[11] = bfhi(w1.y); tv[12] = bflo(w1.z); tv[13] = bfhi(w1.z); tv[14] = bflo(w1.w); tv[15] = bfhi(w1.w); }
            float mylogit = 0.f;
            for (int e = 0; e < NE; ++e) { const v4u w0 = *(const v4u*)(WR + (size_t)e * D + 16 * F.lane), w1 = *(const v4u*)(WR + (size_t)e * D + 16 * F.lane + 8);
                float a = tv[0] * bflo(w0.x) + tv[1] * bfhi(w0.x) + tv[2] * bflo(w0.y) + tv[3] * bfhi(w0.y) + tv[4] * bflo(w0.z) + tv[5] * bfhi(w0.z) + tv[6] * bflo(w0.w) + tv[7] * bfhi(w0.w)
                        + tv[8] * bflo(w1.x) + tv[9] * bfhi(w1.x) + tv[10] * bflo(w1.y) + tv[11] * bfhi(w1.y) + tv[12] * bflo(w1.z) + tv[13] * bfhi(w1.z) + tv[14] * bflo(w1.w) + tv[15] * bfhi(w1.w);
                a = wave_sum(a); if (F.lane == e) mylogit = a * rstd + args.in[14][e]; }
            float v = F.lane < NE ? mylogit : -INFINITY; int se[4]; float sv[4];
#pragma unroll
            for (int k = 0; k < 4; ++k) { const float mxv = wave_max(v); const unsigned long long mk = __ballot(v == mxv); const int idx = __ffsll((long long)mk) - 1; se[k] = idx; sv[k] = mxv; if (F.lane == idx) v = -INFINITY; }
            const float e0 = 1.0f, e1 = __expf(sv[1] - sv[0]), e2 = __expf(sv[2] - sv[0]), e3 = __expf(sv[3] - sv[0]); const float inv = 1.0f / (e0 + e1 + e2 + e3);
            if (F.lane == 0) { SELE[m * 4 + 0] = se[0]; SELE[m * 4 + 1] = se[1]; SELE[m * 4 + 2] = se[2]; SELE[m * 4 + 3] = se[3];
                SELW[m * 4 + 0] = e0 * inv; SELW[m * 4 + 1] = e1 * inv; SELW[m * 4 + 2] = e2 * inv; SELW[m * 4 + 3] = e3 * inv; RSTD[m] = rstd;
                atomicAdd((int*)&sh[se[0]], 1); atomicAdd((int*)&sh[se[1]], 1); atomicAdd((int*)&sh[se[2]], 1); atomicAdd((int*)&sh[se[3]], 1); }
        }
        __syncthreads();
        if (F.tid < NE) HIST[ch * NE + F.tid] = sh[F.tid];
    }
}
__device__ __forceinline__ void p_lists(Frame& F, const Args& args) {
    const int* SELE = wsp<int>(F, WS_SELE); const float* SELW = wsp<float>(F, WS_SELW); const float* RSTD = wsp<float>(F, WS_RSTD); const int* HIST = wsp<int>(F, WS_HIST);
    int* POS = wsp<int>(F, WS_POS); int* ROWTOK = wsp<int>(F, WS_ROWTOK); float* ROWGATE = wsp<float>(F, WS_ROWGATE); float* ROWRSTD = wsp<float>(F, WS_ROWRSTD); int* TILEE = wsp<int>(F, WS_TILEE);
    LAS int* stot = (LAS int*)F.lds;
    LAS int* soff = stot + 32;
    LAS int* sbase = soff + 40;
    for (int ch = F.bid; ch < 256; ch += F.G) {
        __syncthreads();
        if (F.tid < NE) { int tot = 0, before = 0; for (int w = 0; w < 256; ++w) { const int hv = HIST[w * NE + F.tid]; if (w < ch) before += hv; tot += hv; } stot[F.tid] = tot; sbase[F.tid] = before; }
        __syncthreads();
        if (F.tid == 0) { int o = 0; for (int e = 0; e < NE; ++e) { soff[e] = o; o += (stot[e] + 255) & ~255; } soff[NE] = o; }
        __syncthreads();
        if (F.wave == 0) {
            const size_t m = (size_t)ch * 64 + F.lane; int se[4]; float sw[4];
#pragma unroll
            for (int k = 0; k < 4; ++k) { se[k] = SELE[m * 4 + k]; sw[k] = SELW[m * 4 + k]; }
            const float rs = RSTD[m]; int pos[4] = {0, 0, 0, 0};
            for (int e = 0; e < NE; ++e) { const unsigned long long mk = __ballot(se[0] == e || se[1] == e || se[2] == e || se[3] == e);
                const int rank = __popcll(mk & ((1ull << F.lane) - 1ull)); const int pp = soff[e] + sbase[e] + rank;
#pragma unroll
                for (int k = 0; k < 4; ++k) if (se[k] == e) pos[k] = pp; }
#pragma unroll
            for (int k = 0; k < 4; ++k) { POS[m * 4 + k] = pos[k]; ROWTOK[pos[k]] = (int)m; ROWGATE[pos[k]] = sw[k]; ROWRSTD[pos[k]] = rs; }
        }
        if (ch < NE) { const int e = ch; for (int r = soff[e] + stot[e] + F.tid; r < soff[e + 1]; r += NTHR) { ROWTOK[r] = 0; ROWGATE[r] = 0.f; ROWRSTD[r] = 0.f; } }
        if (ch == 0) { const int nt = soff[NE] >> 8; for (int t = F.tid; t < nt; t += NTHR) { int e = 0; while (soff[e + 1] <= t * 256) ++e; TILEE[t] = e; } if (F.tid == 0) TILEE[MAXTILES] = nt; }
    }
}
__device__ __forceinline__ void p_combine(Frame& F, const Args& args) {
    const float* X1 = wsp<float>(F, WS_X1); const bf16* YS = wsp<bf16>(F, WS_YS); const int* POS = wsp<int>(F, WS_POS); bf16* XN = wsp<bf16>(F, WS_XN);
    const int gw = F.bid * NWAVES + F.wave, NGW = F.G * NWAVES, lane = F.lane;
    for (int m = gw; m < M; m += NGW) {
        f32x4 v[4]; float s = 0.f; int ps[4];
#pragma unroll
        for (int k = 0; k < 4; ++k) ps[k] = POS[(size_t)m * 4 + k];
#pragma unroll
        for (int j = 0; j < 4; ++j) { v[j] = *((const f32x4*)(X1 + (size_t)m * D) + lane + 64 * j);
#pragma unroll
            for (int k = 0; k < 4; ++k) { const v2u w = *(const v2u*)(YS + (size_t)ps[k] * D + 256 * j + 4 * lane); v[j].x += bflo(w.x); v[j].y += bfhi(w.x); v[j].z += bflo(w.y); v[j].w += bfhi(w.y); }
            s += (v[j].x * v[j].x + v[j].y * v[j].y) + (v[j].z * v[j].z + v[j].w * v[j].w);
            *((f32x4*)(F.out + (size_t)m * D) + lane + 64 * j) = v[j]; }
        const float rstd = 1.0f / sqrtf(wave_sum(s) * (1.0f / D) + RMS_EPS);
#pragma unroll
        for (int j = 0; j < 4; ++j) { const f32x4 g = *((const f32x4*)args.in[19] + lane + 64 * j); const f32x4 o = v[j] * rstd * g;
            *(v2u*)(XN + (size_t)m * D + 256 * j + 4 * lane) = (v2u){pk2(o.x, o.y), pk2(o.z, o.w)}; }
    }
}

enum { PH_PRO = 0, PH_INPROJ, PH_PREP, PH_ROUTE, PH_MIXA, PH_MIXB, PH_MIXC, PH_OUTPROJ, PH_ROUTER, PH_LISTS, PH_GU, PH_DN, PH_COMB, PH_PLE, NPH };

__global__ void __launch_bounds__(NTHR, 2) fwd(Args args) {
    extern __shared__ __attribute__((aligned(16))) unsigned char lds[];
    Frame F;
    F.lds = (LAS unsigned char*)lds; F.MISC = (volatile LAS unsigned*)(F.lds + MISC_OFF);
    F.tid = threadIdx.x; F.lane = F.tid & 63; F.wave = __builtin_amdgcn_readfirstlane(F.tid >> 6); F.G = gridDim.x; F.bid = blockIdx.x;
    F.ws = args.ws; F.ctl = (gu32*)(args.ws + WS_CTL); F.out = args.out;

    for (int u = F.tid; u < (LDS_BYTES - RING_BYTES) / 4; u += NTHR) ((LAS unsigned*)(F.lds + RING_BYTES))[u] = 0u;
    __syncthreads();
    XcdBarrier bar; bar.bar = (unsigned*)(F.ctl + CW_BAR); bar.x = 0; bar.st = nullptr;
    if (!MK_PER_PHASE) bar = xcd_barrier_post((unsigned*)(F.ctl + CW_BAR), F.MISC + 8);
    const int lo = args.ph_lo, hi = args.ph_hi;
#ifdef ONLY
#define IN(k) ((k) == ONLY)
#else
#define IN(k) (lo <= (k) && (k) < hi)
#endif
#ifdef USE_SGEMM
#define GEMM(gather, A_, arow_, lda_, Bt_, K_, S_, E_) sgemm_phase(F, A_, arow_, lda_, Bt_, K_, S_, E_)
#else
#define GEMM(gather, A_, arow_, lda_, Bt_, K_, S_, E_) pg8::gemm_phase<decltype(E_), decltype(S_), gather, true>(F.lds, A_, arow_, Bt_, K_, S_, E_)
#endif
#ifndef DUP_PHASE
#define DUP_PHASE -1
#endif
#define NREP(k) ((k) == DUP_PHASE ? 2 : 1)
#define SEAM(k) do { if (IN(k) && IN((k) + 1)) xcd_barrier(bar); } while (0)

    if (IN(PH_PRO)) { for (int rep = 0; rep < NREP(PH_PRO); ++rep) { p0_prologue(F, args); __syncthreads(); } } SEAM(PH_PRO);
    if (IN(PH_INPROJ)) { for (int rep = 0; rep < NREP(PH_INPROJ); ++rep) { StaticOrder S{M / 256, NU / 256, F.G, F.bid}; EpiStoreBf16 E{wsp<bf16>(F, WS_U), NU};
        GEMM(false, wsp<bf16>(F, WS_XN), nullptr, D, wsp<bf16>(F, WS_WIN), D, S, E); } } SEAM(PH_INPROJ);
    if (IN(PH_PREP)) { for (int rep = 0; rep < NREP(PH_PREP); ++rep) { p_prep(F, args); __syncthreads(); } } SEAM(PH_PREP);
    if (IN(PH_ROUTE)) { for (int rep = 0; rep < NREP(PH_ROUTE); ++rep) { p_route(F, args); __syncthreads(); } } SEAM(PH_ROUTE);
    if (IN(PH_MIXA)) { for (int rep = 0; rep < NREP(PH_MIXA); ++rep) { p_mix_a(F, args); __syncthreads(); } } SEAM(PH_MIXA);
    if (IN(PH_MIXB)) { for (int rep = 0; rep < NREP(PH_MIXB); ++rep) { p_mix_b(F, args); __syncthreads(); } } SEAM(PH_MIXB);
    if (IN(PH_MIXC)) { for (int rep = 0; rep < NREP(PH_MIXC); ++rep) { p_mix_c(F, args); __syncthreads(); } } SEAM(PH_MIXC);
    if (IN(PH_OUTPROJ)) { for (int rep = 0; rep < NREP(PH_OUTPROJ); ++rep) { StaticOrder S{M / 256, D / 256, F.G, F.bid}; EpiOutProj E{args.in[0], args.in[12], wsp<float>(F, WS_X1), wsp<bf16>(F, WS_XN), wsp<float>(F, WS_SS)};
        GEMM(false, wsp<bf16>(F, WS_MIX), nullptr, D, wsp<bf16>(F, WS_WOUT), D, S, E); } } SEAM(PH_OUTPROJ);
    if (IN(PH_ROUTER)) { for (int rep = 0; rep < NREP(PH_ROUTER); ++rep) { p_router(F, args); __syncthreads(); } } SEAM(PH_ROUTER);
    if (IN(PH_LISTS)) { for (int rep = 0; rep < NREP(PH_LISTS); ++rep) { p_lists(F, args); __syncthreads(); } } SEAM(PH_LISTS);
    if (IN(PH_GU)) { for (int rep = 0; rep < NREP(PH_GU); ++rep) { GroupedOrder S{wsp<int>(F, WS_TILEE), 8, F.G, F.bid}; EpiGateUp E{wsp<int>(F, WS_TILEE), wsp<float>(F, WS_ROWRSTD), args.in[16], wsp<bf16>(F, WS_ACT)};
        GEMM(true, wsp<bf16>(F, WS_XN), wsp<int>(F, WS_ROWTOK), D, wsp<bf16>(F, WS_WGU), D, S, E); } } SEAM(PH_GU);
    if (IN(PH_DN)) { for (int rep = 0; rep < NREP(PH_DN); ++rep) { GroupedOrder S{wsp<int>(F, WS_TILEE), 4, F.G, F.bid}; EpiDown E{wsp<float>(F, WS_ROWGATE), args.in[18], wsp<bf16>(F, WS_YS)};
        GEMM(false, wsp<bf16>(F, WS_ACT), nullptr, FF, wsp<bf16>(F, WS_WDN), FF, S, E); } } SEAM(PH_DN);
    if (IN(PH_COMB)) { for (int rep = 0; rep < NREP(PH_COMB); ++rep) { p_combine(F, args); __syncthreads(); } } SEAM(PH_COMB);
    if (IN(PH_PLE)) { StaticOrder S{M / 256, D / 256, F.G, F.bid};
        { int kple = PLE; asm volatile("" : "+s"(kple)); EpiStoreBf16 E{wsp<bf16>(F, WS_MIX), D}; GEMM(false, wsp<bf16>(F, WS_PB), nullptr, kple, wsp<bf16>(F, WS_WPP), kple, S, E); }
        { EpiPle E{wsp<bf16>(F, WS_MIX), F.out}; GEMM(false, wsp<bf16>(F, WS_XN), nullptr, D, wsp<bf16>(F, WS_WPG), D, S, E); } }
#undef IN
#undef SEAM
}

extern "C" void kernel_launch(void* const* d_in, const int* in_sizes, int n_in, void* d_out, int out_size, void* d_ws, size_t ws_size, hipStream_t stream) {
    static int grid = 0;
    if (grid == 0) {
        if (n_in != 22 || out_size != M * D || ws_size < WS_END) { fprintf(stderr, "kernel_launch: unexpected problem (n_in %d, out %d, ws %zu); nothing launched\n", n_in, out_size, ws_size); grid = -1; return; }
        int dev = 0, cus = 0, per_cu = 0;
        if (hipGetDevice(&dev) != hipSuccess || hipDeviceGetAttribute(&cus, hipDeviceAttributeMultiprocessorCount, dev) != hipSuccess) { grid = -1; return; }
        if (hipFuncSetAttribute((const void*)fwd, hipFuncAttributeMaxDynamicSharedMemorySize, LDS_BYTES) != hipSuccess) { fprintf(stderr, "kernel_launch: hipFuncSetAttribute failed\n"); grid = -1; return; }
        if (hipOccupancyMaxActiveBlocksPerMultiprocessor(&per_cu, (const void*)fwd, NTHR, LDS_BYTES) != hipSuccess || per_cu < 1) fprintf(stderr, "kernel_launch: occupancy query says %d\n", per_cu);
        (void)hipGetLastError();
        grid = cus;
    }
    if (grid < 0) return;
    if (hipMemsetAsync((char*)d_ws + WS_CTL, 0, CTL_ZERO_BYTES, stream) != hipSuccess) return;
    Args a{};
    for (int i = 0; i < 22; ++i) a.in[i] = (const float*)d_in[i];
    a.out = (float*)d_out; a.ws = (unsigned char*)d_ws; a.li = 0; a.pad = 0;
#if MK_PER_PHASE
    for (int ph = 0; ph < NPH; ++ph) { a.ph_lo = ph; a.ph_hi = ph + 1; hipLaunchKernelGGL(fwd, dim3(grid), dim3(NTHR), LDS_BYTES, stream, a); }
#else
    a.ph_lo = 0; a.ph_hi = NPH; hipLaunchKernelGGL(fwd, dim3(grid), dim3(NTHR), LDS_BYTES, stream, a);
#endif
}
```

```cpp
#include <hip/hip_runtime.h>
#include <cstdio>
#include <cstdint>

#ifndef MK_PER_PHASE
#define MK_PER_PHASE 0
#endif

#define GAS __attribute__((address_space(1)))
#define LAS __attribute__((address_space(3)))
typedef unsigned short bf16;
typedef unsigned v4u __attribute__((ext_vector_type(4)));
typedef unsigned v2u __attribute__((ext_vector_type(2)));
typedef float f32x4 __attribute__((ext_vector_type(4)));
typedef short bf16x8 __attribute__((ext_vector_type(8)));
typedef int v8i __attribute__((ext_vector_type(8)));
typedef GAS unsigned gu32;
#define RLX_AGENT __ATOMIC_RELAXED, __HIP_MEMORY_SCOPE_AGENT
#define LDS_WAIT() asm volatile("s_waitcnt lgkmcnt(0)" ::: "memory")
#define VM_WAIT() asm volatile("s_waitcnt vmcnt(0)" ::: "memory")

constexpr int BATCH = 2, SEQ = 8192, D = 1024, M = BATCH * SEQ;
constexpr int PROJ = 3600, NU = 3584;
constexpr int HD = 64, NH = 8, WM = 512;
constexpr int LCH = 128, NCH = SEQ / LCH;
constexpr int MBS = 256, NBK = SEQ / MBS;
constexpr int NPAIR = NBK * (NBK - 1) / 2;
constexpr int NE = 32, TOPK = 4, FF = 1024, PLE = 256;
constexpr int MAXROWS = M * TOPK + NE * 256, MAXTILES = MAXROWS / 256;
constexpr float RMS_EPS = 1e-6f;
constexpr float SW_LIMIT = 7.0f, SW_ALPHA = 1.702f;
constexpr float LOG2E = 1.4426950408889634f;
constexpr float W8_SCALE = 64.0f, W8_INV = 1.0f / 64.0f;
constexpr int UQM = 0, UKM = 512, UVM = 1024, UOM = 1536, UQB = 2048, UKB = 2560, UVB = 3072;
constexpr int NBH = BATCH * NH;

constexpr size_t MiB = 1u << 20;
constexpr size_t WS_CTL = 0, CTL_ZERO_BYTES = 1 * MiB;
constexpr size_t WS_WIN = 2 * MiB;
constexpr size_t WS_WOUT = 10 * MiB;
constexpr size_t WS_WPG = 12 * MiB;
constexpr size_t WS_WPP = 14 * MiB;
constexpr size_t WS_WR = 15 * MiB;
constexpr size_t WS_WGU = 16 * MiB;
constexpr size_t WS_WDN = 144 * MiB;
constexpr size_t WS_XN = 208 * MiB;
constexpr size_t WS_PB = 240 * MiB;
constexpr size_t WS_GATES = 248 * MiB;
constexpr size_t WS_SA = 249 * MiB;
constexpr size_t WS_SMX = WS_SA + 512 * 1024;
constexpr size_t WS_SB = WS_SMX + 512 * 1024;
constexpr size_t WS_SW = WS_SB + 512 * 1024;
constexpr size_t WS_SMALL = 251 * MiB;
constexpr size_t WS_DEC = WS_SMALL;
constexpr size_t WS_MC = WS_DEC + 4096;
constexpr size_t WS_KMEAN = WS_MC + 4096;
constexpr size_t WS_MCNT = WS_KMEAN + 131072;
constexpr size_t WS_SELE = 252 * MiB;
constexpr size_t WS_SELW = WS_SELE + 262144;
constexpr size_t WS_RSTD = WS_SELW + 262144;
constexpr size_t WS_HIST = WS_RSTD + 65536;
constexpr size_t WS_POS = WS_HIST + 32768;
constexpr size_t WS_ROWTOK = WS_POS + 262144;
constexpr size_t WS_ROWGATE = WS_ROWTOK + 294912;
constexpr size_t WS_ROWRSTD = WS_ROWGATE + 294912;
constexpr size_t WS_TILEE = WS_ROWRSTD + 294912;
constexpr size_t WS_SS = 254 * MiB;
constexpr size_t WS_DN = 255 * MiB;
constexpr size_t WS_NS = WS_DN + 262144;
constexpr size_t WS_U = 260 * MiB;
constexpr size_t WS_QM = 372 * MiB;
constexpr size_t WS_KM = 388 * MiB;
constexpr size_t WS_QN = 404 * MiB;
constexpr size_t WS_KN = 420 * MiB;
constexpr size_t WS_T8 = 404 * MiB;
constexpr size_t WS_VT = 436 * MiB;
constexpr size_t WS_MIX = 452 * MiB;
constexpr size_t WS_X1 = 484 * MiB;
constexpr size_t WS_MLIST = 548 * MiB;
constexpr size_t WS_OP = 556 * MiB;
constexpr size_t WS_LP = 652 * MiB;
constexpr size_t WS_DC = 654 * MiB;
constexpr size_t WS_CS = 670 * MiB;
constexpr size_t WS_ACT = 688 * MiB;
constexpr size_t WS_YS = 260 * MiB;
constexpr size_t WS_END = 832 * MiB;
static_assert(WS_ACT + (size_t)MAXROWS * 1024 * 2 <= WS_END && WS_YS + (size_t)MAXROWS * 1024 * 2 <= WS_QN, "ws map");
constexpr int CW_BAR = 4096;

constexpr int RING_BYTES = 131072;
constexpr int MISC_OFF = RING_BYTES + 320;
constexpr int GSCR_OFF = RING_BYTES + 1024;
constexpr int LDS_BYTES = 147456;
constexpr int NWAVES = 8, NTHR = 512;

typedef float f32x2_t __attribute__((ext_vector_type(2)));
typedef __bf16 bf16x2_t __attribute__((ext_vector_type(2)));
typedef float f32x16 __attribute__((ext_vector_type(16)));
__device__ __forceinline__ unsigned pk2(float lo, float hi) { f32x2_t v = {lo, hi}; bf16x2_t b = __builtin_convertvector(v, bf16x2_t); return __builtin_bit_cast(unsigned, b); }
__device__ __forceinline__ unsigned f2bf(float f) { return pk2(f, 0.f) & 0xffffu; }
__device__ __forceinline__ unsigned pk4f8(float a, float b, float c, float d) { int w = 0; w = __builtin_amdgcn_cvt_pk_fp8_f32(a, b, w, false); w = __builtin_amdgcn_cvt_pk_fp8_f32(c, d, w, true); return (unsigned)w; }
__device__ __forceinline__ float bf2f(unsigned short b) { return __builtin_bit_cast(float, (unsigned)b << 16); }
__device__ __forceinline__ float bflo(unsigned w) { return __builtin_bit_cast(float, w << 16); }
__device__ __forceinline__ float bfhi(unsigned w) { return __builtin_bit_cast(float, w & 0xffff0000u); }
__device__ __forceinline__ float sigmoidf_(float x) { return 1.0f / (1.0f + __expf(-x)); }

#define XB_TMO      128
#define XB_XCNT(j)  (256  + 64 * (j))
#define XB_XSUB(j)  (1280 + 64 * (j))
#define XB_XGEN(j)  (2304 + 64 * (j))
#define XB_TOP      3328
#define XB_TOPGEN   3392
#define XCD_BAR_WORDS 3456
#define XB_SPIN_CAP (1u << 18)
__device__ __forceinline__ unsigned xb_ld(unsigned* p)              { return __hip_atomic_load(p, __ATOMIC_RELAXED, __HIP_MEMORY_SCOPE_AGENT); }
__device__ __forceinline__ unsigned xb_add(unsigned* p, unsigned v) { return __hip_atomic_fetch_add(p, v, __ATOMIC_RELAXED, __HIP_MEMORY_SCOPE_AGENT); }
__device__ __forceinline__ unsigned xb_xcc_id() { return (unsigned)__builtin_amdgcn_s_getreg((3 << 11) | 20) & 0xFu; }
#define XB_SPIN(cond, bar) do { unsigned _sp = 0; while (cond) { __builtin_amdgcn_s_sleep(1); \
    if ((++_sp & 255u) == 0u) { if (xb_ld(&(bar)[XB_TMO])) break; if (_sp > XB_SPIN_CAP) { atomicAdd(&(bar)[XB_TMO], 1u); break; } } } } while (0)
struct XcdBarrier { unsigned* bar; unsigned x; volatile LAS unsigned* st; };
__device__ __forceinline__ XcdBarrier xcd_barrier_post(unsigned* bar, volatile LAS unsigned* st) {
    XcdBarrier b; b.bar = bar; b.x = xb_xcc_id(); b.st = st;
    if (threadIdx.x == 0) (void)xb_add(&bar[XB_XCNT(b.x)], 1u);
    return b;
}
__device__ __forceinline__ void xcd_barrier_complete(unsigned* bar, unsigned x, unsigned& nloc, unsigned& nx) {
    const unsigned G = gridDim.x * gridDim.y * gridDim.z;
    unsigned sum, cnt, mine, sp = 0u;
    for (;;) {
        sum = 0u; cnt = 0u; mine = 0u;
#pragma unroll
        for (unsigned j = 0; j < 16; ++j) { const unsigned c = xb_ld(&bar[XB_XCNT(j)]); sum += c; cnt += (c > 0u) ? 1u : 0u; mine = (j == x) ? c : mine; }
        if (sum == G) break;
        __builtin_amdgcn_s_sleep(1);
        if ((++sp & 255u) == 0u) { if (xb_ld(&bar[XB_TMO])) break; if (sp > XB_SPIN_CAP) { atomicAdd(&bar[XB_TMO], 1u); break; } }
    }
    nloc = mine > 0u ? mine : 1u; nx = cnt > 0u ? cnt : 1u;
}
__device__ __forceinline__ void xcd_barrier(const XcdBarrier& b) {
    asm volatile("s_waitcnt vmcnt(0)" ::: "memory");
    __syncthreads();
    if (threadIdx.x == 0) {
        unsigned* bar = b.bar;
        __builtin_amdgcn_s_waitcnt(0);
        unsigned nloc = b.st[0], nx = b.st[1];
        if (nloc == 0u) { xcd_barrier_complete(bar, b.x, nloc, nx); b.st[0] = nloc; b.st[1] = nx; }
        const unsigned old = xb_add(&bar[XB_XSUB(b.x)], 1u);
        const unsigned gen = old / nloc;
        if (old + 1u == (gen + 1u) * nloc) {
            __builtin_amdgcn_fence(__ATOMIC_RELEASE, "agent");
            asm volatile("s_waitcnt vmcnt(0)" ::: "memory");
            const unsigned og = xb_add(&bar[XB_TOP], 1u);
            const unsigned tg = og / nx;
            if (og + 1u == (tg + 1u) * nx) xb_add(&bar[XB_TOPGEN], 1u);
            else XB_SPIN(xb_ld(&bar[XB_TOPGEN]) == tg, bar);
            __builtin_amdgcn_fence(__ATOMIC_ACQUIRE, "agent");
            xb_add(&bar[XB_XGEN(b.x)], 1u);
            asm volatile("s_waitcnt vmcnt(0)" ::: "memory");
        } else {
            XB_SPIN(xb_ld(&bar[XB_XGEN(b.x)]) == gen, bar);
            __builtin_amdgcn_fence(__ATOMIC_ACQUIRE, "agent");
            asm volatile("s_waitcnt vmcnt(0)" ::: "memory");
        }
    }
    __syncthreads();
}

struct Args { const float* in[22]; float* out; unsigned char* ws; int ph_lo, ph_hi, li, pad; };
struct Frame {
    LAS unsigned char* lds; volatile LAS unsigned* MISC; gu32* ctl;
    int tid, lane, wave, G, bid;
    float* out; unsigned char* ws;
};
template <class T> __device__ __forceinline__ T* wsp(const Frame& F, size_t off) { return (T*)(F.ws + off); }

__device__ __forceinline__ float wave_sum(float v) {
#pragma unroll
    for (int o = 1; o < 64; o <<= 1) v += __shfl_xor(v, o);
    return v;
}
__device__ __forceinline__ float wave_max(float v) {
#pragma unroll
    for (int o = 1; o < 64; o <<= 1) v = fmaxf(v, __shfl_xor(v, o));
    return v;
}

struct Unit { int pm, pn; };
struct StaticOrder {
    int nM, nN, G, c;
    __device__ __forceinline__ bool next(int i, Unit& u) const {
        const int nwg = nM * nN; const int L = i * G + c; if (L >= nwg) return false;
        int wgid = L; { const int q = nwg / 8, r = nwg % 8, xcd = wgid % 8, off = wgid / 8; wgid = (xcd < r ? xcd * (q + 1) : r * (q + 1) + (xcd - r) * q) + off; }
        const int nig = 8 * nN, gid = wgid / nig, fm = gid * 8, gsz = (nM - fm) < 8 ? (nM - fm) : 8;
        u.pm = fm + ((wgid % nig) % gsz); u.pn = (wgid % nig) / gsz; return true;
    }
};
struct GroupedOrder {
    const int* tile_e; int NT, G, c;
    __device__ __forceinline__ bool next(int i, Unit& u) const {
        const int nwg = tile_e[MAXTILES] * NT; const int L0 = i * G + c; if (L0 >= nwg) return false;
        const int q = nwg / 8, r = nwg % 8, xcd = L0 % 8, off = L0 / 8; const int L = (xcd < r ? xcd * (q + 1) : r * (q + 1) + (xcd - r) * q) + off;
        const int t = L / NT, n = L % NT; u.pm = t; u.pn = tile_e[t] * NT + n; return true;
    }
};
__device__ __forceinline__ int perm32(int rho) { const int n = rho >> 4, i = rho & 15; return 8 * (i >> 2) + 4 * n + (i & 3); }

template <class Sched, class Epi>
__device__ __forceinline__ void sgemm_phase(const Frame& F, const bf16* A, const int* arow, int lda, const bf16* Bt, int K, const Sched& S, const Epi& E) {
    const int wid = F.wave, lane = F.lane, wr = wid >> 2, wc = wid & 3, fr = lane & 15, fq = lane >> 4;
    Unit u;
    for (int i = 0; S.next(i, u); ++i) {
        for (int ai = 0; ai < 2; ++ai) {
            f32x4 acc[2][4][2];
#pragma unroll
            for (int bj = 0; bj < 2; ++bj)
#pragma unroll
                for (int m = 0; m < 4; ++m)
#pragma unroll
                    for (int n = 0; n < 2; ++n) acc[bj][m][n] = (f32x4){0.f, 0.f, 0.f, 0.f};
            const bf16* ap[4]; const bf16* bp[2][2];
#pragma unroll
            for (int m = 0; m < 4; ++m) { const int r = u.pm * 256 + ai * 128 + wr * 64 + m * 16 + fr; const int src = arow ? arow[r] : r; ap[m] = A + (size_t)src * lda + fq * 8; }
#pragma unroll
            for (int bj = 0; bj < 2; ++bj)
#pragma unroll
                for (int n = 0; n < 2; ++n) bp[bj][n] = Bt + (size_t)(u.pn * 256 + bj * 128 + wc * 32 + perm32(16 * n + fr)) * K + fq * 8;
            for (int k = 0; k < K; k += 32) {
                bf16x8 af[4], bfr[2][2];
#pragma unroll
                for (int m = 0; m < 4; ++m) af[m] = *(const bf16x8*)(ap[m] + k);
#pragma unroll
                for (int bj = 0; bj < 2; ++bj)
#pragma unroll
                    for (int n = 0; n < 2; ++n) bfr[bj][n] = *(const bf16x8*)(bp[bj][n] + k);
#pragma unroll
                for (int bj = 0; bj < 2; ++bj)
#pragma unroll
                    for (int m = 0; m < 4; ++m)
#pragma unroll
                        for (int n = 0; n < 2; ++n) acc[bj][m][n] = __builtin_amdgcn_mfma_f32_16x16x32_bf16(bfr[bj][n], af[m], acc[bj][m][n], 0, 0, 0);
            }
#pragma unroll
            for (int m = 0; m < 4; ++m) {
                float lo[8], hi[8];
#pragma unroll
                for (int j = 0; j < 4; ++j) { lo[j] = acc[0][m][0][j]; lo[4 + j] = acc[0][m][1][j]; hi[j] = acc[1][m][0][j]; hi[4 + j] = acc[1][m][1][j]; }
                E(u, ai * 128 + wr * 64 + m * 16 + fr, wc * 32 + fq * 8, lo, hi);
            }
        }
    }
}

namespace pg8 {
constexpr int BM = 256, BK = 64, HALF = 128, HTB = HALF * BK * 2, STAGE_BYTES = 8 * HTB;
__device__ __forceinline__ int lds_byte(int r, int c) { const int st = (r >> 4) * 2 + (c >> 5), rr = r & 15, cc = c & 31, ob = rr * 64 + cc * 2; return st * 1024 + (ob ^ (((ob >> 9) & 1) << 5)); }
__device__ __forceinline__ void stage_rc(int b, int& R, int& C) { const int st = b / 1024, sb = b % 1024, swz = sb ^ (((sb >> 9) & 1) << 5); R = (st >> 1) * 16 + swz / 64; C = (st & 1) * 32 + (swz % 64) / 2; }

template <bool FP8>
__device__ __forceinline__ void mma_block(f32x4 (&c)[4][2], const bf16x8 (&At)[4][2], const bf16x8 (&Bq)[2][2]) {
    if constexpr (FP8) {
#pragma unroll
        for (int m = 0; m < 4; ++m)
#pragma unroll
            for (int n = 0; n < 2; ++n) {
                const v4u b0 = __builtin_bit_cast(v4u, Bq[n][0]), b1 = __builtin_bit_cast(v4u, Bq[n][1]), a0 = __builtin_bit_cast(v4u, At[m][0]), a1 = __builtin_bit_cast(v4u, At[m][1]);
                const v8i bw = {(int)b0.x, (int)b0.y, (int)b0.z, (int)b0.w, (int)b1.x, (int)b1.y, (int)b1.z, (int)b1.w}, aw = {(int)a0.x, (int)a0.y, (int)a0.z, (int)a0.w, (int)a1.x, (int)a1.y, (int)a1.z, (int)a1.w};
                c[m][n] = __builtin_amdgcn_mfma_scale_f32_16x16x128_f8f6f4(bw, aw, c[m][n], 0, 0, 0, 0x7F7F7F7F, 0, 0x7F7F7F7F); }
    } else {
#pragma unroll
        for (int m = 0; m < 4; ++m)
#pragma unroll
            for (int n = 0; n < 2; ++n)
#pragma unroll
                for (int k = 0; k < 2; ++k) c[m][n] = __builtin_amdgcn_mfma_f32_16x16x32_bf16(Bq[n][k], At[m][k], c[m][n], 0, 0, 0);
    }
}
template <class Epi, class Sched, bool GATHER, bool ALIGN_EPI, bool FP8>
__device__ __forceinline__ void gemm_phase(LAS unsigned char* lds, const void* A, const int* arow, const void* Bt, const int K, const Sched& S, const Epi& E) {
    const int RB = FP8 ? K : 2 * K;
    const int tid = threadIdx.x, wid = __builtin_amdgcn_readfirstlane(tid >> 6), lane = tid & 63, wr = wid >> 2, wc = wid & 3, fr = lane & 15, fq = lane >> 4;
    const int nt = RB / 128;
    unsigned voffB[2], vA[2][2];
#pragma unroll
    for (int i = 0; i < 2; ++i) { int sR, sC; stage_rc(tid * 16 + i * 8192, sR, sC); const int Rb = (sR & ~31) + perm32(sR & 31);
        voffB[i] = (unsigned)(Rb * RB + sC * 2);
        vA[0][i] = (unsigned)(sR * RB + sC * 2); vA[1][i] = (unsigned)((sR + HALF) * RB + sC * 2); }
    const unsigned kstep = 128u;
    const unsigned hstep = (unsigned)HALF * RB;
    const unsigned r64 = 64u * RB;
    const unsigned tstep = 2 * hstep;
    const __amdgpu_buffer_rsrc_t rA = __builtin_amdgcn_make_buffer_rsrc((void*)A, 0, 0x7fffffff, 0x00020000), rB = __builtin_amdgcn_make_buffer_rsrc((void*)Bt, 0, 0x7fffffff, 0x00020000);
    const unsigned ldsw = (unsigned)wid * 1024u;
    const int aoff = lds_byte(wr * 64 + fr, fq * 8), boff = lds_byte(wc * 32 + fr, fq * 8);
#define PG8_SA(b, h) (((b) * 2 + (h)) * HTB)
#define PG8_SB(b, h) ((4 + (b) * 2 + (h)) * HTB)
#define PG8_STAGE_B(bufoff, so) do { _Pragma("unroll") for (int _i = 0; _i < 2; ++_i) \
        __builtin_amdgcn_raw_ptr_buffer_load_lds(rB, (LAS unsigned*)(lds + (bufoff) + ldsw + _i * 8192), 16, voffB[0], (int)((so) + _i * r64), 0, 0); } while (0)
#define PG8_STAGE_A(bufoff, so, h, nx) do { _Pragma("unroll") for (int _i = 0; _i < 2; ++_i) { if constexpr (GATHER) \
        __builtin_amdgcn_raw_ptr_buffer_load_lds(rA, (LAS unsigned*)(lds + (bufoff) + ldsw + _i * 8192), 16, vA[h][_i], (int)(so), 0, 0); else \
        __builtin_amdgcn_raw_ptr_buffer_load_lds(rA, (LAS unsigned*)(lds + (bufoff) + ldsw + _i * 8192), 16, vA[0][0], (int)((so) + (h) * hstep + _i * r64), 0, 0); } } while (0)
#define PG8_LDA(dst, b, h) do { _Pragma("unroll") for (int m = 0; m < 4; ++m) _Pragma("unroll") for (int k = 0; k < 2; ++k) dst[m][k] = *(const LAS bf16x8*)(lds + PG8_SA(b, h) + aoff + m * 2048 + k * 1024); } while (0)
#define PG8_LDB(dst, b, h) do { _Pragma("unroll") for (int n = 0; n < 2; ++n) _Pragma("unroll") for (int k = 0; k < 2; ++k) dst[n][k] = *(const LAS bf16x8*)(lds + PG8_SB(b, h) + boff + n * 2048 + k * 1024); } while (0)
#define PG8_MMA(ai, bj, At, Bq) do { __builtin_amdgcn_s_setprio(1); mma_block<FP8>(acc[ai][bj], At, Bq); __builtin_amdgcn_s_setprio(0); } while (0)
#define PG8_WAIT_V(n) asm volatile("s_waitcnt vmcnt(" #n ")" ::: "memory")
#define PG8_WAIT_L(n) asm volatile("s_waitcnt lgkmcnt(" #n ")" ::: "memory")
#define PG8_BAR __builtin_amdgcn_s_barrier()
#define PG8_SCHED __builtin_amdgcn_sched_barrier(0)
#define PG8_GOFF(dst, u) do { if (GATHER) { _Pragma("unroll") for (int _h = 0; _h < 2; ++_h) _Pragma("unroll") for (int _i = 0; _i < 2; ++_i) { int _R, _C; stage_rc(tid * 16 + _i * 8192, _R, _C); \
        dst[_h][_i] = (unsigned)(arow[(u).pm * BM + _h * HALF + _R] * RB + _C * 2); } } } while (0)
    LAS v4u* gscr = (LAS v4u*)(lds + GSCR_OFF) + tid;
    Unit cur, nxt; int ui = 0;
    if (!S.next(0, cur)) return;
    PG8_GOFF(vA, cur);
    f32x4 acc[2][2][4][2];
#pragma unroll
    for (int a = 0; a < 2; ++a)
#pragma unroll
        for (int b = 0; b < 2; ++b)
#pragma unroll
            for (int m = 0; m < 4; ++m)
#pragma unroll
                for (int n = 0; n < 2; ++n) acc[a][b][m][n] = (f32x4){0.f, 0.f, 0.f, 0.f};
    bf16x8 At[4][2], B0[2][2], B1[2][2];
    unsigned cA = GATHER ? 0u : (unsigned)cur.pm * tstep, cB = (unsigned)cur.pn * tstep;
    PG8_STAGE_B(PG8_SB(0, 0), cB); PG8_STAGE_B(PG8_SB(0, 1), cB + hstep); PG8_STAGE_A(PG8_SA(0, 0), cA, 0, false); PG8_STAGE_A(PG8_SA(0, 1), cA, 1, false);
    if (wr == 1) PG8_BAR;
    PG8_WAIT_V(2); PG8_BAR;
    PG8_STAGE_B(PG8_SB(1, 0), cB + kstep); PG8_STAGE_A(PG8_SA(1, 0), cA + kstep, 0, false); PG8_STAGE_B(PG8_SB(1, 1), cB + hstep + kstep);
    PG8_WAIT_V(6); PG8_BAR;
    for (;;) {
        const bool has_next = S.next(ui + 1, nxt);
        const unsigned nA = has_next ? (GATHER ? 0u : (unsigned)nxt.pm * tstep) : cA, nB = has_next ? (unsigned)nxt.pn * tstep : cB;
        if (GATHER) { if (has_next) { unsigned nv[2][2]; PG8_GOFF(nv, nxt); *gscr = (v4u){nv[0][0], nv[0][1], nv[1][0], nv[1][1]}; } else *gscr = (v4u){vA[0][0], vA[0][1], vA[1][0], vA[1][1]}; }
#pragma unroll 1
        for (int t = 0; t < nt; t += 2) {
            const bool last = (t == nt - 2);
            const unsigned a1 = cA + (unsigned)(t + 1) * kstep;
            const unsigned a2 = last ? nA : cA + (unsigned)(t + 2) * kstep, b2 = last ? nB : cB + (unsigned)(t + 2) * kstep;
            const unsigned a3 = a2 + kstep, b3 = b2 + kstep;
            PG8_LDB(B0, 0, 0); PG8_LDB(B1, 0, 1); PG8_SCHED; PG8_LDA(At, 0, 0); PG8_STAGE_A(PG8_SA(1, 1), a1, 1, false);
            if (GATHER) { if (last) { const v4u nv = *gscr; vA[0][0] = nv.x; vA[0][1] = nv.y; vA[1][0] = nv.z; vA[1][1] = nv.w; } }
            PG8_WAIT_V(8); PG8_WAIT_L(0); PG8_BAR; PG8_MMA(0, 0, At, B0); PG8_MMA(0, 1, At, B1); PG8_BAR; PG8_SCHED;
            PG8_LDA(At, 0, 1); PG8_STAGE_B(PG8_SB(0, 0), b2); PG8_STAGE_B(PG8_SB(0, 1), b2 + hstep); PG8_STAGE_A(PG8_SA(0, 0), a2, 0, last);
            PG8_WAIT_V(8); PG8_WAIT_L(0); PG8_BAR; PG8_MMA(1, 0, At, B0); PG8_MMA(1, 1, At, B1); PG8_BAR; PG8_SCHED;
            PG8_LDB(B0, 1, 0); PG8_LDB(B1, 1, 1); PG8_SCHED; PG8_LDA(At, 1, 0); PG8_STAGE_A(PG8_SA(0, 1), a2, 1, last);
            PG8_WAIT_V(8); PG8_WAIT_L(0); PG8_BAR; PG8_MMA(0, 0, At, B0); PG8_MMA(0, 1, At, B1); PG8_BAR; PG8_SCHED;
            PG8_LDA(At, 1, 1); PG8_STAGE_B(PG8_SB(1, 0), b3); PG8_STAGE_B(PG8_SB(1, 1), b3 + hstep); PG8_STAGE_A(PG8_SA(1, 0), a3, 0, last);
            PG8_WAIT_V(8); PG8_WAIT_L(0); PG8_BAR; PG8_MMA(1, 0, At, B0); PG8_MMA(1, 1, At, B1); PG8_BAR; PG8_SCHED;
        }
        if constexpr (ALIGN_EPI) { if (wr == 0) PG8_BAR; }
        {
            int fr2 = fr, fq2 = fq; asm volatile("" : "+v"(fr2), "+v"(fq2));
#pragma unroll
            for (int ai = 0; ai < 2; ++ai)
#pragma unroll
                for (int m = 0; m < 4; ++m) { float lo[8], hi[8];
#pragma unroll
                    for (int j = 0; j < 4; ++j) { lo[j] = acc[ai][0][m][0][j]; lo[4 + j] = acc[ai][0][m][1][j]; hi[j] = acc[ai][1][m][0][j]; hi[4 + j] = acc[ai][1][m][1][j]; }
                    E(cur, ai * HALF + wr * 64 + m * 16 + fr2, wc * 32 + fq2 * 8, lo, hi); asm volatile("" ::: "memory"); }
        }
        if (!has_next) break;
#pragma unroll
        for (int a = 0; a < 2; ++a)
#pragma unroll
            for (int b = 0; b < 2; ++b)
#pragma unroll
                for (int m = 0; m < 4; ++m)
#pragma unroll
                    for (int n = 0; n < 2; ++n) acc[a][b][m][n] = (f32x4){0.f, 0.f, 0.f, 0.f};
        cur = nxt; cA = nA; cB = nB; ++ui;
        if constexpr (ALIGN_EPI) { if (wr == 1) PG8_BAR; }
    }
    PG8_WAIT_V(0);
    if constexpr (!ALIGN_EPI) { if (wr == 0) PG8_BAR; }
    PG8_BAR;
#undef PG8_SA
#undef PG8_SB
#undef PG8_STAGE_A
#undef PG8_STAGE_B
#undef PG8_LDA
#undef PG8_LDB
#undef PG8_MMA
#undef PG8_WAIT_V
#undef PG8_WAIT_L
#undef PG8_BAR
#undef PG8_SCHED
#undef PG8_GOFF
}
}
__device__ __forceinline__ void store8bf(bf16* p, const float (&v)[8]) { v4u w; w.x = pk2(v[0], v[1]); w.y = pk2(v[2], v[3]); w.z = pk2(v[4], v[5]); w.w = pk2(v[6], v[7]); *(v4u*)p = w; }

struct EpiStoreBf16 { bf16* O; int ldc;
    __device__ __forceinline__ void operator()(const Unit& u, int r, int c, const float (&lo)[8], const float (&hi)[8]) const {
        bf16* o = O + (size_t)(u.pm * 256 + r) * ldc + u.pn * 256 + c; store8bf(o, lo); store8bf(o + 128, hi); } };
struct EpiOutProj { const float* x; const float* g; float* X1; bf16* T1; float* SS; unsigned char* T8;
    __device__ __forceinline__ void operator()(const Unit& u, int r, int c, const float (&lo)[8], const float (&hi)[8]) const {
        const size_t row = (size_t)u.pm * 256 + r; const int col = u.pn * 256 + c; float ss = 0.f;
#pragma unroll
        for (int h = 0; h < 2; ++h) { const float* v = h ? hi : lo; const int cc = col + h * 128; float o[8], t[8];
#pragma unroll
            for (int j = 0; j < 8; ++j) { o[j] = x[row * D + cc + j] + v[j]; ss += o[j] * o[j]; t[j] = o[j] * g[cc + j]; }
            *(f32x4*)(X1 + row * D + cc) = (f32x4){o[0], o[1], o[2], o[3]}; *(f32x4*)(X1 + row * D + cc + 4) = (f32x4){o[4], o[5], o[6], o[7]};
            store8bf(T1 + row * D + cc, t); *(v2u*)(T8 + row * D + cc) = (v2u){pk4f8(t[0], t[1], t[2], t[3]), pk4f8(t[4], t[5], t[6], t[7])}; }
        ss += __shfl_xor(ss, 16); ss += __shfl_xor(ss, 32);
        if ((threadIdx.x & 63) < 16) SS[row * 16 + u.pn * 4 + (c >> 5)] = ss; } };
struct EpiGateUp { const int* tile_e; const float* rowrstd; const float* b_gu; unsigned char* ACT;
    __device__ __forceinline__ void operator()(const Unit& u, int r, int c, const float (&lo)[8], const float (&hi)[8]) const {
        const int e = u.pn >> 3, nt = u.pn & 7; const size_t row = (size_t)u.pm * 256 + r; const float rs = rowrstd[row] * W8_INV;
        const float* bg = b_gu + (size_t)e * 2048 + nt * 128 + c; float a[8];
#pragma unroll
        for (int j = 0; j < 8; ++j) { float glu = lo[j] * rs + bg[j], lin = hi[j] * rs + bg[1024 + j];
            glu = fminf(glu, SW_LIMIT); lin = fminf(fmaxf(lin, -SW_LIMIT), SW_LIMIT);
            a[j] = glu * sigmoidf_(SW_ALPHA * glu) * (lin + 1.0f); }
        *(v2u*)(ACT + row * FF + nt * 128 + c) = (v2u){pk4f8(a[0], a[1], a[2], a[3]), pk4f8(a[4], a[5], a[6], a[7])}; } };
struct EpiDown { const float* rowgate; const float* b_dn; bf16* YS;
    __device__ __forceinline__ void operator()(const Unit& u, int r, int c, const float (&lo)[8], const float (&hi)[8]) const {
        const int e = u.pn >> 2, nt = u.pn & 3; const size_t row = (size_t)u.pm * 256 + r; const float gt = rowgate[row];
        const float* bd = b_dn + (size_t)e * 1024 + nt * 256 + c; float a[8], b[8];
#pragma unroll
        for (int j = 0; j < 8; ++j) { a[j] = (lo[j] * W8_INV + bd[j]) * gt; b[j] = (hi[j] * W8_INV + bd[128 + j]) * gt; }
        bf16* o = YS + row * D + nt * 256 + c; store8bf(o, a); store8bf(o + 128, b); } };
struct EpiPle { const bf16* PE; float* out;
    __device__ __forceinline__ void operator()(const Unit& u, int r, int c, const float (&lo)[8], const float (&hi)[8]) const {
        const size_t row = (size_t)u.pm * 256 + r; const int col = u.pn * 256 + c;
#pragma unroll
        for (int h = 0; h < 2; ++h) { const float* v = h ? hi : lo; const int cc = col + h * 128; const v4u pe = *(const v4u*)(PE + row * D + cc);
            f32x4 x0 = *(const f32x4*)(out + row * D + cc), x1 = *(const f32x4*)(out + row * D + cc + 4);
            x0[0] += sigmoidf_(v[0]) * bflo(pe.x); x0[1] += sigmoidf_(v[1]) * bfhi(pe.x); x0[2] += sigmoidf_(v[2]) * bflo(pe.y); x0[3] += sigmoidf_(v[3]) * bfhi(pe.y);
            x1[0] += sigmoidf_(v[4]) * bflo(pe.z); x1[1] += sigmoidf_(v[5]) * bfhi(pe.z); x1[2] += sigmoidf_(v[6]) * bflo(pe.w); x1[3] += sigmoidf_(v[7]) * bfhi(pe.w);
            *(f32x4*)(out + row * D + cc) = x0; *(f32x4*)(out + row * D + cc + 4) = x1; } } };

__device__ __forceinline__ void transpose_tile(const float* src, int ldw, bf16* dst, int K, LAS float* scr, int lane) {
    float v[32];
#pragma unroll
    for (int i = 0; i < 32; ++i) v[i] = src[(size_t)(2 * i + (lane >> 5)) * ldw + (lane & 31)];
#pragma unroll
    for (int i = 0; i < 32; ++i) scr[(2 * i + (lane >> 5)) * 33 + (lane & 31)] = v[i];
    LDS_WAIT(); asm volatile("" ::: "memory");
    const int c = lane & 7;
#pragma unroll
    for (int j = 0; j < 4; ++j) { const int n = (lane >> 3) + 8 * j; const LAS float* s = scr + (8 * c) * 33 + n;
        v4u o; o.x = pk2(s[0 * 33], s[1 * 33]); o.y = pk2(s[2 * 33], s[3 * 33]); o.z = pk2(s[4 * 33], s[5 * 33]); o.w = pk2(s[6 * 33], s[7 * 33]);
        *(v4u*)(dst + (size_t)n * K + 8 * c) = o; }
    LDS_WAIT(); asm volatile("" ::: "memory");
}
__device__ __forceinline__ void transpose_tile_f8(const float* src, int ldw, unsigned char* dst, int K, LAS float* scr, int lane) {
    float v[32];
#pragma unroll
    for (int i = 0; i < 32; ++i) v[i] = src[(size_t)(2 * i + (lane >> 5)) * ldw + (lane & 31)];
#pragma unroll
    for (int i = 0; i < 32; ++i) scr[(2 * i + (lane >> 5)) * 33 + (lane & 31)] = v[i];
    LDS_WAIT(); asm volatile("" ::: "memory");
    const int n = lane >> 1, hf = lane & 1; const LAS float* s = scr + (32 * hf) * 33 + n;
    unsigned w[8];
#pragma unroll
    for (int q = 0; q < 8; ++q) w[q] = pk4f8(s[(4 * q) * 33] * W8_SCALE, s[(4 * q + 1) * 33] * W8_SCALE, s[(4 * q + 2) * 33] * W8_SCALE, s[(4 * q + 3) * 33] * W8_SCALE);
    unsigned char* o = dst + (size_t)n * K + 32 * hf;
    *(v4u*)o = (v4u){w[0], w[1], w[2], w[3]}; *(v4u*)(o + 16) = (v4u){w[4], w[5], w[6], w[7]};
    LDS_WAIT(); asm volatile("" ::: "memory");
}
__device__ __forceinline__ void p0_prologue(Frame& F, const Args& args) {
    LAS float* scr = (LAS float*)(F.lds + F.wave * 16384);
    const int gw = F.bid * NWAVES + F.wave, NGW = F.G * NWAVES, lane = F.lane;
    constexpr int I_IN = 16 * (NU / 32), I_SQ = 16 * 32, I_PP = 4 * 32, I_R = 16, I_GU = 16 * 64, I_DN = 16 * 32;
    constexpr int NITEMS = I_IN + 2 * I_SQ + I_PP + I_R + NE * I_GU + NE * I_DN;
    for (int it = gw; it < NITEMS; it += NGW) {
        int r = it; const float* src; bf16* dst; int ldw, K;
        if (r < I_IN) { const int kb = r / (NU / 32), nb = r % (NU / 32), n0 = 32 * nb, sc = n0 < 2048 ? n0 : n0 + 16;
            src = args.in[3] + (size_t)(64 * kb) * PROJ + sc; ldw = PROJ; dst = wsp<bf16>(F, WS_WIN) + (size_t)n0 * D + 64 * kb; K = D; }
        else if ((r -= I_IN) < I_SQ) { const int kb = r / 32, n0 = 32 * (r % 32); src = args.in[11] + (size_t)(64 * kb) * D + n0; ldw = D; dst = wsp<bf16>(F, WS_WOUT) + (size_t)n0 * D + 64 * kb; K = D; }
        else if ((r -= I_SQ) < I_SQ) { const int kb = r / 32, n0 = 32 * (r % 32); src = args.in[20] + (size_t)(64 * kb) * D + n0; ldw = D; dst = wsp<bf16>(F, WS_WPG) + (size_t)n0 * D + 64 * kb; K = D; }
        else if ((r -= I_SQ) < I_PP) { const int kb = r / 32, n0 = 32 * (r % 32); src = args.in[21] + (size_t)(64 * kb) * D + n0; ldw = D; dst = wsp<bf16>(F, WS_WPP) + (size_t)n0 * PLE + 64 * kb; K = PLE; }
        else if ((r -= I_PP) < I_R) { const int kb = r; src = args.in[13] + (size_t)(64 * kb) * NE; ldw = NE; dst = wsp<bf16>(F, WS_WR) + 64 * kb; K = D; }
        else if ((r -= I_R) < NE * I_GU) { const int e = r / I_GU, q = r % I_GU, kb = q / 64, n0 = 32 * (q % 64), pn = n0 >> 8, c = n0 & 255;
            const int sc = c < 128 ? pn * 128 + c : 1024 + pn * 128 + (c - 128);
            transpose_tile_f8(args.in[15] + ((size_t)e * D + 64 * kb) * 2048 + sc, 2048, wsp<unsigned char>(F, WS_WGU) + ((size_t)e * 2048 + n0) * D + 64 * kb, D, scr, lane); continue; }
        else { r -= NE * I_GU; const int e = r / I_DN, q = r % I_DN, kb = q / 32, n0 = 32 * (q % 32);
            transpose_tile_f8(args.in[17] + ((size_t)e * FF + 64 * kb) * D + n0, D, wsp<unsigned char>(F, WS_WDN) + ((size_t)e * D + n0) * FF + 64 * kb, FF, scr, lane); continue; }
        transpose_tile(src, ldw, dst, K, scr, lane);
    }
    __syncthreads();
    { LAS float* slab = (LAS float*)F.lds;
      for (int e = F.tid; e < D * 4; e += NTHR) { const int k = e >> 2, c4 = (e & 3) * 4; const f32x4 w = *(const f32x4*)(args.in[3] + (size_t)k * PROJ + 2048 + c4);
          slab[(c4 + 0) * D + k] = w.x; slab[(c4 + 1) * D + k] = w.y; slab[(c4 + 2) * D + k] = w.z; slab[(c4 + 3) * D + k] = w.w; } }
    __syncthreads();
    bf16* XN = wsp<bf16>(F, WS_XN); float* GT = wsp<float>(F, WS_GATES);
    for (int m = gw; m < M; m += NGW) {
        asm volatile("" ::: "memory");
        const f32x4* xr = (const f32x4*)(args.in[0] + (size_t)m * D) + lane; const f32x4* gr = (const f32x4*)args.in[2] + lane;
        f32x4 v[4]; float s = 0.f;
#pragma unroll
        for (int j = 0; j < 4; ++j) { v[j] = xr[64 * j]; s += (v[j].x * v[j].x + v[j].y * v[j].y) + (v[j].z * v[j].z + v[j].w * v[j].w); }
        const float rstd = 1.0f / sqrtf(wave_sum(s) * (1.0f / D) + RMS_EPS);
#pragma unroll
        for (int j = 0; j < 4; ++j) { const f32x4 g = gr[64 * j]; v[j] = v[j] * rstd * g;
            *(v2u*)(XN + (size_t)m * D + 256 * j + 4 * lane) = (v2u){pk2(v[j].x, v[j].y), pk2(v[j].z, v[j].w)}; }
        float mine = 0.f;
#pragma unroll
        for (int c = 0; c < 16; ++c) { float a = 0.f;
#pragma unroll
            for (int j = 0; j < 4; ++j) { const f32x4 w = *(const LAS f32x4*)((LAS float*)F.lds + c * D + 256 * j + 4 * lane); a += (v[j].x * w.x + v[j].y * w.y) + (v[j].z * w.z + v[j].w * w.w); }
            a = wave_sum(a); if (lane == c) mine = a; }
        if (lane < 16) GT[(size_t)m * 16 + lane] = mine + (lane < 8 ? args.in[6][lane] : args.in[7][lane - 8]);
    }
    bf16* PB = wsp<bf16>(F, WS_PB);
    for (size_t i = (size_t)F.bid * NTHR + F.tid; i < (size_t)M * PLE / 4; i += (size_t)F.G * NTHR) { const f32x4 v = ((const f32x4*)args.in[1])[i]; *(v2u*)(PB + 4 * i) = (v2u){pk2(v.x, v.y), pk2(v.z, v.w)}; }
}

__device__ __forceinline__ float logsigmoidf_(float f) { return f >= 0.f ? -log1pf(__expf(-f)) : f - log1pf(__expf(f)); }
__device__ __forceinline__ void p_prep(Frame& F, const Args& args) {
    const bf16* U = wsp<bf16>(F, WS_U);
    { bf16* QM = wsp<bf16>(F, WS_QM); bf16* KM = wsp<bf16>(F, WS_KM);
      for (size_t i = (size_t)F.bid * NTHR + F.tid; i < (size_t)M * 128; i += (size_t)F.G * NTHR) {
          const int m = (int)(i >> 7), ch = (int)(i & 127) * 8, t = m & (SEQ - 1);
          float y[8];
          { const f32x4 b0 = *(const f32x4*)(args.in[5] + ch), b1 = *(const f32x4*)(args.in[5] + ch + 4); y[0] = b0.x; y[1] = b0.y; y[2] = b0.z; y[3] = b0.w; y[4] = b1.x; y[5] = b1.y; y[6] = b1.z; y[7] = b1.w; }
#pragma unroll
          for (int j = 0; j < 4; ++j) { const int tt = t - 3 + j; if (tt >= 0) { const v4u w = *(const v4u*)(U + (size_t)(m - 3 + j) * NU + ch);
              const f32x4 c0 = *(const f32x4*)(args.in[4] + j * 1024 + ch), c1 = *(const f32x4*)(args.in[4] + j * 1024 + ch + 4);
              y[0] += bflo(w.x) * c0.x; y[1] += bfhi(w.x) * c0.y; y[2] += bflo(w.y) * c0.z; y[3] += bfhi(w.y) * c0.w; y[4] += bflo(w.z) * c1.x; y[5] += bfhi(w.z) * c1.y; y[6] += bflo(w.w) * c1.z; y[7] += bfhi(w.w) * c1.w; } }
          const float sc = ch < 512 ? 0.125f : 1.0f;
#pragma unroll
          for (int e = 0; e < 8; ++e) y[e] = y[e] * sigmoidf_(y[e]) * sc;
          bf16* o = ch < 512 ? QM + (size_t)m * WM + ch : KM + (size_t)m * WM + (ch - 512);
          *(v4u*)o = (v4u){pk2(y[0], y[1]), pk2(y[2], y[3]), pk2(y[4], y[5]), pk2(y[6], y[7])}; } }
    { bf16* KN = wsp<bf16>(F, WS_KN); bf16* VT = wsp<bf16>(F, WS_VT); float* KMEAN = wsp<float>(F, WS_KMEAN);
      LAS float* red = (LAS float*)F.lds;
      LAS unsigned char* vtl = F.lds + 4096;
      for (int un = F.bid; un < NBH * NBK; un += F.G) {
          const int bh = un / NBK, j = un % NBK, b = bh / NH, h = bh % NH;
          const int key = F.tid >> 1, hf = F.tid & 1; const size_t m = (size_t)b * SEQ + j * MBS + key;
          __syncthreads();
          float kv[32]; float ss = 0.f;
#pragma unroll
          for (int i = 0; i < 4; ++i) { const v4u w = *(const v4u*)(U + m * NU + UKB + h * HD + 32 * hf + 8 * i);
              kv[8 * i] = bflo(w.x); kv[8 * i + 1] = bfhi(w.x); kv[8 * i + 2] = bflo(w.y); kv[8 * i + 3] = bfhi(w.y); kv[8 * i + 4] = bflo(w.z); kv[8 * i + 5] = bfhi(w.z); kv[8 * i + 6] = bflo(w.w); kv[8 * i + 7] = bfhi(w.w); }
#pragma unroll
          for (int e = 0; e < 32; ++e) ss += kv[e] * kv[e];
          ss += __shfl_xor(ss, 1);
          const float rstd = 1.0f / sqrtf(ss * (1.0f / HD) + RMS_EPS);
#pragma unroll
          for (int e = 0; e < 32; ++e) kv[e] = kv[e] * rstd * args.in[10][32 * hf + e];
#pragma unroll
          for (int i = 0; i < 4; ++i) *(v4u*)(KN + m * WM + h * HD + 32 * hf + 8 * i) = (v4u){pk2(kv[8 * i], kv[8 * i + 1]), pk2(kv[8 * i + 2], kv[8 * i + 3]), pk2(kv[8 * i + 4], kv[8 * i + 5]), pk2(kv[8 * i + 6], kv[8 * i + 7])};
#pragma unroll
          for (int e = 0; e < 32; ++e) { float a = kv[e]; a += __shfl_xor(a, 2); a += __shfl_xor(a, 4); a += __shfl_xor(a, 8); a += __shfl_xor(a, 16); a += __shfl_xor(a, 32); kv[e] = a; }
          if (F.lane < 2) {
#pragma unroll
              for (int e = 0; e < 32; ++e) red[F.wave * 64 + 32 * hf + e] = kv[e]; }
#pragma unroll
          for (int i = 0; i < 4; ++i) { const v4u w = *(const v4u*)(U + m * NU + UVB + h * HD + 32 * hf + 8 * i); const unsigned ww[4] = {w.x, w.y, w.z, w.w};
#pragma unroll
              for (int e = 0; e < 4; ++e) { *(LAS unsigned short*)(vtl + (32 * hf + 8 * i + 2 * e) * 528 + 2 * key) = (unsigned short)(ww[e] & 0xffffu); *(LAS unsigned short*)(vtl + (32 * hf + 8 * i + 2 * e + 1) * 528 + 2 * key) = (unsigned short)(ww[e] >> 16); } }
          __syncthreads();
          if (F.wave == 0) { float sm = 0.f;
#pragma unroll
              for (int w = 0; w < NWAVES; ++w) sm += red[w * 64 + F.lane];
              KMEAN[(size_t)un * HD + F.lane] = sm * (1.0f / MBS); }
          { const int d = F.tid >> 3, pc = F.tid & 7;
#pragma unroll
            for (int i = 0; i < 4; ++i) *(v4u*)(VT + ((size_t)bh * HD + d) * SEQ + j * MBS + pc * 32 + 8 * i) = *(const LAS v4u*)(vtl + d * 528 + (pc * 32 + 8 * i) * 2); }
      } }
    { const float* GT = wsp<float>(F, WS_GATES); float* SA = wsp<float>(F, WS_SA); float* SMX = wsp<float>(F, WS_SMX); float* SB = wsp<float>(F, WS_SB); float* SW = wsp<float>(F, WS_SW);
      float* DEC = wsp<float>(F, WS_DEC); float* MC = wsp<float>(F, WS_MC);
      LAS float* sbl = (LAS float*)(F.lds + 4096); LAS float* sA = sbl + 64; LAS float* sm = sA + 64;
      for (int bh = F.bid; bh < NBH; bh += F.G) {
          const int b = bh / NH, h = bh % NH;
          __syncthreads();
          for (int c = F.wave; c < NCH; c += NWAVES) {
              const size_t m0 = (size_t)b * SEQ + c * LCH + 2 * F.lane;
              const float i0 = GT[m0 * 16 + h], i1 = GT[(m0 + 1) * 16 + h];
              const float l0 = logsigmoidf_(GT[m0 * 16 + 8 + h]), l1 = logsigmoidf_(GT[(m0 + 1) * 16 + 8 + h]);
              float s = l0 + l1, inc = s;
#pragma unroll
              for (int o = 1; o < 64; o <<= 1) { const float t = __shfl_up(inc, o); if (F.lane >= o) inc += t; }
              const float b0 = (inc - s) + l0, b1 = inc;
              const float a0 = i0 - b0, a1 = i1 - b1;
              float mx = fmaxf(a0, a1), pm = mx;
#pragma unroll
              for (int o = 1; o < 64; o <<= 1) { const float t = __shfl_up(pm, o); if (F.lane >= o) pm = fmaxf(pm, t); }
              float ex = __shfl_up(pm, 1); if (F.lane == 0) ex = -INFINITY;
              const float cm0 = fmaxf(ex, a0), cm1 = fmaxf(cm0, a1);
              const size_t o0 = (size_t)bh * SEQ + c * LCH + 2 * F.lane;
              SA[o0] = a0; SA[o0 + 1] = a1; SB[o0] = b0; SB[o0 + 1] = b1; SMX[o0] = cm0; SMX[o0 + 1] = cm1;
              if (F.lane == 63) { sbl[c] = b1; sA[c] = cm1; }
          }
          __syncthreads();
          if (F.tid == 0) { float m = 0.f; for (int c = 0; c < NCH; ++c) { sm[c] = m; m = sbl[c] + fmaxf(m, sA[c]); } sm[NCH] = m; }
          VM_WAIT(); __syncthreads();
          for (int c = F.wave; c < NCH; c += NWAVES) {
              const float mc = sm[c], mn = sm[c + 1], bL = sbl[c];
              const size_t o0 = (size_t)bh * SEQ + c * LCH + 2 * F.lane;
              const float a0 = SA[o0], a1 = SA[o0 + 1], c0 = SMX[o0], c1 = SMX[o0 + 1];
              SMX[o0] = fmaxf(mc, c0); SMX[o0 + 1] = fmaxf(mc, c1);
              SW[o0] = __expf(bL + a0 - mn); SW[o0 + 1] = __expf(bL + a1 - mn);
              if (F.lane == 0) { DEC[bh * NCH + c] = __expf(bL + mc - mn); MC[bh * NCH + c] = mc; }
          }
      } }
}

__device__ __forceinline__ void mlstm_state(Frame& F);
__device__ __forceinline__ int pair_idx(int i, int j) { return i * (i - 1) / 2 + j; }
__device__ __forceinline__ void p_route(Frame& F, const Args& args) {
    const bf16* U = wsp<bf16>(F, WS_U); bf16* QN = wsp<bf16>(F, WS_QN); const float* KMEAN = wsp<float>(F, WS_KMEAN);
    int* MLIST = wsp<int>(F, WS_MLIST); int* MCNT = wsp<int>(F, WS_MCNT);
    LAS float* skm = (LAS float*)F.lds;
    LAS int* ssel = (LAS int*)(F.lds + 8192);
    LAS int* wtot = (LAS int*)(F.lds + 8192 + 3072);
    for (int un = F.bid; un < NBH * NBK; un += F.G) {
        const int bh = un / NBK, i = un % NBK, b = bh / NH, h = bh % NH;
        __syncthreads();
        for (int e = F.tid; e < NBK * HD; e += NTHR) skm[e] = KMEAN[(size_t)bh * NBK * HD + e];
        __syncthreads();
        int s0 = -1, s1 = -1, s2 = -1;
        if (F.tid < MBS) {
            const size_t m = (size_t)b * SEQ + i * MBS + F.tid;
            float q[HD]; float ss = 0.f;
#pragma unroll
            for (int d8 = 0; d8 < 8; ++d8) { const v4u w = *(const v4u*)(U + m * NU + UQB + h * HD + 8 * d8);
                q[8 * d8 + 0] = bflo(w.x); q[8 * d8 + 1] = bfhi(w.x); q[8 * d8 + 2] = bflo(w.y); q[8 * d8 + 3] = bfhi(w.y);
                q[8 * d8 + 4] = bflo(w.z); q[8 * d8 + 5] = bfhi(w.z); q[8 * d8 + 6] = bflo(w.w); q[8 * d8 + 7] = bfhi(w.w); }
#pragma unroll
            for (int d = 0; d < HD; ++d) ss += q[d] * q[d];
            const float rstd = 1.0f / sqrtf(ss * (1.0f / HD) + RMS_EPS);
#pragma unroll
            for (int d = 0; d < HD; ++d) q[d] = q[d] * rstd * args.in[9][d] * 0.125f;
#pragma unroll
            for (int d8 = 0; d8 < 8; ++d8) { v4u w; w.x = pk2(q[8 * d8] * LOG2E, q[8 * d8 + 1] * LOG2E); w.y = pk2(q[8 * d8 + 2] * LOG2E, q[8 * d8 + 3] * LOG2E); w.z = pk2(q[8 * d8 + 4] * LOG2E, q[8 * d8 + 5] * LOG2E); w.w = pk2(q[8 * d8 + 6] * LOG2E, q[8 * d8 + 7] * LOG2E);
                *(v4u*)(QN + m * WM + h * HD + 8 * d8) = w; }
            float v0 = -INFINITY, v1 = -INFINITY, v2 = -INFINITY;
            for (int j = 0; j < i; ++j) {
                float g = 0.f;
#pragma unroll
                for (int d = 0; d < HD; ++d) g += q[d] * skm[j * HD + d];
                if (g > v0) { v2 = v1; s2 = s1; v1 = v0; s1 = s0; v0 = g; s0 = j; }
                else if (g > v1) { v2 = v1; s2 = s1; v1 = g; s1 = j; }
                else if (g > v2) { v2 = g; s2 = j; }
            }
            ssel[F.tid * 3 + 0] = s0; ssel[F.tid * 3 + 1] = s1; ssel[F.tid * 3 + 2] = s2;
        }
        if (F.wave < 4) { for (int j = 0; j < i; ++j) { const bool f = (s0 == j) || (s1 == j) || (s2 == j); const unsigned long long mk = __ballot(f); if (F.lane == 0) wtot[j * 4 + F.wave] = __popcll(mk); } }
        __syncthreads();
        if (F.wave < 4) { for (int j = 0; j < i; ++j) { const bool f = (s0 == j) || (s1 == j) || (s2 == j); const unsigned long long mk = __ballot(f);
                int base = 0; for (int w = 0; w < F.wave; ++w) base += wtot[j * 4 + w];
                if (f) { const int pos = base + __popcll(mk & ((1ull << F.lane) - 1ull)); const int slot = (s0 == j) ? 0 : ((s1 == j) ? 1 : 2);
                    MLIST[((size_t)bh * NPAIR + pair_idx(i, j)) * MBS + pos] = F.tid | (slot << 8); } } }
        if (F.tid < i) MCNT[bh * NPAIR + pair_idx(i, F.tid)] = wtot[F.tid * 4] + wtot[F.tid * 4 + 1] + wtot[F.tid * 4 + 2] + wtot[F.tid * 4 + 3];
    }    __syncthreads();
    mlstm_state(F);
}

__device__ __forceinline__ float moba_m0(const Frame& F, const Args& args) { return 8.0f * wave_max(fabsf(args.in[9][F.lane])) * wave_max(fabsf(args.in[10][F.lane])); }


constexpr int MB_VOFF = 32768, MB_VSTR = 520, MB_MISC = MB_VOFF + 64 * MB_VSTR;
__device__ __forceinline__ void moba_load_kv(const Frame& F, int bh, int j) {
    const bf16* KN = wsp<bf16>(F, WS_KN); const bf16* VT = wsp<bf16>(F, WS_VT); const int b = bh / NH, head = bh % NH;
#pragma unroll
    for (int k = 0; k < 4; ++k) { const int p = F.tid + NTHR * k, key = p >> 3, c = p & 7;
        const v4u w = *(const v4u*)(KN + ((size_t)b * SEQ + j * MBS + key) * WM + head * HD + c * 8);
        *(LAS v4u*)(F.lds + key * 128 + ((c ^ ((key >> 1) & 7)) << 4)) = w; }
#pragma unroll
    for (int k = 0; k < 4; ++k) { const int p = F.tid + NTHR * k, d = p >> 5, c = p & 31;
        const v4u w = *(const v4u*)(VT + ((size_t)bh * HD + d) * SEQ + j * MBS + c * 8);
        LAS v2u* dst = (LAS v2u*)(F.lds + MB_VOFF + d * MB_VSTR + c * 16); dst[0] = (v2u){w.x, w.y}; dst[1] = (v2u){w.z, w.w}; }
}
template <bool MASK>
__device__ __forceinline__ void moba_core(LAS const unsigned char* lds, const bf16x8 (&qf)[4], f32x16 (&o)[2], float& l, int nkt, int dkey0, float slope2, float m0l, int q, int h) {
    float br[16];
#pragma unroll
    for (int r = 0; r < 16; ++r) br[r] = slope2 * (float)((r & 3) + 8 * (r >> 2)) - m0l;
#pragma unroll 1
    for (int kt = 0; kt < nkt; ++kt) {
        const float cb = slope2 * (float)(dkey0 + 32 * kt);
        f32x16 s;
#pragma unroll
        for (int r = 0; r < 16; ++r) s[r] = br[r] + cb;
        const int key = 32 * kt + q, sw = (key >> 1) & 7;
#pragma unroll
        for (int s4 = 0; s4 < 4; ++s4) { const bf16x8 kf = *(const LAS bf16x8*)(lds + key * 128 + (((2 * s4 + h) ^ sw) << 4)); s = __builtin_amdgcn_mfma_f32_32x32x16_bf16(kf, qf[s4], s, 0, 0, 0); }
        float p[16];
#pragma unroll
        for (int r = 0; r < 16; ++r) { p[r] = __builtin_amdgcn_exp2f(s[r]); if (MASK && kt == nkt - 1 && ((r & 3) + 8 * (r >> 2) + 4 * h > q)) p[r] = 0.f; l += p[r]; }
        bf16x8 pb[2];
#pragma unroll
        for (int s2 = 0; s2 < 2; ++s2) { v4u w; w.x = pk2(p[8 * s2], p[8 * s2 + 1]); w.y = pk2(p[8 * s2 + 2], p[8 * s2 + 3]); w.z = pk2(p[8 * s2 + 4], p[8 * s2 + 5]); w.w = pk2(p[8 * s2 + 6], p[8 * s2 + 7]); pb[s2] = __builtin_bit_cast(bf16x8, w); }
#pragma unroll
        for (int mt = 0; mt < 2; ++mt)
#pragma unroll
            for (int s2 = 0; s2 < 2; ++s2) { const LAS unsigned char* vp = lds + MB_VOFF + (32 * mt + q) * MB_VSTR + (32 * kt + 16 * s2 + 4 * h) * 2;
                const v2u lo = *(const LAS v2u*)vp, hi = *(const LAS v2u*)(vp + 16); const v4u w = {lo.x, lo.y, hi.x, hi.y};
                o[mt] = __builtin_amdgcn_mfma_f32_32x32x16_bf16(__builtin_bit_cast(bf16x8, w), pb[s2], o[mt], 0, 0, 0); }
    }
}
__device__ __forceinline__ void moba_routed(Frame& F, const Args& args) {
    const bf16* QN = wsp<bf16>(F, WS_QN); const int* MLIST = wsp<int>(F, WS_MLIST); const int* MCNT = wsp<int>(F, WS_MCNT);
    float* OP = wsp<float>(F, WS_OP); float* LP = wsp<float>(F, WS_LP);
    const float m0l = moba_m0(F, args) * LOG2E;
    LAS int* utot = (LAS int*)(F.lds + MB_MISC); LAS int* ustart = utot + 512; LAS int* cpre = ustart + 512;
    constexpr int NQ = NBH * (NBK - 1);
    __syncthreads();
    if (F.tid < NQ) { const int bh = F.tid / (NBK - 1), j = F.tid % (NBK - 1); int t = 0; for (int i = j + 1; i < NBK; ++i) t += MCNT[bh * NPAIR + pair_idx(i, j)]; utot[F.tid] = t; }
    __syncthreads();
    if (F.tid == 0) { int a = 0; for (int qq = 0; qq < NQ; ++qq) { ustart[qq] = a; a += (utot[qq] + 255) >> 8; } ustart[NQ] = a; }
    __syncthreads();
    const int nunits = ustart[NQ];
    const int q = F.lane & 31, h = F.lane >> 5;
    for (int un = F.bid; un < nunits; un += F.G) {
        int lo = 0, hi = NQ;
        while (hi - lo > 1) { const int mid = (lo + hi) >> 1; if (ustart[mid] <= un) lo = mid; else hi = mid; }
        const int qq = lo, chunk = un - ustart[qq], bh = qq / (NBK - 1), j = qq % (NBK - 1), b = bh / NH, head = bh % NH, tot = utot[qq];
        __syncthreads();
        if (F.tid == 0) { int a = 0; for (int i = j + 1; i < NBK; ++i) { cpre[i] = a; a += MCNT[bh * NPAIR + pair_idx(i, j)]; } cpre[NBK] = a; }
        moba_load_kv(F, bh, j);
        __syncthreads();
        const int gr = chunk * 256 + F.wave * 32 + q; const bool valid = gr < tot;
        if (__ballot(valid) != 0ull) {
            const int grc = valid ? gr : chunk * 256;
            int i = j + 1; while (cpre[i + 1] <= grc) ++i;
            const int ent = MLIST[((size_t)bh * NPAIR + pair_idx(i, j)) * MBS + (grc - cpre[i])]; const int qo = ent & 255, slot = ent >> 8;
            const int tq = i * MBS + qo; const size_t mq = (size_t)b * SEQ + tq;
            bf16x8 qf[4];
#pragma unroll
            for (int s4 = 0; s4 < 4; ++s4) qf[s4] = *(const bf16x8*)(QN + mq * WM + head * HD + 16 * s4 + 8 * h);
            f32x16 o[2]; float l = 0.f;
#pragma unroll
            for (int r = 0; r < 16; ++r) { o[0][r] = 0.f; o[1][r] = 0.f; }
            const float slope2 = exp2f(-(float)(head + 1)) * LOG2E;
            moba_core<false>(F.lds, qf, o, l, 8, j * MBS + 4 * h - tq, slope2, m0l, q, h);
            l += __shfl_xor(l, 32);
            if (valid) { float* op = OP + ((mq * NH + head) * 3 + slot) * HD;
#pragma unroll
                for (int mt = 0; mt < 2; ++mt)
#pragma unroll
                    for (int g = 0; g < 4; ++g) *(f32x4*)(op + 32 * mt + 8 * g + 4 * h) = (f32x4){o[mt][4 * g], o[mt][4 * g + 1], o[mt][4 * g + 2], o[mt][4 * g + 3]};
                if (h == 0) LP[(mq * NH + head) * 3 + slot] = l; }
        }
    }
}
__device__ __forceinline__ void moba_own(Frame& F, const Args& args) {
    const bf16* QN = wsp<bf16>(F, WS_QN); const float* OP = wsp<float>(F, WS_OP); const float* LP = wsp<float>(F, WS_LP); bf16* MIX = wsp<bf16>(F, WS_MIX);
    const float m0l = moba_m0(F, args) * LOG2E;
    const int q = F.lane & 31, h = F.lane >> 5;
    for (int un = F.bid; un < NBH * NBK; un += F.G) {
        const int bh = un / NBK, i = un % NBK, b = bh / NH, head = bh % NH;
        __syncthreads();
        moba_load_kv(F, bh, i);
        __syncthreads();
        const int qo = F.wave * 32 + q; const size_t mq = (size_t)b * SEQ + i * MBS + qo;
        bf16x8 qf[4];
#pragma unroll
        for (int s4 = 0; s4 < 4; ++s4) qf[s4] = *(const bf16x8*)(QN + mq * WM + head * HD + 16 * s4 + 8 * h);
        f32x16 o[2]; float l = 0.f;
#pragma unroll
        for (int r = 0; r < 16; ++r) { o[0][r] = 0.f; o[1][r] = 0.f; }
        const float slope2 = exp2f(-(float)(head + 1)) * LOG2E;
        moba_core<true>(F.lds, qf, o, l, F.wave + 1, 4 * h - qo, slope2, m0l, q, h);
        l += __shfl_xor(l, 32);
        const int nsel = i < 3 ? i : 3;
        for (int sl = 0; sl < nsel; ++sl) { const float* op = OP + ((mq * NH + head) * 3 + sl) * HD; l += LP[(mq * NH + head) * 3 + sl];
#pragma unroll
            for (int mt = 0; mt < 2; ++mt)
#pragma unroll
                for (int g = 0; g < 4; ++g) { const f32x4 v = *(const f32x4*)(op + 32 * mt + 8 * g + 4 * h); o[mt][4 * g] += v.x; o[mt][4 * g + 1] += v.y; o[mt][4 * g + 2] += v.z; o[mt][4 * g + 3] += v.w; } }
        const float inv = 1.0f / l;
#pragma unroll
        for (int mt = 0; mt < 2; ++mt)
#pragma unroll
            for (int g = 0; g < 4; ++g) *(v2u*)(MIX + mq * D + WM + head * HD + 32 * mt + 8 * g + 4 * h) = (v2u){pk2(o[mt][4 * g] * inv, o[mt][4 * g + 1] * inv), pk2(o[mt][4 * g + 2] * inv, o[mt][4 * g + 3] * inv)};
    }
}


constexpr int ML_STR = 272;
typedef LAS unsigned short* lds_u16p;
__device__ __forceinline__ void mlstm_state(Frame& F) {
    const bf16* U = wsp<bf16>(F, WS_U); const bf16* KM = wsp<bf16>(F, WS_KM); const float* SW = wsp<float>(F, WS_SW); float* DC = wsp<float>(F, WS_DC); float* DN = wsp<float>(F, WS_DN);
    LAS unsigned char* vt = F.lds; LAS unsigned char* kt = F.lds + 64 * ML_STR; LAS float* sw = (LAS float*)(F.lds + 128 * ML_STR);
    const int l15 = F.lane & 15, kq = F.lane >> 4;
    for (int un = F.bid; un < NBH * NCH; un += F.G) {
        const int bh = un / NCH, c = un % NCH, b = bh / NH, head = bh % NH; const size_t m0 = (size_t)b * SEQ + c * LCH;
        __syncthreads();
        if (F.tid < LCH) sw[F.tid] = SW[(size_t)bh * SEQ + c * LCH + F.tid];
#pragma unroll
        for (int k = 0; k < 2; ++k) { const int p = F.tid + NTHR * k, sidx = p >> 3, cc = p & 7;
            const float w = SW[(size_t)bh * SEQ + c * LCH + sidx];
            const v4u kv = *(const v4u*)(KM + (m0 + sidx) * WM + head * HD + 8 * cc), vv = *(const v4u*)(U + (m0 + sidx) * NU + UVM + head * HD + 8 * cc);
            const unsigned kw[4] = {kv.x, kv.y, kv.z, kv.w}, vw[4] = {vv.x, vv.y, vv.z, vv.w};
#pragma unroll
            for (int e = 0; e < 4; ++e) {
                *(lds_u16p)(kt + (8 * cc + 2 * e) * ML_STR + 2 * sidx) = (unsigned short)(kw[e] & 0xffffu); *(lds_u16p)(kt + (8 * cc + 2 * e + 1) * ML_STR + 2 * sidx) = (unsigned short)(kw[e] >> 16);
                const unsigned pw = pk2(w * bflo(vw[e]), w * bfhi(vw[e]));
                *(lds_u16p)(vt + (8 * cc + 2 * e) * ML_STR + 2 * sidx) = (unsigned short)(pw & 0xffffu); *(lds_u16p)(vt + (8 * cc + 2 * e + 1) * ML_STR + 2 * sidx) = (unsigned short)(pw >> 16); } }
        __syncthreads();
#pragma unroll
        for (int tt = 0; tt < 2; ++tt) { const int tile = 2 * F.wave + tt, mt = tile >> 2, nt = tile & 3; f32x4 acc = {0.f, 0.f, 0.f, 0.f};
#pragma unroll
            for (int ks = 0; ks < 4; ++ks) { const bf16x8 av = *(const LAS bf16x8*)(vt + (16 * mt + l15) * ML_STR + (32 * ks + 8 * kq) * 2), bv = *(const LAS bf16x8*)(kt + (16 * nt + l15) * ML_STR + (32 * ks + 8 * kq) * 2);
                acc = __builtin_amdgcn_mfma_f32_16x16x32_bf16(av, bv, acc, 0, 0, 0); }
#pragma unroll
            for (int r = 0; r < 4; ++r) DC[(size_t)un * 4096 + (16 * mt + 4 * kq + r) * HD + 16 * nt + l15] = acc[r]; }
        if (F.tid < HD) { float a = 0.f;
#pragma unroll 8
            for (int sidx = 0; sidx < LCH; ++sidx) a += sw[sidx] * bf2f(*(lds_u16p)(kt + F.tid * ML_STR + 2 * sidx));
            DN[(size_t)un * HD + F.tid] = a; }
    }
}
__device__ __forceinline__ void mlstm_out(Frame& F, const Args& args) {
    const bf16* U = wsp<bf16>(F, WS_U); const bf16* QM = wsp<bf16>(F, WS_QM); const bf16* KM = wsp<bf16>(F, WS_KM);
    const float* SA = wsp<float>(F, WS_SA); const float* SMX = wsp<float>(F, WS_SMX); const float* SB = wsp<float>(F, WS_SB);
    const float* CS = wsp<float>(F, WS_CS); const float* NS = wsp<float>(F, WS_NS); const float* MC = wsp<float>(F, WS_MC); bf16* MIX = wsp<bf16>(F, WS_MIX);
    LAS unsigned char* sp = F.lds; LAS unsigned char* vt = F.lds + LCH * ML_STR;
    const int l15 = F.lane & 15, kq = F.lane >> 4, w = F.wave, t0 = 16 * w;
    for (int un = F.bid; un < NBH * NCH; un += F.G) {
        const int bh = un / NCH, c = un % NCH, b = bh / NH, head = bh % NH; const size_t m0 = (size_t)b * SEQ + c * LCH; const size_t g0 = (size_t)bh * SEQ + c * LCH;
        __syncthreads();
#pragma unroll
        for (int k = 0; k < 2; ++k) { const int p = F.tid + NTHR * k, sidx = p >> 3, cc = p & 7;
            const v4u vv = *(const v4u*)(U + (m0 + sidx) * NU + UVM + head * HD + 8 * cc); const unsigned vw[4] = {vv.x, vv.y, vv.z, vv.w};
#pragma unroll
            for (int e = 0; e < 4; ++e) { *(lds_u16p)(vt + (8 * cc + 2 * e) * ML_STR + 2 * sidx) = (unsigned short)(vw[e] & 0xffffu); *(lds_u16p)(vt + (8 * cc + 2 * e + 1) * ML_STR + 2 * sidx) = (unsigned short)(vw[e] >> 16); } }
        for (int e = F.tid; e < 16 * LCH; e += NTHR) { const int r = e >> 7, sidx = e & 127; *(lds_u16p)(vt + (64 + r) * ML_STR + 2 * sidx) = (unsigned short)(r == 0 ? 0x3F80u : 0u); }
        bf16x8 qa[2];
#pragma unroll
        for (int ks = 0; ks < 2; ++ks) qa[ks] = *(const bf16x8*)(QM + (m0 + t0 + l15) * WM + head * HD + 32 * ks + 8 * kq);
        float mx[4];
#pragma unroll
        for (int r = 0; r < 4; ++r) mx[r] = SMX[g0 + t0 + 4 * kq + r];
        for (int st = 0; st <= w; ++st) {
            bf16x8 kb[2];
#pragma unroll
            for (int ks = 0; ks < 2; ++ks) kb[ks] = *(const bf16x8*)(KM + (m0 + 16 * st + l15) * WM + head * HD + 32 * ks + 8 * kq);
            const float as = SA[g0 + 16 * st + l15];
            f32x4 acc = {0.f, 0.f, 0.f, 0.f};
            acc = __builtin_amdgcn_mfma_f32_16x16x32_bf16(qa[0], kb[0], acc, 0, 0, 0); acc = __builtin_amdgcn_mfma_f32_16x16x32_bf16(qa[1], kb[1], acc, 0, 0, 0);
#pragma unroll
            for (int r = 0; r < 4; ++r) { float v = acc[r] * __expf(as - mx[r]); if (st == w && l15 > 4 * kq + r) v = 0.f;
                *(lds_u16p)(sp + (t0 + 4 * kq + r) * ML_STR + 2 * (16 * st + l15)) = (unsigned short)f2bf(v); }
        }
        if ((w & 1) == 0) {
#pragma unroll
            for (int r = 0; r < 4; ++r) *(lds_u16p)(sp + (t0 + 4 * kq + r) * ML_STR + 2 * (16 * (w + 1) + l15)) = (unsigned short)0; }
        __syncthreads();
        f32x4 a1[5], a2[5];
#pragma unroll
        for (int nt = 0; nt < 5; ++nt) { a1[nt] = (f32x4){0.f, 0.f, 0.f, 0.f}; a2[nt] = (f32x4){0.f, 0.f, 0.f, 0.f}; }
        const int nks = (w + 2) >> 1;
        for (int ks = 0; ks < nks; ++ks) { const bf16x8 av = *(const LAS bf16x8*)(sp + (t0 + l15) * ML_STR + (32 * ks + 8 * kq) * 2);
#pragma unroll
            for (int nt = 0; nt < 5; ++nt) { const bf16x8 bv = *(const LAS bf16x8*)(vt + (16 * nt + l15) * ML_STR + (32 * ks + 8 * kq) * 2); a1[nt] = __builtin_amdgcn_mfma_f32_16x16x32_bf16(av, bv, a1[nt], 0, 0, 0); } }
#pragma unroll
        for (int ks = 0; ks < 2; ++ks)
#pragma unroll
            for (int nt = 0; nt < 5; ++nt) { f32x4 c0, c1;
                if (nt < 4) { const float* cp = CS + (size_t)un * 4096 + (16 * nt + l15) * HD + 32 * ks + 8 * kq; c0 = *(const f32x4*)cp; c1 = *(const f32x4*)(cp + 4); }
                else { const float* np = NS + (size_t)un * HD + 32 * ks + 8 * kq; c0 = *(const f32x4*)np; c1 = *(const f32x4*)(np + 4); if (l15 != 0) { c0 = (f32x4){0.f, 0.f, 0.f, 0.f}; c1 = c0; } }
                const v4u wv = {pk2(c0.x, c0.y), pk2(c0.z, c0.w), pk2(c1.x, c1.y), pk2(c1.z, c1.w)};
                a2[nt] = __builtin_amdgcn_mfma_f32_16x16x32_bf16(qa[ks], __builtin_bit_cast(bf16x8, wv), a2[nt], 0, 0, 0); }
        const float mc = MC[un];
#pragma unroll
        for (int r = 0; r < 4; ++r) { const int t = t0 + 4 * kq + r; const float sc = __expf(mc - mx[r]);
            float den = a1[4][r] + sc * a2[4][r]; den = __shfl(den, F.lane & 48);
            const float dn = fmaxf(fabsf(den), __expf(-(SB[g0 + t] + mx[r]))); const float inv = 1.0f / dn;
            float hv[4], ss = 0.f;
#pragma unroll
            for (int nt = 0; nt < 4; ++nt) { hv[nt] = (a1[nt][r] + sc * a2[nt][r]) * inv; ss += hv[nt] * hv[nt]; }
            ss += __shfl_xor(ss, 1); ss += __shfl_xor(ss, 2); ss += __shfl_xor(ss, 4); ss += __shfl_xor(ss, 8);
            const float rstd = 1.0f / sqrtf(ss * (1.0f / HD) + RMS_EPS);
#pragma unroll
            for (int nt = 0; nt < 4; ++nt) { const int v = 16 * nt + l15; const float og = bf2f(U[(m0 + t) * NU + UOM + head * HD + v]);
                MIX[(m0 + t) * D + head * HD + v] = (bf16)f2bf(hv[nt] * rstd * args.in[8][head * HD + v] * sigmoidf_(og)); } }
    }
}

__device__ __forceinline__ void mlstm_scan(Frame& F) {
    const float* DC = wsp<float>(F, WS_DC); const float* DN = wsp<float>(F, WS_DN); float* CS = wsp<float>(F, WS_CS); float* NS = wsp<float>(F, WS_NS); const float* DEC = wsp<float>(F, WS_DEC);
    constexpr int TOT = NBH * (4096 + HD); const int per = (TOT + F.G - 1) / F.G;
    for (int q = F.tid; q < per; q += NTHR) { const int e = F.bid * per + q; if (e >= TOT) break;
        const int bh = e / (4096 + HD), r = e % (4096 + HD);
        const float* src = r < 4096 ? DC + (size_t)bh * NCH * 4096 + r : DN + (size_t)bh * NCH * HD + (r - 4096);
        float* dst = r < 4096 ? CS + (size_t)bh * NCH * 4096 + r : NS + (size_t)bh * NCH * HD + (r - 4096);
        const size_t str = r < 4096 ? 4096 : HD;
        float st = 0.f;
#pragma unroll 1
        for (int c0 = 0; c0 < NCH; c0 += 8) { float d[8], g[8];
#pragma unroll
            for (int i = 0; i < 8; ++i) { d[i] = src[(size_t)(c0 + i) * str]; g[i] = DEC[bh * NCH + c0 + i]; }
#pragma unroll
            for (int i = 0; i < 8; ++i) { dst[(size_t)(c0 + i) * str] = st; st = g[i] * st + d[i]; } }
    }
}

__device__ __forceinline__ void p_mix_a(Frame& F, const Args& args) {
    const bf16* U = wsp<bf16>(F, WS_U);
    moba_routed(F, args);
    mlstm_scan(F);
}

__device__ __forceinline__ void p_mix_b(Frame& F, const Args& args) {
    moba_own(F, args);
    __syncthreads();
    mlstm_out(F, args);
}

__device__ __forceinline__ void p_router(Frame& F, const Args& args) {
    const bf16* T1 = wsp<bf16>(F, WS_XN); const bf16* WR = wsp<bf16>(F, WS_WR); const float* SS = wsp<float>(F, WS_SS);
    int* SELE = wsp<int>(F, WS_SELE); float* SELW = wsp<float>(F, WS_SELW); float* RSTD = wsp<float>(F, WS_RSTD); int* HIST = wsp<int>(F, WS_HIST);
    LAS float* part = (LAS float*)F.lds;
    LAS int* sh = (LAS int*)(F.lds + 2 * 64 * 33 * 4);
    const int l15 = F.lane & 15, kq = F.lane >> 4, tile = F.wave & 3, kh = F.wave >> 2;
    for (int ch = F.bid; ch < 256; ch += F.G) {
        __syncthreads();
        if (F.tid < NE) sh[F.tid] = 0;
        f32x4 acc[2] = {{0.f, 0.f, 0.f, 0.f}, {0.f, 0.f, 0.f, 0.f}};
        const bf16* ap = T1 + ((size_t)ch * 64 + 16 * tile + l15) * D + 512 * kh + 8 * kq; const bf16* bp = WR + (size_t)l15 * D + 512 * kh + 8 * kq;
#pragma unroll 4
        for (int ks = 0; ks < 16; ++ks) { const bf16x8 av = *(const bf16x8*)(ap + 32 * ks), b0 = *(const bf16x8*)(bp + 32 * ks), b1 = *(const bf16x8*)(bp + 16 * D + 32 * ks);
            acc[0] = __builtin_amdgcn_mfma_f32_16x16x32_bf16(av, b0, acc[0], 0, 0, 0); acc[1] = __builtin_amdgcn_mfma_f32_16x16x32_bf16(av, b1, acc[1], 0, 0, 0); }
#pragma unroll
        for (int nt = 0; nt < 2; ++nt)
#pragma unroll
            for (int r = 0; r < 4; ++r) part[(kh * 64 + 16 * tile + 4 * kq + r) * 33 + 16 * nt + l15] = acc[nt][r];
        __syncthreads();
        if (F.tid < 64) {
            const size_t m = (size_t)ch * 64 + F.tid; float ss = 0.f;
#pragma unroll
            for (int q = 0; q < 16; ++q) ss += SS[m * 16 + q];
            const float rstd = 1.0f / sqrtf(ss * (1.0f / D) + RMS_EPS);
            float v0 = -INFINITY, v1 = -INFINITY, v2 = -INFINITY, v3 = -INFINITY; int s0 = 0, s1 = 0, s2 = 0, s3 = 0;
            for (int e = 0; e < NE; ++e) { const float g = (part[F.tid * 33 + e] + part[(64 + F.tid) * 33 + e]) * rstd + args.in[14][e];
                if (g > v0) { v3 = v2; s3 = s2; v2 = v1; s2 = s1; v1 = v0; s1 = s0; v0 = g; s0 = e; }
                else if (g > v1) { v3 = v2; s3 = s2; v2 = v1; s2 = s1; v1 = g; s1 = e; }
                else if (g > v2) { v3 = v2; s3 = s2; v2 = g; s2 = e; }
                else if (g > v3) { v3 = g; s3 = e; } }
            const float e1 = __expf(v1 - v0), e2 = __expf(v2 - v0), e3 = __expf(v3 - v0); const float inv = 1.0f / (1.0f + e1 + e2 + e3);
            *(int4*)(SELE + m * 4) = make_int4(s0, s1, s2, s3); *(f32x4*)(SELW + m * 4) = (f32x4){inv, e1 * inv, e2 * inv, e3 * inv}; RSTD[m] = rstd;
            atomicAdd((int*)&sh[s0], 1); atomicAdd((int*)&sh[s1], 1); atomicAdd((int*)&sh[s2], 1); atomicAdd((int*)&sh[s3], 1);
        }
        __syncthreads();
        if (F.tid < NE) HIST[ch * NE + F.tid] = sh[F.tid];
    }
}
__device__ __forceinline__ void p_lists(Frame& F, const Args& args) {
    const int* SELE = wsp<int>(F, WS_SELE); const float* SELW = wsp<float>(F, WS_SELW); const float* RSTD = wsp<float>(F, WS_RSTD); const int* HIST = wsp<int>(F, WS_HIST);
    int* POS = wsp<int>(F, WS_POS); int* ROWTOK = wsp<int>(F, WS_ROWTOK); float* ROWGATE = wsp<float>(F, WS_ROWGATE); float* ROWRSTD = wsp<float>(F, WS_ROWRSTD); int* TILEE = wsp<int>(F, WS_TILEE);
    LAS int* stot = (LAS int*)F.lds;
    LAS int* soff = stot + 32;
    LAS int* sbase = soff + 40;
    for (int ch = F.bid; ch < 256; ch += F.G) {
        __syncthreads();
        if (F.tid < NE) { int tot = 0, before = 0; for (int w = 0; w < 256; ++w) { const int hv = HIST[w * NE + F.tid]; if (w < ch) before += hv; tot += hv; } stot[F.tid] = tot; sbase[F.tid] = before; }
        __syncthreads();
        if (F.tid == 0) { int o = 0; for (int e = 0; e < NE; ++e) { soff[e] = o; o += (stot[e] + 255) & ~255; } soff[NE] = o; }
        __syncthreads();
        if (F.wave == 0) {
            const size_t m = (size_t)ch * 64 + F.lane; int se[4]; float sw[4];
#pragma unroll
            for (int k = 0; k < 4; ++k) { se[k] = SELE[m * 4 + k]; sw[k] = SELW[m * 4 + k]; }
            const float rs = RSTD[m]; int pos[4] = {0, 0, 0, 0};
            for (int e = 0; e < NE; ++e) { const unsigned long long mk = __ballot(se[0] == e || se[1] == e || se[2] == e || se[3] == e);
                const int rank = __popcll(mk & ((1ull << F.lane) - 1ull)); const int pp = soff[e] + sbase[e] + rank;
#pragma unroll
                for (int k = 0; k < 4; ++k) if (se[k] == e) pos[k] = pp; }
#pragma unroll
            for (int k = 0; k < 4; ++k) { POS[m * 4 + k] = pos[k]; ROWTOK[pos[k]] = (int)m; ROWGATE[pos[k]] = sw[k]; ROWRSTD[pos[k]] = rs; }
        }
        if (ch < NE) { const int e = ch; for (int r = soff[e] + stot[e] + F.tid; r < soff[e + 1]; r += NTHR) { ROWTOK[r] = 0; ROWGATE[r] = 0.f; ROWRSTD[r] = 0.f; } }
        if (ch == 0) { const int nt = soff[NE] >> 8; for (int t = F.tid; t < nt; t += NTHR) { int e = 0; while (soff[e + 1] <= t * 256) ++e; TILEE[t] = e; } if (F.tid == 0) TILEE[MAXTILES] = nt; }
    }
}
__device__ __forceinline__ void p_combine(Frame& F, const Args& args) {
    const float* X1 = wsp<float>(F, WS_X1); const bf16* YS = wsp<bf16>(F, WS_YS); const int* POS = wsp<int>(F, WS_POS); bf16* XN = wsp<bf16>(F, WS_XN);
    const int gw = F.bid * NWAVES + F.wave, NGW = F.G * NWAVES, lane = F.lane;
    for (int m = gw; m < M; m += NGW) {
        f32x4 v[4]; float s = 0.f; int ps[4];
#pragma unroll
        for (int k = 0; k < 4; ++k) ps[k] = POS[(size_t)m * 4 + k];
#pragma unroll
        for (int j = 0; j < 4; ++j) { v[j] = *((const f32x4*)(X1 + (size_t)m * D) + lane + 64 * j);
#pragma unroll
            for (int k = 0; k < 4; ++k) { const v2u w = *(const v2u*)(YS + (size_t)ps[k] * D + 256 * j + 4 * lane); v[j].x += bflo(w.x); v[j].y += bfhi(w.x); v[j].z += bflo(w.y); v[j].w += bfhi(w.y); }
            s += (v[j].x * v[j].x + v[j].y * v[j].y) + (v[j].z * v[j].z + v[j].w * v[j].w);
            *((f32x4*)(F.out + (size_t)m * D) + lane + 64 * j) = v[j]; }
        const float rstd = 1.0f / sqrtf(wave_sum(s) * (1.0f / D) + RMS_EPS);
#pragma unroll
        for (int j = 0; j < 4; ++j) { const f32x4 g = *((const f32x4*)args.in[19] + lane + 64 * j); const f32x4 o = v[j] * rstd * g;
            *(v2u*)(XN + (size_t)m * D + 256 * j + 4 * lane) = (v2u){pk2(o.x, o.y), pk2(o.z, o.w)}; }
    }
}

enum { PH_PRO = 0, PH_INPROJ, PH_PREP, PH_ROUTE, PH_MIXA, PH_MIXB, PH_OUTPROJ, PH_ROUTER, PH_LISTS, PH_GU, PH_DN, PH_COMB, PH_PLE, NPH };

__global__ void __launch_bounds__(NTHR, 2) fwd(Args args) {
    extern __shared__ __attribute__((aligned(16))) unsigned char lds[];
    Frame F;
    F.lds = (LAS unsigned char*)lds; F.MISC = (volatile LAS unsigned*)(F.lds + MISC_OFF);
    F.tid = threadIdx.x; F.lane = F.tid & 63; F.wave = __builtin_amdgcn_readfirstlane(F.tid >> 6); F.G = gridDim.x; F.bid = blockIdx.x;
    F.ws = args.ws; F.ctl = (gu32*)(args.ws + WS_CTL); F.out = args.out;

    for (int u = F.tid; u < (LDS_BYTES - RING_BYTES) / 4; u += NTHR) ((LAS unsigned*)(F.lds + RING_BYTES))[u] = 0u;
    __syncthreads();
    XcdBarrier bar; bar.bar = (unsigned*)(F.ctl + CW_BAR); bar.x = 0; bar.st = nullptr;
    if (!MK_PER_PHASE) bar = xcd_barrier_post((unsigned*)(F.ctl + CW_BAR), F.MISC + 8);
    const int lo = args.ph_lo, hi = args.ph_hi;
#ifdef ONLY
#define IN(k) ((k) == ONLY)
#else
#define IN(k) (lo <= (k) && (k) < hi)
#endif
#ifdef USE_SGEMM
#define GEMM(gather, A_, arow_, lda_, Bt_, K_, S_, E_) sgemm_phase(F, A_, arow_, lda_, Bt_, K_, S_, E_)
#else
#define GEMM(gather, A_, arow_, lda_, Bt_, K_, S_, E_) pg8::gemm_phase<decltype(E_), decltype(S_), gather, true, false>(F.lds, A_, arow_, Bt_, K_, S_, E_)
#define GEMM8(gather, A_, arow_, Bt_, K_, S_, E_) pg8::gemm_phase<decltype(E_), decltype(S_), gather, true, true>(F.lds, A_, arow_, Bt_, K_, S_, E_)
#endif
#ifndef DUP_PHASE
#define DUP_PHASE -1
#endif
#define NREP(k) ((k) == DUP_PHASE ? 2 : 1)
#define SEAM(k) do { if (IN(k) && IN((k) + 1)) xcd_barrier(bar); } while (0)

    if (IN(PH_PRO)) { for (int rep = 0; rep < NREP(PH_PRO); ++rep) { p0_prologue(F, args); __syncthreads(); } } SEAM(PH_PRO);
    if (IN(PH_INPROJ)) { for (int rep = 0; rep < NREP(PH_INPROJ); ++rep) { StaticOrder S{M / 256, NU / 256, F.G, F.bid}; EpiStoreBf16 E{wsp<bf16>(F, WS_U), NU};
        GEMM(false, wsp<bf16>(F, WS_XN), nullptr, D, wsp<bf16>(F, WS_WIN), D, S, E); } } SEAM(PH_INPROJ);
    if (IN(PH_PREP)) { for (int rep = 0; rep < NREP(PH_PREP); ++rep) { p_prep(F, args); __syncthreads(); } } SEAM(PH_PREP);
    if (IN(PH_ROUTE)) { for (int rep = 0; rep < NREP(PH_ROUTE); ++rep) { p_route(F, args); __syncthreads(); } } SEAM(PH_ROUTE);
    if (IN(PH_MIXA)) { for (int rep = 0; rep < NREP(PH_MIXA); ++rep) { p_mix_a(F, args); __syncthreads(); } } SEAM(PH_MIXA);
    if (IN(PH_MIXB)) { for (int rep = 0; rep < NREP(PH_MIXB); ++rep) { p_mix_b(F, args); __syncthreads(); } } SEAM(PH_MIXB);
    if (IN(PH_OUTPROJ)) { for (int rep = 0; rep < NREP(PH_OUTPROJ); ++rep) { StaticOrder S{M / 256, D / 256, F.G, F.bid}; EpiOutProj E{args.in[0], args.in[12], wsp<float>(F, WS_X1), wsp<bf16>(F, WS_XN), wsp<float>(F, WS_SS), wsp<unsigned char>(F, WS_T8)};
        GEMM(false, wsp<bf16>(F, WS_MIX), nullptr, D, wsp<bf16>(F, WS_WOUT), D, S, E); } } SEAM(PH_OUTPROJ);
    if (IN(PH_ROUTER)) { { StaticOrder S{M / 256, D / 256, F.G, F.bid}; int kple = PLE; asm volatile("" : "+s"(kple)); EpiStoreBf16 E{wsp<bf16>(F, WS_MIX), D}; GEMM(false, wsp<bf16>(F, WS_PB), nullptr, kple, wsp<bf16>(F, WS_WPP), kple, S, E); }
        for (int rep = 0; rep < NREP(PH_ROUTER); ++rep) { p_router(F, args); __syncthreads(); } } SEAM(PH_ROUTER);
    if (IN(PH_LISTS)) { for (int rep = 0; rep < NREP(PH_LISTS); ++rep) { p_lists(F, args); __syncthreads(); } } SEAM(PH_LISTS);
    if (IN(PH_GU)) { for (int rep = 0; rep < NREP(PH_GU); ++rep) { GroupedOrder S{wsp<int>(F, WS_TILEE), 8, F.G, F.bid}; EpiGateUp E{wsp<int>(F, WS_TILEE), wsp<float>(F, WS_ROWRSTD), args.in[16], wsp<unsigned char>(F, WS_ACT)};
        GEMM8(true, wsp<unsigned char>(F, WS_T8), wsp<int>(F, WS_ROWTOK), wsp<unsigned char>(F, WS_WGU), D, S, E); } } SEAM(PH_GU);
    if (IN(PH_DN)) { for (int rep = 0; rep < NREP(PH_DN); ++rep) { GroupedOrder S{wsp<int>(F, WS_TILEE), 4, F.G, F.bid}; EpiDown E{wsp<float>(F, WS_ROWGATE), args.in[18], wsp<bf16>(F, WS_YS)};
        GEMM8(false, wsp<unsigned char>(F, WS_ACT), nullptr, wsp<unsigned char>(F, WS_WDN), FF, S, E); } } SEAM(PH_DN);
    if (IN(PH_COMB)) { for (int rep = 0; rep < NREP(PH_COMB); ++rep) { p_combine(F, args); __syncthreads(); } } SEAM(PH_COMB);
    if (IN(PH_PLE)) { StaticOrder S{M / 256, D / 256, F.G, F.bid};
        { EpiPle E{wsp<bf16>(F, WS_MIX), F.out}; GEMM(false, wsp<bf16>(F, WS_XN), nullptr, D, wsp<bf16>(F, WS_WPG), D, S, E); } }
#undef IN
#undef SEAM
}

extern "C" void kernel_launch(void* const* d_in, const int* in_sizes, int n_in, void* d_out, int out_size, void* d_ws, size_t ws_size, hipStream_t stream) {
    static int grid = 0;
    if (grid == 0) {
        if (n_in != 22 || out_size != M * D || ws_size < WS_END) { fprintf(stderr, "kernel_launch: unexpected problem (n_in %d, out %d, ws %zu); nothing launched\n", n_in, out_size, ws_size); grid = -1; return; }
        int dev = 0, cus = 0, per_cu = 0;
        if (hipGetDevice(&dev) != hipSuccess || hipDeviceGetAttribute(&cus, hipDeviceAttributeMultiprocessorCount, dev) != hipSuccess) { grid = -1; return; }
        if (hipFuncSetAttribute((const void*)fwd, hipFuncAttributeMaxDynamicSharedMemorySize, LDS_BYTES) != hipSuccess) { fprintf(stderr, "kernel_launch: hipFuncSetAttribute failed\n"); grid = -1; return; }
        if (hipOccupancyMaxActiveBlocksPerMultiprocessor(&per_cu, (const void*)fwd, NTHR, LDS_BYTES) != hipSuccess || per_cu < 1) fprintf(stderr, "kernel_launch: occupancy query says %d\n", per_cu);
        (void)hipGetLastError();
        grid = cus;
    }
    if (grid < 0) return;
    if (hipMemsetAsync((char*)d_ws + WS_CTL, 0, CTL_ZERO_BYTES, stream) != hipSuccess) return;
    Args a{};
    for (int i = 0; i < 22; ++i) a.in[i] = (const float*)d_in[i];
    a.out = (float*)d_out; a.ws = (unsigned char*)d_ws; a.li = 0; a.pad = 0;
#if MK_PER_PHASE
    for (int ph = 0; ph < NPH; ++ph) { a.ph_lo = ph; a.ph_hi = ph + 1; hipLaunchKernelGGL(fwd, dim3(grid), dim3(NTHR), LDS_BYTES, stream, a); }
#else
    a.ph_lo = 0; a.ph_hi = NPH; hipLaunchKernelGGL(fwd, dim3(grid), dim3(NTHR), LDS_BYTES, stream, a);
#endif
}
```

```cpp
#include <hip/hip_runtime.h>
#include <cstdio>
#include <cstdint>

#ifndef MK_PER_PHASE
#define MK_PER_PHASE 0
#endif

#define GAS __attribute__((address_space(1)))
#define LAS __attribute__((address_space(3)))
typedef unsigned short bf16;
typedef unsigned v4u __attribute__((ext_vector_type(4)));
typedef unsigned v2u __attribute__((ext_vector_type(2)));
typedef float f32x4 __attribute__((ext_vector_type(4)));
typedef short bf16x8 __attribute__((ext_vector_type(8)));
typedef int v8i __attribute__((ext_vector_type(8)));
typedef GAS unsigned gu32;
#define RLX_AGENT __ATOMIC_RELAXED, __HIP_MEMORY_SCOPE_AGENT
#define LDS_WAIT() asm volatile("s_waitcnt lgkmcnt(0)" ::: "memory")
#define VM_WAIT() asm volatile("s_waitcnt vmcnt(0)" ::: "memory")

constexpr int BATCH = 2, SEQ = 8192, D = 1024, M = BATCH * SEQ;
constexpr int PROJ = 3600, NU = 3584;
constexpr int HD = 64, NH = 8, WM = 512;
constexpr int LCH = 128, NCH = SEQ / LCH;
constexpr int MBS = 256, NBK = SEQ / MBS;
constexpr int NPAIR = NBK * (NBK - 1) / 2;
constexpr int NE = 32, TOPK = 4, FF = 1024, PLE = 256;
constexpr int MAXROWS = M * TOPK + NE * 256, MAXTILES = MAXROWS / 256;
constexpr float RMS_EPS = 1e-6f;
constexpr float SW_LIMIT = 7.0f, SW_ALPHA = 1.702f;
constexpr float LOG2E = 1.4426950408889634f;
constexpr float W8_SCALE = 64.0f, W8_INV = 1.0f / 64.0f;
constexpr int UQM = 0, UKM = 512, UVM = 1024, UOM = 1536, UQB = 2048, UKB = 2560, UVB = 3072;
constexpr int NBH = BATCH * NH;

constexpr size_t MiB = 1u << 20;
constexpr size_t WS_CTL = 0, CTL_ZERO_BYTES = 1 * MiB;
constexpr size_t WS_WIN = 2 * MiB;
constexpr size_t WS_WOUT = 10 * MiB;
constexpr size_t WS_WPG = 12 * MiB;
constexpr size_t WS_WPP = 14 * MiB;
constexpr size_t WS_WR = 15 * MiB;
constexpr size_t WS_WGU = 16 * MiB;
constexpr size_t WS_WDN = 144 * MiB;
constexpr size_t WS_XN = 208 * MiB;
constexpr size_t WS_PB = 240 * MiB;
constexpr size_t WS_GATES = 248 * MiB;
constexpr size_t WS_SA = 249 * MiB;
constexpr size_t WS_SMX = WS_SA + 512 * 1024;
constexpr size_t WS_SB = WS_SMX + 512 * 1024;
constexpr size_t WS_SW = WS_SB + 512 * 1024;
constexpr size_t WS_SMALL = 251 * MiB;
constexpr size_t WS_DEC = WS_SMALL;
constexpr size_t WS_MC = WS_DEC + 4096;
constexpr size_t WS_KMEAN = WS_MC + 4096;
constexpr size_t WS_MCNT = WS_KMEAN + 131072;
constexpr size_t WS_SELE = 252 * MiB;
constexpr size_t WS_SELW = WS_SELE + 262144;
constexpr size_t WS_RSTD = WS_SELW + 262144;
constexpr size_t WS_HIST = WS_RSTD + 65536;
constexpr size_t WS_POS = WS_HIST + 32768;
constexpr size_t WS_ROWTOK = WS_POS + 262144;
constexpr size_t WS_ROWGATE = WS_ROWTOK + 294912;
constexpr size_t WS_ROWRSTD = WS_ROWGATE + 294912;
constexpr size_t WS_TILEE = WS_ROWRSTD + 294912;
constexpr size_t WS_SS = 254 * MiB;
constexpr size_t WS_DN = 255 * MiB;
constexpr size_t WS_NS = WS_DN + 262144;
constexpr size_t WS_U = 260 * MiB;
constexpr size_t WS_QM = 372 * MiB;
constexpr size_t WS_KM = 388 * MiB;
constexpr size_t WS_QN = 404 * MiB;
constexpr size_t WS_KN = 420 * MiB;
constexpr size_t WS_T8 = 404 * MiB;
constexpr size_t WS_VT = 436 * MiB;
constexpr size_t WS_MIX = 452 * MiB;
constexpr size_t WS_X1 = 484 * MiB;
constexpr size_t WS_MLIST = 548 * MiB;
constexpr size_t WS_OP = 556 * MiB;
constexpr size_t WS_LP = 652 * MiB;
constexpr size_t WS_DC = 654 * MiB;
constexpr size_t WS_CS = 670 * MiB;
constexpr size_t WS_ACT = 688 * MiB;
constexpr size_t WS_YS = 260 * MiB;
constexpr size_t WS_END = 832 * MiB;
static_assert(WS_ACT + (size_t)MAXROWS * 1024 * 2 <= WS_END && WS_YS + (size_t)MAXROWS * 1024 * 2 <= WS_QN, "ws map");
constexpr int CW_BAR = 4096;

constexpr int RING_BYTES = 131072;
constexpr int LDS_BYTES = 147456;
constexpr int MISC_OFF = LDS_BYTES - 256;
constexpr int BG_SCR = 77824;
constexpr int GSCR_OFF = RING_BYTES + 1024;
constexpr int NWAVES = 8, NTHR = 512;
static_assert(BG_SCR + NWAVES * 8448 <= MISC_OFF, "LDS map");

typedef float f32x2_t __attribute__((ext_vector_type(2)));
typedef __bf16 bf16x2_t __attribute__((ext_vector_type(2)));
typedef float f32x16 __attribute__((ext_vector_type(16)));
__device__ __forceinline__ unsigned pk2(float lo, float hi) { f32x2_t v = {lo, hi}; bf16x2_t b = __builtin_convertvector(v, bf16x2_t); return __builtin_bit_cast(unsigned, b); }
__device__ __forceinline__ unsigned f2bf(float f) { return pk2(f, 0.f) & 0xffffu; }
__device__ __forceinline__ unsigned pk4f8(float a, float b, float c, float d) { int w = 0; w = __builtin_amdgcn_cvt_pk_fp8_f32(a, b, w, false); w = __builtin_amdgcn_cvt_pk_fp8_f32(c, d, w, true); return (unsigned)w; }
__device__ __forceinline__ float bf2f(unsigned short b) { return __builtin_bit_cast(float, (unsigned)b << 16); }
__device__ __forceinline__ float bflo(unsigned w) { return __builtin_bit_cast(float, w << 16); }
__device__ __forceinline__ float bfhi(unsigned w) { return __builtin_bit_cast(float, w & 0xffff0000u); }
__device__ __forceinline__ float sigmoidf_(float x) { return 1.0f / (1.0f + __expf(-x)); }

#define XB_TMO      128
#define XB_XCNT(j)  (256  + 64 * (j))
#define XB_XSUB(j)  (1280 + 64 * (j))
#define XB_XGEN(j)  (2304 + 64 * (j))
#define XB_TOP      3328
#define XB_TOPGEN   3392
#define XCD_BAR_WORDS 3456
#define XB_SPIN_CAP (1u << 18)
__device__ __forceinline__ unsigned xb_ld(unsigned* p)              { return __hip_atomic_load(p, __ATOMIC_RELAXED, __HIP_MEMORY_SCOPE_AGENT); }
__device__ __forceinline__ unsigned xb_add(unsigned* p, unsigned v) { return __hip_atomic_fetch_add(p, v, __ATOMIC_RELAXED, __HIP_MEMORY_SCOPE_AGENT); }
__device__ __forceinline__ unsigned xb_xcc_id() { return (unsigned)__builtin_amdgcn_s_getreg((3 << 11) | 20) & 0xFu; }
#define XB_SPIN(cond, bar) do { unsigned _sp = 0; while (cond) { __builtin_amdgcn_s_sleep(1); \
    if ((++_sp & 255u) == 0u) { if (xb_ld(&(bar)[XB_TMO])) break; if (_sp > XB_SPIN_CAP) { atomicAdd(&(bar)[XB_TMO], 1u); break; } } } } while (0)
struct XcdBarrier { unsigned* bar; unsigned x; volatile LAS unsigned* st; };
__device__ __forceinline__ XcdBarrier xcd_barrier_post(unsigned* bar, volatile LAS unsigned* st) {
    XcdBarrier b; b.bar = bar; b.x = xb_xcc_id(); b.st = st;
    if (threadIdx.x == 0) (void)xb_add(&bar[XB_XCNT(b.x)], 1u);
    return b;
}
__device__ __forceinline__ void xcd_barrier_complete(unsigned* bar, unsigned x, unsigned& nloc, unsigned& nx) {
    const unsigned G = gridDim.x * gridDim.y * gridDim.z;
    unsigned sum, cnt, mine, sp = 0u;
    for (;;) {
        sum = 0u; cnt = 0u; mine = 0u;
#pragma unroll
        for (unsigned j = 0; j < 16; ++j) { const unsigned c = xb_ld(&bar[XB_XCNT(j)]); sum += c; cnt += (c > 0u) ? 1u : 0u; mine = (j == x) ? c : mine; }
        if (sum == G) break;
        __builtin_amdgcn_s_sleep(1);
        if ((++sp & 255u) == 0u) { if (xb_ld(&bar[XB_TMO])) break; if (sp > XB_SPIN_CAP) { atomicAdd(&bar[XB_TMO], 1u); break; } }
    }
    nloc = mine > 0u ? mine : 1u; nx = cnt > 0u ? cnt : 1u;
}
__device__ __forceinline__ void xcd_barrier(const XcdBarrier& b) {
    asm volatile("s_waitcnt vmcnt(0)" ::: "memory");
    __syncthreads();
    if (threadIdx.x == 0) {
        unsigned* bar = b.bar;
        __builtin_amdgcn_s_waitcnt(0);
        unsigned nloc = b.st[0], nx = b.st[1];
        if (nloc == 0u) { xcd_barrier_complete(bar, b.x, nloc, nx); b.st[0] = nloc; b.st[1] = nx; }
        const unsigned old = xb_add(&bar[XB_XSUB(b.x)], 1u);
        const unsigned gen = old / nloc;
        if (old + 1u == (gen + 1u) * nloc) {
            __builtin_amdgcn_fence(__ATOMIC_RELEASE, "agent");
            asm volatile("s_waitcnt vmcnt(0)" ::: "memory");
            const unsigned og = xb_add(&bar[XB_TOP], 1u);
            const unsigned tg = og / nx;
            if (og + 1u == (tg + 1u) * nx) xb_add(&bar[XB_TOPGEN], 1u);
            else XB_SPIN(xb_ld(&bar[XB_TOPGEN]) == tg, bar);
            __builtin_amdgcn_fence(__ATOMIC_ACQUIRE, "agent");
            xb_add(&bar[XB_XGEN(b.x)], 1u);
            asm volatile("s_waitcnt vmcnt(0)" ::: "memory");
        } else {
            XB_SPIN(xb_ld(&bar[XB_XGEN(b.x)]) == gen, bar);
            __builtin_amdgcn_fence(__ATOMIC_ACQUIRE, "agent");
            asm volatile("s_waitcnt vmcnt(0)" ::: "memory");
        }
    }
    __syncthreads();
}

struct Args { const float* in[22]; float* out; unsigned char* ws; int ph_lo, ph_hi, li, pad; };
struct Frame {
    LAS unsigned char* lds; volatile LAS unsigned* MISC; gu32* ctl;
    int tid, lane, wave, G, bid;
    float* out; unsigned char* ws;
};
template <class T> __device__ __forceinline__ T* wsp(const Frame& F, size_t off) { return (T*)(F.ws + off); }

__device__ __forceinline__ float wave_sum(float v) {
#pragma unroll
    for (int o = 1; o < 64; o <<= 1) v += __shfl_xor(v, o);
    return v;
}
__device__ __forceinline__ float wave_max(float v) {
#pragma unroll
    for (int o = 1; o < 64; o <<= 1) v = fmaxf(v, __shfl_xor(v, o));
    return v;
}

struct Unit { int pm, pn; };
struct StaticOrder {
    int nM, nN, G, c;
    __device__ __forceinline__ bool next(int i, Unit& u) const {
        const int nwg = nM * nN; const int L = i * G + c; if (L >= nwg) return false;
        int wgid = L; { const int q = nwg / 8, r = nwg % 8, xcd = wgid % 8, off = wgid / 8; wgid = (xcd < r ? xcd * (q + 1) : r * (q + 1) + (xcd - r) * q) + off; }
        const int nig = 8 * nN, gid = wgid / nig, fm = gid * 8, gsz = (nM - fm) < 8 ? (nM - fm) : 8;
        u.pm = fm + ((wgid % nig) % gsz); u.pn = (wgid % nig) / gsz; return true;
    }
};
struct GroupedOrder {
    const int* tile_e; int NT, G, c;
    __device__ __forceinline__ bool next(int i, Unit& u) const {
        const int nwg = tile_e[MAXTILES] * NT; const int L0 = i * G + c; if (L0 >= nwg) return false;
        const int q = nwg / 8, r = nwg % 8, xcd = L0 % 8, off = L0 / 8; const int L = (xcd < r ? xcd * (q + 1) : r * (q + 1) + (xcd - r) * q) + off;
        const int t = L / NT, n = L % NT; u.pm = t; u.pn = tile_e[t] * NT + n; return true;
    }
};
__device__ __forceinline__ int perm32(int rho) { const int n = rho >> 4, i = rho & 15; return 8 * (i >> 2) + 4 * n + (i & 3); }

template <class Sched, class Epi>
__device__ __forceinline__ void sgemm_phase(const Frame& F, const bf16* A, const int* arow, int lda, const bf16* Bt, int K, const Sched& S, const Epi& E) {
    const int wid = F.wave, lane = F.lane, wr = wid >> 2, wc = wid & 3, fr = lane & 15, fq = lane >> 4;
    Unit u;
    for (int i = 0; S.next(i, u); ++i) {
        for (int ai = 0; ai < 2; ++ai) {
            f32x4 acc[2][4][2];
#pragma unroll
            for (int bj = 0; bj < 2; ++bj)
#pragma unroll
                for (int m = 0; m < 4; ++m)
#pragma unroll
                    for (int n = 0; n < 2; ++n) acc[bj][m][n] = (f32x4){0.f, 0.f, 0.f, 0.f};
            const bf16* ap[4]; const bf16* bp[2][2];
#pragma unroll
            for (int m = 0; m < 4; ++m) { const int r = u.pm * 256 + ai * 128 + wr * 64 + m * 16 + fr; const int src = arow ? arow[r] : r; ap[m] = A + (size_t)src * lda + fq * 8; }
#pragma unroll
            for (int bj = 0; bj < 2; ++bj)
#pragma unroll
                for (int n = 0; n < 2; ++n) bp[bj][n] = Bt + (size_t)(u.pn * 256 + bj * 128 + wc * 32 + perm32(16 * n + fr)) * K + fq * 8;
            for (int k = 0; k < K; k += 32) {
                bf16x8 af[4], bfr[2][2];
#pragma unroll
                for (int m = 0; m < 4; ++m) af[m] = *(const bf16x8*)(ap[m] + k);
#pragma unroll
                for (int bj = 0; bj < 2; ++bj)
#pragma unroll
                    for (int n = 0; n < 2; ++n) bfr[bj][n] = *(const bf16x8*)(bp[bj][n] + k);
#pragma unroll
                for (int bj = 0; bj < 2; ++bj)
#pragma unroll
                    for (int m = 0; m < 4; ++m)
#pragma unroll
                        for (int n = 0; n < 2; ++n) acc[bj][m][n] = __builtin_amdgcn_mfma_f32_16x16x32_bf16(bfr[bj][n], af[m], acc[bj][m][n], 0, 0, 0);
            }
#pragma unroll
            for (int m = 0; m < 4; ++m) {
                float lo[8], hi[8];
#pragma unroll
                for (int j = 0; j < 4; ++j) { lo[j] = acc[0][m][0][j]; lo[4 + j] = acc[0][m][1][j]; hi[j] = acc[1][m][0][j]; hi[4 + j] = acc[1][m][1][j]; }
                typename Epi::Pre pre; E.pre(u, wr * 64 + fr, wc * 32 + fq * 8, pre); E(u, ai * 128 + wr * 64 + m * 16 + fr, wc * 32 + fq * 8, lo, hi, pre, ai * 4 + m);
            }
        }
    }
}

namespace pg8 {
constexpr int BM = 256, BK = 64, HALF = 128, HTB = HALF * BK * 2, STAGE_BYTES = 8 * HTB;
__device__ __forceinline__ int lds_byte(int r, int c) { const int st = (r >> 4) * 2 + (c >> 5), rr = r & 15, cc = c & 31, ob = rr * 64 + cc * 2; return st * 1024 + (ob ^ (((ob >> 9) & 1) << 5)); }
__device__ __forceinline__ void stage_rc(int b, int& R, int& C) { const int st = b / 1024, sb = b % 1024, swz = sb ^ (((sb >> 9) & 1) << 5); R = (st >> 1) * 16 + swz / 64; C = (st & 1) * 32 + (swz % 64) / 2; }

template <bool FP8>
__device__ __forceinline__ void mma_block(f32x4 (&c)[4][2], const bf16x8 (&At)[4][2], const bf16x8 (&Bq)[2][2]) {
    if constexpr (FP8) {
#pragma unroll
        for (int m = 0; m < 4; ++m)
#pragma unroll
            for (int n = 0; n < 2; ++n) {
                const v4u b0 = __builtin_bit_cast(v4u, Bq[n][0]), b1 = __builtin_bit_cast(v4u, Bq[n][1]), a0 = __builtin_bit_cast(v4u, At[m][0]), a1 = __builtin_bit_cast(v4u, At[m][1]);
                const v8i bw = {(int)b0.x, (int)b0.y, (int)b0.z, (int)b0.w, (int)b1.x, (int)b1.y, (int)b1.z, (int)b1.w}, aw = {(int)a0.x, (int)a0.y, (int)a0.z, (int)a0.w, (int)a1.x, (int)a1.y, (int)a1.z, (int)a1.w};
                c[m][n] = __builtin_amdgcn_mfma_scale_f32_16x16x128_f8f6f4(bw, aw, c[m][n], 0, 0, 0, 0x7F7F7F7F, 0, 0x7F7F7F7F); }
    } else {
#pragma unroll
        for (int m = 0; m < 4; ++m)
#pragma unroll
            for (int n = 0; n < 2; ++n)
#pragma unroll
                for (int k = 0; k < 2; ++k) c[m][n] = __builtin_amdgcn_mfma_f32_16x16x32_bf16(Bq[n][k], At[m][k], c[m][n], 0, 0, 0);
    }
}
template <class Epi, class Sched, bool GATHER, bool ALIGN_EPI, bool FP8>
__device__ __forceinline__ void gemm_phase(LAS unsigned char* lds, const void* A, const int* arow, const void* Bt, const int K, const Sched& S, const Epi& E) {
    const int RB = FP8 ? K : 2 * K;
    const int tid = threadIdx.x, wid = __builtin_amdgcn_readfirstlane(tid >> 6), lane = tid & 63, wr = wid >> 2, wc = wid & 3, fr = lane & 15, fq = lane >> 4;
    const int nt = RB / 128;
    unsigned voffB[2], vA[2][2];
#pragma unroll
    for (int i = 0; i < 2; ++i) { int sR, sC; stage_rc(tid * 16 + i * 8192, sR, sC); const int Rb = (sR & ~31) + perm32(sR & 31);
        voffB[i] = (unsigned)(Rb * RB + sC * 2);
        vA[0][i] = (unsigned)(sR * RB + sC * 2); vA[1][i] = (unsigned)((sR + HALF) * RB + sC * 2); }
    const unsigned kstep = 128u;
    const unsigned hstep = (unsigned)HALF * RB;
    const unsigned r64 = 64u * RB;
    const unsigned tstep = 2 * hstep;
    const __amdgpu_buffer_rsrc_t rA = __builtin_amdgcn_make_buffer_rsrc((void*)A, 0, 0x7fffffff, 0x00020000), rB = __builtin_amdgcn_make_buffer_rsrc((void*)Bt, 0, 0x7fffffff, 0x00020000);
    const unsigned ldsw = (unsigned)wid * 1024u;
    const int aoff = lds_byte(wr * 64 + fr, fq * 8), boff = lds_byte(wc * 32 + fr, fq * 8);
#define PG8_SA(b, h) (((b) * 2 + (h)) * HTB)
#define PG8_SB(b, h) ((4 + (b) * 2 + (h)) * HTB)
#define PG8_STAGE_B(bufoff, so) do { _Pragma("unroll") for (int _i = 0; _i < 2; ++_i) \
        __builtin_amdgcn_raw_ptr_buffer_load_lds(rB, (LAS unsigned*)(lds + (bufoff) + ldsw + _i * 8192), 16, voffB[0], (int)((so) + _i * r64), 0, 0); } while (0)
#define PG8_STAGE_A(bufoff, so, h, nx) do { _Pragma("unroll") for (int _i = 0; _i < 2; ++_i) { if constexpr (GATHER) \
        __builtin_amdgcn_raw_ptr_buffer_load_lds(rA, (LAS unsigned*)(lds + (bufoff) + ldsw + _i * 8192), 16, vA[h][_i], (int)(so), 0, 0); else \
        __builtin_amdgcn_raw_ptr_buffer_load_lds(rA, (LAS unsigned*)(lds + (bufoff) + ldsw + _i * 8192), 16, vA[0][0], (int)((so) + (h) * hstep + _i * r64), 0, 0); } } while (0)
#define PG8_LDA(dst, b, h) do { _Pragma("unroll") for (int m = 0; m < 4; ++m) _Pragma("unroll") for (int k = 0; k < 2; ++k) dst[m][k] = *(const LAS bf16x8*)(lds + PG8_SA(b, h) + aoff + m * 2048 + k * 1024); } while (0)
#define PG8_LDB(dst, b, h) do { _Pragma("unroll") for (int n = 0; n < 2; ++n) _Pragma("unroll") for (int k = 0; k < 2; ++k) dst[n][k] = *(const LAS bf16x8*)(lds + PG8_SB(b, h) + boff + n * 2048 + k * 1024); } while (0)
#define PG8_MMA(ai, bj, At, Bq) do { __builtin_amdgcn_s_setprio(1); mma_block<FP8>(acc[ai][bj], At, Bq); __builtin_amdgcn_s_setprio(0); } while (0)
#define PG8_WAIT_V(n) asm volatile("s_waitcnt vmcnt(" #n ")" ::: "memory")
#define PG8_WAIT_L(n) asm volatile("s_waitcnt lgkmcnt(" #n ")" ::: "memory")
#define PG8_BAR __builtin_amdgcn_s_barrier()
#define PG8_SCHED __builtin_amdgcn_sched_barrier(0)
#define PG8_GOFF(dst, u) do { if (GATHER) { _Pragma("unroll") for (int _h = 0; _h < 2; ++_h) _Pragma("unroll") for (int _i = 0; _i < 2; ++_i) { int _R, _C; stage_rc(tid * 16 + _i * 8192, _R, _C); \
        dst[_h][_i] = (unsigned)(arow[(u).pm * BM + _h * HALF + _R] * RB + _C * 2); } } } while (0)
    LAS v4u* gscr = (LAS v4u*)(lds + GSCR_OFF) + tid;
    Unit cur, nxt; int ui = 0;
    if (!S.next(0, cur)) return;
    PG8_GOFF(vA, cur);
    f32x4 acc[2][2][4][2];
#pragma unroll
    for (int a = 0; a < 2; ++a)
#pragma unroll
        for (int b = 0; b < 2; ++b)
#pragma unroll
            for (int m = 0; m < 4; ++m)
#pragma unroll
                for (int n = 0; n < 2; ++n) acc[a][b][m][n] = (f32x4){0.f, 0.f, 0.f, 0.f};
    bf16x8 At[4][2], B0[2][2], B1[2][2];
    unsigned cA = GATHER ? 0u : (unsigned)cur.pm * tstep, cB = (unsigned)cur.pn * tstep;
    PG8_STAGE_B(PG8_SB(0, 0), cB); PG8_STAGE_B(PG8_SB(0, 1), cB + hstep); PG8_STAGE_A(PG8_SA(0, 0), cA, 0, false); PG8_STAGE_A(PG8_SA(0, 1), cA, 1, false);
    if (wr == 1) PG8_BAR;
    PG8_WAIT_V(2); PG8_BAR;
    PG8_STAGE_B(PG8_SB(1, 0), cB + kstep); PG8_STAGE_A(PG8_SA(1, 0), cA + kstep, 0, false); PG8_STAGE_B(PG8_SB(1, 1), cB + hstep + kstep);
    PG8_WAIT_V(6); PG8_BAR;
    for (;;) {
        const bool has_next = S.next(ui + 1, nxt);
        const unsigned nA = has_next ? (GATHER ? 0u : (unsigned)nxt.pm * tstep) : cA, nB = has_next ? (unsigned)nxt.pn * tstep : cB;
        if (GATHER) { if (has_next) { unsigned nv[2][2]; PG8_GOFF(nv, nxt); *gscr = (v4u){nv[0][0], nv[0][1], nv[1][0], nv[1][1]}; } else *gscr = (v4u){vA[0][0], vA[0][1], vA[1][0], vA[1][1]}; }
#pragma unroll 1
        for (int t = 0; t < nt; t += 2) {
            const bool last = (t == nt - 2);
            const unsigned a1 = cA + (unsigned)(t + 1) * kstep;
            const unsigned a2 = last ? nA : cA + (unsigned)(t + 2) * kstep, b2 = last ? nB : cB + (unsigned)(t + 2) * kstep;
            const unsigned a3 = a2 + kstep, b3 = b2 + kstep;
            PG8_LDB(B0, 0, 0); PG8_LDB(B1, 0, 1); PG8_SCHED; PG8_LDA(At, 0, 0); PG8_STAGE_A(PG8_SA(1, 1), a1, 1, false);
            if (GATHER) { if (last) { const v4u nv = *gscr; vA[0][0] = nv.x; vA[0][1] = nv.y; vA[1][0] = nv.z; vA[1][1] = nv.w; } }
            PG8_WAIT_V(8); PG8_WAIT_L(0); PG8_BAR; PG8_MMA(0, 0, At, B0); PG8_MMA(0, 1, At, B1); PG8_BAR; PG8_SCHED;
            PG8_LDA(At, 0, 1); PG8_STAGE_B(PG8_SB(0, 0), b2); PG8_STAGE_B(PG8_SB(0, 1), b2 + hstep); PG8_STAGE_A(PG8_SA(0, 0), a2, 0, last);
            PG8_WAIT_V(8); PG8_WAIT_L(0); PG8_BAR; PG8_MMA(1, 0, At, B0); PG8_MMA(1, 1, At, B1); PG8_BAR; PG8_SCHED;
            PG8_LDB(B0, 1, 0); PG8_LDB(B1, 1, 1); PG8_SCHED; PG8_LDA(At, 1, 0); PG8_STAGE_A(PG8_SA(0, 1), a2, 1, last);
            PG8_WAIT_V(8); PG8_WAIT_L(0); PG8_BAR; PG8_MMA(0, 0, At, B0); PG8_MMA(0, 1, At, B1); PG8_BAR; PG8_SCHED;
            PG8_LDA(At, 1, 1); PG8_STAGE_B(PG8_SB(1, 0), b3); PG8_STAGE_B(PG8_SB(1, 1), b3 + hstep); PG8_STAGE_A(PG8_SA(1, 0), a3, 0, last);
            PG8_WAIT_V(8); PG8_WAIT_L(0); PG8_BAR; PG8_MMA(1, 0, At, B0); PG8_MMA(1, 1, At, B1); PG8_BAR; PG8_SCHED;
        }
        if constexpr (ALIGN_EPI) { if (wr == 0) PG8_BAR; }
        {
            int fr2 = fr, fq2 = fq; asm volatile("" : "+v"(fr2), "+v"(fq2));
            typename Epi::Pre pre; E.pre(cur, wr * 64 + fr2, wc * 32 + fq2 * 8, pre);
#pragma unroll
            for (int ai = 0; ai < 2; ++ai)
#pragma unroll
                for (int m = 0; m < 4; ++m) { float lo[8], hi[8];
#pragma unroll
                    for (int j = 0; j < 4; ++j) { lo[j] = acc[ai][0][m][0][j]; lo[4 + j] = acc[ai][0][m][1][j]; hi[j] = acc[ai][1][m][0][j]; hi[4 + j] = acc[ai][1][m][1][j]; }
                    E(cur, ai * HALF + wr * 64 + m * 16 + fr2, wc * 32 + fq2 * 8, lo, hi, pre, ai * 4 + m); if (Epi::FENCE) asm volatile("" ::: "memory"); }
        }
        if (!has_next) break;
#pragma unroll
        for (int a = 0; a < 2; ++a)
#pragma unroll
            for (int b = 0; b < 2; ++b)
#pragma unroll
                for (int m = 0; m < 4; ++m)
#pragma unroll
                    for (int n = 0; n < 2; ++n) acc[a][b][m][n] = (f32x4){0.f, 0.f, 0.f, 0.f};
        cur = nxt; cA = nA; cB = nB; ++ui;
        if constexpr (ALIGN_EPI) { if (wr == 1) PG8_BAR; }
    }
    PG8_WAIT_V(0);
    if constexpr (!ALIGN_EPI) { if (wr == 0) PG8_BAR; }
    PG8_BAR;
#undef PG8_SA
#undef PG8_SB
#undef PG8_STAGE_A
#undef PG8_STAGE_B
#undef PG8_LDA
#undef PG8_LDB
#undef PG8_MMA
#undef PG8_WAIT_V
#undef PG8_WAIT_L
#undef PG8_BAR
#undef PG8_SCHED
#undef PG8_GOFF
}
}
__device__ __forceinline__ void store8bf(bf16* p, const float (&v)[8]) { v4u w; w.x = pk2(v[0], v[1]); w.y = pk2(v[2], v[3]); w.z = pk2(v[4], v[5]); w.w = pk2(v[6], v[7]); *(v4u*)p = w; }

struct NoPre {};
struct EpiStoreBf16 { bf16* O; int ldc;
    typedef NoPre Pre; static constexpr bool FENCE = false;
    __device__ __forceinline__ void pre(const Unit&, int, int, Pre&) const {}
    __device__ __forceinline__ void operator()(const Unit& u, int r, int c, const float (&lo)[8], const float (&hi)[8], const Pre&, int) const {
        bf16* o = O + (size_t)(u.pm * 256 + r) * ldc + u.pn * 256 + c; store8bf(o, lo); store8bf(o + 128, hi); } };
struct EpiOutProj { const float* x; const float* g; bf16* X1; bf16* T1; float* SS; unsigned char* T8;
    typedef NoPre Pre; static constexpr bool FENCE = true;
    __device__ __forceinline__ void pre(const Unit&, int, int, Pre&) const {}
    __device__ __forceinline__ void operator()(const Unit& u, int r, int c, const float (&lo)[8], const float (&hi)[8], const Pre&, int) const {
        const size_t row = (size_t)u.pm * 256 + r; const int col = u.pn * 256 + c; float ss = 0.f;
#pragma unroll
        for (int h = 0; h < 2; ++h) { const float* v = h ? hi : lo; const int cc = col + h * 128; float o[8], t[8];
#pragma unroll
            for (int j = 0; j < 8; ++j) { o[j] = x[row * D + cc + j] + v[j]; ss += o[j] * o[j]; t[j] = o[j] * g[cc + j]; }
            store8bf(X1 + row * D + cc, o);
            store8bf(T1 + row * D + cc, t); *(v2u*)(T8 + row * D + cc) = (v2u){pk4f8(t[0], t[1], t[2], t[3]), pk4f8(t[4], t[5], t[6], t[7])}; }
        ss += __shfl_xor(ss, 16); ss += __shfl_xor(ss, 32);
        if ((threadIdx.x & 63) < 16) SS[row * 16 + u.pn * 4 + (c >> 5)] = ss; } };
struct PreRow { float lo[8], hi[8], rw[8]; };
struct EpiGateUp { const int* tile_e; const float* rowrstd; const float* b_gu; unsigned char* ACT;
    typedef PreRow Pre; static constexpr bool FENCE = false;
    __device__ __forceinline__ void pre(const Unit& u, int r0, int c, Pre& p) const {
        const int e = u.pn >> 3, nt = u.pn & 7; const float* bg = b_gu + (size_t)e * 2048 + nt * 128 + c;
        const f32x4 a0 = *(const f32x4*)bg, a1 = *(const f32x4*)(bg + 4), b0 = *(const f32x4*)(bg + 1024), b1 = *(const f32x4*)(bg + 1028);
        p.lo[0] = a0.x; p.lo[1] = a0.y; p.lo[2] = a0.z; p.lo[3] = a0.w; p.lo[4] = a1.x; p.lo[5] = a1.y; p.lo[6] = a1.z; p.lo[7] = a1.w;
        p.hi[0] = b0.x; p.hi[1] = b0.y; p.hi[2] = b0.z; p.hi[3] = b0.w; p.hi[4] = b1.x; p.hi[5] = b1.y; p.hi[6] = b1.z; p.hi[7] = b1.w;
#pragma unroll
        for (int g = 0; g < 8; ++g) p.rw[g] = rowrstd[(size_t)u.pm * 256 + r0 + 128 * (g >> 2) + 16 * (g & 3)] * W8_INV; }
    __device__ __forceinline__ void operator()(const Unit& u, int r, int c, const float (&lo)[8], const float (&hi)[8], const Pre& p, int g) const {
        const int nt = u.pn & 7; const size_t row = (size_t)u.pm * 256 + r; const float rs = p.rw[g]; float a[8];
#pragma unroll
        for (int j = 0; j < 8; ++j) { float glu = lo[j] * rs + p.lo[j], lin = hi[j] * rs + p.hi[j];
            glu = fminf(glu, SW_LIMIT); lin = fminf(fmaxf(lin, -SW_LIMIT), SW_LIMIT);
            a[j] = glu * sigmoidf_(SW_ALPHA * glu) * (lin + 1.0f); }
        *(v2u*)(ACT + row * FF + nt * 128 + c) = (v2u){pk4f8(a[0], a[1], a[2], a[3]), pk4f8(a[4], a[5], a[6], a[7])}; } };
struct EpiDown { const float* rowgate; const float* b_dn; unsigned char* YS;
    typedef PreRow Pre; static constexpr bool FENCE = false;
    __device__ __forceinline__ void pre(const Unit& u, int r0, int c, Pre& p) const {
        const int e = u.pn >> 2, nt = u.pn & 3; const float* bd = b_dn + (size_t)e * 1024 + nt * 256 + c;
        const f32x4 a0 = *(const f32x4*)bd, a1 = *(const f32x4*)(bd + 4), b0 = *(const f32x4*)(bd + 128), b1 = *(const f32x4*)(bd + 132);
        p.lo[0] = a0.x; p.lo[1] = a0.y; p.lo[2] = a0.z; p.lo[3] = a0.w; p.lo[4] = a1.x; p.lo[5] = a1.y; p.lo[6] = a1.z; p.lo[7] = a1.w;
        p.hi[0] = b0.x; p.hi[1] = b0.y; p.hi[2] = b0.z; p.hi[3] = b0.w; p.hi[4] = b1.x; p.hi[5] = b1.y; p.hi[6] = b1.z; p.hi[7] = b1.w;
#pragma unroll
        for (int g = 0; g < 8; ++g) p.rw[g] = rowgate[(size_t)u.pm * 256 + r0 + 128 * (g >> 2) + 16 * (g & 3)]; }
    __device__ __forceinline__ void operator()(const Unit& u, int r, int c, const float (&lo)[8], const float (&hi)[8], const Pre& p, int g) const {
        const int nt = u.pn & 3; const size_t row = (size_t)u.pm * 256 + r; const float gt = p.rw[g]; float a[8], b[8];
#pragma unroll
        for (int j = 0; j < 8; ++j) { a[j] = (lo[j] * W8_INV + p.lo[j]) * gt; b[j] = (hi[j] * W8_INV + p.hi[j]) * gt; }
        unsigned char* o = YS + row * D + nt * 256 + c; *(v2u*)o = (v2u){pk4f8(a[0], a[1], a[2], a[3]), pk4f8(a[4], a[5], a[6], a[7])}; *(v2u*)(o + 128) = (v2u){pk4f8(b[0], b[1], b[2], b[3]), pk4f8(b[4], b[5], b[6], b[7])}; } };
struct EpiPle { const bf16* PE; const bf16* X2; float* out;
    typedef NoPre Pre; static constexpr bool FENCE = true;
    __device__ __forceinline__ void pre(const Unit&, int, int, Pre&) const {}
    __device__ __forceinline__ void operator()(const Unit& u, int r, int c, const float (&lo)[8], const float (&hi)[8], const Pre&, int) const {
        const size_t row = (size_t)u.pm * 256 + r; const int col = u.pn * 256 + c;
#pragma unroll
        for (int h = 0; h < 2; ++h) { const float* v = h ? hi : lo; const int cc = col + h * 128; const v4u pe = *(const v4u*)(PE + row * D + cc), xw = *(const v4u*)(X2 + row * D + cc);
            f32x4 x0, x1;
            x0[0] = bflo(xw.x) + sigmoidf_(v[0]) * bflo(pe.x); x0[1] = bfhi(xw.x) + sigmoidf_(v[1]) * bfhi(pe.x); x0[2] = bflo(xw.y) + sigmoidf_(v[2]) * bflo(pe.y); x0[3] = bfhi(xw.y) + sigmoidf_(v[3]) * bfhi(pe.y);
            x1[0] = bflo(xw.z) + sigmoidf_(v[4]) * bflo(pe.z); x1[1] = bfhi(xw.z) + sigmoidf_(v[5]) * bfhi(pe.z); x1[2] = bflo(xw.w) + sigmoidf_(v[6]) * bflo(pe.w); x1[3] = bfhi(xw.w) + sigmoidf_(v[7]) * bfhi(pe.w);
            *(f32x4*)(out + row * D + cc) = x0; *(f32x4*)(out + row * D + cc + 4) = x1; } } };

struct TrItem { const float* src; void* dst; int ldw, K, f8; };
__device__ __forceinline__ void tr_load(const TrItem& t, float (&v)[32], int lane) {
#pragma unroll
    for (int i = 0; i < 32; ++i) v[i] = t.src[(size_t)(2 * i + (lane >> 5)) * t.ldw + (lane & 31)];
}
__device__ __forceinline__ void tr_store(const TrItem& t, const float (&v)[32], LAS float* scr, int lane) {
#pragma unroll
    for (int i = 0; i < 32; ++i) scr[(2 * i + (lane >> 5)) * 33 + (lane & 31)] = v[i];
    LDS_WAIT(); asm volatile("" ::: "memory");
    if (t.f8) { const int n = lane >> 1, hf = lane & 1; const LAS float* s = scr + (32 * hf) * 33 + n; unsigned w[8];
#pragma unroll
        for (int q = 0; q < 8; ++q) w[q] = pk4f8(s[(4 * q) * 33] * W8_SCALE, s[(4 * q + 1) * 33] * W8_SCALE, s[(4 * q + 2) * 33] * W8_SCALE, s[(4 * q + 3) * 33] * W8_SCALE);
        unsigned char* o = (unsigned char*)t.dst + (size_t)n * t.K + 32 * hf;
        *(v4u*)o = (v4u){w[0], w[1], w[2], w[3]}; *(v4u*)(o + 16) = (v4u){w[4], w[5], w[6], w[7]};
    } else { const int c = lane & 7;
#pragma unroll
        for (int j = 0; j < 4; ++j) { const int n = (lane >> 3) + 8 * j; const LAS float* s = scr + (8 * c) * 33 + n;
            v4u o; o.x = pk2(s[0 * 33], s[1 * 33]); o.y = pk2(s[2 * 33], s[3 * 33]); o.z = pk2(s[4 * 33], s[5 * 33]); o.w = pk2(s[6 * 33], s[7 * 33]);
            *(v4u*)((bf16*)t.dst + (size_t)n * t.K + 8 * c) = o; } }
    LDS_WAIT(); asm volatile("" ::: "memory");
}
constexpr int I_IN = 16 * (NU / 32), I_SQ = 16 * 32, I_PP = 4 * 32, I_R = 16, I_GU = 16 * 64, I_DN = 16 * 32;
constexpr int NITEMS = I_IN + 2 * I_SQ + I_PP + I_R + NE * I_GU + NE * I_DN;
__device__ __forceinline__ TrItem tr_decode(const Frame& F, const Args& args, int r) {
    TrItem t; t.f8 = 0;
    if (r < I_IN) { const int kb = r / (NU / 32), nb = r % (NU / 32), n0 = 32 * nb, sc = n0 < 2048 ? n0 : n0 + 16;
        t.src = args.in[3] + (size_t)(64 * kb) * PROJ + sc; t.ldw = PROJ; t.dst = wsp<bf16>(F, WS_WIN) + (size_t)n0 * D + 64 * kb; t.K = D; }
    else if ((r -= I_IN) < I_SQ) { const int kb = r / 32, n0 = 32 * (r % 32); t.src = args.in[11] + (size_t)(64 * kb) * D + n0; t.ldw = D; t.dst = wsp<bf16>(F, WS_WOUT) + (size_t)n0 * D + 64 * kb; t.K = D; }
    else if ((r -= I_SQ) < I_SQ) { const int kb = r / 32, n0 = 32 * (r % 32); t.src = args.in[20] + (size_t)(64 * kb) * D + n0; t.ldw = D; t.dst = wsp<bf16>(F, WS_WPG) + (size_t)n0 * D + 64 * kb; t.K = D; }
    else if ((r -= I_SQ) < I_PP) { const int kb = r / 32, n0 = 32 * (r % 32); t.src = args.in[21] + (size_t)(64 * kb) * D + n0; t.ldw = D; t.dst = wsp<bf16>(F, WS_WPP) + (size_t)n0 * PLE + 64 * kb; t.K = PLE; }
    else if ((r -= I_PP) < I_R) { const int kb = r; t.src = args.in[13] + (size_t)(64 * kb) * NE; t.ldw = NE; t.dst = wsp<bf16>(F, WS_WR) + 64 * kb; t.K = D; }
    else if ((r -= I_R) < NE * I_GU) { const int e = r / I_GU, q = r % I_GU, kb = q / 64, n0 = 32 * (q % 64), pn = n0 >> 8, c = n0 & 255;
        const int sc = c < 128 ? pn * 128 + c : 1024 + pn * 128 + (c - 128);
        t.src = args.in[15] + ((size_t)e * D + 64 * kb) * 2048 + sc; t.ldw = 2048; t.dst = wsp<unsigned char>(F, WS_WGU) + ((size_t)e * 2048 + n0) * D + 64 * kb; t.K = D; t.f8 = 1; }
    else { r -= NE * I_GU; const int e = r / I_DN, q = r % I_DN, kb = q / 32, n0 = 32 * (q % 32);
        t.src = args.in[17] + ((size_t)e * FF + 64 * kb) * D + n0; t.ldw = D; t.dst = wsp<unsigned char>(F, WS_WDN) + ((size_t)e * D + n0) * FF + 64 * kb; t.K = FF; t.f8 = 1; }
    return t;
}
constexpr int BGS_CONV = 0, BGS_KPART = 4, BGS_ROUTE = 6, BGS_STATE = 8, BGS_MIXA = 12, BGS_MIXB = 19, BGS_END = 21;
struct Bg { float v[32]; TrItem it; int live; };
constexpr int I_SMALL = I_IN + 2 * I_SQ + I_PP + I_R, NBG = 6144;
template <bool REMAP>
__device__ __forceinline__ void tr_run(Frame& F, const Args& args, int first, int count, int w, int nw) {
    LAS float* scr = (LAS float*)(F.lds + F.wave * 16384); const int lane = F.lane;
    float v[32], nv[32]; int q = w;
#define TR_ITEM(qq) (REMAP ? ((qq) < I_SMALL ? (qq) : (qq) + NBG) : first + (qq))
    TrItem cur = tr_decode(F, args, TR_ITEM(q < count ? q : 0));
    if (q < count) tr_load(cur, v, lane);
    while (q < count) { const int nq = q + nw; TrItem nx = tr_decode(F, args, TR_ITEM(nq < count ? nq : 0));
        if (nq < count) tr_load(nx, nv, lane);
        tr_store(cur, v, scr, lane);
#pragma unroll
        for (int i = 0; i < 32; ++i) v[i] = nv[i];
        cur = nx; q = nq; }
#undef TR_ITEM
}
__device__ __forceinline__ void bg_issue(const Frame& F, const Args& args, Bg& bg, int slot) {
    if (F.G != 256) { bg.live = 0; return; }
    int ln = F.lane; asm volatile("" : "+v"(ln));
    const int item = I_SMALL + NBG + (slot * 256 + F.bid) * NWAVES + F.wave; bg.live = item < NITEMS;
    bg.it = tr_decode(F, args, bg.live ? item : I_SMALL);
    if (bg.live) tr_load(bg.it, bg.v, ln);
}
__device__ __forceinline__ void bg_retire(const Frame& F, Bg& bg) { int ln = F.lane; asm volatile("" : "+v"(ln)); if (bg.live) tr_store(bg.it, bg.v, (LAS float*)(F.lds + BG_SCR + F.wave * 8448), ln); }
#define BG_DECL(base, n) Bg bg; int bg_s = (base); const int bg_e = (base) + (n); bg.live = 0
#define BG_TOP() do { if (bg_s < bg_e) bg_issue(F, args, bg, bg_s); } while (0)
#define BG_BOT() do { if (bg_s < bg_e) { bg_retire(F, bg); ++bg_s; } } while (0)
#define BG_FLUSH() do { while (bg_s < bg_e) { bg_issue(F, args, bg, bg_s); bg_retire(F, bg); ++bg_s; } } while (0)
__device__ __forceinline__ void p0_prologue(Frame& F, const Args& args) {
    const int gw = F.bid * NWAVES + F.wave, NGW = F.G * NWAVES, lane = F.lane;
    tr_run<false>(F, args, 0, F.G == 256 ? I_SMALL : NITEMS, gw, NGW);
    __syncthreads();
    { LAS float* slab = (LAS float*)F.lds;
      f32x4 w[8];
#pragma unroll
      for (int q = 0; q < 8; ++q) { const int e = F.tid + NTHR * q; w[q] = *(const f32x4*)(args.in[3] + (size_t)(e >> 2) * PROJ + 2048 + (e & 3) * 4); }
#pragma unroll
      for (int q = 0; q < 8; ++q) { const int e = F.tid + NTHR * q, k = e >> 2, c4 = (e & 3) * 4;
          slab[(c4 + 0) * D + k] = w[q].x; slab[(c4 + 1) * D + k] = w[q].y; slab[(c4 + 2) * D + k] = w[q].z; slab[(c4 + 3) * D + k] = w[q].w; } }
    __syncthreads();
    bf16* XN = wsp<bf16>(F, WS_XN); float* GT = wsp<float>(F, WS_GATES);
    f32x4 nv[4];
    if (gw < M) {
#pragma unroll
        for (int j = 0; j < 4; ++j) nv[j] = ((const f32x4*)(args.in[0] + (size_t)gw * D) + lane)[64 * j]; }
    for (int m = gw; m < M; m += NGW) {
        const f32x4* gr = (const f32x4*)args.in[2] + lane;
        f32x4 v[4]; float s = 0.f;
#pragma unroll
        for (int j = 0; j < 4; ++j) v[j] = nv[j];
        if (m + NGW < M) {
#pragma unroll
            for (int j = 0; j < 4; ++j) nv[j] = ((const f32x4*)(args.in[0] + (size_t)(m + NGW) * D) + lane)[64 * j]; }
        asm volatile("" ::: "memory");
#pragma unroll
        for (int j = 0; j < 4; ++j) s += (v[j].x * v[j].x + v[j].y * v[j].y) + (v[j].z * v[j].z + v[j].w * v[j].w);
        const float rstd = 1.0f / sqrtf(wave_sum(s) * (1.0f / D) + RMS_EPS);
#pragma unroll
        for (int j = 0; j < 4; ++j) { const f32x4 g = gr[64 * j]; v[j] = v[j] * rstd * g;
            *(v2u*)(XN + (size_t)m * D + 256 * j + 4 * lane) = (v2u){pk2(v[j].x, v[j].y), pk2(v[j].z, v[j].w)}; }
        float ga[16];
#pragma unroll
        for (int c = 0; c < 16; ++c) { float a = 0.f;
#pragma unroll
            for (int j = 0; j < 4; ++j) { const f32x4 w = *(const LAS f32x4*)((LAS float*)F.lds + c * D + 256 * j + 4 * lane); a += (v[j].x * w.x + v[j].y * w.y) + (v[j].z * w.z + v[j].w * w.w); }
            ga[c] = a; }
#pragma unroll
        for (int c = 0; c < 8; ++c) { const bool up = lane & 1; const float mine = up ? ga[c + 8] : ga[c], oth = up ? ga[c] : ga[c + 8]; ga[c] = mine + __shfl_xor(oth, 1); }
#pragma unroll
        for (int c = 0; c < 4; ++c) { const bool up = lane & 2; const float mine = up ? ga[c + 4] : ga[c], oth = up ? ga[c] : ga[c + 4]; ga[c] = mine + __shfl_xor(oth, 2); }
#pragma unroll
        for (int c = 0; c < 2; ++c) { const bool up = lane & 4; const float mine = up ? ga[c + 2] : ga[c], oth = up ? ga[c] : ga[c + 2]; ga[c] = mine + __shfl_xor(oth, 4); }
        { const bool up = lane & 8; const float mine = up ? ga[1] : ga[0], oth = up ? ga[0] : ga[1]; ga[0] = mine + __shfl_xor(oth, 8); }
        ga[0] += __shfl_xor(ga[0], 16); ga[0] += __shfl_xor(ga[0], 32);
        if (lane < 16) { const int col = 8 * (lane & 1) + 4 * ((lane >> 1) & 1) + 2 * ((lane >> 2) & 1) + ((lane >> 3) & 1);
            GT[(size_t)m * 16 + col] = ga[0] + (col < 8 ? args.in[6][col] : args.in[7][col - 8]); }
    }
    bf16* PB = wsp<bf16>(F, WS_PB);
    { const size_t n4 = (size_t)M * PLE / 4, st = (size_t)F.G * NTHR;
      for (size_t i0 = (size_t)F.bid * NTHR + F.tid; i0 < n4; i0 += 4 * st) { f32x4 t[4];
#pragma unroll
          for (int q = 0; q < 4; ++q) if (i0 + q * st < n4) t[q] = ((const f32x4*)args.in[1])[i0 + q * st];
#pragma unroll
          for (int q = 0; q < 4; ++q) if (i0 + q * st < n4) *(v2u*)(PB + 4 * (i0 + q * st)) = (v2u){pk2(t[q].x, t[q].y), pk2(t[q].z, t[q].w)}; } }
}

__device__ __forceinline__ float logsigmoidf_(float f) { return f >= 0.f ? -log1pf(__expf(-f)) : f - log1pf(__expf(f)); }
__device__ __forceinline__ void p_prep(Frame& F, const Args& args) {
    const bf16* U = wsp<bf16>(F, WS_U);
    { bf16* QM = wsp<bf16>(F, WS_QM); bf16* KM = wsp<bf16>(F, WS_KM);
      BG_DECL(BGS_CONV, 4);
      const size_t cst = (size_t)F.G * NTHR; const int cit = (int)(((size_t)M * 128 + cst - 1) / cst), cq = (cit + 3) / 4;
      for (int sl = 0; sl < 4; ++sl) { BG_TOP();
#pragma unroll 2
      for (int kk = sl * cq; kk < (sl + 1) * cq && kk < cit; ++kk) { const size_t i = (size_t)F.bid * NTHR + F.tid + (size_t)kk * cst; if (i >= (size_t)M * 128) break;
          const int m = (int)(i >> 7), ch = (int)(i & 127) * 8, t = m & (SEQ - 1);
          float y[8];
          { const f32x4 b0 = *(const f32x4*)(args.in[5] + ch), b1 = *(const f32x4*)(args.in[5] + ch + 4); y[0] = b0.x; y[1] = b0.y; y[2] = b0.z; y[3] = b0.w; y[4] = b1.x; y[5] = b1.y; y[6] = b1.z; y[7] = b1.w; }
#pragma unroll
          for (int j = 0; j < 4; ++j) { const int tt = t - 3 + j; if (tt >= 0) { const v4u w = *(const v4u*)(U + (size_t)(m - 3 + j) * NU + ch);
              const f32x4 c0 = *(const f32x4*)(args.in[4] + j * 1024 + ch), c1 = *(const f32x4*)(args.in[4] + j * 1024 + ch + 4);
              y[0] += bflo(w.x) * c0.x; y[1] += bfhi(w.x) * c0.y; y[2] += bflo(w.y) * c0.z; y[3] += bfhi(w.y) * c0.w; y[4] += bflo(w.z) * c1.x; y[5] += bfhi(w.z) * c1.y; y[6] += bflo(w.w) * c1.z; y[7] += bfhi(w.w) * c1.w; } }
          const float sc = ch < 512 ? 0.125f : 1.0f;
#pragma unroll
          for (int e = 0; e < 8; ++e) y[e] = y[e] * sigmoidf_(y[e]) * sc;
          bf16* o = ch < 512 ? QM + (size_t)m * WM + ch : KM + (size_t)m * WM + (ch - 512);
          *(v4u*)o = (v4u){pk2(y[0], y[1]), pk2(y[2], y[3]), pk2(y[4], y[5]), pk2(y[6], y[7])}; }
      BG_BOT(); } }
    { bf16* KN = wsp<bf16>(F, WS_KN); bf16* VT = wsp<bf16>(F, WS_VT); float* KMEAN = wsp<float>(F, WS_KMEAN);
      LAS float* red = (LAS float*)F.lds;
      LAS unsigned char* vtl = F.lds + 4096;
      BG_DECL(BGS_KPART, 2);
      for (int un = F.bid; un < NBH * NBK; un += F.G) { BG_TOP();
          const int bh = un / NBK, j = un % NBK, b = bh / NH, h = bh % NH;
          const int key = F.tid >> 1, hf = F.tid & 1; const size_t m = (size_t)b * SEQ + j * MBS + key;
          __syncthreads();
          float kv[32]; float ss = 0.f;
#pragma unroll
          for (int i = 0; i < 4; ++i) { const v4u w = *(const v4u*)(U + m * NU + UKB + h * HD + 32 * hf + 8 * i);
              kv[8 * i] = bflo(w.x); kv[8 * i + 1] = bfhi(w.x); kv[8 * i + 2] = bflo(w.y); kv[8 * i + 3] = bfhi(w.y); kv[8 * i + 4] = bflo(w.z); kv[8 * i + 5] = bfhi(w.z); kv[8 * i + 6] = bflo(w.w); kv[8 * i + 7] = bfhi(w.w); }
#pragma unroll
          for (int e = 0; e < 32; ++e) ss += kv[e] * kv[e];
          ss += __shfl_xor(ss, 1);
          const float rstd = 1.0f / sqrtf(ss * (1.0f / HD) + RMS_EPS);
#pragma unroll
          for (int e = 0; e < 32; ++e) kv[e] = kv[e] * rstd * args.in[10][32 * hf + e];
#pragma unroll
          for (int i = 0; i < 4; ++i) *(v4u*)(KN + m * WM + h * HD + 32 * hf + 8 * i) = (v4u){pk2(kv[8 * i], kv[8 * i + 1]), pk2(kv[8 * i + 2], kv[8 * i + 3]), pk2(kv[8 * i + 4], kv[8 * i + 5]), pk2(kv[8 * i + 6], kv[8 * i + 7])};
#pragma unroll
          for (int e = 0; e < 32; ++e) { float a = kv[e]; a += __shfl_xor(a, 2); a += __shfl_xor(a, 4); a += __shfl_xor(a, 8); a += __shfl_xor(a, 16); a += __shfl_xor(a, 32); kv[e] = a; }
          if (F.lane < 2) {
#pragma unroll
              for (int e = 0; e < 32; ++e) red[F.wave * 64 + 32 * hf + e] = kv[e]; }
#pragma unroll
          for (int i = 0; i < 4; ++i) { const v4u w = *(const v4u*)(U + m * NU + UVB + h * HD + 32 * hf + 8 * i); const unsigned ww[4] = {w.x, w.y, w.z, w.w};
#pragma unroll
              for (int e = 0; e < 4; ++e) { *(LAS unsigned short*)(vtl + (32 * hf + 8 * i + 2 * e) * 528 + 2 * key) = (unsigned short)(ww[e] & 0xffffu); *(LAS unsigned short*)(vtl + (32 * hf + 8 * i + 2 * e + 1) * 528 + 2 * key) = (unsigned short)(ww[e] >> 16); } }
          __syncthreads();
          if (F.wave == 0) { float sm = 0.f;
#pragma unroll
              for (int w = 0; w < NWAVES; ++w) sm += red[w * 64 + F.lane];
              KMEAN[(size_t)un * HD + F.lane] = sm * (1.0f / MBS); }
          { const int d = F.tid >> 3, pc = F.tid & 7;
#pragma unroll
            for (int i = 0; i < 4; ++i) *(v4u*)(VT + ((size_t)bh * HD + d) * SEQ + j * MBS + pc * 32 + 8 * i) = *(const LAS v4u*)(vtl + d * 528 + (pc * 32 + 8 * i) * 2); }
          BG_BOT();
      } }
    { const float* GT = wsp<float>(F, WS_GATES); float* SA = wsp<float>(F, WS_SA); float* SMX = wsp<float>(F, WS_SMX); float* SB = wsp<float>(F, WS_SB); float* SW = wsp<float>(F, WS_SW);
      float* DEC = wsp<float>(F, WS_DEC); float* MC = wsp<float>(F, WS_MC);
      LAS float* sbl = (LAS float*)(F.lds + 4096); LAS float* sA = sbl + 64; LAS float* sm = sA + 64;
      for (int bh = F.bid; bh < NBH; bh += F.G) {
          const int b = bh / NH, h = bh % NH;
          __syncthreads();
          for (int c = F.wave; c < NCH; c += NWAVES) {
              const size_t m0 = (size_t)b * SEQ + c * LCH + 2 * F.lane;
              const float i0 = GT[m0 * 16 + h], i1 = GT[(m0 + 1) * 16 + h];
              const float l0 = logsigmoidf_(GT[m0 * 16 + 8 + h]), l1 = logsigmoidf_(GT[(m0 + 1) * 16 + 8 + h]);
              float s = l0 + l1, inc = s;
#pragma unroll
              for (int o = 1; o < 64; o <<= 1) { const float t = __shfl_up(inc, o); if (F.lane >= o) inc += t; }
              const float b0 = (inc - s) + l0, b1 = inc;
              const float a0 = i0 - b0, a1 = i1 - b1;
              float mx = fmaxf(a0, a1), pm = mx;
#pragma unroll
              for (int o = 1; o < 64; o <<= 1) { const float t = __shfl_up(pm, o); if (F.lane >= o) pm = fmaxf(pm, t); }
              float ex = __shfl_up(pm, 1); if (F.lane == 0) ex = -INFINITY;
              const float cm0 = fmaxf(ex, a0), cm1 = fmaxf(cm0, a1);
              const size_t o0 = (size_t)bh * SEQ + c * LCH + 2 * F.lane;
              SA[o0] = a0; SA[o0 + 1] = a1; SB[o0] = b0; SB[o0 + 1] = b1; SMX[o0] = cm0; SMX[o0 + 1] = cm1;
              if (F.lane == 63) { sbl[c] = b1; sA[c] = cm1; }
          }
          __syncthreads();
          if (F.tid == 0) { float m = 0.f; for (int c = 0; c < NCH; ++c) { sm[c] = m; m = sbl[c] + fmaxf(m, sA[c]); } sm[NCH] = m; }
          VM_WAIT(); __syncthreads();
          for (int c = F.wave; c < NCH; c += NWAVES) {
              const float mc = sm[c], mn = sm[c + 1], bL = sbl[c];
              const size_t o0 = (size_t)bh * SEQ + c * LCH + 2 * F.lane;
              const float a0 = SA[o0], a1 = SA[o0 + 1], c0 = SMX[o0], c1 = SMX[o0 + 1];
              SMX[o0] = fmaxf(mc, c0); SMX[o0 + 1] = fmaxf(mc, c1);
              SW[o0] = __expf(bL + a0 - mn); SW[o0 + 1] = __expf(bL + a1 - mn);
              if (F.lane == 0) { DEC[bh * NCH + c] = __expf(bL + mc - mn); MC[bh * NCH + c] = mc; }
          }
      } }
}

__device__ __forceinline__ void mlstm_state(Frame& F, const Args& args);
__device__ __forceinline__ int pair_idx(int i, int j) { return i * (i - 1) / 2 + j; }
__device__ __forceinline__ void p_route(Frame& F, const Args& args) {
    const bf16* U = wsp<bf16>(F, WS_U); bf16* QN = wsp<bf16>(F, WS_QN); const float* KMEAN = wsp<float>(F, WS_KMEAN);
    int* MLIST = wsp<int>(F, WS_MLIST); int* MCNT = wsp<int>(F, WS_MCNT);
    LAS float* skm = (LAS float*)F.lds;
    LAS int* ssel = (LAS int*)(F.lds + 8192);
    LAS int* wtot = (LAS int*)(F.lds + 8192 + 3072);
    BG_DECL(BGS_ROUTE, 2);
    for (int un = F.bid; un < NBH * NBK; un += F.G) { BG_TOP();
        const int bh = un / NBK, i = un % NBK, b = bh / NH, h = bh % NH;
        __syncthreads();
        for (int e = F.tid; e < NBK * HD; e += NTHR) skm[e] = KMEAN[(size_t)bh * NBK * HD + e];
        __syncthreads();
        BG_BOT();
        int s0 = -1, s1 = -1, s2 = -1;
        if (F.tid < MBS) {
            const size_t m = (size_t)b * SEQ + i * MBS + F.tid;
            float q[HD]; float ss = 0.f;
#pragma unroll
            for (int d8 = 0; d8 < 8; ++d8) { const v4u w = *(const v4u*)(U + m * NU + UQB + h * HD + 8 * d8);
                q[8 * d8 + 0] = bflo(w.x); q[8 * d8 + 1] = bfhi(w.x); q[8 * d8 + 2] = bflo(w.y); q[8 * d8 + 3] = bfhi(w.y);
                q[8 * d8 + 4] = bflo(w.z); q[8 * d8 + 5] = bfhi(w.z); q[8 * d8 + 6] = bflo(w.w); q[8 * d8 + 7] = bfhi(w.w); }
#pragma unroll
            for (int d = 0; d < HD; ++d) ss += q[d] * q[d];
            const float rstd = 1.0f / sqrtf(ss * (1.0f / HD) + RMS_EPS);
#pragma unroll
            for (int d = 0; d < HD; ++d) q[d] = q[d] * rstd * args.in[9][d] * 0.125f;
#pragma unroll
            for (int d8 = 0; d8 < 8; ++d8) { v4u w; w.x = pk2(q[8 * d8] * LOG2E, q[8 * d8 + 1] * LOG2E); w.y = pk2(q[8 * d8 + 2] * LOG2E, q[8 * d8 + 3] * LOG2E); w.z = pk2(q[8 * d8 + 4] * LOG2E, q[8 * d8 + 5] * LOG2E); w.w = pk2(q[8 * d8 + 6] * LOG2E, q[8 * d8 + 7] * LOG2E);
                *(v4u*)(QN + m * WM + h * HD + 8 * d8) = w; }
            float v0 = -INFINITY, v1 = -INFINITY, v2 = -INFINITY;
            for (int j = 0; j < i; ++j) {
                float g = 0.f; const LAS f32x4* kp = (const LAS f32x4*)(skm + j * HD);
#pragma unroll
                for (int d4 = 0; d4 < HD / 4; ++d4) { const f32x4 w = kp[d4]; g += (q[4 * d4] * w.x + q[4 * d4 + 1] * w.y) + (q[4 * d4 + 2] * w.z + q[4 * d4 + 3] * w.w); }
                if (g > v0) { v2 = v1; s2 = s1; v1 = v0; s1 = s0; v0 = g; s0 = j; }
                else if (g > v1) { v2 = v1; s2 = s1; v1 = g; s1 = j; }
                else if (g > v2) { v2 = g; s2 = j; }
            }
            ssel[F.tid * 3 + 0] = s0; ssel[F.tid * 3 + 1] = s1; ssel[F.tid * 3 + 2] = s2;
        }
        if (F.wave < 4) { for (int j = 0; j < i; ++j) { const bool f = (s0 == j) || (s1 == j) || (s2 == j); const unsigned long long mk = __ballot(f); if (F.lane == 0) wtot[j * 4 + F.wave] = __popcll(mk); } }
        __syncthreads();
        if (F.wave < 4) { for (int j = 0; j < i; ++j) { const bool f = (s0 == j) || (s1 == j) || (s2 == j); const unsigned long long mk = __ballot(f);
                int base = 0; for (int w = 0; w < F.wave; ++w) base += wtot[j * 4 + w];
                if (f) { const int pos = base + __popcll(mk & ((1ull << F.lane) - 1ull)); const int slot = (s0 == j) ? 0 : ((s1 == j) ? 1 : 2);
                    MLIST[((size_t)bh * NPAIR + pair_idx(i, j)) * MBS + pos] = F.tid | (slot << 8); } } }
        if (F.tid < i) MCNT[bh * NPAIR + pair_idx(i, F.tid)] = wtot[F.tid * 4] + wtot[F.tid * 4 + 1] + wtot[F.tid * 4 + 2] + wtot[F.tid * 4 + 3];
    }
    __syncthreads();
    mlstm_state(F, args);
}

__device__ __forceinline__ float moba_m0(const Frame& F, const Args& args) { return 8.0f * wave_max(fabsf(args.in[9][F.lane])) * wave_max(fabsf(args.in[10][F.lane])); }


constexpr int MB_VOFF = 32768, MB_VSTR = 520, MB_MISC = MB_VOFF + 64 * MB_VSTR;
__device__ __forceinline__ void moba_load_kv(const Frame& F, int bh, int j) {
    const bf16* KN = wsp<bf16>(F, WS_KN); const bf16* VT = wsp<bf16>(F, WS_VT); const int b = bh / NH, head = bh % NH;
#pragma unroll
    for (int k = 0; k < 4; ++k) { const int p = F.tid + NTHR * k, key = p >> 3, c = p & 7;
        const v4u w = *(const v4u*)(KN + ((size_t)b * SEQ + j * MBS + key) * WM + head * HD + c * 8);
        *(LAS v4u*)(F.lds + key * 128 + ((c ^ ((key >> 1) & 7)) << 4)) = w; }
#pragma unroll
    for (int k = 0; k < 4; ++k) { const int p = F.tid + NTHR * k, d = p >> 5, c = p & 31;
        const v4u w = *(const v4u*)(VT + ((size_t)bh * HD + d) * SEQ + j * MBS + c * 8);
        LAS v2u* dst = (LAS v2u*)(F.lds + MB_VOFF + d * MB_VSTR + c * 16); dst[0] = (v2u){w.x, w.y}; dst[1] = (v2u){w.z, w.w}; }
}
template <bool MASK>
__device__ __forceinline__ void moba_core(LAS const unsigned char* lds, const bf16x8 (&qf)[4], f32x16 (&o)[2], float& l, int nkt, int dkey0, float slope2, float m0l, int q, int h) {
    float br[16];
#pragma unroll
    for (int r = 0; r < 16; ++r) br[r] = slope2 * (float)((r & 3) + 8 * (r >> 2)) - m0l;
#pragma unroll 1
    for (int kt = 0; kt < nkt; ++kt) {
        const float cb = slope2 * (float)(dkey0 + 32 * kt);
        f32x16 s;
#pragma unroll
        for (int r = 0; r < 16; ++r) s[r] = br[r] + cb;
        const int key = 32 * kt + q, sw = (key >> 1) & 7;
#pragma unroll
        for (int s4 = 0; s4 < 4; ++s4) { const bf16x8 kf = *(const LAS bf16x8*)(lds + key * 128 + (((2 * s4 + h) ^ sw) << 4)); s = __builtin_amdgcn_mfma_f32_32x32x16_bf16(kf, qf[s4], s, 0, 0, 0); }
        float p[16];
#pragma unroll
        for (int r = 0; r < 16; ++r) { p[r] = __builtin_amdgcn_exp2f(s[r]); if (MASK && kt == nkt - 1 && ((r & 3) + 8 * (r >> 2) + 4 * h > q)) p[r] = 0.f; l += p[r]; }
        bf16x8 pb[2];
#pragma unroll
        for (int s2 = 0; s2 < 2; ++s2) { v4u w; w.x = pk2(p[8 * s2], p[8 * s2 + 1]); w.y = pk2(p[8 * s2 + 2], p[8 * s2 + 3]); w.z = pk2(p[8 * s2 + 4], p[8 * s2 + 5]); w.w = pk2(p[8 * s2 + 6], p[8 * s2 + 7]); pb[s2] = __builtin_bit_cast(bf16x8, w); }
#pragma unroll
        for (int mt = 0; mt < 2; ++mt)
#pragma unroll
            for (int s2 = 0; s2 < 2; ++s2) { const LAS unsigned char* vp = lds + MB_VOFF + (32 * mt + q) * MB_VSTR + (32 * kt + 16 * s2 + 4 * h) * 2;
                const v2u lo = *(const LAS v2u*)vp, hi = *(const LAS v2u*)(vp + 16); const v4u w = {lo.x, lo.y, hi.x, hi.y};
                o[mt] = __builtin_amdgcn_mfma_f32_32x32x16_bf16(__builtin_bit_cast(bf16x8, w), pb[s2], o[mt], 0, 0, 0); }
    }
}
__device__ __forceinline__ void moba_routed(Frame& F, const Args& args) {
    const bf16* QN = wsp<bf16>(F, WS_QN); const int* MLIST = wsp<int>(F, WS_MLIST); const int* MCNT = wsp<int>(F, WS_MCNT);
    float* OP = wsp<float>(F, WS_OP); float* LP = wsp<float>(F, WS_LP);
    const float m0l = moba_m0(F, args) * LOG2E;
    LAS int* utot = (LAS int*)(F.lds + MB_MISC); LAS int* ustart = utot + 512; LAS int* cpre = ustart + 512;
    constexpr int NQ = NBH * (NBK - 1);
    __syncthreads();
    if (F.tid < NQ) { const int bh = F.tid / (NBK - 1), j = F.tid % (NBK - 1); int t = 0; for (int i = j + 1; i < NBK; ++i) t += MCNT[bh * NPAIR + pair_idx(i, j)]; utot[F.tid] = t; }
    __syncthreads();
    if (F.wave == 0) {
        int loc[8], sum = 0;
#pragma unroll
        for (int e = 0; e < 8; ++e) { const int qq = F.lane * 8 + e; loc[e] = qq < NQ ? (utot[qq] + 255) >> 8 : 0; sum += loc[e]; }
        int inc = sum;
#pragma unroll
        for (int o = 1; o < 64; o <<= 1) { const int t = __shfl_up(inc, o); if (F.lane >= o) inc += t; }
        int a = inc - sum;
#pragma unroll
        for (int e = 0; e < 8; ++e) { const int qq = F.lane * 8 + e; if (qq <= NQ) ustart[qq] = a; a += loc[e]; }
    }
    __syncthreads();
    const int nunits = ustart[NQ];
    const int q = F.lane & 31, h = F.lane >> 5;
    BG_DECL(BGS_MIXA, 7);
    for (int un = F.bid; un < nunits; un += F.G) { BG_TOP();
        int lo = 0, hi = NQ;
        while (hi - lo > 1) { const int mid = (lo + hi) >> 1; if (ustart[mid] <= un) lo = mid; else hi = mid; }
        const int qq = lo, chunk = un - ustart[qq], bh = qq / (NBK - 1), j = qq % (NBK - 1), b = bh / NH, head = bh % NH, tot = utot[qq];
        __syncthreads();
        if (F.wave == 0) { const int i = j + 1 + F.lane; const int cnt = i < NBK ? MCNT[bh * NPAIR + pair_idx(i, j)] : 0; int inc = cnt;
#pragma unroll
            for (int o = 1; o < 32; o <<= 1) { const int t = __shfl_up(inc, o); if (F.lane >= o) inc += t; }
            if (i <= NBK) cpre[i] = inc - cnt; }
        moba_load_kv(F, bh, j);
        __syncthreads();
        const int gr = chunk * 256 + F.wave * 32 + q; const bool valid = gr < tot;
        if (__ballot(valid) != 0ull) {
            const int grc = valid ? gr : chunk * 256;
            int i = j + 1; while (cpre[i + 1] <= grc) ++i;
            const int ent = MLIST[((size_t)bh * NPAIR + pair_idx(i, j)) * MBS + (grc - cpre[i])]; const int qo = ent & 255, slot = ent >> 8;
            const int tq = i * MBS + qo; const size_t mq = (size_t)b * SEQ + tq;
            bf16x8 qf[4];
#pragma unroll
            for (int s4 = 0; s4 < 4; ++s4) qf[s4] = *(const bf16x8*)(QN + mq * WM + head * HD + 16 * s4 + 8 * h);
            f32x16 o[2]; float l = 0.f;
#pragma unroll
            for (int r = 0; r < 16; ++r) { o[0][r] = 0.f; o[1][r] = 0.f; }
            const float slope2 = exp2f(-(float)(head + 1)) * LOG2E;
            moba_core<false>(F.lds, qf, o, l, 8, j * MBS + 4 * h - tq, slope2, m0l, q, h);
            l += __shfl_xor(l, 32);
            if (valid) { float* op = OP + ((mq * NH + head) * 3 + slot) * HD;
#pragma unroll
                for (int mt = 0; mt < 2; ++mt)
#pragma unroll
                    for (int g = 0; g < 4; ++g) *(f32x4*)(op + 32 * mt + 8 * g + 4 * h) = (f32x4){o[mt][4 * g], o[mt][4 * g + 1], o[mt][4 * g + 2], o[mt][4 * g + 3]};
                if (h == 0) LP[(mq * NH + head) * 3 + slot] = l; }
        }
        BG_BOT();
    }
    BG_FLUSH();
}
__device__ __forceinline__ void moba_own(Frame& F, const Args& args) {
    const bf16* QN = wsp<bf16>(F, WS_QN); const float* OP = wsp<float>(F, WS_OP); const float* LP = wsp<float>(F, WS_LP); bf16* MIX = wsp<bf16>(F, WS_MIX);
    const float m0l = moba_m0(F, args) * LOG2E;
    const int q = F.lane & 31, h = F.lane >> 5;
    BG_DECL(BGS_MIXB, 2);
    for (int un = F.bid; un < NBH * NBK; un += F.G) { BG_TOP();
        const int bh = un / NBK, i = un % NBK, b = bh / NH, head = bh % NH;
        const int qo = F.wave * 32 + q; const size_t mq = (size_t)b * SEQ + i * MBS + qo;
        f32x16 o[2]; float l = 0.f;
#pragma unroll
        for (int r = 0; r < 16; ++r) { o[0][r] = 0.f; o[1][r] = 0.f; }
        const int nsel = i < 3 ? i : 3;
        for (int sl = 0; sl < nsel; ++sl) { const float* op = OP + ((mq * NH + head) * 3 + sl) * HD; if (h == 0) l += LP[(mq * NH + head) * 3 + sl];
#pragma unroll
            for (int mt = 0; mt < 2; ++mt)
#pragma unroll
                for (int g = 0; g < 4; ++g) { const f32x4 v = *(const f32x4*)(op + 32 * mt + 8 * g + 4 * h); o[mt][4 * g] += v.x; o[mt][4 * g + 1] += v.y; o[mt][4 * g + 2] += v.z; o[mt][4 * g + 3] += v.w; } }
        bf16x8 qf[4];
#pragma unroll
        for (int s4 = 0; s4 < 4; ++s4) qf[s4] = *(const bf16x8*)(QN + mq * WM + head * HD + 16 * s4 + 8 * h);
        __syncthreads();
        moba_load_kv(F, bh, i);
        __syncthreads();
        const float slope2 = exp2f(-(float)(head + 1)) * LOG2E;
        moba_core<true>(F.lds, qf, o, l, F.wave + 1, 4 * h - qo, slope2, m0l, q, h);
        l += __shfl_xor(l, 32);
        const float inv = 1.0f / l;
#pragma unroll
        for (int mt = 0; mt < 2; ++mt)
#pragma unroll
            for (int g = 0; g < 4; ++g) *(v2u*)(MIX + mq * D + WM + head * HD + 32 * mt + 8 * g + 4 * h) = (v2u){pk2(o[mt][4 * g] * inv, o[mt][4 * g + 1] * inv), pk2(o[mt][4 * g + 2] * inv, o[mt][4 * g + 3] * inv)};
        BG_BOT();
    }
}


constexpr int ML_STR = 272;
typedef LAS unsigned short* lds_u16p;
__device__ __forceinline__ void mlstm_state(Frame& F, const Args& args) {
    const bf16* U = wsp<bf16>(F, WS_U); const bf16* KM = wsp<bf16>(F, WS_KM); const float* SW = wsp<float>(F, WS_SW); float* DC = wsp<float>(F, WS_DC); float* DN = wsp<float>(F, WS_DN);
    LAS unsigned char* vt = F.lds; LAS unsigned char* kt = F.lds + 64 * ML_STR; LAS float* sw = (LAS float*)(F.lds + 128 * ML_STR);
    const int l15 = F.lane & 15, kq = F.lane >> 4;
    BG_DECL(BGS_STATE, 4);
    for (int un = F.bid; un < NBH * NCH; un += F.G) { BG_TOP();
        const int bh = un / NCH, c = un % NCH, b = bh / NH, head = bh % NH; const size_t m0 = (size_t)b * SEQ + c * LCH;
        __syncthreads();
        if (F.tid < LCH) sw[F.tid] = SW[(size_t)bh * SEQ + c * LCH + F.tid];
#pragma unroll
        for (int k = 0; k < 2; ++k) { const int p = F.tid + NTHR * k, sidx = p >> 3, cc = p & 7;
            const float w = SW[(size_t)bh * SEQ + c * LCH + sidx];
            const v4u kv = *(const v4u*)(KM + (m0 + sidx) * WM + head * HD + 8 * cc), vv = *(const v4u*)(U + (m0 + sidx) * NU + UVM + head * HD + 8 * cc);
            const unsigned kw[4] = {kv.x, kv.y, kv.z, kv.w}, vw[4] = {vv.x, vv.y, vv.z, vv.w};
#pragma unroll
            for (int e = 0; e < 4; ++e) {
                *(lds_u16p)(kt + (8 * cc + 2 * e) * ML_STR + 2 * sidx) = (unsigned short)(kw[e] & 0xffffu); *(lds_u16p)(kt + (8 * cc + 2 * e + 1) * ML_STR + 2 * sidx) = (unsigned short)(kw[e] >> 16);
                const unsigned pw = pk2(w * bflo(vw[e]), w * bfhi(vw[e]));
                *(lds_u16p)(vt + (8 * cc + 2 * e) * ML_STR + 2 * sidx) = (unsigned short)(pw & 0xffffu); *(lds_u16p)(vt + (8 * cc + 2 * e + 1) * ML_STR + 2 * sidx) = (unsigned short)(pw >> 16); } }
        __syncthreads();
#pragma unroll
        for (int tt = 0; tt < 2; ++tt) { const int tile = 2 * F.wave + tt, mt = tile >> 2, nt = tile & 3; f32x4 acc = {0.f, 0.f, 0.f, 0.f};
#pragma unroll
            for (int ks = 0; ks < 4; ++ks) { const bf16x8 av = *(const LAS bf16x8*)(vt + (16 * mt + l15) * ML_STR + (32 * ks + 8 * kq) * 2), bv = *(const LAS bf16x8*)(kt + (16 * nt + l15) * ML_STR + (32 * ks + 8 * kq) * 2);
                acc = __builtin_amdgcn_mfma_f32_16x16x32_bf16(av, bv, acc, 0, 0, 0); }
#pragma unroll
            for (int r = 0; r < 4; ++r) DC[(size_t)un * 4096 + (16 * mt + 4 * kq + r) * HD + 16 * nt + l15] = acc[r]; }
        if (F.tid < HD) { float a = 0.f;
#pragma unroll 8
            for (int sidx = 0; sidx < LCH; ++sidx) a += sw[sidx] * bf2f(*(lds_u16p)(kt + F.tid * ML_STR + 2 * sidx));
            DN[(size_t)un * HD + F.tid] = a; }
        BG_BOT();
    }
}
__device__ __forceinline__ void mlstm_out(Frame& F, const Args& args) {
    const bf16* U = wsp<bf16>(F, WS_U); const bf16* QM = wsp<bf16>(F, WS_QM); const bf16* KM = wsp<bf16>(F, WS_KM);
    const float* SA = wsp<float>(F, WS_SA); const float* SMX = wsp<float>(F, WS_SMX); const float* SB = wsp<float>(F, WS_SB);
    const float* CS = wsp<float>(F, WS_CS); const float* NS = wsp<float>(F, WS_NS); const float* MC = wsp<float>(F, WS_MC); bf16* MIX = wsp<bf16>(F, WS_MIX);
    LAS unsigned char* sp = F.lds; LAS unsigned char* vt = F.lds + LCH * ML_STR;
    const int l15 = F.lane & 15, kq = F.lane >> 4, w = F.wave, t0 = 16 * w;
    for (int un = F.bid; un < NBH * NCH; un += F.G) {
        const int bh = un / NCH, c = un % NCH, b = bh / NH, head = bh % NH; const size_t m0 = (size_t)b * SEQ + c * LCH; const size_t g0 = (size_t)bh * SEQ + c * LCH;
        __syncthreads();
#pragma unroll
        for (int k = 0; k < 2; ++k) { const int p = F.tid + NTHR * k, sidx = p >> 3, cc = p & 7;
            const v4u vv = *(const v4u*)(U + (m0 + sidx) * NU + UVM + head * HD + 8 * cc); const unsigned vw[4] = {vv.x, vv.y, vv.z, vv.w};
#pragma unroll
            for (int e = 0; e < 4; ++e) { *(lds_u16p)(vt + (8 * cc + 2 * e) * ML_STR + 2 * sidx) = (unsigned short)(vw[e] & 0xffffu); *(lds_u16p)(vt + (8 * cc + 2 * e + 1) * ML_STR + 2 * sidx) = (unsigned short)(vw[e] >> 16); } }
        for (int e = F.tid; e < 16 * LCH; e += NTHR) { const int r = e >> 7, sidx = e & 127; *(lds_u16p)(vt + (64 + r) * ML_STR + 2 * sidx) = (unsigned short)(r == 0 ? 0x3F80u : 0u); }
        bf16x8 qa[2];
#pragma unroll
        for (int ks = 0; ks < 2; ++ks) qa[ks] = *(const bf16x8*)(QM + (m0 + t0 + l15) * WM + head * HD + 32 * ks + 8 * kq);
        float mx[4], sbv[4]; unsigned ogv[4][2];
#pragma unroll
        for (int r = 0; r < 4; ++r) { mx[r] = SMX[g0 + t0 + 4 * kq + r]; sbv[r] = SB[g0 + t0 + 4 * kq + r];
            const bf16* up = U + (m0 + t0 + 4 * kq + r) * NU + UOM + head * HD + l15;
            ogv[r][0] = (unsigned)up[0] | ((unsigned)up[16] << 16); ogv[r][1] = (unsigned)up[32] | ((unsigned)up[48] << 16); }
        bf16x8 kb[4][2]; float as[4];
#pragma unroll
        for (int st = 0; st < 4; ++st) if (st <= w) {
#pragma unroll
            for (int ks = 0; ks < 2; ++ks) kb[st][ks] = *(const bf16x8*)(KM + (m0 + 16 * st + l15) * WM + head * HD + 32 * ks + 8 * kq);
            as[st] = SA[g0 + 16 * st + l15]; }
        bf16x8 cf[2][5];
#pragma unroll
        for (int ks = 0; ks < 2; ++ks)
#pragma unroll
            for (int nt = 0; nt < 5; ++nt) { f32x4 c0, c1;
                if (nt < 4) { const float* cp = CS + (size_t)un * 4096 + (16 * nt + l15) * HD + 32 * ks + 8 * kq; c0 = *(const f32x4*)cp; c1 = *(const f32x4*)(cp + 4); }
                else { const float* np = NS + (size_t)un * HD + 32 * ks + 8 * kq; c0 = *(const f32x4*)np; c1 = *(const f32x4*)(np + 4); if (l15 != 0) { c0 = (f32x4){0.f, 0.f, 0.f, 0.f}; c1 = c0; } }
                const v4u wv = {pk2(c0.x, c0.y), pk2(c0.z, c0.w), pk2(c1.x, c1.y), pk2(c1.z, c1.w)}; cf[ks][nt] = __builtin_bit_cast(bf16x8, wv); }
#pragma unroll
        for (int hf = 0; hf < 2; ++hf) {
            if (hf == 1) {
#pragma unroll
                for (int st = 0; st < 4; ++st) if (st + 4 <= w) {
#pragma unroll
                    for (int ks = 0; ks < 2; ++ks) kb[st][ks] = *(const bf16x8*)(KM + (m0 + 16 * (st + 4) + l15) * WM + head * HD + 32 * ks + 8 * kq);
                    as[st] = SA[g0 + 16 * (st + 4) + l15]; } }
#pragma unroll
            for (int s4 = 0; s4 < 4; ++s4) { const int st = 4 * hf + s4; if (st <= w) {
                f32x4 acc = {0.f, 0.f, 0.f, 0.f};
                acc = __builtin_amdgcn_mfma_f32_16x16x32_bf16(qa[0], kb[s4][0], acc, 0, 0, 0); acc = __builtin_amdgcn_mfma_f32_16x16x32_bf16(qa[1], kb[s4][1], acc, 0, 0, 0);
#pragma unroll
                for (int r = 0; r < 4; ++r) { float v = acc[r] * __expf(as[s4] - mx[r]); if (st == w && l15 > 4 * kq + r) v = 0.f;
                    *(lds_u16p)(sp + (t0 + 4 * kq + r) * ML_STR + 2 * (16 * st + l15)) = (unsigned short)f2bf(v); } } }
        }
        if ((w & 1) == 0) {
#pragma unroll
            for (int r = 0; r < 4; ++r) *(lds_u16p)(sp + (t0 + 4 * kq + r) * ML_STR + 2 * (16 * (w + 1) + l15)) = (unsigned short)0; }
        __syncthreads();
        f32x4 a1[5], a2[5];
#pragma unroll
        for (int nt = 0; nt < 5; ++nt) { a1[nt] = (f32x4){0.f, 0.f, 0.f, 0.f}; a2[nt] = (f32x4){0.f, 0.f, 0.f, 0.f}; }
        const int nks = (w + 2) >> 1;
        for (int ks = 0; ks < nks; ++ks) { const bf16x8 av = *(const LAS bf16x8*)(sp + (t0 + l15) * ML_STR + (32 * ks + 8 * kq) * 2);
#pragma unroll
            for (int nt = 0; nt < 5; ++nt) { const bf16x8 bv = *(const LAS bf16x8*)(vt + (16 * nt + l15) * ML_STR + (32 * ks + 8 * kq) * 2); a1[nt] = __builtin_amdgcn_mfma_f32_16x16x32_bf16(av, bv, a1[nt], 0, 0, 0); } }
#pragma unroll
        for (int ks = 0; ks < 2; ++ks)
#pragma unroll
            for (int nt = 0; nt < 5; ++nt) a2[nt] = __builtin_amdgcn_mfma_f32_16x16x32_bf16(qa[ks], cf[ks][nt], a2[nt], 0, 0, 0);
        const float mc = MC[un];
#pragma unroll
        for (int r = 0; r < 4; ++r) { const int t = t0 + 4 * kq + r; const float sc = __expf(mc - mx[r]);
            float den = a1[4][r] + sc * a2[4][r]; den = __shfl(den, F.lane & 48);
            const float dn = fmaxf(fabsf(den), __expf(-(sbv[r] + mx[r]))); const float inv = 1.0f / dn;
            float hv[4], ss = 0.f;
#pragma unroll
            for (int nt = 0; nt < 4; ++nt) { hv[nt] = (a1[nt][r] + sc * a2[nt][r]) * inv; ss += hv[nt] * hv[nt]; }
            ss += __shfl_xor(ss, 1); ss += __shfl_xor(ss, 2); ss += __shfl_xor(ss, 4); ss += __shfl_xor(ss, 8);
            const float rstd = 1.0f / sqrtf(ss * (1.0f / HD) + RMS_EPS);
#pragma unroll
            for (int nt = 0; nt < 4; ++nt) { const int v = 16 * nt + l15; const float og = (nt & 1) ? bfhi(ogv[r][nt >> 1]) : bflo(ogv[r][nt >> 1]);
                MIX[(m0 + t) * D + head * HD + v] = (bf16)f2bf(hv[nt] * rstd * args.in[8][head * HD + v] * sigmoidf_(og)); } }
    }
}

__device__ __forceinline__ void mlstm_scan(Frame& F) {
    const float* DC = wsp<float>(F, WS_DC); const float* DN = wsp<float>(F, WS_DN); float* CS = wsp<float>(F, WS_CS); float* NS = wsp<float>(F, WS_NS); const float* DEC = wsp<float>(F, WS_DEC);
    constexpr int TOT = NBH * (4096 + HD); const int per = (TOT + F.G - 1) / F.G;
    for (int q = F.tid; q < per; q += NTHR) { const int e = F.bid * per + q; if (e >= TOT) break;
        const int bh = e / (4096 + HD), r = e % (4096 + HD);
        const float* src = r < 4096 ? DC + (size_t)bh * NCH * 4096 + r : DN + (size_t)bh * NCH * HD + (r - 4096);
        float* dst = r < 4096 ? CS + (size_t)bh * NCH * 4096 + r : NS + (size_t)bh * NCH * HD + (r - 4096);
        const size_t str = r < 4096 ? 4096 : HD;
        float st = 0.f;
#pragma unroll 1
        for (int c0 = 0; c0 < NCH; c0 += 8) { float d[8], g[8];
#pragma unroll
            for (int i = 0; i < 8; ++i) { d[i] = src[(size_t)(c0 + i) * str]; g[i] = DEC[bh * NCH + c0 + i]; }
#pragma unroll
            for (int i = 0; i < 8; ++i) { dst[(size_t)(c0 + i) * str] = st; st = g[i] * st + d[i]; } }
    }
}

__device__ __forceinline__ void p_mix_a(Frame& F, const Args& args) {
    const bf16* U = wsp<bf16>(F, WS_U);
    moba_routed(F, args);
    mlstm_scan(F);
}

__device__ __forceinline__ void p_mix_b(Frame& F, const Args& args) {
    moba_own(F, args);
    __syncthreads();
    mlstm_out(F, args);
}

__device__ __forceinline__ void p_router(Frame& F, const Args& args) {
    const bf16* T1 = wsp<bf16>(F, WS_XN); const bf16* WR = wsp<bf16>(F, WS_WR); const float* SS = wsp<float>(F, WS_SS);
    int* SELE = wsp<int>(F, WS_SELE); float* SELW = wsp<float>(F, WS_SELW); float* RSTD = wsp<float>(F, WS_RSTD); int* HIST = wsp<int>(F, WS_HIST);
    LAS float* part = (LAS float*)F.lds;
    LAS int* sh = (LAS int*)(F.lds + 2 * 64 * 33 * 4);
    const int l15 = F.lane & 15, kq = F.lane >> 4, tile = F.wave & 3, kh = F.wave >> 2;
    for (int ch = F.bid; ch < 256; ch += F.G) {
        __syncthreads();
        if (F.tid < NE) sh[F.tid] = 0;
        f32x4 acc[2] = {{0.f, 0.f, 0.f, 0.f}, {0.f, 0.f, 0.f, 0.f}};
        const bf16* ap = T1 + ((size_t)ch * 64 + 16 * tile + l15) * D + 512 * kh + 8 * kq; const bf16* bp = WR + (size_t)l15 * D + 512 * kh + 8 * kq;
#pragma unroll 4
        for (int ks = 0; ks < 16; ++ks) { const bf16x8 av = *(const bf16x8*)(ap + 32 * ks), b0 = *(const bf16x8*)(bp + 32 * ks), b1 = *(const bf16x8*)(bp + 16 * D + 32 * ks);
            acc[0] = __builtin_amdgcn_mfma_f32_16x16x32_bf16(av, b0, acc[0], 0, 0, 0); acc[1] = __builtin_amdgcn_mfma_f32_16x16x32_bf16(av, b1, acc[1], 0, 0, 0); }
#pragma unroll
        for (int nt = 0; nt < 2; ++nt)
#pragma unroll
            for (int r = 0; r < 4; ++r) part[(kh * 64 + 16 * tile + 4 * kq + r) * 33 + 16 * nt + l15] = acc[nt][r];
        __syncthreads();
        if (F.tid < 64) {
            const size_t m = (size_t)ch * 64 + F.tid; float ss = 0.f;
#pragma unroll
            for (int q = 0; q < 16; ++q) ss += SS[m * 16 + q];
            const float rstd = 1.0f / sqrtf(ss * (1.0f / D) + RMS_EPS);
            float v0 = -INFINITY, v1 = -INFINITY, v2 = -INFINITY, v3 = -INFINITY; int s0 = 0, s1 = 0, s2 = 0, s3 = 0;
            for (int e = 0; e < NE; ++e) { const float g = (part[F.tid * 33 + e] + part[(64 + F.tid) * 33 + e]) * rstd + args.in[14][e];
                if (g > v0) { v3 = v2; s3 = s2; v2 = v1; s2 = s1; v1 = v0; s1 = s0; v0 = g; s0 = e; }
                else if (g > v1) { v3 = v2; s3 = s2; v2 = v1; s2 = s1; v1 = g; s1 = e; }
                else if (g > v2) { v3 = v2; s3 = s2; v2 = g; s2 = e; }
                else if (g > v3) { v3 = g; s3 = e; } }
            const float e1 = __expf(v1 - v0), e2 = __expf(v2 - v0), e3 = __expf(v3 - v0); const float inv = 1.0f / (1.0f + e1 + e2 + e3);
            *(int4*)(SELE + m * 4) = make_int4(s0, s1, s2, s3); *(f32x4*)(SELW + m * 4) = (f32x4){inv, e1 * inv, e2 * inv, e3 * inv}; RSTD[m] = rstd;
            atomicAdd((int*)&sh[s0], 1); atomicAdd((int*)&sh[s1], 1); atomicAdd((int*)&sh[s2], 1); atomicAdd((int*)&sh[s3], 1);
        }
        __syncthreads();
        if (F.tid < NE) HIST[ch * NE + F.tid] = sh[F.tid];
    }
}
__device__ __forceinline__ void p_lists(Frame& F, const Args& args) {
    const int* SELE = wsp<int>(F, WS_SELE); const float* SELW = wsp<float>(F, WS_SELW); const float* RSTD = wsp<float>(F, WS_RSTD); const int* HIST = wsp<int>(F, WS_HIST);
    int* POS = wsp<int>(F, WS_POS); int* ROWTOK = wsp<int>(F, WS_ROWTOK); float* ROWGATE = wsp<float>(F, WS_ROWGATE); float* ROWRSTD = wsp<float>(F, WS_ROWRSTD); int* TILEE = wsp<int>(F, WS_TILEE);
    LAS int* stot = (LAS int*)F.lds;
    LAS int* soff = stot + 32;
    LAS int* sbase = soff + 40;
    for (int ch = F.bid; ch < 256; ch += F.G) {
        __syncthreads();
        if (F.tid < NE) { int tot = 0, before = 0; for (int w = 0; w < 256; ++w) { const int hv = HIST[w * NE + F.tid]; if (w < ch) before += hv; tot += hv; } stot[F.tid] = tot; sbase[F.tid] = before; }
        __syncthreads();
        if (F.tid == 0) { int o = 0; for (int e = 0; e < NE; ++e) { soff[e] = o; o += (stot[e] + 255) & ~255; } soff[NE] = o; }
        __syncthreads();
        if (F.wave == 0) {
            const size_t m = (size_t)ch * 64 + F.lane; int se[4]; float sw[4];
#pragma unroll
            for (int k = 0; k < 4; ++k) { se[k] = SELE[m * 4 + k]; sw[k] = SELW[m * 4 + k]; }
            const float rs = RSTD[m]; int pos[4] = {0, 0, 0, 0};
            for (int e = 0; e < NE; ++e) { const unsigned long long mk = __ballot(se[0] == e || se[1] == e || se[2] == e || se[3] == e);
                const int rank = __popcll(mk & ((1ull << F.lane) - 1ull)); const int pp = soff[e] + sbase[e] + rank;
#pragma unroll
                for (int k = 0; k < 4; ++k) if (se[k] == e) pos[k] = pp; }
#pragma unroll
            for (int k = 0; k < 4; ++k) { POS[m * 4 + k] = pos[k]; ROWTOK[pos[k]] = (int)m; ROWGATE[pos[k]] = sw[k]; ROWRSTD[pos[k]] = rs; }
        }
        if (ch < NE) { const int e = ch; for (int r = soff[e] + stot[e] + F.tid; r < soff[e + 1]; r += NTHR) { ROWTOK[r] = 0; ROWGATE[r] = 0.f; ROWRSTD[r] = 0.f; } }
        if (ch == 0) { const int nt = soff[NE] >> 8; for (int t = F.tid; t < nt; t += NTHR) { int e = 0; while (soff[e + 1] <= t * 256) ++e; TILEE[t] = e; } if (F.tid == 0) TILEE[MAXTILES] = nt; }
    }
}
__device__ __forceinline__ void p_combine(Frame& F, const Args& args) {
    bf16* X1 = wsp<bf16>(F, WS_X1); const unsigned char* YS = wsp<unsigned char>(F, WS_YS); const int* POS = wsp<int>(F, WS_POS); bf16* XN = wsp<bf16>(F, WS_XN);
    const int gw = F.bid * NWAVES + F.wave, NGW = F.G * NWAVES, lane = F.lane;
    for (int m = gw; m < M; m += NGW) {
        f32x4 v[4]; float s = 0.f; int ps[4];
#pragma unroll
        for (int k = 0; k < 4; ++k) ps[k] = POS[(size_t)m * 4 + k];
#pragma unroll
        for (int j = 0; j < 4; ++j) { const v2u xw = *(const v2u*)(X1 + (size_t)m * D + 256 * j + 4 * lane); v[j] = (f32x4){bflo(xw.x), bfhi(xw.x), bflo(xw.y), bfhi(xw.y)};
#pragma unroll
            for (int k = 0; k < 4; ++k) { const int w = *(const int*)(YS + (size_t)ps[k] * D + 256 * j + 4 * lane); const f32x2_t lo = __builtin_amdgcn_cvt_pk_f32_fp8(w, false), hi = __builtin_amdgcn_cvt_pk_f32_fp8(w, true);
                v[j].x += lo.x; v[j].y += lo.y; v[j].z += hi.x; v[j].w += hi.y; }
            s += (v[j].x * v[j].x + v[j].y * v[j].y) + (v[j].z * v[j].z + v[j].w * v[j].w);
            *(v2u*)(X1 + (size_t)m * D + 256 * j + 4 * lane) = (v2u){pk2(v[j].x, v[j].y), pk2(v[j].z, v[j].w)}; }
        const float rstd = 1.0f / sqrtf(wave_sum(s) * (1.0f / D) + RMS_EPS);
#pragma unroll
        for (int j = 0; j < 4; ++j) { const f32x4 g = *((const f32x4*)args.in[19] + lane + 64 * j); const f32x4 o = v[j] * rstd * g;
            *(v2u*)(XN + (size_t)m * D + 256 * j + 4 * lane) = (v2u){pk2(o.x, o.y), pk2(o.z, o.w)}; }
    }
}

enum { PH_PRO = 0, PH_INPROJ, PH_PREP, PH_ROUTE, PH_MIXA, PH_MIXB, PH_OUTPROJ, PH_ROUTER, PH_LISTS, PH_GU, PH_DN, PH_COMB, PH_PLE, NPH };

__global__ void __launch_bounds__(NTHR, 2) fwd(Args args) {
    extern __shared__ __attribute__((aligned(16))) unsigned char lds[];
    Frame F;
    F.lds = (LAS unsigned char*)lds; F.MISC = (volatile LAS unsigned*)(F.lds + MISC_OFF);
    F.tid = threadIdx.x; F.lane = F.tid & 63; F.wave = __builtin_amdgcn_readfirstlane(F.tid >> 6); F.G = gridDim.x; F.bid = blockIdx.x;
    F.ws = args.ws; F.ctl = (gu32*)(args.ws + WS_CTL); F.out = args.out;

    for (int u = F.tid; u < (LDS_BYTES - RING_BYTES) / 4; u += NTHR) ((LAS unsigned*)(F.lds + RING_BYTES))[u] = 0u;
    __syncthreads();
    XcdBarrier bar; bar.bar = (unsigned*)(F.ctl + CW_BAR); bar.x = 0; bar.st = nullptr;
    if (!MK_PER_PHASE) bar = xcd_barrier_post((unsigned*)(F.ctl + CW_BAR), F.MISC + 8);
    const int lo = args.ph_lo, hi = args.ph_hi;
#ifdef ONLY
#define IN(k) ((k) == ONLY)
#else
#define IN(k) (lo <= (k) && (k) < hi)
#endif
#ifdef USE_SGEMM
#define GEMM(gather, A_, arow_, lda_, Bt_, K_, S_, E_) sgemm_phase(F, A_, arow_, lda_, Bt_, K_, S_, E_)
#else
#define GEMM(gather, A_, arow_, lda_, Bt_, K_, S_, E_) pg8::gemm_phase<decltype(E_), decltype(S_), gather, true, false>(F.lds, A_, arow_, Bt_, K_, S_, E_)
#define GEMM8(gather, A_, arow_, Bt_, K_, S_, E_) pg8::gemm_phase<decltype(E_), decltype(S_), gather, true, true>(F.lds, A_, arow_, Bt_, K_, S_, E_)
#endif
#ifndef DUP_PHASE
#define DUP_PHASE -1
#endif
#define NREP(k) ((k) == DUP_PHASE ? 2 : 1)
#define SEAM(k) do { if (IN(k) && IN((k) + 1)) xcd_barrier(bar); } while (0)

    if (IN(PH_PRO)) { for (int rep = 0; rep < NREP(PH_PRO); ++rep) { p0_prologue(F, args); __syncthreads(); } } SEAM(PH_PRO);
    if (IN(PH_INPROJ)) { constexpr int GG = 224;
        if (F.G == 256 && F.bid >= GG) tr_run<false>(F, args, I_SMALL, NBG, (F.bid - GG) * NWAVES + F.wave, (256 - GG) * NWAVES);
        else { StaticOrder S{M / 256, NU / 256, F.G == 256 ? GG : F.G, F.bid}; EpiStoreBf16 E{wsp<bf16>(F, WS_U), NU};
            GEMM(false, wsp<bf16>(F, WS_XN), nullptr, D, wsp<bf16>(F, WS_WIN), D, S, E);
        } } SEAM(PH_INPROJ);
    if (IN(PH_PREP)) { for (int rep = 0; rep < NREP(PH_PREP); ++rep) { p_prep(F, args); __syncthreads(); } } SEAM(PH_PREP);
    if (IN(PH_ROUTE)) { for (int rep = 0; rep < NREP(PH_ROUTE); ++rep) { p_route(F, args); __syncthreads(); } } SEAM(PH_ROUTE);
    if (IN(PH_MIXA)) { for (int rep = 0; rep < NREP(PH_MIXA); ++rep) { p_mix_a(F, args); __syncthreads(); } } SEAM(PH_MIXA);
    if (IN(PH_MIXB)) { for (int rep = 0; rep < NREP(PH_MIXB); ++rep) { p_mix_b(F, args); __syncthreads(); } } SEAM(PH_MIXB);
    if (IN(PH_OUTPROJ)) { for (int rep = 0; rep < NREP(PH_OUTPROJ); ++rep) { StaticOrder S{M / 256, D / 256, F.G, F.bid}; EpiOutProj E{args.in[0], args.in[12], wsp<bf16>(F, WS_X1), wsp<bf16>(F, WS_XN), wsp<float>(F, WS_SS), wsp<unsigned char>(F, WS_T8)};
        GEMM(false, wsp<bf16>(F, WS_MIX), nullptr, D, wsp<bf16>(F, WS_WOUT), D, S, E); } } SEAM(PH_OUTPROJ);
    if (IN(PH_ROUTER)) { { StaticOrder S{M / 256, D / 256, F.G, F.bid}; int kple = PLE; asm volatile("" : "+s"(kple)); EpiStoreBf16 E{wsp<bf16>(F, WS_MIX), D}; GEMM(false, wsp<bf16>(F, WS_PB), nullptr, kple, wsp<bf16>(F, WS_WPP), kple, S, E); }
        for (int rep = 0; rep < NREP(PH_ROUTER); ++rep) { p_router(F, args); __syncthreads(); } } SEAM(PH_ROUTER);
    if (IN(PH_LISTS)) { for (int rep = 0; rep < NREP(PH_LISTS); ++rep) { p_lists(F, args); __syncthreads(); } } SEAM(PH_LISTS);
    if (IN(PH_GU)) { for (int rep = 0; rep < NREP(PH_GU); ++rep) { GroupedOrder S{wsp<int>(F, WS_TILEE), 8, F.G, F.bid}; EpiGateUp E{wsp<int>(F, WS_TILEE), wsp<float>(F, WS_ROWRSTD), args.in[16], wsp<unsigned char>(F, WS_ACT)};
        GEMM8(true, wsp<unsigned char>(F, WS_T8), wsp<int>(F, WS_ROWTOK), wsp<unsigned char>(F, WS_WGU), D, S, E); } } SEAM(PH_GU);
    if (IN(PH_DN)) { for (int rep = 0; rep < NREP(PH_DN); ++rep) { GroupedOrder S{wsp<int>(F, WS_TILEE), 4, F.G, F.bid}; EpiDown E{wsp<float>(F, WS_ROWGATE), args.in[18], wsp<unsigned char>(F, WS_YS)};
        GEMM8(false, wsp<unsigned char>(F, WS_ACT), nullptr, wsp<unsigned char>(F, WS_WDN), FF, S, E); } } SEAM(PH_DN);
    if (IN(PH_COMB)) { for (int rep = 0; rep < NREP(PH_COMB); ++rep) { p_combine(F, args); __syncthreads(); } } SEAM(PH_COMB);
    if (IN(PH_PLE)) { StaticOrder S{M / 256, D / 256, F.G, F.bid};
        { EpiPle E{wsp<bf16>(F, WS_MIX), wsp<bf16>(F, WS_X1), F.out}; GEMM(false, wsp<bf16>(F, WS_XN), nullptr, D, wsp<bf16>(F, WS_WPG), D, S, E); } }
#undef IN
#undef SEAM
}

extern "C" void kernel_launch(void* const* d_in, const int* in_sizes, int n_in, void* d_out, int out_size, void* d_ws, size_t ws_size, hipStream_t stream) {
    static int grid = 0;
    if (grid == 0) {
        if (n_in != 22 || out_size != M * D || ws_size < WS_END) { fprintf(stderr, "kernel_launch: unexpected problem (n_in %d, out %d, ws %zu); nothing launched\n", n_in, out_size, ws_size); grid = -1; return; }
        int dev = 0, cus = 0, per_cu = 0;
        if (hipGetDevice(&dev) != hipSuccess || hipDeviceGetAttribute(&cus, hipDeviceAttributeMultiprocessorCount, dev) != hipSuccess) { grid = -1; return; }
        if (hipFuncSetAttribute((const void*)fwd, hipFuncAttributeMaxDynamicSharedMemorySize, LDS_BYTES) != hipSuccess) { fprintf(stderr, "kernel_launch: hipFuncSetAttribute failed\n"); grid = -1; return; }
        if (hipOccupancyMaxActiveBlocksPerMultiprocessor(&per_cu, (const void*)fwd, NTHR, LDS_BYTES) != hipSuccess || per_cu < 1) fprintf(stderr, "kernel_launch: occupancy query says %d\n", per_cu);
        (void)hipGetLastError();
        grid = cus;
    }
    if (grid < 0) return;
    if (hipMemsetAsync((char*)d_ws + WS_CTL, 0, CTL_ZERO_BYTES, stream) != hipSuccess) return;
    Args a{};
    for (int i = 0; i < 22; ++i) a.in[i] = (const float*)d_in[i];
    a.out = (float*)d_out; a.ws = (unsigned char*)d_ws; a.li = 0; a.pad = 0;
#if MK_PER_PHASE
    for (int ph = 0; ph < NPH; ++ph) { a.ph_lo = ph; a.ph_hi = ph + 1; hipLaunchKernelGGL(fwd, dim3(grid), dim3(NTHR), LDS_BYTES, stream, a); }
#else
    a.ph_lo = 0; a.ph_hi = NPH; hipLaunchKernelGGL(fwd, dim3(grid), dim3(NTHR), LDS_BYTES, stream, a);
#endif
}
```

```cpp
#include <hip/hip_runtime.h>
#include <cstdio>
#include <cstdint>

#ifndef MK_PER_PHASE
#define MK_PER_PHASE 0
#endif

#define GAS __attribute__((address_space(1)))
#define LAS __attribute__((address_space(3)))
typedef unsigned short bf16;
typedef unsigned v4u __attribute__((ext_vector_type(4)));
typedef unsigned v2u __attribute__((ext_vector_type(2)));
typedef float f32x4 __attribute__((ext_vector_type(4)));
typedef short bf16x8 __attribute__((ext_vector_type(8)));
typedef int v8i __attribute__((ext_vector_type(8)));
typedef GAS unsigned gu32;
#define RLX_AGENT __ATOMIC_RELAXED, __HIP_MEMORY_SCOPE_AGENT
#define LDS_WAIT() asm volatile("s_waitcnt lgkmcnt(0)" ::: "memory")
#define VM_WAIT() asm volatile("s_waitcnt vmcnt(0)" ::: "memory")

constexpr int BATCH = 2, SEQ = 8192, D = 1024, M = BATCH * SEQ;
constexpr int PROJ = 3600, NU = 3584;
constexpr int HD = 64, NH = 8, WM = 512;
constexpr int LCH = 128, NCH = SEQ / LCH;
constexpr int MBS = 256, NBK = SEQ / MBS;
constexpr int NPAIR = NBK * (NBK - 1) / 2;
constexpr int NE = 32, TOPK = 4, FF = 1024, PLE = 256;
constexpr int MAXROWS = M * TOPK + NE * 256, MAXTILES = MAXROWS / 256;
constexpr float RMS_EPS = 1e-6f;
constexpr float SW_LIMIT = 7.0f, SW_ALPHA = 1.702f;
constexpr float LOG2E = 1.4426950408889634f;
constexpr float W8_SCALE = 64.0f, W8_INV = 1.0f / 64.0f;
constexpr int UQM = 0, UKM = 512, UVM = 1024, UOM = 1536, UQB = 2048, UKB = 2560, UVB = 3072;
constexpr int NBH = BATCH * NH;

constexpr size_t MiB = 1u << 20;
constexpr size_t WS_CTL = 0, CTL_ZERO_BYTES = 32768;
constexpr size_t WS_WIN = 2 * MiB;
constexpr size_t WS_WOUT = 10 * MiB;
constexpr size_t WS_WPG = 12 * MiB;
constexpr size_t WS_WPP = 14 * MiB;
constexpr size_t WS_WR = 15 * MiB;
constexpr size_t WS_WGU = 16 * MiB;
constexpr size_t WS_WDN = 144 * MiB;
constexpr size_t WS_XN = 208 * MiB;
constexpr size_t WS_PB = 240 * MiB;
constexpr size_t WS_GATES = 248 * MiB;
constexpr size_t WS_SA = 249 * MiB;
constexpr size_t WS_SMX = WS_SA + 512 * 1024;
constexpr size_t WS_SB = WS_SMX + 512 * 1024;
constexpr size_t WS_SW = WS_SB + 512 * 1024;
constexpr size_t WS_SMALL = 251 * MiB;
constexpr size_t WS_DEC = WS_SMALL;
constexpr size_t WS_MC = WS_DEC + 4096;
constexpr size_t WS_KMEAN = WS_MC + 4096;
constexpr size_t WS_MCNT = WS_KMEAN + 131072;
constexpr size_t WS_SELE = 252 * MiB;
constexpr size_t WS_SELW = WS_SELE + 262144;
constexpr size_t WS_RSTD = WS_SELW + 262144;
constexpr size_t WS_HIST = WS_RSTD + 65536;
constexpr size_t WS_POS = WS_HIST + 32768;
constexpr size_t WS_ROWTOK = WS_POS + 262144;
constexpr size_t WS_ROWGATE = WS_ROWTOK + 294912;
constexpr size_t WS_ROWRSTD = WS_ROWGATE + 294912;
constexpr size_t WS_TILEE = WS_ROWRSTD + 294912;
constexpr size_t WS_SS = 254 * MiB;
constexpr size_t WS_DN = 255 * MiB;
constexpr size_t WS_NS = WS_DN + 262144;
constexpr size_t WS_U = 260 * MiB;
constexpr size_t WS_QM = 372 * MiB;
constexpr size_t WS_KM = 388 * MiB;
constexpr size_t WS_QN = 404 * MiB;
constexpr size_t WS_KN = 420 * MiB;
constexpr size_t WS_T8 = 404 * MiB;
constexpr size_t WS_VT = 436 * MiB;
constexpr size_t WS_MIX = 452 * MiB;
constexpr size_t WS_X1 = 484 * MiB;
constexpr size_t WS_MLIST = 548 * MiB;
constexpr size_t WS_OP = 556 * MiB;
constexpr size_t WS_LP = 652 * MiB;
constexpr size_t WS_DC = 654 * MiB;
constexpr size_t WS_CS = 670 * MiB;
constexpr size_t WS_ACT = 688 * MiB;
constexpr size_t WS_YS = 260 * MiB;
constexpr size_t WS_END = 832 * MiB;
static_assert(WS_ACT + (size_t)MAXROWS * 1024 * 2 <= WS_END && WS_YS + (size_t)MAXROWS * 1024 * 2 <= WS_QN, "ws map");
constexpr int CW_BAR = 4096;

constexpr int RING_BYTES = 131072;
constexpr int LDS_BYTES = 147456;
constexpr int MISC_OFF = LDS_BYTES - 256;
constexpr int BG_SCR = 77824;
constexpr int GSCR_OFF = RING_BYTES + 1024;
constexpr int NWAVES = 8, NTHR = 512;
static_assert(BG_SCR + NWAVES * 8448 <= MISC_OFF, "LDS map");

typedef float f32x2_t __attribute__((ext_vector_type(2)));
typedef __bf16 bf16x2_t __attribute__((ext_vector_type(2)));
typedef float f32x16 __attribute__((ext_vector_type(16)));
__device__ __forceinline__ unsigned pk2(float lo, float hi) { f32x2_t v = {lo, hi}; bf16x2_t b = __builtin_convertvector(v, bf16x2_t); return __builtin_bit_cast(unsigned, b); }
__device__ __forceinline__ unsigned f2bf(float f) { return pk2(f, 0.f) & 0xffffu; }
__device__ __forceinline__ unsigned pk4f8(float a, float b, float c, float d) { int w = 0; w = __builtin_amdgcn_cvt_pk_fp8_f32(a, b, w, false); w = __builtin_amdgcn_cvt_pk_fp8_f32(c, d, w, true); return (unsigned)w; }
__device__ __forceinline__ float bf2f(unsigned short b) { return __builtin_bit_cast(float, (unsigned)b << 16); }
__device__ __forceinline__ float bflo(unsigned w) { return __builtin_bit_cast(float, w << 16); }
__device__ __forceinline__ float bfhi(unsigned w) { return __builtin_bit_cast(float, w & 0xffff0000u); }
__device__ __forceinline__ float sigmoidf_(float x) { return 1.0f / (1.0f + __expf(-x)); }

#define XB_TMO      128
#define XB_XCNT(j)  (256  + 64 * (j))
#define XB_XSUB(j)  (1280 + 64 * (j))
#define XB_XGEN(j)  (2304 + 64 * (j))
#define XB_TOP      3328
#define XB_TOPGEN   3392
#define XCD_BAR_WORDS 3456
#define XB_SPIN_CAP (1u << 18)
__device__ __forceinline__ unsigned xb_ld(unsigned* p)              { return __hip_atomic_load(p, __ATOMIC_RELAXED, __HIP_MEMORY_SCOPE_AGENT); }
__device__ __forceinline__ unsigned xb_add(unsigned* p, unsigned v) { return __hip_atomic_fetch_add(p, v, __ATOMIC_RELAXED, __HIP_MEMORY_SCOPE_AGENT); }
__device__ __forceinline__ unsigned xb_xcc_id() { return (unsigned)__builtin_amdgcn_s_getreg((3 << 11) | 20) & 0xFu; }
#define XB_SPIN(cond, bar) do { unsigned _sp = 0; while (cond) { __builtin_amdgcn_s_sleep(1); \
    if ((++_sp & 255u) == 0u) { if (xb_ld(&(bar)[XB_TMO])) break; if (_sp > XB_SPIN_CAP) { atomicAdd(&(bar)[XB_TMO], 1u); break; } } } } while (0)
struct XcdBarrier { unsigned* bar; unsigned x; volatile LAS unsigned* st; };
__device__ __forceinline__ XcdBarrier xcd_barrier_post(unsigned* bar, volatile LAS unsigned* st) {
    XcdBarrier b; b.bar = bar; b.x = xb_xcc_id(); b.st = st;
    if (threadIdx.x == 0) (void)xb_add(&bar[XB_XCNT(b.x)], 1u);
    return b;
}
__device__ __forceinline__ void xcd_barrier_complete(unsigned* bar, unsigned x, unsigned& nloc, unsigned& nx) {
    const unsigned G = gridDim.x * gridDim.y * gridDim.z;
    unsigned sum, cnt, mine, sp = 0u;
    for (;;) {
        sum = 0u; cnt = 0u; mine = 0u;
#pragma unroll
        for (unsigned j = 0; j < 16; ++j) { const unsigned c = xb_ld(&bar[XB_XCNT(j)]); sum += c; cnt += (c > 0u) ? 1u : 0u; mine = (j == x) ? c : mine; }
        if (sum == G) break;
        __builtin_amdgcn_s_sleep(1);
        if ((++sp & 255u) == 0u) { if (xb_ld(&bar[XB_TMO])) break; if (sp > XB_SPIN_CAP) { atomicAdd(&bar[XB_TMO], 1u); break; } }
    }
    nloc = mine > 0u ? mine : 1u; nx = cnt > 0u ? cnt : 1u;
}
__device__ __forceinline__ void xcd_barrier(const XcdBarrier& b) {
    asm volatile("s_waitcnt vmcnt(0)" ::: "memory");
    __syncthreads();
    if (threadIdx.x == 0) {
        unsigned* bar = b.bar;
        __builtin_amdgcn_s_waitcnt(0);
        unsigned nloc = b.st[0], nx = b.st[1];
        if (nloc == 0u) { xcd_barrier_complete(bar, b.x, nloc, nx); b.st[0] = nloc; b.st[1] = nx; }
        const unsigned old = xb_add(&bar[XB_XSUB(b.x)], 1u);
        const unsigned gen = old / nloc;
        if (old + 1u == (gen + 1u) * nloc) {
            __builtin_amdgcn_fence(__ATOMIC_RELEASE, "agent");
            asm volatile("s_waitcnt vmcnt(0)" ::: "memory");
            const unsigned og = xb_add(&bar[XB_TOP], 1u);
            const unsigned tg = og / nx;
            if (og + 1u == (tg + 1u) * nx) xb_add(&bar[XB_TOPGEN], 1u);
            else XB_SPIN(xb_ld(&bar[XB_TOPGEN]) == tg, bar);
            __builtin_amdgcn_fence(__ATOMIC_ACQUIRE, "agent");
            xb_add(&bar[XB_XGEN(b.x)], 1u);
            asm volatile("s_waitcnt vmcnt(0)" ::: "memory");
        } else {
            XB_SPIN(xb_ld(&bar[XB_XGEN(b.x)]) == gen, bar);
            __builtin_amdgcn_fence(__ATOMIC_ACQUIRE, "agent");
            asm volatile("s_waitcnt vmcnt(0)" ::: "memory");
        }
    }
    __syncthreads();
}

struct Args { const float* in[22]; float* out; unsigned char* ws; int ph_lo, ph_hi, li, pad; };
struct Frame {
    LAS unsigned char* lds; volatile LAS unsigned* MISC; gu32* ctl;
    int tid, lane, wave, G, bid;
    float* out; unsigned char* ws;
};
template <class T> __device__ __forceinline__ T* wsp(const Frame& F, size_t off) { return (T*)(F.ws + off); }

__device__ __forceinline__ float wave_sum(float v) {
#pragma unroll
    for (int o = 1; o < 64; o <<= 1) v += __shfl_xor(v, o);
    return v;
}
__device__ __forceinline__ float wave_max(float v) {
#pragma unroll
    for (int o = 1; o < 64; o <<= 1) v = fmaxf(v, __shfl_xor(v, o));
    return v;
}

struct Unit { int pm, pn; };
struct StaticOrder {
    int nM, nN, G, c;
    __device__ __forceinline__ bool next(int i, Unit& u) const {
        const int nwg = nM * nN; const int L = i * G + c; if (L >= nwg) return false;
        int wgid = L; { const int q = nwg / 8, r = nwg % 8, xcd = wgid % 8, off = wgid / 8; wgid = (xcd < r ? xcd * (q + 1) : r * (q + 1) + (xcd - r) * q) + off; }
        const int nig = 8 * nN, gid = wgid / nig, fm = gid * 8, gsz = (nM - fm) < 8 ? (nM - fm) : 8;
        u.pm = fm + ((wgid % nig) % gsz); u.pn = (wgid % nig) / gsz; return true;
    }
};
struct GroupedOrder {
    const int* tile_e; int NT, G, c;
    __device__ __forceinline__ bool next(int i, Unit& u) const {
        const int nwg = tile_e[MAXTILES] * NT; const int L0 = i * G + c; if (L0 >= nwg) return false;
        const int q = nwg / 8, r = nwg % 8, xcd = L0 % 8, off = L0 / 8; const int L = (xcd < r ? xcd * (q + 1) : r * (q + 1) + (xcd - r) * q) + off;
        const int t = L / NT, n = L % NT; u.pm = t; u.pn = tile_e[t] * NT + n; return true;
    }
};
struct PeOrder {
    int first, stride;
    __device__ __forceinline__ bool next(int i, Unit& u) const { const int L = first + i * stride; if (first < 0 || L >= (M / 256) * (D / 256)) return false; u.pm = L >> 2; u.pn = L & 3; return true; }
};
__device__ __forceinline__ int perm32(int rho) { const int n = rho >> 4, i = rho & 15; return 8 * (i >> 2) + 4 * n + (i & 3); }

template <class Sched, class Epi>
__device__ __forceinline__ void sgemm_phase(const Frame& F, const bf16* A, const int* arow, int lda, const bf16* Bt, int K, const Sched& S, const Epi& E) {
    const int wid = F.wave, lane = F.lane, wr = wid >> 2, wc = wid & 3, fr = lane & 15, fq = lane >> 4;
    Unit u;
    for (int i = 0; S.next(i, u); ++i) {
        for (int ai = 0; ai < 2; ++ai) {
            f32x4 acc[2][4][2];
#pragma unroll
            for (int bj = 0; bj < 2; ++bj)
#pragma unroll
                for (int m = 0; m < 4; ++m)
#pragma unroll
                    for (int n = 0; n < 2; ++n) acc[bj][m][n] = (f32x4){0.f, 0.f, 0.f, 0.f};
            const bf16* ap[4]; const bf16* bp[2][2];
#pragma unroll
            for (int m = 0; m < 4; ++m) { const int r = u.pm * 256 + ai * 128 + wr * 64 + m * 16 + fr; const int src = arow ? arow[r] : r; ap[m] = A + (size_t)src * lda + fq * 8; }
#pragma unroll
            for (int bj = 0; bj < 2; ++bj)
#pragma unroll
                for (int n = 0; n < 2; ++n) bp[bj][n] = Bt + (size_t)(u.pn * 256 + bj * 128 + wc * 32 + perm32(16 * n + fr)) * K + fq * 8;
            for (int k = 0; k < K; k += 32) {
                bf16x8 af[4], bfr[2][2];
#pragma unroll
                for (int m = 0; m < 4; ++m) af[m] = *(const bf16x8*)(ap[m] + k);
#pragma unroll
                for (int bj = 0; bj < 2; ++bj)
#pragma unroll
                    for (int n = 0; n < 2; ++n) bfr[bj][n] = *(const bf16x8*)(bp[bj][n] + k);
#pragma unroll
                for (int bj = 0; bj < 2; ++bj)
#pragma unroll
                    for (int m = 0; m < 4; ++m)
#pragma unroll
                        for (int n = 0; n < 2; ++n) acc[bj][m][n] = __builtin_amdgcn_mfma_f32_16x16x32_bf16(bfr[bj][n], af[m], acc[bj][m][n], 0, 0, 0);
            }
#pragma unroll
            for (int m = 0; m < 4; ++m) {
                float lo[8], hi[8];
#pragma unroll
                for (int j = 0; j < 4; ++j) { lo[j] = acc[0][m][0][j]; lo[4 + j] = acc[0][m][1][j]; hi[j] = acc[1][m][0][j]; hi[4 + j] = acc[1][m][1][j]; }
                typename Epi::Pre pre; E.pre(u, wr * 64 + fr, wc * 32 + fq * 8, pre); { typename Epi::Ld ld; E.load(u, ai * 128 + wr * 64 + m * 16 + fr, wc * 32 + fq * 8, ld); E(u, ai * 128 + wr * 64 + m * 16 + fr, wc * 32 + fq * 8, lo, hi, pre, ai * 4 + m, ld); }
            }
        }
    }
}

namespace pg8 {
constexpr int BM = 256, BK = 64, HALF = 128, HTB = HALF * BK * 2, STAGE_BYTES = 8 * HTB;
__device__ __forceinline__ int lds_byte(int r, int c) { const int st = (r >> 4) * 2 + (c >> 5), rr = r & 15, cc = c & 31, ob = rr * 64 + cc * 2; return st * 1024 + (ob ^ (((ob >> 9) & 1) << 5)); }
__device__ __forceinline__ void stage_rc(int b, int& R, int& C) { const int st = b / 1024, sb = b % 1024, swz = sb ^ (((sb >> 9) & 1) << 5); R = (st >> 1) * 16 + swz / 64; C = (st & 1) * 32 + (swz % 64) / 2; }

template <bool FP8>
__device__ __forceinline__ void mma_block(f32x4 (&c)[4][2], const bf16x8 (&At)[4][2], const bf16x8 (&Bq)[2][2]) {
    if constexpr (FP8) {
#pragma unroll
        for (int m = 0; m < 4; ++m)
#pragma unroll
            for (int n = 0; n < 2; ++n) {
                const v4u b0 = __builtin_bit_cast(v4u, Bq[n][0]), b1 = __builtin_bit_cast(v4u, Bq[n][1]), a0 = __builtin_bit_cast(v4u, At[m][0]), a1 = __builtin_bit_cast(v4u, At[m][1]);
                const v8i bw = {(int)b0.x, (int)b0.y, (int)b0.z, (int)b0.w, (int)b1.x, (int)b1.y, (int)b1.z, (int)b1.w}, aw = {(int)a0.x, (int)a0.y, (int)a0.z, (int)a0.w, (int)a1.x, (int)a1.y, (int)a1.z, (int)a1.w};
                c[m][n] = __builtin_amdgcn_mfma_scale_f32_16x16x128_f8f6f4(bw, aw, c[m][n], 0, 0, 0, 0x7F7F7F7F, 0, 0x7F7F7F7F); }
    } else {
#pragma unroll
        for (int m = 0; m < 4; ++m)
#pragma unroll
            for (int n = 0; n < 2; ++n)
#pragma unroll
                for (int k = 0; k < 2; ++k) c[m][n] = __builtin_amdgcn_mfma_f32_16x16x32_bf16(Bq[n][k], At[m][k], c[m][n], 0, 0, 0);
    }
}
template <class Epi, class Sched, bool GATHER, bool ALIGN_EPI, bool FP8>
__device__ __forceinline__ void gemm_phase(LAS unsigned char* lds, const void* A, const int* arow, const void* Bt, const int K, const Sched& S, const Epi& E) {
    const int RB = FP8 ? K : 2 * K;
    const int tid = threadIdx.x, wid = __builtin_amdgcn_readfirstlane(tid >> 6), lane = tid & 63, wr = wid >> 2, wc = wid & 3, fr = lane & 15, fq = lane >> 4;
    const int nt = RB / 128;
    unsigned voffB[2], vA[2][2];
#pragma unroll
    for (int i = 0; i < 2; ++i) { int sR, sC; stage_rc(tid * 16 + i * 8192, sR, sC); const int Rb = (sR & ~31) + perm32(sR & 31);
        voffB[i] = (unsigned)(Rb * RB + sC * 2);
        vA[0][i] = (unsigned)(sR * RB + sC * 2); vA[1][i] = (unsigned)((sR + HALF) * RB + sC * 2); }
    const unsigned kstep = 128u;
    const unsigned hstep = (unsigned)HALF * RB;
    const unsigned r64 = 64u * RB;
    const unsigned tstep = 2 * hstep;
    const __amdgpu_buffer_rsrc_t rA = __builtin_amdgcn_make_buffer_rsrc((void*)A, 0, 0x7fffffff, 0x00020000), rB = __builtin_amdgcn_make_buffer_rsrc((void*)Bt, 0, 0x7fffffff, 0x00020000);
    const unsigned ldsw = (unsigned)wid * 1024u;
    const int aoff = lds_byte(wr * 64 + fr, fq * 8), boff = lds_byte(wc * 32 + fr, fq * 8);
#define PG8_SA(b, h) (((b) * 2 + (h)) * HTB)
#define PG8_SB(b, h) ((4 + (b) * 2 + (h)) * HTB)
#define PG8_STAGE_B(bufoff, so) do { _Pragma("unroll") for (int _i = 0; _i < 2; ++_i) \
        __builtin_amdgcn_raw_ptr_buffer_load_lds(rB, (LAS unsigned*)(lds + (bufoff) + ldsw + _i * 8192), 16, voffB[0], (int)((so) + _i * r64), 0, 0); } while (0)
#define PG8_STAGE_A(bufoff, so, h, nx) do { _Pragma("unroll") for (int _i = 0; _i < 2; ++_i) { if constexpr (GATHER) \
        __builtin_amdgcn_raw_ptr_buffer_load_lds(rA, (LAS unsigned*)(lds + (bufoff) + ldsw + _i * 8192), 16, vA[h][_i], (int)(so), 0, 0); else \
        __builtin_amdgcn_raw_ptr_buffer_load_lds(rA, (LAS unsigned*)(lds + (bufoff) + ldsw + _i * 8192), 16, vA[0][0], (int)((so) + (h) * hstep + _i * r64), 0, 0); } } while (0)
#define PG8_LDA(dst, b, h) do { _Pragma("unroll") for (int m = 0; m < 4; ++m) _Pragma("unroll") for (int k = 0; k < 2; ++k) dst[m][k] = *(const LAS bf16x8*)(lds + PG8_SA(b, h) + aoff + m * 2048 + k * 1024); } while (0)
#define PG8_LDB(dst, b, h) do { _Pragma("unroll") for (int n = 0; n < 2; ++n) _Pragma("unroll") for (int k = 0; k < 2; ++k) dst[n][k] = *(const LAS bf16x8*)(lds + PG8_SB(b, h) + boff + n * 2048 + k * 1024); } while (0)
#define PG8_MMA(ai, bj, At, Bq) do { __builtin_amdgcn_s_setprio(1); mma_block<FP8>(acc[ai][bj], At, Bq); __builtin_amdgcn_s_setprio(0); } while (0)
#define PG8_WAIT_V(n) asm volatile("s_waitcnt vmcnt(" #n ")" ::: "memory")
#define PG8_WAIT_L(n) asm volatile("s_waitcnt lgkmcnt(" #n ")" ::: "memory")
#define PG8_BAR __builtin_amdgcn_s_barrier()
#define PG8_SCHED __builtin_amdgcn_sched_barrier(0)
#define PG8_GOFF(dst, u) do { if (GATHER) { _Pragma("unroll") for (int _h = 0; _h < 2; ++_h) _Pragma("unroll") for (int _i = 0; _i < 2; ++_i) { int _R, _C; stage_rc(tid * 16 + _i * 8192, _R, _C); \
        dst[_h][_i] = (unsigned)(arow[(u).pm * BM + _h * HALF + _R] * RB + _C * 2); } } } while (0)
    LAS v4u* gscr = (LAS v4u*)(lds + GSCR_OFF) + tid;
    Unit cur, nxt; int ui = 0;
    if (!S.next(0, cur)) return;
    PG8_GOFF(vA, cur);
    f32x4 acc[2][2][4][2];
#pragma unroll
    for (int a = 0; a < 2; ++a)
#pragma unroll
        for (int b = 0; b < 2; ++b)
#pragma unroll
            for (int m = 0; m < 4; ++m)
#pragma unroll
                for (int n = 0; n < 2; ++n) acc[a][b][m][n] = (f32x4){0.f, 0.f, 0.f, 0.f};
    bf16x8 At[4][2], B0[2][2], B1[2][2];
    unsigned cA = GATHER ? 0u : (unsigned)cur.pm * tstep, cB = (unsigned)cur.pn * tstep;
    PG8_STAGE_B(PG8_SB(0, 0), cB); PG8_STAGE_B(PG8_SB(0, 1), cB + hstep); PG8_STAGE_A(PG8_SA(0, 0), cA, 0, false); PG8_STAGE_A(PG8_SA(0, 1), cA, 1, false);
    if (wr == 1) PG8_BAR;
    PG8_WAIT_V(2); PG8_BAR;
    PG8_STAGE_B(PG8_SB(1, 0), cB + kstep); PG8_STAGE_A(PG8_SA(1, 0), cA + kstep, 0, false); PG8_STAGE_B(PG8_SB(1, 1), cB + hstep + kstep);
    PG8_WAIT_V(6); PG8_BAR;
    for (;;) {
        const bool has_next = S.next(ui + 1, nxt);
        const unsigned nA = has_next ? (GATHER ? 0u : (unsigned)nxt.pm * tstep) : cA, nB = has_next ? (unsigned)nxt.pn * tstep : cB;
        if (GATHER) { if (has_next) { unsigned nv[2][2]; PG8_GOFF(nv, nxt); *gscr = (v4u){nv[0][0], nv[0][1], nv[1][0], nv[1][1]}; } else *gscr = (v4u){vA[0][0], vA[0][1], vA[1][0], vA[1][1]}; }
#pragma unroll 1
        for (int t = 0; t < nt; t += 2) {
            const bool last = (t == nt - 2);
            const unsigned a1 = cA + (unsigned)(t + 1) * kstep;
            const unsigned a2 = last ? nA : cA + (unsigned)(t + 2) * kstep, b2 = last ? nB : cB + (unsigned)(t + 2) * kstep;
            const unsigned a3 = a2 + kstep, b3 = b2 + kstep;
            PG8_LDB(B0, 0, 0); PG8_LDB(B1, 0, 1); PG8_SCHED; PG8_LDA(At, 0, 0); PG8_STAGE_A(PG8_SA(1, 1), a1, 1, false);
            if (GATHER) { if (last) { const v4u nv = *gscr; vA[0][0] = nv.x; vA[0][1] = nv.y; vA[1][0] = nv.z; vA[1][1] = nv.w; } }
            PG8_WAIT_V(8); PG8_WAIT_L(0); PG8_BAR; PG8_MMA(0, 0, At, B0); PG8_MMA(0, 1, At, B1); PG8_BAR; PG8_SCHED;
            PG8_LDA(At, 0, 1); PG8_STAGE_B(PG8_SB(0, 0), b2); PG8_STAGE_B(PG8_SB(0, 1), b2 + hstep); PG8_STAGE_A(PG8_SA(0, 0), a2, 0, last);
            PG8_WAIT_V(8); PG8_WAIT_L(0); PG8_BAR; PG8_MMA(1, 0, At, B0); PG8_MMA(1, 1, At, B1); PG8_BAR; PG8_SCHED;
            PG8_LDB(B0, 1, 0); PG8_LDB(B1, 1, 1); PG8_SCHED; PG8_LDA(At, 1, 0); PG8_STAGE_A(PG8_SA(0, 1), a2, 1, last);
            PG8_WAIT_V(8); PG8_WAIT_L(0); PG8_BAR; PG8_MMA(0, 0, At, B0); PG8_MMA(0, 1, At, B1); PG8_BAR; PG8_SCHED;
            PG8_LDA(At, 1, 1); PG8_STAGE_B(PG8_SB(1, 0), b3); PG8_STAGE_B(PG8_SB(1, 1), b3 + hstep); PG8_STAGE_A(PG8_SA(1, 0), a3, 0, last);
            PG8_WAIT_V(8); PG8_WAIT_L(0); PG8_BAR; PG8_MMA(1, 0, At, B0); PG8_MMA(1, 1, At, B1); PG8_BAR; PG8_SCHED;
        }
        if constexpr (ALIGN_EPI) { if (wr == 0) PG8_BAR; }
        {
            int fr2 = fr, fq2 = fq; asm volatile("" : "+v"(fr2), "+v"(fq2));
            typename Epi::Pre pre; E.pre(cur, wr * 64 + fr2, wc * 32 + fq2 * 8, pre);
            typename Epi::Ld ld; E.load(cur, wr * 64 + fr2, wc * 32 + fq2 * 8, ld);
#pragma unroll
            for (int ai = 0; ai < 2; ++ai)
#pragma unroll
                for (int m = 0; m < 4; ++m) { float lo[8], hi[8]; const int g = ai * 4 + m;
#pragma unroll
                    for (int j = 0; j < 4; ++j) { lo[j] = acc[ai][0][m][0][j]; lo[4 + j] = acc[ai][0][m][1][j]; hi[j] = acc[ai][1][m][0][j]; hi[4 + j] = acc[ai][1][m][1][j]; }
                    typename Epi::Ld nld; if (g < 7) E.load(cur, ((g + 1) >> 2) * HALF + wr * 64 + ((g + 1) & 3) * 16 + fr2, wc * 32 + fq2 * 8, nld);
                    E(cur, ai * HALF + wr * 64 + m * 16 + fr2, wc * 32 + fq2 * 8, lo, hi, pre, g, ld); if (Epi::FENCE) asm volatile("" ::: "memory"); ld = nld; }
        }
        if (!has_next) break;
#pragma unroll
        for (int a = 0; a < 2; ++a)
#pragma unroll
            for (int b = 0; b < 2; ++b)
#pragma unroll
                for (int m = 0; m < 4; ++m)
#pragma unroll
                    for (int n = 0; n < 2; ++n) acc[a][b][m][n] = (f32x4){0.f, 0.f, 0.f, 0.f};
        cur = nxt; cA = nA; cB = nB; ++ui;
        if constexpr (ALIGN_EPI) { if (wr == 1) PG8_BAR; }
    }
    PG8_WAIT_V(0);
    if constexpr (!ALIGN_EPI) { if (wr == 0) PG8_BAR; }
    PG8_BAR;
#undef PG8_SA
#undef PG8_SB
#undef PG8_STAGE_A
#undef PG8_STAGE_B
#undef PG8_LDA
#undef PG8_LDB
#undef PG8_MMA
#undef PG8_WAIT_V
#undef PG8_WAIT_L
#undef PG8_BAR
#undef PG8_SCHED
#undef PG8_GOFF
}
}
__device__ __forceinline__ void store8bf(bf16* p, const float (&v)[8]) { v4u w; w.x = pk2(v[0], v[1]); w.y = pk2(v[2], v[3]); w.z = pk2(v[4], v[5]); w.w = pk2(v[6], v[7]); *(v4u*)p = w; }

struct NoPre {};
struct EpiStoreBf16 { bf16* O; int ldc;
    typedef NoPre Pre; typedef NoPre Ld; static constexpr bool FENCE = false;
    __device__ __forceinline__ void pre(const Unit&, int, int, Pre&) const {}
    __device__ __forceinline__ void load(const Unit&, int, int, Ld&) const {}
    __device__ __forceinline__ void operator()(const Unit& u, int r, int c, const float (&lo)[8], const float (&hi)[8], const Pre&, int, const Ld&) const {
        bf16* o = O + (size_t)(u.pm * 256 + r) * ldc + u.pn * 256 + c; store8bf(o, lo); store8bf(o + 128, hi); } };
struct LdOut { f32x4 x[4]; };
struct EpiOutProj { const float* x; bf16* X1; float* SS; unsigned char* T8;
    typedef NoPre Pre; typedef LdOut Ld; static constexpr bool FENCE = true;
    __device__ __forceinline__ void pre(const Unit&, int, int, Pre&) const {}
    __device__ __forceinline__ void load(const Unit& u, int r, int c, Ld& l) const { const float* xp = x + ((size_t)u.pm * 256 + r) * D + u.pn * 256 + c;
        l.x[0] = *(const f32x4*)xp; l.x[1] = *(const f32x4*)(xp + 4); l.x[2] = *(const f32x4*)(xp + 128); l.x[3] = *(const f32x4*)(xp + 132); }
    __device__ __forceinline__ void operator()(const Unit& u, int r, int c, const float (&lo)[8], const float (&hi)[8], const Pre&, int, const Ld& l) const {
        const size_t row = (size_t)u.pm * 256 + r; const int col = u.pn * 256 + c; float ss = 0.f;
#pragma unroll
        for (int h = 0; h < 2; ++h) { const float* v = h ? hi : lo; const int cc = col + h * 128; float o[8];
#pragma unroll
            for (int j = 0; j < 8; ++j) { o[j] = l.x[2 * h + (j >> 2)][j & 3] + v[j]; ss += o[j] * o[j]; }
            store8bf(X1 + row * D + cc, o); *(v2u*)(T8 + row * D + cc) = (v2u){pk4f8(o[0], o[1], o[2], o[3]), pk4f8(o[4], o[5], o[6], o[7])}; }
        ss += __shfl_xor(ss, 16); ss += __shfl_xor(ss, 32);
        if ((threadIdx.x & 63) < 16) SS[row * 16 + u.pn * 4 + (c >> 5)] = ss; } };
struct PreRow { float lo[8], hi[8], rw[8]; };
struct EpiGateUp { const int* tile_e; const float* rowrstd; const float* b_gu; unsigned char* ACT;
    typedef PreRow Pre; typedef NoPre Ld; static constexpr bool FENCE = false;
    __device__ __forceinline__ void load(const Unit&, int, int, Ld&) const {}
    __device__ __forceinline__ void pre(const Unit& u, int r0, int c, Pre& p) const {
        const int e = u.pn >> 3, nt = u.pn & 7; const float* bg = b_gu + (size_t)e * 2048 + nt * 128 + c;
        const f32x4 a0 = *(const f32x4*)bg, a1 = *(const f32x4*)(bg + 4), b0 = *(const f32x4*)(bg + 1024), b1 = *(const f32x4*)(bg + 1028);
        p.lo[0] = a0.x; p.lo[1] = a0.y; p.lo[2] = a0.z; p.lo[3] = a0.w; p.lo[4] = a1.x; p.lo[5] = a1.y; p.lo[6] = a1.z; p.lo[7] = a1.w;
        p.hi[0] = b0.x; p.hi[1] = b0.y; p.hi[2] = b0.z; p.hi[3] = b0.w; p.hi[4] = b1.x; p.hi[5] = b1.y; p.hi[6] = b1.z; p.hi[7] = b1.w;
#pragma unroll
        for (int g = 0; g < 8; ++g) p.rw[g] = rowrstd[(size_t)u.pm * 256 + r0 + 128 * (g >> 2) + 16 * (g & 3)] * W8_INV; }
    __device__ __forceinline__ void operator()(const Unit& u, int r, int c, const float (&lo)[8], const float (&hi)[8], const Pre& p, int g, const Ld&) const {
        const int nt = u.pn & 7; const size_t row = (size_t)u.pm * 256 + r; const float rs = p.rw[g]; float a[8];
#pragma unroll
        for (int j = 0; j < 8; ++j) { float glu = lo[j] * rs + p.lo[j], lin = hi[j] * rs + p.hi[j];
            glu = fminf(glu, SW_LIMIT); lin = fminf(fmaxf(lin, -SW_LIMIT), SW_LIMIT);
            a[j] = glu * sigmoidf_(SW_ALPHA * glu) * (lin + 1.0f); }
        *(v2u*)(ACT + row * FF + nt * 128 + c) = (v2u){pk4f8(a[0], a[1], a[2], a[3]), pk4f8(a[4], a[5], a[6], a[7])}; } };
struct EpiDown { const float* rowgate; const float* b_dn; unsigned char* YS;
    typedef PreRow Pre; typedef NoPre Ld; static constexpr bool FENCE = false;
    __device__ __forceinline__ void load(const Unit&, int, int, Ld&) const {}
    __device__ __forceinline__ void pre(const Unit& u, int r0, int c, Pre& p) const {
        const int e = u.pn >> 2, nt = u.pn & 3; const float* bd = b_dn + (size_t)e * 1024 + nt * 256 + c;
        const f32x4 a0 = *(const f32x4*)bd, a1 = *(const f32x4*)(bd + 4), b0 = *(const f32x4*)(bd + 128), b1 = *(const f32x4*)(bd + 132);
        p.lo[0] = a0.x; p.lo[1] = a0.y; p.lo[2] = a0.z; p.lo[3] = a0.w; p.lo[4] = a1.x; p.lo[5] = a1.y; p.lo[6] = a1.z; p.lo[7] = a1.w;
        p.hi[0] = b0.x; p.hi[1] = b0.y; p.hi[2] = b0.z; p.hi[3] = b0.w; p.hi[4] = b1.x; p.hi[5] = b1.y; p.hi[6] = b1.z; p.hi[7] = b1.w;
#pragma unroll
        for (int g = 0; g < 8; ++g) p.rw[g] = rowgate[(size_t)u.pm * 256 + r0 + 128 * (g >> 2) + 16 * (g & 3)]; }
    __device__ __forceinline__ void operator()(const Unit& u, int r, int c, const float (&lo)[8], const float (&hi)[8], const Pre& p, int g, const Ld&) const {
        const int nt = u.pn & 3; const size_t row = (size_t)u.pm * 256 + r; const float gt = p.rw[g]; float a[8], b[8];
#pragma unroll
        for (int j = 0; j < 8; ++j) { a[j] = (lo[j] * W8_INV + p.lo[j]) * gt; b[j] = (hi[j] * W8_INV + p.hi[j]) * gt; }
        unsigned char* o = YS + row * D + nt * 256 + c; *(v2u*)o = (v2u){pk4f8(a[0], a[1], a[2], a[3]), pk4f8(a[4], a[5], a[6], a[7])}; *(v2u*)(o + 128) = (v2u){pk4f8(b[0], b[1], b[2], b[3]), pk4f8(b[4], b[5], b[6], b[7])}; } };
struct LdPle { v4u pe[2], xw[2]; float rs; };
struct EpiPle { const bf16* PE; const bf16* X2; const float* RS; float* out;
    typedef NoPre Pre; typedef LdPle Ld; static constexpr bool FENCE = true;
    __device__ __forceinline__ void pre(const Unit&, int, int, Pre&) const {}
    __device__ __forceinline__ void load(const Unit& u, int r, int c, Ld& l) const { const size_t o = ((size_t)u.pm * 256 + r) * D + u.pn * 256 + c;
        l.pe[0] = *(const v4u*)(PE + o); l.pe[1] = *(const v4u*)(PE + o + 128); l.xw[0] = *(const v4u*)(X2 + o); l.xw[1] = *(const v4u*)(X2 + o + 128); l.rs = RS[(size_t)u.pm * 256 + r]; }
    __device__ __forceinline__ void operator()(const Unit& u, int r, int c, const float (&lo)[8], const float (&hi)[8], const Pre&, int, const Ld& l) const {
        const size_t row = (size_t)u.pm * 256 + r; const int col = u.pn * 256 + c;
#pragma unroll
        for (int h = 0; h < 2; ++h) { float v[8]; const int cc = col + h * 128; const v4u pe = l.pe[h], xw = l.xw[h];
#pragma unroll
            for (int j = 0; j < 8; ++j) v[j] = (h ? hi[j] : lo[j]) * l.rs;
            f32x4 x0, x1;
            x0[0] = bflo(xw.x) + sigmoidf_(v[0]) * bflo(pe.x); x0[1] = bfhi(xw.x) + sigmoidf_(v[1]) * bfhi(pe.x); x0[2] = bflo(xw.y) + sigmoidf_(v[2]) * bflo(pe.y); x0[3] = bfhi(xw.y) + sigmoidf_(v[3]) * bfhi(pe.y);
            x1[0] = bflo(xw.z) + sigmoidf_(v[4]) * bflo(pe.z); x1[1] = bfhi(xw.z) + sigmoidf_(v[5]) * bfhi(pe.z); x1[2] = bflo(xw.w) + sigmoidf_(v[6]) * bflo(pe.w); x1[3] = bfhi(xw.w) + sigmoidf_(v[7]) * bfhi(pe.w);
            *(f32x4*)(out + row * D + cc) = x0; *(f32x4*)(out + row * D + cc + 4) = x1; } } };

struct TrItem { const float* src; void* dst; const float* gk; int ldw, K, f8; };
__device__ __forceinline__ void tr_load(const TrItem& t, float (&v)[32], int lane) {
#pragma unroll
    for (int i = 0; i < 32; ++i) v[i] = t.src[(size_t)(2 * i + (lane >> 5)) * t.ldw + (lane & 31)];
}
__device__ __forceinline__ void tr_store(const TrItem& t, const float (&v)[32], LAS float* scr, int lane) {
#pragma unroll
    for (int i = 0; i < 32; ++i) scr[(2 * i + (lane >> 5)) * 33 + (lane & 31)] = v[i];
    LDS_WAIT(); asm volatile("" ::: "memory");
    if (t.f8) { const int n = lane >> 1, hf = lane & 1; const LAS float* s = scr + (32 * hf) * 33 + n; unsigned w[8];
#pragma unroll
        for (int q = 0; q < 8; ++q) { f32x4 g = {W8_SCALE, W8_SCALE, W8_SCALE, W8_SCALE}; if (t.gk) g = *(const f32x4*)(t.gk + 32 * hf + 4 * q) * W8_SCALE;
            w[q] = pk4f8(s[(4 * q) * 33] * g.x, s[(4 * q + 1) * 33] * g.y, s[(4 * q + 2) * 33] * g.z, s[(4 * q + 3) * 33] * g.w); }
        unsigned char* o = (unsigned char*)t.dst + (size_t)n * t.K + 32 * hf;
        *(v4u*)o = (v4u){w[0], w[1], w[2], w[3]}; *(v4u*)(o + 16) = (v4u){w[4], w[5], w[6], w[7]};
    } else { const int c = lane & 7;
        f32x4 g0 = {1.f, 1.f, 1.f, 1.f}, g1 = g0; if (t.gk) { g0 = *(const f32x4*)(t.gk + 8 * c); g1 = *(const f32x4*)(t.gk + 8 * c + 4); }
#pragma unroll
        for (int j = 0; j < 4; ++j) { const int n = (lane >> 3) + 8 * j; const LAS float* s = scr + (8 * c) * 33 + n;
            v4u o; o.x = pk2(s[0 * 33] * g0.x, s[1 * 33] * g0.y); o.y = pk2(s[2 * 33] * g0.z, s[3 * 33] * g0.w); o.z = pk2(s[4 * 33] * g1.x, s[5 * 33] * g1.y); o.w = pk2(s[6 * 33] * g1.z, s[7 * 33] * g1.w);
            *(v4u*)((bf16*)t.dst + (size_t)n * t.K + 8 * c) = o; } }
    LDS_WAIT(); asm volatile("" ::: "memory");
}
constexpr int I_IN = 16 * (NU / 32), I_SQ = 16 * 32, I_PP = 4 * 32, I_R = 16, I_GU = 16 * 64, I_DN = 16 * 32;
constexpr int NITEMS = I_IN + 2 * I_SQ + I_PP + I_R + NE * I_GU + NE * I_DN;
__device__ __forceinline__ TrItem tr_decode(const Frame& F, const Args& args, int r) {
    TrItem t; t.f8 = 0; t.gk = nullptr;
    if (r < I_IN) { const int kb = r / (NU / 32), nb = r % (NU / 32), n0 = 32 * nb, sc = n0 < 2048 ? n0 : n0 + 16;
        t.src = args.in[3] + (size_t)(64 * kb) * PROJ + sc; t.ldw = PROJ; t.dst = wsp<bf16>(F, WS_WIN) + (size_t)n0 * D + 64 * kb; t.K = D; }
    else if ((r -= I_IN) < I_SQ) { const int kb = r / 32, n0 = 32 * (r % 32); t.src = args.in[11] + (size_t)(64 * kb) * D + n0; t.ldw = D; t.dst = wsp<bf16>(F, WS_WOUT) + (size_t)n0 * D + 64 * kb; t.K = D; }
    else if ((r -= I_SQ) < I_SQ) { const int kb = r / 32, n0 = 32 * (r % 32); t.src = args.in[20] + (size_t)(64 * kb) * D + n0; t.ldw = D; t.dst = wsp<bf16>(F, WS_WPG) + (size_t)n0 * D + 64 * kb; t.K = D; t.gk = args.in[19] + 64 * kb; }
    else if ((r -= I_SQ) < I_PP) { const int kb = r / 32, n0 = 32 * (r % 32); t.src = args.in[21] + (size_t)(64 * kb) * D + n0; t.ldw = D; t.dst = wsp<bf16>(F, WS_WPP) + (size_t)n0 * PLE + 64 * kb; t.K = PLE; }
    else if ((r -= I_PP) < I_R) { const int kb = r; t.src = args.in[13] + (size_t)(64 * kb) * NE; t.ldw = NE; t.dst = wsp<bf16>(F, WS_WR) + 64 * kb; t.K = D; t.gk = args.in[12] + 64 * kb; }
    else if ((r -= I_R) < NE * I_GU) { const int e = r / I_GU, q = r % I_GU, kb = q / 64, n0 = 32 * (q % 64), pn = n0 >> 8, c = n0 & 255;
        const int sc = c < 128 ? pn * 128 + c : 1024 + pn * 128 + (c - 128);
        t.src = args.in[15] + ((size_t)e * D + 64 * kb) * 2048 + sc; t.ldw = 2048; t.dst = wsp<unsigned char>(F, WS_WGU) + ((size_t)e * 2048 + n0) * D + 64 * kb; t.K = D; t.f8 = 1; t.gk = args.in[12] + 64 * kb; }
    else { r -= NE * I_GU; const int e = r / I_DN, q = r % I_DN, kb = q / 32, n0 = 32 * (q % 32);
        t.src = args.in[17] + ((size_t)e * FF + 64 * kb) * D + n0; t.ldw = D; t.dst = wsp<unsigned char>(F, WS_WDN) + ((size_t)e * D + n0) * FF + 64 * kb; t.K = FF; t.f8 = 1; }
    return t;
}
constexpr int BGS_CONV = 0, BGS_KPART = 4, BGS_ROUTE = 6, BGS_STATE = 8, BGS_MIXA = 12, BGS_MIXB = 20, BGS_END = 22;
struct Bg { float v[32]; TrItem it; int live; };
constexpr int I_SMALL = I_IN + 2 * I_SQ + I_PP + I_R, NBG = 4096;
template <bool REMAP>
__device__ __forceinline__ void tr_run(Frame& F, const Args& args, int first, int count, int w, int nw) {
    LAS float* scr = (LAS float*)(F.lds + F.wave * 16384); const int lane = F.lane;
    float v[32], nv[32]; int q = w;
#define TR_ITEM(qq) (REMAP ? ((qq) < I_SMALL ? (qq) : (qq) + NBG) : first + (qq))
    TrItem cur = tr_decode(F, args, TR_ITEM(q < count ? q : 0));
    if (q < count) tr_load(cur, v, lane);
    while (q < count) { const int nq = q + nw; TrItem nx = tr_decode(F, args, TR_ITEM(nq < count ? nq : 0));
        if (nq < count) tr_load(nx, nv, lane);
        tr_store(cur, v, scr, lane);
#pragma unroll
        for (int i = 0; i < 32; ++i) v[i] = nv[i];
        cur = nx; q = nq; }
#undef TR_ITEM
}
__device__ __forceinline__ void bg_issue(const Frame& F, const Args& args, Bg& bg, int slot) {
    if (F.G != 256) { bg.live = 0; return; }
    int ln = F.lane; asm volatile("" : "+v"(ln));
    const int item = I_SMALL + NBG + (slot * 256 + F.bid) * NWAVES + F.wave; bg.live = item < NITEMS;
    bg.it = tr_decode(F, args, bg.live ? item : I_SMALL);
    if (bg.live) tr_load(bg.it, bg.v, ln);
}
__device__ __forceinline__ void bg_retire(const Frame& F, Bg& bg) { int ln = F.lane; asm volatile("" : "+v"(ln)); if (bg.live) tr_store(bg.it, bg.v, (LAS float*)(F.lds + BG_SCR + F.wave * 8448), ln); }
#define BG_DECL(base, n) Bg bg; int bg_s = (base); const int bg_e = (base) + (n); bg.live = 0
#define BG_TOP() do { if (bg_s < bg_e) bg_issue(F, args, bg, bg_s); } while (0)
#define BG_BOT() do { if (bg_s < bg_e) { bg_retire(F, bg); ++bg_s; } } while (0)
#define BG_FLUSH() do { while (bg_s < bg_e) { bg_issue(F, args, bg, bg_s); bg_retire(F, bg); ++bg_s; } } while (0)
__device__ __forceinline__ void p0_prologue(Frame& F, const Args& args) {
    const int gw = F.bid * NWAVES + F.wave, NGW = F.G * NWAVES, lane = F.lane;
    tr_run<false>(F, args, 0, F.G == 256 ? I_SMALL : NITEMS, gw, NGW);
    __syncthreads();
    { LAS float* slab = (LAS float*)F.lds;
      f32x4 w[8];
#pragma unroll
      for (int q = 0; q < 8; ++q) { const int e = F.tid + NTHR * q; w[q] = *(const f32x4*)(args.in[3] + (size_t)(e >> 2) * PROJ + 2048 + (e & 3) * 4); }
#pragma unroll
      for (int q = 0; q < 8; ++q) { const int e = F.tid + NTHR * q, k = e >> 2, c4 = (e & 3) * 4;
          slab[(c4 + 0) * D + k] = w[q].x; slab[(c4 + 1) * D + k] = w[q].y; slab[(c4 + 2) * D + k] = w[q].z; slab[(c4 + 3) * D + k] = w[q].w; } }
    __syncthreads();
    bf16* XN = wsp<bf16>(F, WS_XN); float* GT = wsp<float>(F, WS_GATES);
    f32x4 nv[2][4];
#pragma unroll
    for (int r = 0; r < 2; ++r) if (gw + r * NGW < M) {
#pragma unroll
        for (int j = 0; j < 4; ++j) nv[r][j] = ((const f32x4*)(args.in[0] + (size_t)(gw + r * NGW) * D) + lane)[64 * j]; }
    for (int m = gw; m < M; m += 2 * NGW) {
        const f32x4* gr = (const f32x4*)args.in[2] + lane;
        f32x4 v[2][4]; const bool two = m + NGW < M;
#pragma unroll
        for (int r = 0; r < 2; ++r)
#pragma unroll
            for (int j = 0; j < 4; ++j) v[r][j] = (r == 0 || two) ? nv[r][j] : (f32x4){0.f, 0.f, 0.f, 0.f};
#pragma unroll
        for (int r = 0; r < 2; ++r) if (m + (2 + r) * NGW < M) {
#pragma unroll
            for (int j = 0; j < 4; ++j) nv[r][j] = ((const f32x4*)(args.in[0] + (size_t)(m + (2 + r) * NGW) * D) + lane)[64 * j]; }
        asm volatile("" ::: "memory");
#pragma unroll
        for (int r = 0; r < 2; ++r) { float s = 0.f;
#pragma unroll
            for (int j = 0; j < 4; ++j) s += (v[r][j].x * v[r][j].x + v[r][j].y * v[r][j].y) + (v[r][j].z * v[r][j].z + v[r][j].w * v[r][j].w);
            const float rstd = 1.0f / sqrtf(wave_sum(s) * (1.0f / D) + RMS_EPS);
#pragma unroll
            for (int j = 0; j < 4; ++j) { const f32x4 g = gr[64 * j]; v[r][j] = v[r][j] * rstd * g;
                if (r == 0 || two) *(v2u*)(XN + (size_t)(m + r * NGW) * D + 256 * j + 4 * lane) = (v2u){pk2(v[r][j].x, v[r][j].y), pk2(v[r][j].z, v[r][j].w)}; } }
        float ga[32];
#pragma unroll
        for (int c = 0; c < 16; ++c) { float a0 = 0.f, a1 = 0.f;
#pragma unroll
            for (int j = 0; j < 4; ++j) { const f32x4 w = *(const LAS f32x4*)((LAS float*)F.lds + c * D + 256 * j + 4 * lane);
                a0 += (v[0][j].x * w.x + v[0][j].y * w.y) + (v[0][j].z * w.z + v[0][j].w * w.w); a1 += (v[1][j].x * w.x + v[1][j].y * w.y) + (v[1][j].z * w.z + v[1][j].w * w.w); }
            ga[c] = a0; ga[16 + c] = a1; }
#define BFLY(HALF, BIT) { const bool up = lane & (BIT); _Pragma("unroll") for (int c = 0; c < (HALF); ++c) { const float mine = up ? ga[c + (HALF)] : ga[c], oth = up ? ga[c] : ga[c + (HALF)]; ga[c] = mine + __shfl_xor(oth, (BIT)); } }
        BFLY(16, 1) BFLY(8, 2) BFLY(4, 4) BFLY(2, 8) BFLY(1, 16)
#undef BFLY
        ga[0] += __shfl_xor(ga[0], 32);
        if (lane < 32) { const int idx = 16 * (lane & 1) + 8 * ((lane >> 1) & 1) + 4 * ((lane >> 2) & 1) + 2 * ((lane >> 3) & 1) + ((lane >> 4) & 1); const int r = idx >> 4, col = idx & 15;
            if (r == 0 || two) GT[(size_t)(m + r * NGW) * 16 + col] = ga[0] + (col < 8 ? args.in[6][col] : args.in[7][col - 8]); }
    }
    bf16* PB = wsp<bf16>(F, WS_PB);
    { const size_t n4 = (size_t)M * PLE / 4, st = (size_t)F.G * NTHR;
      for (size_t i0 = (size_t)F.bid * NTHR + F.tid; i0 < n4; i0 += 4 * st) { f32x4 t[4];
#pragma unroll
          for (int q = 0; q < 4; ++q) if (i0 + q * st < n4) t[q] = ((const f32x4*)args.in[1])[i0 + q * st];
#pragma unroll
          for (int q = 0; q < 4; ++q) if (i0 + q * st < n4) *(v2u*)(PB + 4 * (i0 + q * st)) = (v2u){pk2(t[q].x, t[q].y), pk2(t[q].z, t[q].w)}; } }
}

__device__ __forceinline__ float logsigmoidf_(float f) { return f >= 0.f ? -log1pf(__expf(-f)) : f - log1pf(__expf(f)); }
__device__ __forceinline__ void gate_scans(Frame& F, int first, int stride) {
    { const float* GT = wsp<float>(F, WS_GATES); float* SA = wsp<float>(F, WS_SA); float* SMX = wsp<float>(F, WS_SMX); float* SB = wsp<float>(F, WS_SB); float* SW = wsp<float>(F, WS_SW);
      float* DEC = wsp<float>(F, WS_DEC); float* MC = wsp<float>(F, WS_MC);
      LAS float* sbl = (LAS float*)(F.lds + 4096); LAS float* sA = sbl + 64; LAS float* sm = sA + 64;
      for (int bh = first; bh < NBH; bh += stride) {
          const int b = bh / NH, h = bh % NH;
          __syncthreads();
          for (int c = F.wave; c < NCH; c += NWAVES) {
              const size_t m0 = (size_t)b * SEQ + c * LCH + 2 * F.lane;
              const float i0 = GT[m0 * 16 + h], i1 = GT[(m0 + 1) * 16 + h];
              const float l0 = logsigmoidf_(GT[m0 * 16 + 8 + h]), l1 = logsigmoidf_(GT[(m0 + 1) * 16 + 8 + h]);
              float s = l0 + l1, inc = s;
#pragma unroll
              for (int o = 1; o < 64; o <<= 1) { const float t = __shfl_up(inc, o); if (F.lane >= o) inc += t; }
              const float b0 = (inc - s) + l0, b1 = inc;
              const float a0 = i0 - b0, a1 = i1 - b1;
              float mx = fmaxf(a0, a1), pm = mx;
#pragma unroll
              for (int o = 1; o < 64; o <<= 1) { const float t = __shfl_up(pm, o); if (F.lane >= o) pm = fmaxf(pm, t); }
              float ex = __shfl_up(pm, 1); if (F.lane == 0) ex = -INFINITY;
              const float cm0 = fmaxf(ex, a0), cm1 = fmaxf(cm0, a1);
              const size_t o0 = (size_t)bh * SEQ + c * LCH + 2 * F.lane;
              SA[o0] = a0; SA[o0 + 1] = a1; SB[o0] = b0; SB[o0 + 1] = b1; SMX[o0] = cm0; SMX[o0 + 1] = cm1;
              if (F.lane == 63) { sbl[c] = b1; sA[c] = cm1; }
          }
          __syncthreads();
          if (F.tid == 0) { float m = 0.f; for (int c = 0; c < NCH; ++c) { sm[c] = m; m = sbl[c] + fmaxf(m, sA[c]); } sm[NCH] = m; }
          VM_WAIT(); __syncthreads();
          for (int c = F.wave; c < NCH; c += NWAVES) {
              const float mc = sm[c], mn = sm[c + 1], bL = sbl[c];
              const size_t o0 = (size_t)bh * SEQ + c * LCH + 2 * F.lane;
              const float a0 = SA[o0], a1 = SA[o0 + 1], c0 = SMX[o0], c1 = SMX[o0 + 1];
              SMX[o0] = fmaxf(mc, c0); SMX[o0 + 1] = fmaxf(mc, c1);
              SW[o0] = __expf(bL + a0 - mn); SW[o0 + 1] = __expf(bL + a1 - mn);
              if (F.lane == 0) { DEC[bh * NCH + c] = __expf(bL + mc - mn); MC[bh * NCH + c] = mc; }
          }
      } }
}
__device__ __forceinline__ void p_prep(Frame& F, const Args& args) {
    const bf16* U = wsp<bf16>(F, WS_U);
    { bf16* QM = wsp<bf16>(F, WS_QM); bf16* KM = wsp<bf16>(F, WS_KM);
      BG_DECL(BGS_CONV, 4);
      const size_t cst = (size_t)F.G * NTHR, ctot = (size_t)(M / 4) * 128; const int cit = (int)((ctot + cst - 1) / cst), cq = (cit + 3) / 4;
      for (int sl = 0; sl < 4; ++sl) { BG_TOP();
      for (int kk = sl * cq; kk < (sl + 1) * cq && kk < cit; ++kk) { const size_t i = (size_t)F.bid * NTHR + F.tid + (size_t)kk * cst; if (i >= ctot) break;
          const int m0 = (int)(i >> 7) * 4, ch = (int)(i & 127) * 8, t0 = m0 & (SEQ - 1);
          float xin[7][8];
#pragma unroll
          for (int j = 0; j < 7; ++j) { v4u w = {0u, 0u, 0u, 0u}; if (t0 - 3 + j >= 0) w = *(const v4u*)(U + (size_t)(m0 - 3 + j) * NU + ch);
              xin[j][0] = bflo(w.x); xin[j][1] = bfhi(w.x); xin[j][2] = bflo(w.y); xin[j][3] = bfhi(w.y); xin[j][4] = bflo(w.z); xin[j][5] = bfhi(w.z); xin[j][6] = bflo(w.w); xin[j][7] = bfhi(w.w); }
          float cw[4][8], cb[8];
#pragma unroll
          for (int j = 0; j < 4; ++j) { const f32x4 c0 = *(const f32x4*)(args.in[4] + j * 1024 + ch), c1 = *(const f32x4*)(args.in[4] + j * 1024 + ch + 4);
              cw[j][0] = c0.x; cw[j][1] = c0.y; cw[j][2] = c0.z; cw[j][3] = c0.w; cw[j][4] = c1.x; cw[j][5] = c1.y; cw[j][6] = c1.z; cw[j][7] = c1.w; }
          { const f32x4 b0 = *(const f32x4*)(args.in[5] + ch), b1 = *(const f32x4*)(args.in[5] + ch + 4); cb[0] = b0.x; cb[1] = b0.y; cb[2] = b0.z; cb[3] = b0.w; cb[4] = b1.x; cb[5] = b1.y; cb[6] = b1.z; cb[7] = b1.w; }
          const float sc = ch < 512 ? 0.125f : 1.0f;
#pragma unroll
          for (int tt = 0; tt < 4; ++tt) { float y[8];
#pragma unroll
              for (int e = 0; e < 8; ++e) { float a = cb[e];
#pragma unroll
                  for (int j = 0; j < 4; ++j) a += xin[tt + j][e] * cw[j][e];
                  y[e] = a * sigmoidf_(a) * sc; }
              bf16* o = ch < 512 ? QM + (size_t)(m0 + tt) * WM + ch : KM + (size_t)(m0 + tt) * WM + (ch - 512);
              *(v4u*)o = (v4u){pk2(y[0], y[1]), pk2(y[2], y[3]), pk2(y[4], y[5]), pk2(y[6], y[7])}; } }
      BG_BOT(); } }
    { bf16* KN = wsp<bf16>(F, WS_KN); bf16* VT = wsp<bf16>(F, WS_VT); float* KMEAN = wsp<float>(F, WS_KMEAN);
      LAS float* red = (LAS float*)F.lds;
      LAS unsigned char* vtl = F.lds + 4096;
      BG_DECL(BGS_KPART, 2);
      for (int un = F.bid; un < NBH * NBK; un += F.G) { BG_TOP();
          const int bh = un / NBK, j = un % NBK, b = bh / NH, h = bh % NH;
          const int key = F.tid >> 1, hf = F.tid & 1; const size_t m = (size_t)b * SEQ + j * MBS + key;
          __syncthreads();
          float kv[32]; float ss = 0.f;
#pragma unroll
          for (int i = 0; i < 4; ++i) { const v4u w = *(const v4u*)(U + m * NU + UKB + h * HD + 32 * hf + 8 * i);
              kv[8 * i] = bflo(w.x); kv[8 * i + 1] = bfhi(w.x); kv[8 * i + 2] = bflo(w.y); kv[8 * i + 3] = bfhi(w.y); kv[8 * i + 4] = bflo(w.z); kv[8 * i + 5] = bfhi(w.z); kv[8 * i + 6] = bflo(w.w); kv[8 * i + 7] = bfhi(w.w); }
#pragma unroll
          for (int e = 0; e < 32; ++e) ss += kv[e] * kv[e];
          ss += __shfl_xor(ss, 1);
          const float rstd = 1.0f / sqrtf(ss * (1.0f / HD) + RMS_EPS);
#pragma unroll
          for (int e = 0; e < 32; ++e) kv[e] = kv[e] * rstd * args.in[10][32 * hf + e];
#pragma unroll
          for (int i = 0; i < 4; ++i) *(v4u*)(KN + m * WM + h * HD + 32 * hf + 8 * i) = (v4u){pk2(kv[8 * i], kv[8 * i + 1]), pk2(kv[8 * i + 2], kv[8 * i + 3]), pk2(kv[8 * i + 4], kv[8 * i + 5]), pk2(kv[8 * i + 6], kv[8 * i + 7])};
#pragma unroll
          for (int e = 0; e < 32; ++e) { float a = kv[e]; a += __shfl_xor(a, 2); a += __shfl_xor(a, 4); a += __shfl_xor(a, 8); a += __shfl_xor(a, 16); a += __shfl_xor(a, 32); kv[e] = a; }
          if (F.lane < 2) {
#pragma unroll
              for (int e = 0; e < 32; ++e) red[F.wave * 64 + 32 * hf + e] = kv[e]; }
#pragma unroll
          for (int i = 0; i < 4; ++i) { const v4u w = *(const v4u*)(U + m * NU + UVB + h * HD + 32 * hf + 8 * i); const unsigned ww[4] = {w.x, w.y, w.z, w.w};
#pragma unroll
              for (int e = 0; e < 4; ++e) { *(LAS unsigned short*)(vtl + (32 * hf + 8 * i + 2 * e) * 528 + 2 * key) = (unsigned short)(ww[e] & 0xffffu); *(LAS unsigned short*)(vtl + (32 * hf + 8 * i + 2 * e + 1) * 528 + 2 * key) = (unsigned short)(ww[e] >> 16); } }
          __syncthreads();
          if (F.wave == 0) { float sm = 0.f;
#pragma unroll
              for (int w = 0; w < NWAVES; ++w) sm += red[w * 64 + F.lane];
              KMEAN[(size_t)un * HD + F.lane] = sm * (1.0f / MBS); }
          { const int d = F.tid >> 3, pc = F.tid & 7;
#pragma unroll
            for (int i = 0; i < 4; ++i) *(v4u*)(VT + ((size_t)bh * HD + d) * SEQ + j * MBS + pc * 32 + 8 * i) = *(const LAS v4u*)(vtl + d * 528 + (pc * 32 + 8 * i) * 2); }
          BG_BOT();
      } }
    if (F.G != 256) gate_scans(F, F.bid, F.G);

}

__device__ __forceinline__ void mlstm_state(Frame& F, const Args& args);
__device__ __forceinline__ int pair_idx(int i, int j) { return i * (i - 1) / 2 + j; }
__device__ __forceinline__ void p_route(Frame& F, const Args& args) {
    const bf16* U = wsp<bf16>(F, WS_U); bf16* QN = wsp<bf16>(F, WS_QN); const float* KMEAN = wsp<float>(F, WS_KMEAN);
    int* MLIST = wsp<int>(F, WS_MLIST); int* MCNT = wsp<int>(F, WS_MCNT);
    LAS float* skm = (LAS float*)F.lds;
    LAS int* ssel = (LAS int*)(F.lds + 8192);
    LAS int* wtot = (LAS int*)(F.lds + 8192 + 3072);
    BG_DECL(BGS_ROUTE, 2);
    for (int un = F.bid; un < NBH * NBK; un += F.G) { BG_TOP();
        const int bh = un / NBK, i = un % NBK, b = bh / NH, h = bh % NH;
        __syncthreads();
        for (int e = F.tid; e < NBK * HD; e += NTHR) skm[e] = KMEAN[(size_t)bh * NBK * HD + e];
        __syncthreads();
        BG_BOT();
        int s0 = -1, s1 = -1, s2 = -1;
        if (F.tid < MBS) {
            const size_t m = (size_t)b * SEQ + i * MBS + F.tid;
            float q[HD]; float ss = 0.f;
#pragma unroll
            for (int d8 = 0; d8 < 8; ++d8) { const v4u w = *(const v4u*)(U + m * NU + UQB + h * HD + 8 * d8);
                q[8 * d8 + 0] = bflo(w.x); q[8 * d8 + 1] = bfhi(w.x); q[8 * d8 + 2] = bflo(w.y); q[8 * d8 + 3] = bfhi(w.y);
                q[8 * d8 + 4] = bflo(w.z); q[8 * d8 + 5] = bfhi(w.z); q[8 * d8 + 6] = bflo(w.w); q[8 * d8 + 7] = bfhi(w.w); }
#pragma unroll
            for (int d = 0; d < HD; ++d) ss += q[d] * q[d];
            const float rstd = 1.0f / sqrtf(ss * (1.0f / HD) + RMS_EPS);
#pragma unroll
            for (int d = 0; d < HD; ++d) q[d] = q[d] * rstd * args.in[9][d] * 0.125f;
#pragma unroll
            for (int d8 = 0; d8 < 8; ++d8) { v4u w; w.x = pk2(q[8 * d8] * LOG2E, q[8 * d8 + 1] * LOG2E); w.y = pk2(q[8 * d8 + 2] * LOG2E, q[8 * d8 + 3] * LOG2E); w.z = pk2(q[8 * d8 + 4] * LOG2E, q[8 * d8 + 5] * LOG2E); w.w = pk2(q[8 * d8 + 6] * LOG2E, q[8 * d8 + 7] * LOG2E);
                *(v4u*)(QN + m * WM + h * HD + 8 * d8) = w; }
            float v0 = -INFINITY, v1 = -INFINITY, v2 = -INFINITY;
            for (int j = 0; j < i; ++j) {
                float g = 0.f; const LAS f32x4* kp = (const LAS f32x4*)(skm + j * HD);
#pragma unroll
                for (int d4 = 0; d4 < HD / 4; ++d4) { const f32x4 w = kp[d4]; g += (q[4 * d4] * w.x + q[4 * d4 + 1] * w.y) + (q[4 * d4 + 2] * w.z + q[4 * d4 + 3] * w.w); }
                if (g > v0) { v2 = v1; s2 = s1; v1 = v0; s1 = s0; v0 = g; s0 = j; }
                else if (g > v1) { v2 = v1; s2 = s1; v1 = g; s1 = j; }
                else if (g > v2) { v2 = g; s2 = j; }
            }
            ssel[F.tid * 3 + 0] = s0; ssel[F.tid * 3 + 1] = s1; ssel[F.tid * 3 + 2] = s2;
        }
        if (F.wave < 4) { for (int j = 0; j < i; ++j) { const bool f = (s0 == j) || (s1 == j) || (s2 == j); const unsigned long long mk = __ballot(f); if (F.lane == 0) wtot[j * 4 + F.wave] = __popcll(mk); } }
        __syncthreads();
        if (F.wave < 4) { for (int j = 0; j < i; ++j) { const bool f = (s0 == j) || (s1 == j) || (s2 == j); const unsigned long long mk = __ballot(f);
                int base = 0; for (int w = 0; w < F.wave; ++w) base += wtot[j * 4 + w];
                if (f) { const int pos = base + __popcll(mk & ((1ull << F.lane) - 1ull)); const int slot = (s0 == j) ? 0 : ((s1 == j) ? 1 : 2);
                    MLIST[((size_t)bh * NPAIR + pair_idx(i, j)) * MBS + pos] = F.tid | (slot << 8); } } }
        if (F.tid < i) MCNT[bh * NPAIR + pair_idx(i, F.tid)] = wtot[F.tid * 4] + wtot[F.tid * 4 + 1] + wtot[F.tid * 4 + 2] + wtot[F.tid * 4 + 3];
    }
    __syncthreads();
    mlstm_state(F, args);
}

__device__ __forceinline__ float moba_m0(const Frame& F, const Args& args) { return 8.0f * wave_max(fabsf(args.in[9][F.lane])) * wave_max(fabsf(args.in[10][F.lane])); }


constexpr int MB_VOFF = 32768, MB_VSTR = 520, MB_MISC = MB_VOFF + 64 * MB_VSTR;
__device__ __forceinline__ void moba_kv_fetch(const Frame& F, int bh, int j, v4u (&kv)[8]) {
    const bf16* KN = wsp<bf16>(F, WS_KN); const bf16* VT = wsp<bf16>(F, WS_VT); const int b = bh / NH, head = bh % NH;
#pragma unroll
    for (int k = 0; k < 4; ++k) { const int p = F.tid + NTHR * k, key = p >> 3, c = p & 7; kv[k] = *(const v4u*)(KN + ((size_t)b * SEQ + j * MBS + key) * WM + head * HD + c * 8); }
#pragma unroll
    for (int k = 0; k < 4; ++k) { const int p = F.tid + NTHR * k, d = p >> 5, c = p & 31; kv[4 + k] = *(const v4u*)(VT + ((size_t)bh * HD + d) * SEQ + j * MBS + c * 8); }
}
__device__ __forceinline__ void moba_kv_put(const Frame& F, const v4u (&kv)[8]) {
#pragma unroll
    for (int k = 0; k < 4; ++k) { const int p = F.tid + NTHR * k, key = p >> 3, c = p & 7; *(LAS v4u*)(F.lds + key * 128 + ((c ^ ((key >> 1) & 7)) << 4)) = kv[k]; }
#pragma unroll
    for (int k = 0; k < 4; ++k) { const int p = F.tid + NTHR * k, d = p >> 5, c = p & 31; const v4u w = kv[4 + k];
        LAS v2u* dst = (LAS v2u*)(F.lds + MB_VOFF + d * MB_VSTR + c * 16); dst[0] = (v2u){w.x, w.y}; dst[1] = (v2u){w.z, w.w}; }
}
__device__ __forceinline__ void moba_load_kv(const Frame& F, int bh, int j) { v4u kv[8]; moba_kv_fetch(F, bh, j, kv); moba_kv_put(F, kv); }
template <bool MASK>
__device__ __forceinline__ void moba_core(LAS const unsigned char* lds, const bf16x8 (&qf)[4], f32x16 (&o)[2], float& l, int nkt, int dkey0, float slope2, float m0l, int q, int h) {
    float br[16];
#pragma unroll
    for (int r = 0; r < 16; ++r) br[r] = slope2 * (float)((r & 3) + 8 * (r >> 2)) - m0l;
#pragma unroll 1
    for (int kt = 0; kt < nkt; ++kt) {
        const float cb = slope2 * (float)(dkey0 + 32 * kt);
        f32x16 s;
#pragma unroll
        for (int r = 0; r < 16; ++r) s[r] = br[r] + cb;
        const int key = 32 * kt + q, sw = (key >> 1) & 7;
#pragma unroll
        for (int s4 = 0; s4 < 4; ++s4) { const bf16x8 kf = *(const LAS bf16x8*)(lds + key * 128 + (((2 * s4 + h) ^ sw) << 4)); s = __builtin_amdgcn_mfma_f32_32x32x16_bf16(kf, qf[s4], s, 0, 0, 0); }
        float p[16];
#pragma unroll
        for (int r = 0; r < 16; ++r) { p[r] = __builtin_amdgcn_exp2f(s[r]); if (MASK && kt == nkt - 1 && ((r & 3) + 8 * (r >> 2) + 4 * h > q)) p[r] = 0.f; l += p[r]; }
        bf16x8 pb[2];
#pragma unroll
        for (int s2 = 0; s2 < 2; ++s2) { v4u w; w.x = pk2(p[8 * s2], p[8 * s2 + 1]); w.y = pk2(p[8 * s2 + 2], p[8 * s2 + 3]); w.z = pk2(p[8 * s2 + 4], p[8 * s2 + 5]); w.w = pk2(p[8 * s2 + 6], p[8 * s2 + 7]); pb[s2] = __builtin_bit_cast(bf16x8, w); }
#pragma unroll
        for (int mt = 0; mt < 2; ++mt)
#pragma unroll
            for (int s2 = 0; s2 < 2; ++s2) { const LAS unsigned char* vp = lds + MB_VOFF + (32 * mt + q) * MB_VSTR + (32 * kt + 16 * s2 + 4 * h) * 2;
                const v2u lo = *(const LAS v2u*)vp, hi = *(const LAS v2u*)(vp + 16); const v4u w = {lo.x, lo.y, hi.x, hi.y};
                o[mt] = __builtin_amdgcn_mfma_f32_32x32x16_bf16(__builtin_bit_cast(bf16x8, w), pb[s2], o[mt], 0, 0, 0); }
    }
}
__device__ __forceinline__ void moba_routed(Frame& F, const Args& args) {
    const bf16* QN = wsp<bf16>(F, WS_QN); const int* MLIST = wsp<int>(F, WS_MLIST); const int* MCNT = wsp<int>(F, WS_MCNT);
    bf16* OP = wsp<bf16>(F, WS_OP); float* LP = wsp<float>(F, WS_LP);
    const float m0l = moba_m0(F, args) * LOG2E;
    LAS int* utot = (LAS int*)(F.lds + MB_MISC); LAS int* ustart = utot + 512; LAS int* cpre = ustart + 512;
    constexpr int NQ = NBH * (NBK - 1);
    __syncthreads();
    if (F.tid < NQ) { const int bh = F.tid / (NBK - 1), j = F.tid % (NBK - 1); int t = 0; for (int i = j + 1; i < NBK; ++i) t += MCNT[bh * NPAIR + pair_idx(i, j)]; utot[F.tid] = t; }
    __syncthreads();
    if (F.wave == 0) {
        int loc[8], sum = 0;
#pragma unroll
        for (int e = 0; e < 8; ++e) { const int qq = F.lane * 8 + e; loc[e] = qq < NQ ? (utot[qq] + 255) >> 8 : 0; sum += loc[e]; }
        int inc = sum;
#pragma unroll
        for (int o = 1; o < 64; o <<= 1) { const int t = __shfl_up(inc, o); if (F.lane >= o) inc += t; }
        int a = inc - sum;
#pragma unroll
        for (int e = 0; e < 8; ++e) { const int qq = F.lane * 8 + e; if (qq <= NQ) ustart[qq] = a; a += loc[e]; }
    }
    __syncthreads();
    const int nunits = ustart[NQ];
    const int q = F.lane & 31, h = F.lane >> 5;
    BG_DECL(BGS_MIXA, 8);
    v4u kv[8];
    if (F.bid < nunits) { int lo = 0, hi = NQ; while (hi - lo > 1) { const int mid = (lo + hi) >> 1; if (ustart[mid] <= F.bid) lo = mid; else hi = mid; }
        moba_kv_fetch(F, lo / (NBK - 1), lo % (NBK - 1), kv); }
    for (int un = F.bid; un < nunits; un += F.G) {
        int lo = 0, hi = NQ;
        while (hi - lo > 1) { const int mid = (lo + hi) >> 1; if (ustart[mid] <= un) lo = mid; else hi = mid; }
        const int qq = lo, chunk = un - ustart[qq], bh = qq / (NBK - 1), j = qq % (NBK - 1), b = bh / NH, head = bh % NH, tot = utot[qq];
        __syncthreads();
        if (F.wave == 0) { const int i = j + 1 + F.lane; const int cnt = i < NBK ? MCNT[bh * NPAIR + pair_idx(i, j)] : 0; int inc = cnt;
#pragma unroll
            for (int o = 1; o < 32; o <<= 1) { const int t = __shfl_up(inc, o); if (F.lane >= o) inc += t; }
            if (i <= NBK) cpre[i] = inc - cnt; }
        moba_kv_put(F, kv);
        __syncthreads();
        if (un + F.G < nunits) { int l2 = 0, h2 = NQ; while (h2 - l2 > 1) { const int mid = (l2 + h2) >> 1; if (ustart[mid] <= un + F.G) l2 = mid; else h2 = mid; }
            moba_kv_fetch(F, l2 / (NBK - 1), l2 % (NBK - 1), kv); }
        const int gr = chunk * 256 + F.wave * 32 + q; const bool valid = gr < tot; const bool act = __ballot(valid) != 0ull;
        int slot = 0, tq = 0; size_t mq = 0; bf16x8 qf[4];
        if (act) {
            const int grc = valid ? gr : chunk * 256;
            int i = j + 1; while (cpre[i + 1] <= grc) ++i;
            const int ent = MLIST[((size_t)bh * NPAIR + pair_idx(i, j)) * MBS + (grc - cpre[i])]; const int qo = ent & 255; slot = ent >> 8;
            tq = i * MBS + qo; mq = (size_t)b * SEQ + tq;
#pragma unroll
            for (int s4 = 0; s4 < 4; ++s4) qf[s4] = *(const bf16x8*)(QN + mq * WM + head * HD + 16 * s4 + 8 * h); }
        BG_TOP();
        if (act) {
            f32x16 o[2]; float l = 0.f;
#pragma unroll
            for (int r = 0; r < 16; ++r) { o[0][r] = 0.f; o[1][r] = 0.f; }
            const float slope2 = exp2f(-(float)(head + 1)) * LOG2E;
            moba_core<false>(F.lds, qf, o, l, 8, j * MBS + 4 * h - tq, slope2, m0l, q, h);
            l += __shfl_xor(l, 32);
            if (valid) { bf16* op = OP + ((mq * NH + head) * 3 + slot) * HD;
#pragma unroll
                for (int mt = 0; mt < 2; ++mt)
#pragma unroll
                    for (int g = 0; g < 4; ++g) *(v2u*)(op + 32 * mt + 8 * g + 4 * h) = (v2u){pk2(o[mt][4 * g], o[mt][4 * g + 1]), pk2(o[mt][4 * g + 2], o[mt][4 * g + 3])};
                if (h == 0) LP[(mq * NH + head) * 3 + slot] = l; }
        }
        BG_BOT();
    }
    BG_FLUSH();
}
__device__ __forceinline__ void moba_own(Frame& F, const Args& args) {
    const bf16* QN = wsp<bf16>(F, WS_QN); const bf16* OP = wsp<bf16>(F, WS_OP); const float* LP = wsp<float>(F, WS_LP); bf16* MIX = wsp<bf16>(F, WS_MIX);
    const float m0l = moba_m0(F, args) * LOG2E;
    const int q = F.lane & 31, h = F.lane >> 5;
    BG_DECL(BGS_MIXB, 2);
    v4u kv[8];
    if (F.bid < NBH * NBK) moba_kv_fetch(F, F.bid / NBK, F.bid % NBK, kv);
    for (int un = F.bid; un < NBH * NBK; un += F.G) {
        const int bh = un / NBK, i = un % NBK, b = bh / NH, head = bh % NH;
        const int qo = F.wave * 32 + q; const size_t mq = (size_t)b * SEQ + i * MBS + qo;
        f32x16 o[2]; float l = 0.f;
#pragma unroll
        for (int r = 0; r < 16; ++r) { o[0][r] = 0.f; o[1][r] = 0.f; }
        const int nsel = i < 3 ? i : 3;
        for (int sl = 0; sl < nsel; ++sl) { const bf16* op = OP + ((mq * NH + head) * 3 + sl) * HD; if (h == 0) l += LP[(mq * NH + head) * 3 + sl];
#pragma unroll
            for (int mt = 0; mt < 2; ++mt)
#pragma unroll
                for (int g = 0; g < 4; ++g) { const v2u v = *(const v2u*)(op + 32 * mt + 8 * g + 4 * h); o[mt][4 * g] += bflo(v.x); o[mt][4 * g + 1] += bfhi(v.x); o[mt][4 * g + 2] += bflo(v.y); o[mt][4 * g + 3] += bfhi(v.y); } }
        bf16x8 qf[4];
#pragma unroll
        for (int s4 = 0; s4 < 4; ++s4) qf[s4] = *(const bf16x8*)(QN + mq * WM + head * HD + 16 * s4 + 8 * h);
        __syncthreads();
        moba_kv_put(F, kv);
        __syncthreads();
        if (un + F.G < NBH * NBK) moba_kv_fetch(F, (un + F.G) / NBK, (un + F.G) % NBK, kv);
        BG_TOP();
        const float slope2 = exp2f(-(float)(head + 1)) * LOG2E;
        moba_core<true>(F.lds, qf, o, l, F.wave + 1, 4 * h - qo, slope2, m0l, q, h);
        l += __shfl_xor(l, 32);
        const float inv = 1.0f / l;
#pragma unroll
        for (int mt = 0; mt < 2; ++mt)
#pragma unroll
            for (int g = 0; g < 4; ++g) *(v2u*)(MIX + mq * D + WM + head * HD + 32 * mt + 8 * g + 4 * h) = (v2u){pk2(o[mt][4 * g] * inv, o[mt][4 * g + 1] * inv), pk2(o[mt][4 * g + 2] * inv, o[mt][4 * g + 3] * inv)};
        BG_BOT();
    }
}


constexpr int ML_STR = 272;
typedef LAS unsigned short* lds_u16p;
__device__ __forceinline__ void mlstm_state(Frame& F, const Args& args) {
    const bf16* U = wsp<bf16>(F, WS_U); const bf16* KM = wsp<bf16>(F, WS_KM); const float* SW = wsp<float>(F, WS_SW); float* DC = wsp<float>(F, WS_DC); float* DN = wsp<float>(F, WS_DN);
    LAS unsigned char* vt = F.lds; LAS unsigned char* kt = F.lds + 64 * ML_STR; LAS float* sw = (LAS float*)(F.lds + 128 * ML_STR);
    const int l15 = F.lane & 15, kq = F.lane >> 4;
    BG_DECL(BGS_STATE, 4);
    v4u pk_[2], pv_[2]; float pw_[2], psw = 0.f;
#define ST_FETCH(UN) do { const int bh_ = (UN) / NCH, c_ = (UN) % NCH, b_ = bh_ / NH, hd_ = bh_ % NH; const size_t m0_ = (size_t)b_ * SEQ + c_ * LCH; \
        if (F.tid < LCH) psw = SW[(size_t)bh_ * SEQ + c_ * LCH + F.tid]; \
        _Pragma("unroll") for (int k = 0; k < 2; ++k) { const int p = F.tid + NTHR * k, sidx = p >> 3, cc = p & 7; pw_[k] = SW[(size_t)bh_ * SEQ + c_ * LCH + sidx]; \
            pk_[k] = *(const v4u*)(KM + (m0_ + sidx) * WM + hd_ * HD + 8 * cc); pv_[k] = *(const v4u*)(U + (m0_ + sidx) * NU + UVM + hd_ * HD + 8 * cc); } } while (0)
    if (F.bid < NBH * NCH) ST_FETCH(F.bid);
    for (int un = F.bid; un < NBH * NCH; un += F.G) {
        __syncthreads();
        if (F.tid < LCH) sw[F.tid] = psw;
#pragma unroll
        for (int k = 0; k < 2; ++k) { const int p = F.tid + NTHR * k, sidx = p >> 3, cc = p & 7;
            const float w = pw_[k]; const v4u kv = pk_[k], vv = pv_[k];
            const unsigned kw[4] = {kv.x, kv.y, kv.z, kv.w}, vw[4] = {vv.x, vv.y, vv.z, vv.w};
#pragma unroll
            for (int e = 0; e < 4; ++e) {
                *(lds_u16p)(kt + (8 * cc + 2 * e) * ML_STR + 2 * sidx) = (unsigned short)(kw[e] & 0xffffu); *(lds_u16p)(kt + (8 * cc + 2 * e + 1) * ML_STR + 2 * sidx) = (unsigned short)(kw[e] >> 16);
                const unsigned pw = pk2(w * bflo(vw[e]), w * bfhi(vw[e]));
                *(lds_u16p)(vt + (8 * cc + 2 * e) * ML_STR + 2 * sidx) = (unsigned short)(pw & 0xffffu); *(lds_u16p)(vt + (8 * cc + 2 * e + 1) * ML_STR + 2 * sidx) = (unsigned short)(pw >> 16); } }
        if (un + F.G < NBH * NCH) ST_FETCH(un + F.G);
        BG_TOP();
        __syncthreads();
#pragma unroll
        for (int tt = 0; tt < 2; ++tt) { const int tile = 2 * F.wave + tt, mt = tile >> 2, nt = tile & 3; f32x4 acc = {0.f, 0.f, 0.f, 0.f};
#pragma unroll
            for (int ks = 0; ks < 4; ++ks) { const bf16x8 av = *(const LAS bf16x8*)(vt + (16 * mt + l15) * ML_STR + (32 * ks + 8 * kq) * 2), bv = *(const LAS bf16x8*)(kt + (16 * nt + l15) * ML_STR + (32 * ks + 8 * kq) * 2);
                acc = __builtin_amdgcn_mfma_f32_16x16x32_bf16(av, bv, acc, 0, 0, 0); }
#pragma unroll
            for (int r = 0; r < 4; ++r) DC[(size_t)un * 4096 + (16 * mt + 4 * kq + r) * HD + 16 * nt + l15] = acc[r]; }
        if (F.tid < HD) { float a = 0.f;
#pragma unroll 8
            for (int sidx = 0; sidx < LCH; ++sidx) a += sw[sidx] * bf2f(*(lds_u16p)(kt + F.tid * ML_STR + 2 * sidx));
            DN[(size_t)un * HD + F.tid] = a; }
        BG_BOT();
    }
#undef ST_FETCH
}
__device__ __forceinline__ void mlstm_out(Frame& F, const Args& args) {
    const bf16* U = wsp<bf16>(F, WS_U); const bf16* QM = wsp<bf16>(F, WS_QM); const bf16* KM = wsp<bf16>(F, WS_KM);
    const float* SA = wsp<float>(F, WS_SA); const float* SMX = wsp<float>(F, WS_SMX); const float* SB = wsp<float>(F, WS_SB);
    const float* CS = wsp<float>(F, WS_CS); const float* NS = wsp<float>(F, WS_NS); const float* MC = wsp<float>(F, WS_MC); bf16* MIX = wsp<bf16>(F, WS_MIX);
    LAS unsigned char* sp = F.lds; LAS unsigned char* vt = F.lds + LCH * ML_STR;
    const int l15 = F.lane & 15, kq = F.lane >> 4, w = F.wave, t0 = 16 * w;
    for (int un = F.bid; un < NBH * NCH; un += F.G) {
        const int bh = un / NCH, c = un % NCH, b = bh / NH, head = bh % NH; const size_t m0 = (size_t)b * SEQ + c * LCH; const size_t g0 = (size_t)bh * SEQ + c * LCH;
        __syncthreads();
#pragma unroll
        for (int k = 0; k < 2; ++k) { const int p = F.tid + NTHR * k, sidx = p >> 3, cc = p & 7;
            const v4u vv = *(const v4u*)(U + (m0 + sidx) * NU + UVM + head * HD + 8 * cc); const unsigned vw[4] = {vv.x, vv.y, vv.z, vv.w};
#pragma unroll
            for (int e = 0; e < 4; ++e) { *(lds_u16p)(vt + (8 * cc + 2 * e) * ML_STR + 2 * sidx) = (unsigned short)(vw[e] & 0xffffu); *(lds_u16p)(vt + (8 * cc + 2 * e + 1) * ML_STR + 2 * sidx) = (unsigned short)(vw[e] >> 16); } }
        for (int e = F.tid; e < 16 * LCH; e += NTHR) { const int r = e >> 7, sidx = e & 127; *(lds_u16p)(vt + (64 + r) * ML_STR + 2 * sidx) = (unsigned short)(r == 0 ? 0x3F80u : 0u); }
        bf16x8 qa[2];
#pragma unroll
        for (int ks = 0; ks < 2; ++ks) qa[ks] = *(const bf16x8*)(QM + (m0 + t0 + l15) * WM + head * HD + 32 * ks + 8 * kq);
        float mx[4], sbv[4]; unsigned ogv[4][2];
#pragma unroll
        for (int r = 0; r < 4; ++r) { mx[r] = SMX[g0 + t0 + 4 * kq + r]; sbv[r] = SB[g0 + t0 + 4 * kq + r];
            const bf16* up = U + (m0 + t0 + 4 * kq + r) * NU + UOM + head * HD + l15;
            ogv[r][0] = (unsigned)up[0] | ((unsigned)up[16] << 16); ogv[r][1] = (unsigned)up[32] | ((unsigned)up[48] << 16); }
        bf16x8 kb[4][2]; float as[4];
#pragma unroll
        for (int st = 0; st < 4; ++st) if (st <= w) {
#pragma unroll
            for (int ks = 0; ks < 2; ++ks) kb[st][ks] = *(const bf16x8*)(KM + (m0 + 16 * st + l15) * WM + head * HD + 32 * ks + 8 * kq);
            as[st] = SA[g0 + 16 * st + l15]; }
        bf16x8 cf[2][5];
#pragma unroll
        for (int ks = 0; ks < 2; ++ks)
#pragma unroll
            for (int nt = 0; nt < 5; ++nt) { f32x4 c0, c1;
                if (nt < 4) { const float* cp = CS + (size_t)un * 4096 + (16 * nt + l15) * HD + 32 * ks + 8 * kq; c0 = *(const f32x4*)cp; c1 = *(const f32x4*)(cp + 4); }
                else { const float* np = NS + (size_t)un * HD + 32 * ks + 8 * kq; c0 = *(const f32x4*)np; c1 = *(const f32x4*)(np + 4); if (l15 != 0) { c0 = (f32x4){0.f, 0.f, 0.f, 0.f}; c1 = c0; } }
                const v4u wv = {pk2(c0.x, c0.y), pk2(c0.z, c0.w), pk2(c1.x, c1.y), pk2(c1.z, c1.w)}; cf[ks][nt] = __builtin_bit_cast(bf16x8, wv); }
#pragma unroll
        for (int hf = 0; hf < 2; ++hf) {
            if (hf == 1) {
#pragma unroll
                for (int st = 0; st < 4; ++st) if (st + 4 <= w) {
#pragma unroll
                    for (int ks = 0; ks < 2; ++ks) kb[st][ks] = *(const bf16x8*)(KM + (m0 + 16 * (st + 4) + l15) * WM + head * HD + 32 * ks + 8 * kq);
                    as[st] = SA[g0 + 16 * (st + 4) + l15]; } }
#pragma unroll
            for (int s4 = 0; s4 < 4; ++s4) { const int st = 4 * hf + s4; if (st <= w) {
                f32x4 acc = {0.f, 0.f, 0.f, 0.f};
                acc = __builtin_amdgcn_mfma_f32_16x16x32_bf16(qa[0], kb[s4][0], acc, 0, 0, 0); acc = __builtin_amdgcn_mfma_f32_16x16x32_bf16(qa[1], kb[s4][1], acc, 0, 0, 0);
#pragma unroll
                for (int r = 0; r < 4; ++r) { float v = acc[r] * __expf(as[s4] - mx[r]); if (st == w && l15 > 4 * kq + r) v = 0.f;
                    *(lds_u16p)(sp + (t0 + 4 * kq + r) * ML_STR + 2 * (16 * st + l15)) = (unsigned short)f2bf(v); } } }
        }
        if ((w & 1) == 0) {
#pragma unroll
            for (int r = 0; r < 4; ++r) *(lds_u16p)(sp + (t0 + 4 * kq + r) * ML_STR + 2 * (16 * (w + 1) + l15)) = (unsigned short)0; }
        __syncthreads();
        f32x4 a1[5], a2[5];
#pragma unroll
        for (int nt = 0; nt < 5; ++nt) { a1[nt] = (f32x4){0.f, 0.f, 0.f, 0.f}; a2[nt] = (f32x4){0.f, 0.f, 0.f, 0.f}; }
        const int nks = (w + 2) >> 1;
        for (int ks = 0; ks < nks; ++ks) { const bf16x8 av = *(const LAS bf16x8*)(sp + (t0 + l15) * ML_STR + (32 * ks + 8 * kq) * 2);
#pragma unroll
            for (int nt = 0; nt < 5; ++nt) { const bf16x8 bv = *(const LAS bf16x8*)(vt + (16 * nt + l15) * ML_STR + (32 * ks + 8 * kq) * 2); a1[nt] = __builtin_amdgcn_mfma_f32_16x16x32_bf16(av, bv, a1[nt], 0, 0, 0); } }
#pragma unroll
        for (int ks = 0; ks < 2; ++ks)
#pragma unroll
            for (int nt = 0; nt < 5; ++nt) a2[nt] = __builtin_amdgcn_mfma_f32_16x16x32_bf16(qa[ks], cf[ks][nt], a2[nt], 0, 0, 0);
        const float mc = MC[un];
#pragma unroll
        for (int r = 0; r < 4; ++r) { const int t = t0 + 4 * kq + r; const float sc = __expf(mc - mx[r]);
            float den = a1[4][r] + sc * a2[4][r]; den = __shfl(den, F.lane & 48);
            const float dn = fmaxf(fabsf(den), __expf(-(sbv[r] + mx[r]))); const float inv = 1.0f / dn;
            float hv[4], ss = 0.f;
#pragma unroll
            for (int nt = 0; nt < 4; ++nt) { hv[nt] = (a1[nt][r] + sc * a2[nt][r]) * inv; ss += hv[nt] * hv[nt]; }
            ss += __shfl_xor(ss, 1); ss += __shfl_xor(ss, 2); ss += __shfl_xor(ss, 4); ss += __shfl_xor(ss, 8);
            const float rstd = 1.0f / sqrtf(ss * (1.0f / HD) + RMS_EPS);
#pragma unroll
            for (int nt = 0; nt < 4; ++nt) { const int v = 16 * nt + l15; const float og = (nt & 1) ? bfhi(ogv[r][nt >> 1]) : bflo(ogv[r][nt >> 1]);
                MIX[(m0 + t) * D + head * HD + v] = (bf16)f2bf(hv[nt] * rstd * args.in[8][head * HD + v] * sigmoidf_(og)); } }
    }
}

__device__ __forceinline__ void mlstm_scan(Frame& F) {
    const float* DC = wsp<float>(F, WS_DC); const float* DN = wsp<float>(F, WS_DN); float* CS = wsp<float>(F, WS_CS); float* NS = wsp<float>(F, WS_NS); const float* DEC = wsp<float>(F, WS_DEC);
    constexpr int TOT = NBH * (4096 + HD); const int per = (TOT + F.G - 1) / F.G;
    for (int q = F.tid; q < per; q += NTHR) { const int e = F.bid * per + q; if (e >= TOT) break;
        const int bh = e / (4096 + HD), r = e % (4096 + HD);
        const float* src = r < 4096 ? DC + (size_t)bh * NCH * 4096 + r : DN + (size_t)bh * NCH * HD + (r - 4096);
        float* dst = r < 4096 ? CS + (size_t)bh * NCH * 4096 + r : NS + (size_t)bh * NCH * HD + (r - 4096);
        const size_t str = r < 4096 ? 4096 : HD;
        float st = 0.f;
#pragma unroll 1
        for (int c0 = 0; c0 < NCH; c0 += 32) { float d[32], g[32];
#pragma unroll
            for (int i = 0; i < 32; ++i) { d[i] = src[(size_t)(c0 + i) * str]; g[i] = DEC[bh * NCH + c0 + i]; }
#pragma unroll
            for (int i = 0; i < 32; ++i) { dst[(size_t)(c0 + i) * str] = st; st = g[i] * st + d[i]; } }
    }
}

__device__ __forceinline__ void p_mix_a(Frame& F, const Args& args) {
    const bf16* U = wsp<bf16>(F, WS_U);
    moba_routed(F, args);
    mlstm_scan(F);
}

__device__ __forceinline__ void p_mix_b(Frame& F, const Args& args) {
    moba_own(F, args);
    __syncthreads();
    mlstm_out(F, args);
}

__device__ __forceinline__ void p_router(Frame& F, const Args& args) {
    const bf16* T1 = wsp<bf16>(F, WS_X1); const bf16* WR = wsp<bf16>(F, WS_WR); const float* SS = wsp<float>(F, WS_SS);
    int* SELE = wsp<int>(F, WS_SELE); float* SELW = wsp<float>(F, WS_SELW); float* RSTD = wsp<float>(F, WS_RSTD); int* HIST = wsp<int>(F, WS_HIST);
    LAS float* part = (LAS float*)F.lds;
    LAS int* sh = (LAS int*)(F.lds + 2 * 64 * 33 * 4);
    const int l15 = F.lane & 15, kq = F.lane >> 4, tile = F.wave & 3, kh = F.wave >> 2;
    for (int ch = F.bid; ch < 256; ch += F.G) {
        __syncthreads();
        if (F.tid < NE) sh[F.tid] = 0;
        f32x4 acc[2] = {{0.f, 0.f, 0.f, 0.f}, {0.f, 0.f, 0.f, 0.f}};
        const bf16* ap = T1 + ((size_t)ch * 64 + 16 * tile + l15) * D + 512 * kh + 8 * kq; const bf16* bp = WR + (size_t)l15 * D + 512 * kh + 8 * kq;
#pragma unroll 4
        for (int ks = 0; ks < 16; ++ks) { const bf16x8 av = *(const bf16x8*)(ap + 32 * ks), b0 = *(const bf16x8*)(bp + 32 * ks), b1 = *(const bf16x8*)(bp + 16 * D + 32 * ks);
            acc[0] = __builtin_amdgcn_mfma_f32_16x16x32_bf16(av, b0, acc[0], 0, 0, 0); acc[1] = __builtin_amdgcn_mfma_f32_16x16x32_bf16(av, b1, acc[1], 0, 0, 0); }
#pragma unroll
        for (int nt = 0; nt < 2; ++nt)
#pragma unroll
            for (int r = 0; r < 4; ++r) part[(kh * 64 + 16 * tile + 4 * kq + r) * 33 + 16 * nt + l15] = acc[nt][r];
        __syncthreads();
        if (F.tid < 64) {
            const size_t m = (size_t)ch * 64 + F.tid; float ss = 0.f;
#pragma unroll
            for (int q = 0; q < 16; ++q) ss += SS[m * 16 + q];
            const float rstd = 1.0f / sqrtf(ss * (1.0f / D) + RMS_EPS);
            float v0 = -INFINITY, v1 = -INFINITY, v2 = -INFINITY, v3 = -INFINITY; int s0 = 0, s1 = 0, s2 = 0, s3 = 0;
            for (int e = 0; e < NE; ++e) { const float g = (part[F.tid * 33 + e] + part[(64 + F.tid) * 33 + e]) * rstd + args.in[14][e];
                if (g > v0) { v3 = v2; s3 = s2; v2 = v1; s2 = s1; v1 = v0; s1 = s0; v0 = g; s0 = e; }
                else if (g > v1) { v3 = v2; s3 = s2; v2 = v1; s2 = s1; v1 = g; s1 = e; }
                else if (g > v2) { v3 = v2; s3 = s2; v2 = g; s2 = e; }
                else if (g > v3) { v3 = g; s3 = e; } }
            const float e1 = __expf(v1 - v0), e2 = __expf(v2 - v0), e3 = __expf(v3 - v0); const float inv = 1.0f / (1.0f + e1 + e2 + e3);
            *(int4*)(SELE + m * 4) = make_int4(s0, s1, s2, s3); *(f32x4*)(SELW + m * 4) = (f32x4){inv, e1 * inv, e2 * inv, e3 * inv}; RSTD[m] = rstd;
            atomicAdd((int*)&sh[s0], 1); atomicAdd((int*)&sh[s1], 1); atomicAdd((int*)&sh[s2], 1); atomicAdd((int*)&sh[s3], 1);
        }
        __syncthreads();
        if (F.tid < NE) HIST[ch * NE + F.tid] = sh[F.tid];
    }
}
__device__ __forceinline__ void p_lists(Frame& F, const Args& args) {
    const int* SELE = wsp<int>(F, WS_SELE); const float* SELW = wsp<float>(F, WS_SELW); const float* RSTD = wsp<float>(F, WS_RSTD); const int* HIST = wsp<int>(F, WS_HIST);
    int* POS = wsp<int>(F, WS_POS); int* ROWTOK = wsp<int>(F, WS_ROWTOK); float* ROWGATE = wsp<float>(F, WS_ROWGATE); float* ROWRSTD = wsp<float>(F, WS_ROWRSTD); int* TILEE = wsp<int>(F, WS_TILEE);
    LAS int* stot = (LAS int*)F.lds;
    LAS int* soff = stot + 32;
    LAS int* sbase = soff + 40;
    for (int ch = F.bid; ch < 256; ch += F.G) {
        __syncthreads();
        { LAS int* part = sbase + 32;
          const int e = F.tid & 31, pt = F.tid >> 5; int hv[16], tot = 0, before = 0;
#pragma unroll
          for (int i = 0; i < 16; ++i) hv[i] = HIST[(16 * pt + i) * NE + e];
#pragma unroll
          for (int i = 0; i < 16; ++i) { tot += hv[i]; if (16 * pt + i < ch) before += hv[i]; }
          part[(pt * 32 + e) * 2] = tot; part[(pt * 32 + e) * 2 + 1] = before;
          __syncthreads();
          if (F.tid < NE) { int t = 0, bsum = 0;
#pragma unroll
              for (int p = 0; p < 16; ++p) { t += part[(p * 32 + F.tid) * 2]; bsum += part[(p * 32 + F.tid) * 2 + 1]; }
              stot[F.tid] = t; sbase[F.tid] = bsum; } }
        __syncthreads();
        if (F.tid == 0) { int o = 0; for (int e = 0; e < NE; ++e) { soff[e] = o; o += (stot[e] + 255) & ~255; } soff[NE] = o; }
        __syncthreads();
        if (F.wave == 0) {
            const size_t m = (size_t)ch * 64 + F.lane; int se[4]; float sw[4];
#pragma unroll
            for (int k = 0; k < 4; ++k) { se[k] = SELE[m * 4 + k]; sw[k] = SELW[m * 4 + k]; }
            const float rs = RSTD[m]; int pos[4] = {0, 0, 0, 0};
            for (int e = 0; e < NE; ++e) { const unsigned long long mk = __ballot(se[0] == e || se[1] == e || se[2] == e || se[3] == e);
                const int rank = __popcll(mk & ((1ull << F.lane) - 1ull)); const int pp = soff[e] + sbase[e] + rank;
#pragma unroll
                for (int k = 0; k < 4; ++k) if (se[k] == e) pos[k] = pp; }
#pragma unroll
            for (int k = 0; k < 4; ++k) { POS[m * 4 + k] = pos[k]; ROWTOK[pos[k]] = (int)m; ROWGATE[pos[k]] = sw[k]; ROWRSTD[pos[k]] = rs; }
        }
        if (ch < NE) { const int e = ch; for (int r = soff[e] + stot[e] + F.tid; r < soff[e + 1]; r += NTHR) { ROWTOK[r] = 0; ROWGATE[r] = 0.f; ROWRSTD[r] = 0.f; } }
        if (ch == 0) { const int nt = soff[NE] >> 8; for (int t = F.tid; t < nt; t += NTHR) { int e = 0; while (soff[e + 1] <= t * 256) ++e; TILEE[t] = e; } if (F.tid == 0) TILEE[MAXTILES] = nt; }
    }
}
__device__ __forceinline__ void p_combine(Frame& F, const Args& args) {
    bf16* X1 = wsp<bf16>(F, WS_X1); const unsigned char* YS = wsp<unsigned char>(F, WS_YS); const int* POS = wsp<int>(F, WS_POS); float* RS2 = wsp<float>(F, WS_RSTD);
    const int gw = F.bid * NWAVES + F.wave, NGW = F.G * NWAVES, lane = F.lane;
    v2u xw[4]; int yw[4][4]; int4 psn = make_int4(0, 0, 0, 0);
    if (gw < M) { const int4 ps = *(const int4*)(POS + (size_t)gw * 4); const int pv[4] = {ps.x, ps.y, ps.z, ps.w};
#pragma unroll
        for (int j = 0; j < 4; ++j) { xw[j] = *(const v2u*)(X1 + (size_t)gw * D + 256 * j + 4 * lane);
#pragma unroll
            for (int k = 0; k < 4; ++k) yw[j][k] = *(const int*)(YS + (size_t)pv[k] * D + 256 * j + 4 * lane); }
        if (gw + NGW < M) psn = *(const int4*)(POS + (size_t)(gw + NGW) * 4); }
    for (int m = gw; m < M; m += NGW) {
        f32x4 v[4]; float s = 0.f;
#pragma unroll
        for (int j = 0; j < 4; ++j) { v[j] = (f32x4){bflo(xw[j].x), bfhi(xw[j].x), bflo(xw[j].y), bfhi(xw[j].y)};
#pragma unroll
            for (int k = 0; k < 4; ++k) { const f32x2_t lo = __builtin_amdgcn_cvt_pk_f32_fp8(yw[j][k], false), hi = __builtin_amdgcn_cvt_pk_f32_fp8(yw[j][k], true);
                v[j].x += lo.x; v[j].y += lo.y; v[j].z += hi.x; v[j].w += hi.y; } }
        if (m + NGW < M) { const int pv[4] = {psn.x, psn.y, psn.z, psn.w}; const size_t mn = (size_t)(m + NGW);
#pragma unroll
            for (int j = 0; j < 4; ++j) { xw[j] = *(const v2u*)(X1 + mn * D + 256 * j + 4 * lane);
#pragma unroll
                for (int k = 0; k < 4; ++k) yw[j][k] = *(const int*)(YS + (size_t)pv[k] * D + 256 * j + 4 * lane); }
            if (m + 2 * NGW < M) psn = *(const int4*)(POS + (size_t)(m + 2 * NGW) * 4); }
#pragma unroll
        for (int j = 0; j < 4; ++j) { s += (v[j].x * v[j].x + v[j].y * v[j].y) + (v[j].z * v[j].z + v[j].w * v[j].w);
            *(v2u*)(X1 + (size_t)m * D + 256 * j + 4 * lane) = (v2u){pk2(v[j].x, v[j].y), pk2(v[j].z, v[j].w)}; }
        const float rstd = 1.0f / sqrtf(wave_sum(s) * (1.0f / D) + RMS_EPS);
        if (lane == 0) RS2[m] = rstd;
    }
}

enum { PH_PRO = 0, PH_INPROJ, PH_PREP, PH_ROUTE, PH_MIXA, PH_MIXB, PH_OUTPROJ, PH_ROUTER, PH_LISTS, PH_GU, PH_DN, PH_COMB, PH_PLE, NPH };

__global__ void __launch_bounds__(NTHR, 2) fwd(Args args) {
    extern __shared__ __attribute__((aligned(16))) unsigned char lds[];
    Frame F;
    F.lds = (LAS unsigned char*)lds; F.MISC = (volatile LAS unsigned*)(F.lds + MISC_OFF);
    F.tid = threadIdx.x; F.lane = F.tid & 63; F.wave = __builtin_amdgcn_readfirstlane(F.tid >> 6); F.G = gridDim.x; F.bid = blockIdx.x;
    F.ws = args.ws; F.ctl = (gu32*)(args.ws + WS_CTL); F.out = args.out;

    for (int u = F.tid; u < (LDS_BYTES - RING_BYTES) / 4; u += NTHR) ((LAS unsigned*)(F.lds + RING_BYTES))[u] = 0u;
    __syncthreads();
    XcdBarrier bar; bar.bar = (unsigned*)(F.ctl + CW_BAR); bar.x = 0; bar.st = nullptr;
    if (!MK_PER_PHASE) bar = xcd_barrier_post((unsigned*)(F.ctl + CW_BAR), F.MISC + 8);
    const int lo = args.ph_lo, hi = args.ph_hi;
#ifdef ONLY
#define IN(k) ((k) == ONLY)
#else
#define IN(k) (lo <= (k) && (k) < hi)
#endif
#ifdef USE_SGEMM
#define GEMM(gather, A_, arow_, lda_, Bt_, K_, S_, E_) sgemm_phase(F, A_, arow_, lda_, Bt_, K_, S_, E_)
#else
#define GEMM(gather, A_, arow_, lda_, Bt_, K_, S_, E_) pg8::gemm_phase<decltype(E_), decltype(S_), gather, true, false>(F.lds, A_, arow_, Bt_, K_, S_, E_)
#define GEMM8(gather, A_, arow_, Bt_, K_, S_, E_) pg8::gemm_phase<decltype(E_), decltype(S_), gather, true, true>(F.lds, A_, arow_, Bt_, K_, S_, E_)
#endif
#ifndef DUP_PHASE
#define DUP_PHASE -1
#endif
#define NREP(k) ((k) == DUP_PHASE ? 2 : 1)
#ifndef PROBE_PHASE
#define PROBE_PHASE -1
#endif
#define PSTAMP(k, w) do { if (PROBE_PHASE == (k) && F.bid == 0 && F.tid == 0) F.MISC[20 + (w)] = (unsigned)__builtin_amdgcn_s_memrealtime(); } while (0)
#define SEAM(k) do { if (IN(k) && IN((k) + 1)) xcd_barrier(bar); } while (0)

    PSTAMP(PH_PRO, 0);
    if (IN(PH_PRO)) { for (int rep = 0; rep < NREP(PH_PRO); ++rep) { p0_prologue(F, args); __syncthreads(); } } SEAM(PH_PRO); PSTAMP(PH_PRO, 1);
    PSTAMP(PH_INPROJ, 0);
    if (IN(PH_INPROJ)) { constexpr int GG = 224;
        if (F.G == 256 && F.bid >= GG) { if (F.bid - GG < NBH) { gate_scans(F, F.bid - GG, NBH); __syncthreads(); }
            tr_run<false>(F, args, I_SMALL, NBG, (F.bid - GG) * NWAVES + F.wave, (256 - GG) * NWAVES); }
        else { StaticOrder S{M / 256, NU / 256, F.G == 256 ? GG : F.G, F.bid}; EpiStoreBf16 E{wsp<bf16>(F, WS_U), NU};
            GEMM(false, wsp<bf16>(F, WS_XN), nullptr, D, wsp<bf16>(F, WS_WIN), D, S, E);
        } } SEAM(PH_INPROJ); PSTAMP(PH_INPROJ, 1);
    PSTAMP(PH_PREP, 0);
    if (IN(PH_PREP)) { for (int rep = 0; rep < NREP(PH_PREP); ++rep) { p_prep(F, args); __syncthreads(); } } SEAM(PH_PREP); PSTAMP(PH_PREP, 1);
    PSTAMP(PH_ROUTE, 0);
    if (IN(PH_ROUTE)) { for (int rep = 0; rep < NREP(PH_ROUTE); ++rep) { p_route(F, args); __syncthreads(); } } SEAM(PH_ROUTE); PSTAMP(PH_ROUTE, 1);
    PSTAMP(PH_MIXA, 0);
    if (IN(PH_MIXA)) { for (int rep = 0; rep < NREP(PH_MIXA); ++rep) { p_mix_a(F, args); __syncthreads(); } } SEAM(PH_MIXA); PSTAMP(PH_MIXA, 1);
    PSTAMP(PH_MIXB, 0);
    if (IN(PH_MIXB)) { for (int rep = 0; rep < NREP(PH_MIXB); ++rep) { p_mix_b(F, args); __syncthreads(); } } SEAM(PH_MIXB); PSTAMP(PH_MIXB, 1);
    PSTAMP(PH_OUTPROJ, 0);
    if (IN(PH_OUTPROJ)) { for (int rep = 0; rep < NREP(PH_OUTPROJ); ++rep) { StaticOrder S{M / 256, D / 256, F.G, F.bid}; EpiOutProj E{args.in[0], wsp<bf16>(F, WS_X1), wsp<float>(F, WS_SS), wsp<unsigned char>(F, WS_T8)};
        GEMM(false, wsp<bf16>(F, WS_MIX), nullptr, D, wsp<bf16>(F, WS_WOUT), D, S, E); } } SEAM(PH_OUTPROJ); PSTAMP(PH_OUTPROJ, 1);
    PSTAMP(PH_ROUTER, 0);
    if (IN(PH_ROUTER)) {
        for (int rep = 0; rep < NREP(PH_ROUTER); ++rep) { p_router(F, args); __syncthreads(); } } SEAM(PH_ROUTER); PSTAMP(PH_ROUTER, 1);
    PSTAMP(PH_LISTS, 0);
    if (IN(PH_LISTS)) { for (int rep = 0; rep < NREP(PH_LISTS); ++rep) { p_lists(F, args); __syncthreads(); } } SEAM(PH_LISTS); PSTAMP(PH_LISTS, 1);
    PSTAMP(PH_GU, 0);
    if (IN(PH_GU)) { for (int rep = 0; rep < NREP(PH_GU); ++rep) { GroupedOrder S{wsp<int>(F, WS_TILEE), 8, F.G, F.bid}; EpiGateUp E{wsp<int>(F, WS_TILEE), wsp<float>(F, WS_ROWRSTD), args.in[16], wsp<unsigned char>(F, WS_ACT)};
        GEMM8(true, wsp<unsigned char>(F, WS_T8), wsp<int>(F, WS_ROWTOK), wsp<unsigned char>(F, WS_WGU), D, S, E); }
        {
            const int nun = wsp<int>(F, WS_TILEE)[MAXTILES] * 8, rem = nun % F.G; PeOrder S{F.bid, F.G};
            if (rem > 0) { S.first = F.bid >= rem ? F.bid - rem : -1; S.stride = F.G - rem; }
            int kple = PLE; asm volatile("" : "+s"(kple)); EpiStoreBf16 E{wsp<bf16>(F, WS_MIX), D}; GEMM(false, wsp<bf16>(F, WS_PB), nullptr, kple, wsp<bf16>(F, WS_WPP), kple, S, E); } } SEAM(PH_GU); PSTAMP(PH_GU, 1);
    PSTAMP(PH_DN, 0);
    if (IN(PH_DN)) { for (int rep = 0; rep < NREP(PH_DN); ++rep) { GroupedOrder S{wsp<int>(F, WS_TILEE), 4, F.G, F.bid}; EpiDown E{wsp<float>(F, WS_ROWGATE), args.in[18], wsp<unsigned char>(F, WS_YS)};
        GEMM8(false, wsp<unsigned char>(F, WS_ACT), nullptr, wsp<unsigned char>(F, WS_WDN), FF, S, E); }
} SEAM(PH_DN); PSTAMP(PH_DN, 1);
    PSTAMP(PH_COMB, 0);
    if (IN(PH_COMB)) { for (int rep = 0; rep < NREP(PH_COMB); ++rep) { p_combine(F, args); __syncthreads(); } } SEAM(PH_COMB); PSTAMP(PH_COMB, 1);
    PSTAMP(PH_PLE, 0);
    if (IN(PH_PLE)) { StaticOrder S{M / 256, D / 256, F.G, F.bid};
        { EpiPle E{wsp<bf16>(F, WS_MIX), wsp<bf16>(F, WS_X1), wsp<float>(F, WS_RSTD), F.out}; GEMM(false, wsp<bf16>(F, WS_X1), nullptr, D, wsp<bf16>(F, WS_WPG), D, S, E); } }
    if (PROBE_PHASE == PH_PLE) { __syncthreads(); PSTAMP(PH_PLE, 1); }
    if (PROBE_PHASE >= 0 && F.bid == 0 && F.tid == 0) { const unsigned dt = F.MISC[21] - F.MISC[20]; const unsigned long long t0 = __builtin_amdgcn_s_memrealtime(); while (__builtin_amdgcn_s_memrealtime() - t0 < 9ull * dt) __builtin_amdgcn_s_sleep(8); }
#undef IN
#undef SEAM
}

extern "C" void kernel_launch(void* const* d_in, const int* in_sizes, int n_in, void* d_out, int out_size, void* d_ws, size_t ws_size, hipStream_t stream) {
    static int grid = 0;
    if (grid == 0) {
        if (n_in != 22 || out_size != M * D || ws_size < WS_END) { fprintf(stderr, "kernel_launch: unexpected problem (n_in %d, out %d, ws %zu); nothing launched\n", n_in, out_size, ws_size); grid = -1; return; }
        int dev = 0, cus = 0, per_cu = 0;
        if (hipGetDevice(&dev) != hipSuccess || hipDeviceGetAttribute(&cus, hipDeviceAttributeMultiprocessorCount, dev) != hipSuccess) { grid = -1; return; }
        if (hipFuncSetAttribute((const void*)fwd, hipFuncAttributeMaxDynamicSharedMemorySize, LDS_BYTES) != hipSuccess) { fprintf(stderr, "kernel_launch: hipFuncSetAttribute failed\n"); grid = -1; return; }
        if (hipOccupancyMaxActiveBlocksPerMultiprocessor(&per_cu, (const void*)fwd, NTHR, LDS_BYTES) != hipSuccess || per_cu < 1) fprintf(stderr, "kernel_launch: occupancy query says %d\n", per_cu);
        (void)hipGetLastError();
        grid = cus;
    }
    if (grid < 0) return;
    if (hipMemsetAsync((char*)d_ws + WS_CTL, 0, CTL_ZERO_BYTES, stream) != hipSuccess) return;
    Args a{};
    for (int i = 0; i < 22; ++i) a.in[i] = (const float*)d_in[i];
    a.out = (float*)d_out; a.ws = (unsigned char*)d_ws; a.li = 0; a.pad = 0;
#if MK_PER_PHASE
    for (int ph = 0; ph < NPH; ++ph) { a.ph_lo = ph; a.ph_hi = ph + 1; hipLaunchKernelGGL(fwd, dim3(grid), dim3(NTHR), LDS_BYTES, stream, a); }
#else
    a.ph_lo = 0; a.ph_hi = NPH; hipLaunchKernelGGL(fwd, dim3(grid), dim3(NTHR), LDS_BYTES, stream, a);
#endif
}
```

```cpp
#include <hip/hip_runtime.h>
#include <cstdio>
#include <cstdint>

#ifndef MK_PER_PHASE
#define MK_PER_PHASE 0
#endif

#define GAS __attribute__((address_space(1)))
#define LAS __attribute__((address_space(3)))
typedef unsigned short bf16;
typedef unsigned v4u __attribute__((ext_vector_type(4)));
typedef unsigned v2u __attribute__((ext_vector_type(2)));
typedef float f32x4 __attribute__((ext_vector_type(4)));
typedef short bf16x8 __attribute__((ext_vector_type(8)));
typedef int v8i __attribute__((ext_vector_type(8)));
typedef GAS unsigned gu32;
#define RLX_AGENT __ATOMIC_RELAXED, __HIP_MEMORY_SCOPE_AGENT
#define LDS_WAIT() asm volatile("s_waitcnt lgkmcnt(0)" ::: "memory")
#define VM_WAIT() asm volatile("s_waitcnt vmcnt(0)" ::: "memory")

constexpr int BATCH = 2, SEQ = 8192, D = 1024, M = BATCH * SEQ;
constexpr int PROJ = 3600, NU = 3584;
constexpr int HD = 64, NH = 8, WM = 512;
constexpr int LCH = 128, NCH = SEQ / LCH;
constexpr int MBS = 256, NBK = SEQ / MBS;
constexpr int NPAIR = NBK * (NBK - 1) / 2;
constexpr int NE = 32, TOPK = 4, FF = 1024, PLE = 256;
constexpr int MAXROWS = M * TOPK + NE * 256, MAXTILES = MAXROWS / 256;
constexpr float RMS_EPS = 1e-6f;
constexpr float SW_LIMIT = 7.0f, SW_ALPHA = 1.702f;
constexpr float LOG2E = 1.4426950408889634f;
constexpr float W8_SCALE = 64.0f, W8_INV = 1.0f / 64.0f;
constexpr int UQM = 0, UKM = 512, UVM = 1024, UOM = 1536, UQB = 2048, UKB = 2560, UVB = 3072;
constexpr int NBH = BATCH * NH;

constexpr size_t MiB = 1u << 20;
constexpr size_t WS_CTL = 0, CTL_ZERO_BYTES = 32768;
constexpr size_t WS_WIN = 2 * MiB;
constexpr size_t WS_WOUT = 10 * MiB;
constexpr size_t WS_WPG = 12 * MiB;
constexpr size_t WS_WPP = 14 * MiB;
constexpr size_t WS_WR = 15 * MiB;
constexpr size_t WS_WGU = 16 * MiB;
constexpr size_t WS_WDN = 144 * MiB;
constexpr size_t WS_XN = 208 * MiB;
constexpr size_t WS_PB = 240 * MiB;
constexpr size_t WS_GATES = 248 * MiB;
constexpr size_t WS_SA = 249 * MiB;
constexpr size_t WS_SMX = WS_SA + 512 * 1024;
constexpr size_t WS_SB = WS_SMX + 512 * 1024;
constexpr size_t WS_SW = WS_SB + 512 * 1024;
constexpr size_t WS_SMALL = 251 * MiB;
constexpr size_t WS_DEC = WS_SMALL;
constexpr size_t WS_MC = WS_DEC + 4096;
constexpr size_t WS_KMEAN = WS_MC + 4096;
constexpr size_t WS_MCNT = WS_KMEAN + 131072;
constexpr size_t WS_SELE = 252 * MiB;
constexpr size_t WS_SELW = WS_SELE + 262144;
constexpr size_t WS_RSTD = WS_SELW + 262144;
constexpr size_t WS_HIST = WS_RSTD + 65536;
constexpr size_t WS_POS = WS_HIST + 32768;
constexpr size_t WS_ROWTOK = WS_POS + 262144;
constexpr size_t WS_ROWGATE = WS_ROWTOK + 294912;
constexpr size_t WS_ROWRSTD = WS_ROWGATE + 294912;
constexpr size_t WS_TILEE = WS_ROWRSTD + 294912;
constexpr size_t WS_SS = 254 * MiB;
constexpr size_t WS_DN = 255 * MiB;
constexpr size_t WS_NS = WS_DN + 262144;
constexpr size_t WS_U = 260 * MiB;
constexpr size_t WS_QM = 372 * MiB;
constexpr size_t WS_KM = 388 * MiB;
constexpr size_t WS_QN = 404 * MiB;
constexpr size_t WS_KN = 420 * MiB;
constexpr size_t WS_T8 = 404 * MiB;
constexpr size_t WS_VT = 436 * MiB;
constexpr size_t WS_MIX = 452 * MiB;
constexpr size_t WS_X1 = 484 * MiB;
constexpr size_t WS_MLIST = 548 * MiB;
constexpr size_t WS_OP = 556 * MiB;
constexpr size_t WS_LP = 652 * MiB;
constexpr size_t WS_DC = 654 * MiB;
constexpr size_t WS_CS = 670 * MiB;
constexpr size_t WS_ACT = 688 * MiB;
constexpr size_t WS_YS = 260 * MiB;
constexpr size_t WS_END = 832 * MiB;
static_assert(WS_ACT + (size_t)MAXROWS * 1024 * 2 <= WS_END && WS_YS + (size_t)MAXROWS * 1024 * 2 <= WS_QN, "ws map");
constexpr int CW_BAR = 4096;

constexpr int RING_BYTES = 131072;
constexpr int LDS_BYTES = 147456;
constexpr int MISC_OFF = LDS_BYTES - 256;
constexpr int BG_SCR = 77824;
constexpr int GSCR_OFF = RING_BYTES + 1024;
constexpr int NWAVES = 8, NTHR = 512;
static_assert(BG_SCR + NWAVES * 8448 <= MISC_OFF, "LDS map");

typedef float f32x2_t __attribute__((ext_vector_type(2)));
typedef __bf16 bf16x2_t __attribute__((ext_vector_type(2)));
typedef float f32x16 __attribute__((ext_vector_type(16)));
__device__ __forceinline__ unsigned pk2(float lo, float hi) { f32x2_t v = {lo, hi}; bf16x2_t b = __builtin_convertvector(v, bf16x2_t); return __builtin_bit_cast(unsigned, b); }
__device__ __forceinline__ unsigned f2bf(float f) { return pk2(f, 0.f) & 0xffffu; }
__device__ __forceinline__ unsigned pk4f8(float a, float b, float c, float d) { int w = 0; w = __builtin_amdgcn_cvt_pk_fp8_f32(a, b, w, false); w = __builtin_amdgcn_cvt_pk_fp8_f32(c, d, w, true); return (unsigned)w; }
__device__ __forceinline__ float bf2f(unsigned short b) { return __builtin_bit_cast(float, (unsigned)b << 16); }
__device__ __forceinline__ float bflo(unsigned w) { return __builtin_bit_cast(float, w << 16); }
__device__ __forceinline__ float bfhi(unsigned w) { return __builtin_bit_cast(float, w & 0xffff0000u); }
__device__ __forceinline__ float sigmoidf_(float x) { return 1.0f / (1.0f + __expf(-x)); }

#define XB_TMO      128
#define XB_XCNT(j)  (256  + 64 * (j))
#define XB_XSUB(j)  (1280 + 64 * (j))
#define XB_XGEN(j)  (2304 + 64 * (j))
#define XB_TOP      3328
#define XB_TOPGEN   3392
#define XCD_BAR_WORDS 3456
#define XB_SPIN_CAP (1u << 18)
__device__ __forceinline__ unsigned xb_ld(unsigned* p)              { return __hip_atomic_load(p, __ATOMIC_RELAXED, __HIP_MEMORY_SCOPE_AGENT); }
__device__ __forceinline__ unsigned xb_add(unsigned* p, unsigned v) { return __hip_atomic_fetch_add(p, v, __ATOMIC_RELAXED, __HIP_MEMORY_SCOPE_AGENT); }
__device__ __forceinline__ unsigned xb_xcc_id() { return (unsigned)__builtin_amdgcn_s_getreg((3 << 11) | 20) & 0xFu; }
#define XB_SPIN(cond, bar) do { unsigned _sp = 0; while (cond) { __builtin_amdgcn_s_sleep(1); \
    if ((++_sp & 255u) == 0u) { if (xb_ld(&(bar)[XB_TMO])) break; if (_sp > XB_SPIN_CAP) { atomicAdd(&(bar)[XB_TMO], 1u); break; } } } } while (0)
struct XcdBarrier { unsigned* bar; unsigned x; volatile LAS unsigned* st; };
__device__ __forceinline__ XcdBarrier xcd_barrier_post(unsigned* bar, volatile LAS unsigned* st) {
    XcdBarrier b; b.bar = bar; b.x = xb_xcc_id(); b.st = st;
    if (threadIdx.x == 0) (void)xb_add(&bar[XB_XCNT(b.x)], 1u);
    return b;
}
__device__ __forceinline__ void xcd_barrier_complete(unsigned* bar, unsigned x, unsigned& nloc, unsigned& nx) {
    const unsigned G = gridDim.x * gridDim.y * gridDim.z;
    unsigned sum, cnt, mine, sp = 0u;
    for (;;) {
        sum = 0u; cnt = 0u; mine = 0u;
#pragma unroll
        for (unsigned j = 0; j < 16; ++j) { const unsigned c = xb_ld(&bar[XB_XCNT(j)]); sum += c; cnt += (c > 0u) ? 1u : 0u; mine = (j == x) ? c : mine; }
        if (sum == G) break;
        __builtin_amdgcn_s_sleep(1);
        if ((++sp & 255u) == 0u) { if (xb_ld(&bar[XB_TMO])) break; if (sp > XB_SPIN_CAP) { atomicAdd(&bar[XB_TMO], 1u); break; } }
    }
    nloc = mine > 0u ? mine : 1u; nx = cnt > 0u ? cnt : 1u;
}
__device__ __forceinline__ void xcd_barrier(const XcdBarrier& b) {
    asm volatile("s_waitcnt vmcnt(0)" ::: "memory");
    __syncthreads();
    if (threadIdx.x == 0) {
        unsigned* bar = b.bar;
        __builtin_amdgcn_s_waitcnt(0);
        unsigned nloc = b.st[0], nx = b.st[1];
        if (nloc == 0u) { xcd_barrier_complete(bar, b.x, nloc, nx); b.st[0] = nloc; b.st[1] = nx; }
        const unsigned old = xb_add(&bar[XB_XSUB(b.x)], 1u);
        const unsigned gen = old / nloc;
        if (old + 1u == (gen + 1u) * nloc) {
            __builtin_amdgcn_fence(__ATOMIC_RELEASE, "agent");
            asm volatile("s_waitcnt vmcnt(0)" ::: "memory");
            const unsigned og = xb_add(&bar[XB_TOP], 1u);
            const unsigned tg = og / nx;
            if (og + 1u == (tg + 1u) * nx) xb_add(&bar[XB_TOPGEN], 1u);
            else XB_SPIN(xb_ld(&bar[XB_TOPGEN]) == tg, bar);
            __builtin_amdgcn_fence(__ATOMIC_ACQUIRE, "agent");
            xb_add(&bar[XB_XGEN(b.x)], 1u);
            asm volatile("s_waitcnt vmcnt(0)" ::: "memory");
        } else {
            XB_SPIN(xb_ld(&bar[XB_XGEN(b.x)]) == gen, bar);
            __builtin_amdgcn_fence(__ATOMIC_ACQUIRE, "agent");
            asm volatile("s_waitcnt vmcnt(0)" ::: "memory");
        }
    }
    __syncthreads();
}

struct Args { const float* in[22]; float* out; unsigned char* ws; int ph_lo, ph_hi, li, pad; };
struct Frame {
    LAS unsigned char* lds; volatile LAS unsigned* MISC; gu32* ctl;
    int tid, lane, wave, G, bid;
    float* out; unsigned char* ws;
};
template <class T> __device__ __forceinline__ T* wsp(const Frame& F, size_t off) { return (T*)(F.ws + off); }

__device__ __forceinline__ float wave_sum(float v) {
#pragma unroll
    for (int o = 1; o < 64; o <<= 1) v += __shfl_xor(v, o);
    return v;
}
__device__ __forceinline__ float wave_max(float v) {
#pragma unroll
    for (int o = 1; o < 64; o <<= 1) v = fmaxf(v, __shfl_xor(v, o));
    return v;
}

struct Unit { int pm, pn; };
struct StaticOrder {
    int nM, nN, G, c;
    __device__ __forceinline__ bool next(int i, Unit& u) const {
        const int nwg = nM * nN; const int L = i * G + c; if (L >= nwg) return false;
        int wgid = L; { const int q = nwg / 8, r = nwg % 8, xcd = wgid % 8, off = wgid / 8; wgid = (xcd < r ? xcd * (q + 1) : r * (q + 1) + (xcd - r) * q) + off; }
        const int nig = 8 * nN, gid = wgid / nig, fm = gid * 8, gsz = (nM - fm) < 8 ? (nM - fm) : 8;
        u.pm = fm + ((wgid % nig) % gsz); u.pn = (wgid % nig) / gsz; return true;
    }
};
struct GroupedOrder {
    const int* tile_e; int NT, G, c;
    __device__ __forceinline__ bool next(int i, Unit& u) const {
        const int nwg = tile_e[MAXTILES] * NT; const int L0 = i * G + c; if (L0 >= nwg) return false;
        const int q = nwg / 8, r = nwg % 8, xcd = L0 % 8, off = L0 / 8; const int L = (xcd < r ? xcd * (q + 1) : r * (q + 1) + (xcd - r) * q) + off;
        const int t = L / NT, n = L % NT; u.pm = t; u.pn = tile_e[t] * NT + n; return true;
    }
};
struct PeOrder {
    int first, stride;
    __device__ __forceinline__ bool next(int i, Unit& u) const { const int L = first + i * stride; if (first < 0 || L >= (M / 256) * (D / 256)) return false; u.pm = L >> 2; u.pn = L & 3; return true; }
};
__device__ __forceinline__ int perm32(int rho) { const int n = rho >> 4, i = rho & 15; return 8 * (i >> 2) + 4 * n + (i & 3); }

template <class Sched, class Epi>
__device__ __forceinline__ void sgemm_phase(const Frame& F, const bf16* A, const int* arow, int lda, const bf16* Bt, int K, const Sched& S, const Epi& E) {
    const int wid = F.wave, lane = F.lane, wr = wid >> 2, wc = wid & 3, fr = lane & 15, fq = lane >> 4;
    Unit u;
    for (int i = 0; S.next(i, u); ++i) {
        for (int ai = 0; ai < 2; ++ai) {
            f32x4 acc[2][4][2];
#pragma unroll
            for (int bj = 0; bj < 2; ++bj)
#pragma unroll
                for (int m = 0; m < 4; ++m)
#pragma unroll
                    for (int n = 0; n < 2; ++n) acc[bj][m][n] = (f32x4){0.f, 0.f, 0.f, 0.f};
            const bf16* ap[4]; const bf16* bp[2][2];
#pragma unroll
            for (int m = 0; m < 4; ++m) { const int r = u.pm * 256 + ai * 128 + wr * 64 + m * 16 + fr; const int src = arow ? arow[r] : r; ap[m] = A + (size_t)src * lda + fq * 8; }
#pragma unroll
            for (int bj = 0; bj < 2; ++bj)
#pragma unroll
                for (int n = 0; n < 2; ++n) bp[bj][n] = Bt + (size_t)(u.pn * 256 + bj * 128 + wc * 32 + perm32(16 * n + fr)) * K + fq * 8;
            for (int k = 0; k < K; k += 32) {
                bf16x8 af[4], bfr[2][2];
#pragma unroll
                for (int m = 0; m < 4; ++m) af[m] = *(const bf16x8*)(ap[m] + k);
#pragma unroll
                for (int bj = 0; bj < 2; ++bj)
#pragma unroll
                    for (int n = 0; n < 2; ++n) bfr[bj][n] = *(const bf16x8*)(bp[bj][n] + k);
#pragma unroll
                for (int bj = 0; bj < 2; ++bj)
#pragma unroll
                    for (int m = 0; m < 4; ++m)
#pragma unroll
                        for (int n = 0; n < 2; ++n) acc[bj][m][n] = __builtin_amdgcn_mfma_f32_16x16x32_bf16(bfr[bj][n], af[m], acc[bj][m][n], 0, 0, 0);
            }
#pragma unroll
            for (int m = 0; m < 4; ++m) {
                float lo[8], hi[8];
#pragma unroll
                for (int j = 0; j < 4; ++j) { lo[j] = acc[0][m][0][j]; lo[4 + j] = acc[0][m][1][j]; hi[j] = acc[1][m][0][j]; hi[4 + j] = acc[1][m][1][j]; }
                typename Epi::Pre pre; E.pre(u, wr * 64 + fr, wc * 32 + fq * 8, pre); { typename Epi::Ld ld; E.load(u, ai * 128 + wr * 64 + m * 16 + fr, wc * 32 + fq * 8, ld); E(u, ai * 128 + wr * 64 + m * 16 + fr, wc * 32 + fq * 8, lo, hi, pre, ai * 4 + m, ld); }
            }
        }
    }
}

namespace pg8 {
constexpr int BM = 256, BK = 64, HALF = 128, HTB = HALF * BK * 2, STAGE_BYTES = 8 * HTB;
__device__ __forceinline__ int lds_byte(int r, int c) { const int st = (r >> 4) * 2 + (c >> 5), rr = r & 15, cc = c & 31, ob = rr * 64 + cc * 2; return st * 1024 + (ob ^ (((ob >> 9) & 1) << 5)); }
__device__ __forceinline__ void stage_rc(int b, int& R, int& C) { const int st = b / 1024, sb = b % 1024, swz = sb ^ (((sb >> 9) & 1) << 5); R = (st >> 1) * 16 + swz / 64; C = (st & 1) * 32 + (swz % 64) / 2; }

template <bool FP8>
__device__ __forceinline__ void mma_block(f32x4 (&c)[4][2], const bf16x8 (&At)[4][2], const bf16x8 (&Bq)[2][2]) {
    if constexpr (FP8) {
#pragma unroll
        for (int m = 0; m < 4; ++m)
#pragma unroll
            for (int n = 0; n < 2; ++n) {
                const v4u b0 = __builtin_bit_cast(v4u, Bq[n][0]), b1 = __builtin_bit_cast(v4u, Bq[n][1]), a0 = __builtin_bit_cast(v4u, At[m][0]), a1 = __builtin_bit_cast(v4u, At[m][1]);
                const v8i bw = {(int)b0.x, (int)b0.y, (int)b0.z, (int)b0.w, (int)b1.x, (int)b1.y, (int)b1.z, (int)b1.w}, aw = {(int)a0.x, (int)a0.y, (int)a0.z, (int)a0.w, (int)a1.x, (int)a1.y, (int)a1.z, (int)a1.w};
                c[m][n] = __builtin_amdgcn_mfma_scale_f32_16x16x128_f8f6f4(bw, aw, c[m][n], 0, 0, 0, 0x7F7F7F7F, 0, 0x7F7F7F7F); }
    } else {
#pragma unroll
        for (int m = 0; m < 4; ++m)
#pragma unroll
            for (int n = 0; n < 2; ++n)
#pragma unroll
                for (int k = 0; k < 2; ++k) c[m][n] = __builtin_amdgcn_mfma_f32_16x16x32_bf16(Bq[n][k], At[m][k], c[m][n], 0, 0, 0);
    }
}
template <class Epi, class Sched, bool GATHER, bool ALIGN_EPI, bool FP8>
__device__ __forceinline__ void gemm_phase(LAS unsigned char* lds, const void* A, const int* arow, const void* Bt, const int K, const Sched& S, const Epi& E) {
    const int RB = FP8 ? K : 2 * K;
    const int tid = threadIdx.x, wid = __builtin_amdgcn_readfirstlane(tid >> 6), lane = tid & 63, wr = wid >> 2, wc = wid & 3, fr = lane & 15, fq = lane >> 4;
    const int nt = RB / 128;
    unsigned voffB[2], vA[2][2];
#pragma unroll
    for (int i = 0; i < 2; ++i) { int sR, sC; stage_rc(tid * 16 + i * 8192, sR, sC); const int Rb = (sR & ~31) + perm32(sR & 31);
        voffB[i] = (unsigned)(Rb * RB + sC * 2);
        vA[0][i] = (unsigned)(sR * RB + sC * 2); vA[1][i] = (unsigned)((sR + HALF) * RB + sC * 2); }
    const unsigned kstep = 128u;
    const unsigned hstep = (unsigned)HALF * RB;
    const unsigned r64 = 64u * RB;
    const unsigned tstep = 2 * hstep;
    const __amdgpu_buffer_rsrc_t rA = __builtin_amdgcn_make_buffer_rsrc((void*)A, 0, 0x7fffffff, 0x00020000), rB = __builtin_amdgcn_make_buffer_rsrc((void*)Bt, 0, 0x7fffffff, 0x00020000);
    const unsigned ldsw = (unsigned)wid * 1024u;
    const int aoff = lds_byte(wr * 64 + fr, fq * 8), boff = lds_byte(wc * 32 + fr, fq * 8);
#define PG8_SA(b, h) (((b) * 2 + (h)) * HTB)
#define PG8_SB(b, h) ((4 + (b) * 2 + (h)) * HTB)
#define PG8_STAGE_B(bufoff, so) do { _Pragma("unroll") for (int _i = 0; _i < 2; ++_i) \
        __builtin_amdgcn_raw_ptr_buffer_load_lds(rB, (LAS unsigned*)(lds + (bufoff) + ldsw + _i * 8192), 16, voffB[0], (int)((so) + _i * r64), 0, 0); } while (0)
#define PG8_STAGE_A(bufoff, so, h, nx) do { _Pragma("unroll") for (int _i = 0; _i < 2; ++_i) { if constexpr (GATHER) \
        __builtin_amdgcn_raw_ptr_buffer_load_lds(rA, (LAS unsigned*)(lds + (bufoff) + ldsw + _i * 8192), 16, vA[h][_i], (int)(so), 0, 0); else \
        __builtin_amdgcn_raw_ptr_buffer_load_lds(rA, (LAS unsigned*)(lds + (bufoff) + ldsw + _i * 8192), 16, vA[0][0], (int)((so) + (h) * hstep + _i * r64), 0, 0); } } while (0)
#define PG8_LDA(dst, b, h) do { _Pragma("unroll") for (int m = 0; m < 4; ++m) _Pragma("unroll") for (int k = 0; k < 2; ++k) dst[m][k] = *(const LAS bf16x8*)(lds + PG8_SA(b, h) + aoff + m * 2048 + k * 1024); } while (0)
#define PG8_LDB(dst, b, h) do { _Pragma("unroll") for (int n = 0; n < 2; ++n) _Pragma("unroll") for (int k = 0; k < 2; ++k) dst[n][k] = *(const LAS bf16x8*)(lds + PG8_SB(b, h) + boff + n * 2048 + k * 1024); } while (0)
#define PG8_MMA(ai, bj, At, Bq) do { __builtin_amdgcn_s_setprio(1); mma_block<FP8>(acc[ai][bj], At, Bq); __builtin_amdgcn_s_setprio(0); } while (0)
#define PG8_WAIT_V(n) asm volatile("s_waitcnt vmcnt(" #n ")" ::: "memory")
#define PG8_WAIT_L(n) asm volatile("s_waitcnt lgkmcnt(" #n ")" ::: "memory")
#define PG8_BAR __builtin_amdgcn_s_barrier()
#define PG8_SCHED __builtin_amdgcn_sched_barrier(0)
#define PG8_GOFF(dst, u) do { if (GATHER) { _Pragma("unroll") for (int _h = 0; _h < 2; ++_h) _Pragma("unroll") for (int _i = 0; _i < 2; ++_i) { int _R, _C; stage_rc(tid * 16 + _i * 8192, _R, _C); \
        dst[_h][_i] = (unsigned)(arow[(u).pm * BM + _h * HALF + _R] * RB + _C * 2); } } } while (0)
    LAS v4u* gscr = (LAS v4u*)(lds + GSCR_OFF) + tid;
    Unit cur, nxt; int ui = 0;
    if (!S.next(0, cur)) return;
    PG8_GOFF(vA, cur);
    f32x4 acc[2][2][4][2];
#pragma unroll
    for (int a = 0; a < 2; ++a)
#pragma unroll
        for (int b = 0; b < 2; ++b)
#pragma unroll
            for (int m = 0; m < 4; ++m)
#pragma unroll
                for (int n = 0; n < 2; ++n) acc[a][b][m][n] = (f32x4){0.f, 0.f, 0.f, 0.f};
    bf16x8 At[4][2], B0[2][2], B1[2][2];
    unsigned cA = GATHER ? 0u : (unsigned)cur.pm * tstep, cB = (unsigned)cur.pn * tstep;
    PG8_STAGE_B(PG8_SB(0, 0), cB); PG8_STAGE_B(PG8_SB(0, 1), cB + hstep); PG8_STAGE_A(PG8_SA(0, 0), cA, 0, false); PG8_STAGE_A(PG8_SA(0, 1), cA, 1, false);
    if (wr == 1) PG8_BAR;
    PG8_WAIT_V(2); PG8_BAR;
    PG8_STAGE_B(PG8_SB(1, 0), cB + kstep); PG8_STAGE_A(PG8_SA(1, 0), cA + kstep, 0, false); PG8_STAGE_B(PG8_SB(1, 1), cB + hstep + kstep);
    PG8_WAIT_V(6); PG8_BAR;
    for (;;) {
        const bool has_next = S.next(ui + 1, nxt);
        const unsigned nA = has_next ? (GATHER ? 0u : (unsigned)nxt.pm * tstep) : cA, nB = has_next ? (unsigned)nxt.pn * tstep : cB;
        if (GATHER) { if (has_next) { unsigned nv[2][2]; PG8_GOFF(nv, nxt); *gscr = (v4u){nv[0][0], nv[0][1], nv[1][0], nv[1][1]}; } else *gscr = (v4u){vA[0][0], vA[0][1], vA[1][0], vA[1][1]}; }
#pragma unroll 1
        for (int t = 0; t < nt; t += 2) {
            const bool last = (t == nt - 2);
            const unsigned a1 = cA + (unsigned)(t + 1) * kstep;
            const unsigned a2 = last ? nA : cA + (unsigned)(t + 2) * kstep, b2 = last ? nB : cB + (unsigned)(t + 2) * kstep;
            const unsigned a3 = a2 + kstep, b3 = b2 + kstep;
            PG8_LDB(B0, 0, 0); PG8_LDB(B1, 0, 1); PG8_SCHED; PG8_LDA(At, 0, 0); PG8_STAGE_A(PG8_SA(1, 1), a1, 1, false);
            if (GATHER) { if (last) { const v4u nv = *gscr; vA[0][0] = nv.x; vA[0][1] = nv.y; vA[1][0] = nv.z; vA[1][1] = nv.w; } }
            PG8_WAIT_V(8); PG8_WAIT_L(0); PG8_BAR; PG8_MMA(0, 0, At, B0); PG8_MMA(0, 1, At, B1); PG8_BAR; PG8_SCHED;
            PG8_LDA(At, 0, 1); PG8_STAGE_B(PG8_SB(0, 0), b2); PG8_STAGE_B(PG8_SB(0, 1), b2 + hstep); PG8_STAGE_A(PG8_SA(0, 0), a2, 0, last);
            PG8_WAIT_V(8); PG8_WAIT_L(0); PG8_BAR; PG8_MMA(1, 0, At, B0); PG8_MMA(1, 1, At, B1); PG8_BAR; PG8_SCHED;
            PG8_LDB(B0, 1, 0); PG8_LDB(B1, 1, 1); PG8_SCHED; PG8_LDA(At, 1, 0); PG8_STAGE_A(PG8_SA(0, 1), a2, 1, last);
            PG8_WAIT_V(8); PG8_WAIT_L(0); PG8_BAR; PG8_MMA(0, 0, At, B0); PG8_MMA(0, 1, At, B1); PG8_BAR; PG8_SCHED;
            PG8_LDA(At, 1, 1); PG8_STAGE_B(PG8_SB(1, 0), b3); PG8_STAGE_B(PG8_SB(1, 1), b3 + hstep); PG8_STAGE_A(PG8_SA(1, 0), a3, 0, last);
            PG8_WAIT_V(8); PG8_WAIT_L(0); PG8_BAR; PG8_MMA(1, 0, At, B0); PG8_MMA(1, 1, At, B1); PG8_BAR; PG8_SCHED;
        }
        if constexpr (ALIGN_EPI) { if (wr == 0) PG8_BAR; }
        {
            int fr2 = fr, fq2 = fq; asm volatile("" : "+v"(fr2), "+v"(fq2));
            typename Epi::Pre pre; E.pre(cur, wr * 64 + fr2, wc * 32 + fq2 * 8, pre);
            typename Epi::Ld ld; E.load(cur, wr * 64 + fr2, wc * 32 + fq2 * 8, ld);
#pragma unroll
            for (int ai = 0; ai < 2; ++ai)
#pragma unroll
                for (int m = 0; m < 4; ++m) { float lo[8], hi[8]; const int g = ai * 4 + m;
#pragma unroll
                    for (int j = 0; j < 4; ++j) { lo[j] = acc[ai][0][m][0][j]; lo[4 + j] = acc[ai][0][m][1][j]; hi[j] = acc[ai][1][m][0][j]; hi[4 + j] = acc[ai][1][m][1][j]; }
                    typename Epi::Ld nld; if (g < 7) E.load(cur, ((g + 1) >> 2) * HALF + wr * 64 + ((g + 1) & 3) * 16 + fr2, wc * 32 + fq2 * 8, nld);
                    E(cur, ai * HALF + wr * 64 + m * 16 + fr2, wc * 32 + fq2 * 8, lo, hi, pre, g, ld); if (Epi::FENCE) asm volatile("" ::: "memory"); ld = nld; }
        }
        if (!has_next) break;
#pragma unroll
        for (int a = 0; a < 2; ++a)
#pragma unroll
            for (int b = 0; b < 2; ++b)
#pragma unroll
                for (int m = 0; m < 4; ++m)
#pragma unroll
                    for (int n = 0; n < 2; ++n) acc[a][b][m][n] = (f32x4){0.f, 0.f, 0.f, 0.f};
        cur = nxt; cA = nA; cB = nB; ++ui;
        if constexpr (ALIGN_EPI) { if (wr == 1) PG8_BAR; }
    }
    PG8_WAIT_V(0);
    if constexpr (!ALIGN_EPI) { if (wr == 0) PG8_BAR; }
    PG8_BAR;
#undef PG8_SA
#undef PG8_SB
#undef PG8_STAGE_A
#undef PG8_STAGE_B
#undef PG8_LDA
#undef PG8_LDB
#undef PG8_MMA
#undef PG8_WAIT_V
#undef PG8_WAIT_L
#undef PG8_BAR
#undef PG8_SCHED
#undef PG8_GOFF
}
}
__device__ __forceinline__ void store8bf(bf16* p, const float (&v)[8]) { v4u w; w.x = pk2(v[0], v[1]); w.y = pk2(v[2], v[3]); w.z = pk2(v[4], v[5]); w.w = pk2(v[6], v[7]); *(v4u*)p = w; }

struct NoPre {};
struct EpiStoreBf16 { bf16* O; int ldc;
    typedef NoPre Pre; typedef NoPre Ld; static constexpr bool FENCE = false;
    __device__ __forceinline__ void pre(const Unit&, int, int, Pre&) const {}
    __device__ __forceinline__ void load(const Unit&, int, int, Ld&) const {}
    __device__ __forceinline__ void operator()(const Unit& u, int r, int c, const float (&lo)[8], const float (&hi)[8], const Pre&, int, const Ld&) const {
        bf16* o = O + (size_t)(u.pm * 256 + r) * ldc + u.pn * 256 + c; store8bf(o, lo); store8bf(o + 128, hi); } };
struct LdOut { f32x4 x[4]; };
struct EpiOutProj { const float* x; bf16* X1; float* SS; unsigned char* T8;
    typedef NoPre Pre; typedef LdOut Ld; static constexpr bool FENCE = true;
    __device__ __forceinline__ void pre(const Unit&, int, int, Pre&) const {}
    __device__ __forceinline__ void load(const Unit& u, int r, int c, Ld& l) const { const float* xp = x + ((size_t)u.pm * 256 + r) * D + u.pn * 256 + c;
        l.x[0] = __builtin_nontemporal_load((const f32x4*)xp); l.x[1] = __builtin_nontemporal_load((const f32x4*)(xp + 4)); l.x[2] = __builtin_nontemporal_load((const f32x4*)(xp + 128)); l.x[3] = __builtin_nontemporal_load((const f32x4*)(xp + 132)); }
    __device__ __forceinline__ void operator()(const Unit& u, int r, int c, const float (&lo)[8], const float (&hi)[8], const Pre&, int, const Ld& l) const {
        const size_t row = (size_t)u.pm * 256 + r; const int col = u.pn * 256 + c; float ss = 0.f;
#pragma unroll
        for (int h = 0; h < 2; ++h) { const float* v = h ? hi : lo; const int cc = col + h * 128; float o[8];
#pragma unroll
            for (int j = 0; j < 8; ++j) { o[j] = l.x[2 * h + (j >> 2)][j & 3] + v[j]; ss += o[j] * o[j]; }
            store8bf(X1 + row * D + cc, o); *(v2u*)(T8 + row * D + cc) = (v2u){pk4f8(o[0], o[1], o[2], o[3]), pk4f8(o[4], o[5], o[6], o[7])}; }
        ss += __shfl_xor(ss, 16); ss += __shfl_xor(ss, 32);
        if ((threadIdx.x & 63) < 16) SS[row * 16 + u.pn * 4 + (c >> 5)] = ss; } };
struct PreRow { float lo[8], hi[8], rw[8]; };
struct EpiGateUp { const int* tile_e; const float* rowrstd; const float* b_gu; unsigned char* ACT;
    typedef PreRow Pre; typedef NoPre Ld; static constexpr bool FENCE = false;
    __device__ __forceinline__ void load(const Unit&, int, int, Ld&) const {}
    __device__ __forceinline__ void pre(const Unit& u, int r0, int c, Pre& p) const {
        const int e = u.pn >> 3, nt = u.pn & 7; const float* bg = b_gu + (size_t)e * 2048 + nt * 128 + c;
        const f32x4 a0 = *(const f32x4*)bg, a1 = *(const f32x4*)(bg + 4), b0 = *(const f32x4*)(bg + 1024), b1 = *(const f32x4*)(bg + 1028);
        p.lo[0] = a0.x; p.lo[1] = a0.y; p.lo[2] = a0.z; p.lo[3] = a0.w; p.lo[4] = a1.x; p.lo[5] = a1.y; p.lo[6] = a1.z; p.lo[7] = a1.w;
        p.hi[0] = b0.x; p.hi[1] = b0.y; p.hi[2] = b0.z; p.hi[3] = b0.w; p.hi[4] = b1.x; p.hi[5] = b1.y; p.hi[6] = b1.z; p.hi[7] = b1.w;
#pragma unroll
        for (int g = 0; g < 8; ++g) p.rw[g] = rowrstd[(size_t)u.pm * 256 + r0 + 128 * (g >> 2) + 16 * (g & 3)] * W8_INV; }
    __device__ __forceinline__ void operator()(const Unit& u, int r, int c, const float (&lo)[8], const float (&hi)[8], const Pre& p, int g, const Ld&) const {
        const int nt = u.pn & 7; const size_t row = (size_t)u.pm * 256 + r; const float rs = p.rw[g]; float a[8];
#pragma unroll
        for (int j = 0; j < 8; ++j) { float glu = lo[j] * rs + p.lo[j], lin = hi[j] * rs + p.hi[j];
            glu = fminf(glu, SW_LIMIT); lin = fminf(fmaxf(lin, -SW_LIMIT), SW_LIMIT);
            a[j] = glu * sigmoidf_(SW_ALPHA * glu) * (lin + 1.0f); }
        *(v2u*)(ACT + row * FF + nt * 128 + c) = (v2u){pk4f8(a[0], a[1], a[2], a[3]), pk4f8(a[4], a[5], a[6], a[7])}; } };
struct EpiDown { const float* rowgate; const float* b_dn; unsigned char* YS;
    typedef PreRow Pre; typedef NoPre Ld; static constexpr bool FENCE = false;
    __device__ __forceinline__ void load(const Unit&, int, int, Ld&) const {}
    __device__ __forceinline__ void pre(const Unit& u, int r0, int c, Pre& p) const {
        const int e = u.pn >> 2, nt = u.pn & 3; const float* bd = b_dn + (size_t)e * 1024 + nt * 256 + c;
        const f32x4 a0 = *(const f32x4*)bd, a1 = *(const f32x4*)(bd + 4), b0 = *(const f32x4*)(bd + 128), b1 = *(const f32x4*)(bd + 132);
        p.lo[0] = a0.x; p.lo[1] = a0.y; p.lo[2] = a0.z; p.lo[3] = a0.w; p.lo[4] = a1.x; p.lo[5] = a1.y; p.lo[6] = a1.z; p.lo[7] = a1.w;
        p.hi[0] = b0.x; p.hi[1] = b0.y; p.hi[2] = b0.z; p.hi[3] = b0.w; p.hi[4] = b1.x; p.hi[5] = b1.y; p.hi[6] = b1.z; p.hi[7] = b1.w;
#pragma unroll
        for (int g = 0; g < 8; ++g) p.rw[g] = rowgate[(size_t)u.pm * 256 + r0 + 128 * (g >> 2) + 16 * (g & 3)]; }
    __device__ __forceinline__ void operator()(const Unit& u, int r, int c, const float (&lo)[8], const float (&hi)[8], const Pre& p, int g, const Ld&) const {
        const int nt = u.pn & 3; const size_t row = (size_t)u.pm * 256 + r; const float gt = p.rw[g]; float a[8], b[8];
#pragma unroll
        for (int j = 0; j < 8; ++j) { a[j] = (lo[j] * W8_INV + p.lo[j]) * gt; b[j] = (hi[j] * W8_INV + p.hi[j]) * gt; }
        unsigned char* o = YS + row * D + nt * 256 + c; *(v2u*)o = (v2u){pk4f8(a[0], a[1], a[2], a[3]), pk4f8(a[4], a[5], a[6], a[7])}; *(v2u*)(o + 128) = (v2u){pk4f8(b[0], b[1], b[2], b[3]), pk4f8(b[4], b[5], b[6], b[7])}; } };
struct LdPle { v4u pe[2], xw[2]; float rs; };
struct EpiPle { const bf16* PE; const bf16* X2; const float* RS; float* out;
    typedef NoPre Pre; typedef LdPle Ld; static constexpr bool FENCE = true;
    __device__ __forceinline__ void pre(const Unit&, int, int, Pre&) const {}
    __device__ __forceinline__ void load(const Unit& u, int r, int c, Ld& l) const { const size_t o = ((size_t)u.pm * 256 + r) * D + u.pn * 256 + c;
        l.pe[0] = __builtin_nontemporal_load((const v4u*)(PE + o)); l.pe[1] = __builtin_nontemporal_load((const v4u*)(PE + o + 128)); l.xw[0] = *(const v4u*)(X2 + o); l.xw[1] = *(const v4u*)(X2 + o + 128); l.rs = RS[(size_t)u.pm * 256 + r]; }
    __device__ __forceinline__ void operator()(const Unit& u, int r, int c, const float (&lo)[8], const float (&hi)[8], const Pre&, int, const Ld& l) const {
        const size_t row = (size_t)u.pm * 256 + r; const int col = u.pn * 256 + c;
#pragma unroll
        for (int h = 0; h < 2; ++h) { float v[8]; const int cc = col + h * 128; const v4u pe = l.pe[h], xw = l.xw[h];
#pragma unroll
            for (int j = 0; j < 8; ++j) v[j] = (h ? hi[j] : lo[j]) * l.rs;
            f32x4 x0, x1;
            x0[0] = bflo(xw.x) + sigmoidf_(v[0]) * bflo(pe.x); x0[1] = bfhi(xw.x) + sigmoidf_(v[1]) * bfhi(pe.x); x0[2] = bflo(xw.y) + sigmoidf_(v[2]) * bflo(pe.y); x0[3] = bfhi(xw.y) + sigmoidf_(v[3]) * bfhi(pe.y);
            x1[0] = bflo(xw.z) + sigmoidf_(v[4]) * bflo(pe.z); x1[1] = bfhi(xw.z) + sigmoidf_(v[5]) * bfhi(pe.z); x1[2] = bflo(xw.w) + sigmoidf_(v[6]) * bflo(pe.w); x1[3] = bfhi(xw.w) + sigmoidf_(v[7]) * bfhi(pe.w);
            *(f32x4*)(out + row * D + cc) = x0; *(f32x4*)(out + row * D + cc + 4) = x1; } } };

struct TrItem { const float* src; void* dst; const float* gk; int ldw, K, f8; };
__device__ __forceinline__ void tr_load(const TrItem& t, float (&v)[32], int lane) {
#pragma unroll
    for (int i = 0; i < 32; ++i) v[i] = __builtin_nontemporal_load(t.src + (size_t)(2 * i + (lane >> 5)) * t.ldw + (lane & 31));
}
__device__ __forceinline__ void tr_store(const TrItem& t, const float (&v)[32], LAS float* scr, int lane) {
#pragma unroll
    for (int i = 0; i < 32; ++i) scr[(2 * i + (lane >> 5)) * 33 + (lane & 31)] = v[i];
    LDS_WAIT(); asm volatile("" ::: "memory");
    if (t.f8) { const int n = lane >> 1, hf = lane & 1; const LAS float* s = scr + (32 * hf) * 33 + n; unsigned w[8];
#pragma unroll
        for (int q = 0; q < 8; ++q) { f32x4 g = {W8_SCALE, W8_SCALE, W8_SCALE, W8_SCALE}; if (t.gk) g = *(const f32x4*)(t.gk + 32 * hf + 4 * q) * W8_SCALE;
            w[q] = pk4f8(s[(4 * q) * 33] * g.x, s[(4 * q + 1) * 33] * g.y, s[(4 * q + 2) * 33] * g.z, s[(4 * q + 3) * 33] * g.w); }
        unsigned char* o = (unsigned char*)t.dst + (size_t)n * t.K + 32 * hf;
        *(v4u*)o = (v4u){w[0], w[1], w[2], w[3]}; *(v4u*)(o + 16) = (v4u){w[4], w[5], w[6], w[7]};
    } else { const int c = lane & 7;
        f32x4 g0 = {1.f, 1.f, 1.f, 1.f}, g1 = g0; if (t.gk) { g0 = *(const f32x4*)(t.gk + 8 * c); g1 = *(const f32x4*)(t.gk + 8 * c + 4); }
#pragma unroll
        for (int j = 0; j < 4; ++j) { const int n = (lane >> 3) + 8 * j; const LAS float* s = scr + (8 * c) * 33 + n;
            v4u o; o.x = pk2(s[0 * 33] * g0.x, s[1 * 33] * g0.y); o.y = pk2(s[2 * 33] * g0.z, s[3 * 33] * g0.w); o.z = pk2(s[4 * 33] * g1.x, s[5 * 33] * g1.y); o.w = pk2(s[6 * 33] * g1.z, s[7 * 33] * g1.w);
            *(v4u*)((bf16*)t.dst + (size_t)n * t.K + 8 * c) = o; } }
    LDS_WAIT(); asm volatile("" ::: "memory");
}
constexpr int I_IN = 16 * (NU / 32), I_SQ = 16 * 32, I_PP = 4 * 32, I_R = 16, I_GU = 16 * 64, I_DN = 16 * 32;
constexpr int NITEMS = I_IN + 2 * I_SQ + I_PP + I_R + NE * I_GU + NE * I_DN;
__device__ __forceinline__ TrItem tr_decode(const Frame& F, const Args& args, int r) {
    TrItem t; t.f8 = 0; t.gk = nullptr;
    if (r < I_IN) { const int kb = r / (NU / 32), nb = r % (NU / 32), n0 = 32 * nb, sc = n0 < 2048 ? n0 : n0 + 16;
        t.src = args.in[3] + (size_t)(64 * kb) * PROJ + sc; t.ldw = PROJ; t.dst = wsp<bf16>(F, WS_WIN) + (size_t)n0 * D + 64 * kb; t.K = D; }
    else if ((r -= I_IN) < I_SQ) { const int kb = r / 32, n0 = 32 * (r % 32); t.src = args.in[11] + (size_t)(64 * kb) * D + n0; t.ldw = D; t.dst = wsp<bf16>(F, WS_WOUT) + (size_t)n0 * D + 64 * kb; t.K = D; }
    else if ((r -= I_SQ) < I_SQ) { const int kb = r / 32, n0 = 32 * (r % 32); t.src = args.in[20] + (size_t)(64 * kb) * D + n0; t.ldw = D; t.dst = wsp<bf16>(F, WS_WPG) + (size_t)n0 * D + 64 * kb; t.K = D; t.gk = args.in[19] + 64 * kb; }
    else if ((r -= I_SQ) < I_PP) { const int kb = r / 32, n0 = 32 * (r % 32); t.src = args.in[21] + (size_t)(64 * kb) * D + n0; t.ldw = D; t.dst = wsp<bf16>(F, WS_WPP) + (size_t)n0 * PLE + 64 * kb; t.K = PLE; }
    else if ((r -= I_PP) < I_R) { const int kb = r; t.src = args.in[13] + (size_t)(64 * kb) * NE; t.ldw = NE; t.dst = wsp<bf16>(F, WS_WR) + 64 * kb; t.K = D; t.gk = args.in[12] + 64 * kb; }
    else if ((r -= I_R) < NE * I_GU) { const int e = r / I_GU, q = r % I_GU, kb = q / 64, n0 = 32 * (q % 64), pn = n0 >> 8, c = n0 & 255;
        const int sc = c < 128 ? pn * 128 + c : 1024 + pn * 128 + (c - 128);
        t.src = args.in[15] + ((size_t)e * D + 64 * kb) * 2048 + sc; t.ldw = 2048; t.dst = wsp<unsigned char>(F, WS_WGU) + ((size_t)e * 2048 + n0) * D + 64 * kb; t.K = D; t.f8 = 1; t.gk = args.in[12] + 64 * kb; }
    else { r -= NE * I_GU; const int e = r / I_DN, q = r % I_DN, kb = q / 32, n0 = 32 * (q % 32);
        t.src = args.in[17] + ((size_t)e * FF + 64 * kb) * D + n0; t.ldw = D; t.dst = wsp<unsigned char>(F, WS_WDN) + ((size_t)e * D + n0) * FF + 64 * kb; t.K = FF; t.f8 = 1; }
    return t;
}
constexpr int BGS_CONV = 0, BGS_KPART = 4, BGS_ROUTE = 6, BGS_STATE = 8, BGS_MIXA = 12, BGS_MIXB = 20, BGS_END = 22;
struct Bg { float v[32]; TrItem it; int live; };
constexpr int I_SMALL = I_IN + 2 * I_SQ + I_PP + I_R, NBG = 4096;
template <bool REMAP>
__device__ __forceinline__ void tr_run(Frame& F, const Args& args, int first, int count, int w, int nw) {
    LAS float* scr = (LAS float*)(F.lds + F.wave * 16384); const int lane = F.lane;
    float v[32], nv[32]; int q = w;
#define TR_ITEM(qq) (REMAP ? ((qq) < I_SMALL ? (qq) : (qq) + NBG) : first + (qq))
    TrItem cur = tr_decode(F, args, TR_ITEM(q < count ? q : 0));
    if (q < count) tr_load(cur, v, lane);
    while (q < count) { const int nq = q + nw; TrItem nx = tr_decode(F, args, TR_ITEM(nq < count ? nq : 0));
        if (nq < count) tr_load(nx, nv, lane);
        tr_store(cur, v, scr, lane);
#pragma unroll
        for (int i = 0; i < 32; ++i) v[i] = nv[i];
        cur = nx; q = nq; }
#undef TR_ITEM
}
__device__ __forceinline__ void bg_issue(const Frame& F, const Args& args, Bg& bg, int slot) {
    if (F.G != 256) { bg.live = 0; return; }
    int ln = F.lane; asm volatile("" : "+v"(ln));
    const int item = I_SMALL + NBG + (slot * 256 + F.bid) * NWAVES + F.wave; bg.live = item < NITEMS;
    bg.it = tr_decode(F, args, bg.live ? item : I_SMALL);
    if (bg.live) tr_load(bg.it, bg.v, ln);
}
__device__ __forceinline__ void bg_retire(const Frame& F, Bg& bg) { int ln = F.lane; asm volatile("" : "+v"(ln)); if (bg.live) tr_store(bg.it, bg.v, (LAS float*)(F.lds + BG_SCR + F.wave * 8448), ln); }
#define BG_DECL(base, n) Bg bg; int bg_s = (base); const int bg_e = (base) + (n); bg.live = 0
#define BG_TOP() do { if (bg_s < bg_e) bg_issue(F, args, bg, bg_s); } while (0)
#define BG_BOT() do { if (bg_s < bg_e) { bg_retire(F, bg); ++bg_s; } } while (0)
#define BG_FLUSH() do { while (bg_s < bg_e) { bg_issue(F, args, bg, bg_s); bg_retire(F, bg); ++bg_s; } } while (0)
__device__ __forceinline__ void p0_prologue(Frame& F, const Args& args) {
    const int gw = F.bid * NWAVES + F.wave, NGW = F.G * NWAVES, lane = F.lane;
    tr_run<false>(F, args, 0, F.G == 256 ? I_SMALL : NITEMS, gw, NGW);
    __syncthreads();
    { LAS float* slab = (LAS float*)F.lds;
      f32x4 w[8];
#pragma unroll
      for (int q = 0; q < 8; ++q) { const int e = F.tid + NTHR * q; w[q] = *(const f32x4*)(args.in[3] + (size_t)(e >> 2) * PROJ + 2048 + (e & 3) * 4); }
#pragma unroll
      for (int q = 0; q < 8; ++q) { const int e = F.tid + NTHR * q, k = e >> 2, c4 = (e & 3) * 4;
          slab[(c4 + 0) * D + k] = w[q].x; slab[(c4 + 1) * D + k] = w[q].y; slab[(c4 + 2) * D + k] = w[q].z; slab[(c4 + 3) * D + k] = w[q].w; } }
    __syncthreads();
    bf16* XN = wsp<bf16>(F, WS_XN); float* GT = wsp<float>(F, WS_GATES);
    f32x4 nv[2][4];
#pragma unroll
    for (int r = 0; r < 2; ++r) if (gw + r * NGW < M) {
#pragma unroll
        for (int j = 0; j < 4; ++j) nv[r][j] = __builtin_nontemporal_load((const f32x4*)(args.in[0] + (size_t)(gw + r * NGW) * D) + lane + 64 * j); }
    for (int m = gw; m < M; m += 2 * NGW) {
        const f32x4* gr = (const f32x4*)args.in[2] + lane;
        f32x4 v[2][4]; const bool two = m + NGW < M;
#pragma unroll
        for (int r = 0; r < 2; ++r)
#pragma unroll
            for (int j = 0; j < 4; ++j) v[r][j] = (r == 0 || two) ? nv[r][j] : (f32x4){0.f, 0.f, 0.f, 0.f};
#pragma unroll
        for (int r = 0; r < 2; ++r) if (m + (2 + r) * NGW < M) {
#pragma unroll
            for (int j = 0; j < 4; ++j) nv[r][j] = __builtin_nontemporal_load((const f32x4*)(args.in[0] + (size_t)(m + (2 + r) * NGW) * D) + lane + 64 * j); }
        asm volatile("" ::: "memory");
#pragma unroll
        for (int r = 0; r < 2; ++r) { float s = 0.f;
#pragma unroll
            for (int j = 0; j < 4; ++j) s += (v[r][j].x * v[r][j].x + v[r][j].y * v[r][j].y) + (v[r][j].z * v[r][j].z + v[r][j].w * v[r][j].w);
            const float rstd = 1.0f / sqrtf(wave_sum(s) * (1.0f / D) + RMS_EPS);
#pragma unroll
            for (int j = 0; j < 4; ++j) { const f32x4 g = gr[64 * j]; v[r][j] = v[r][j] * rstd * g;
                if (r == 0 || two) *(v2u*)(XN + (size_t)(m + r * NGW) * D + 256 * j + 4 * lane) = (v2u){pk2(v[r][j].x, v[r][j].y), pk2(v[r][j].z, v[r][j].w)}; } }
        float ga[32];
#pragma unroll
        for (int c = 0; c < 16; ++c) { float a0 = 0.f, a1 = 0.f;
#pragma unroll
            for (int j = 0; j < 4; ++j) { const f32x4 w = *(const LAS f32x4*)((LAS float*)F.lds + c * D + 256 * j + 4 * lane);
                a0 += (v[0][j].x * w.x + v[0][j].y * w.y) + (v[0][j].z * w.z + v[0][j].w * w.w); a1 += (v[1][j].x * w.x + v[1][j].y * w.y) + (v[1][j].z * w.z + v[1][j].w * w.w); }
            ga[c] = a0; ga[16 + c] = a1; }
#define BFLY(HALF, BIT) { const bool up = lane & (BIT); _Pragma("unroll") for (int c = 0; c < (HALF); ++c) { const float mine = up ? ga[c + (HALF)] : ga[c], oth = up ? ga[c] : ga[c + (HALF)]; ga[c] = mine + __shfl_xor(oth, (BIT)); } }
        BFLY(16, 1) BFLY(8, 2) BFLY(4, 4) BFLY(2, 8) BFLY(1, 16)
#undef BFLY
        ga[0] += __shfl_xor(ga[0], 32);
        if (lane < 32) { const int idx = 16 * (lane & 1) + 8 * ((lane >> 1) & 1) + 4 * ((lane >> 2) & 1) + 2 * ((lane >> 3) & 1) + ((lane >> 4) & 1); const int r = idx >> 4, col = idx & 15;
            if (r == 0 || two) GT[(size_t)(m + r * NGW) * 16 + col] = ga[0] + (col < 8 ? args.in[6][col] : args.in[7][col - 8]); }
    }
    bf16* PB = wsp<bf16>(F, WS_PB);
    { const size_t n4 = (size_t)M * PLE / 4, st = (size_t)F.G * NTHR;
      for (size_t i0 = (size_t)F.bid * NTHR + F.tid; i0 < n4; i0 += 4 * st) { f32x4 t[4];
#pragma unroll
          for (int q = 0; q < 4; ++q) if (i0 + q * st < n4) t[q] = ((const f32x4*)args.in[1])[i0 + q * st];
#pragma unroll
          for (int q = 0; q < 4; ++q) if (i0 + q * st < n4) *(v2u*)(PB + 4 * (i0 + q * st)) = (v2u){pk2(t[q].x, t[q].y), pk2(t[q].z, t[q].w)}; } }
}

__device__ __forceinline__ float logsigmoidf_(float f) { return f >= 0.f ? -log1pf(__expf(-f)) : f - log1pf(__expf(f)); }
__device__ __forceinline__ void gate_scans(Frame& F, int first, int stride) {
    { const float* GT = wsp<float>(F, WS_GATES); float* SA = wsp<float>(F, WS_SA); float* SMX = wsp<float>(F, WS_SMX); float* SB = wsp<float>(F, WS_SB); float* SW = wsp<float>(F, WS_SW);
      float* DEC = wsp<float>(F, WS_DEC); float* MC = wsp<float>(F, WS_MC);
      LAS float* sbl = (LAS float*)(F.lds + 4096); LAS float* sA = sbl + 64; LAS float* sm = sA + 64;
      for (int bh = first; bh < NBH; bh += stride) {
          const int b = bh / NH, h = bh % NH;
          __syncthreads();
          for (int c = F.wave; c < NCH; c += NWAVES) {
              const size_t m0 = (size_t)b * SEQ + c * LCH + 2 * F.lane;
              const float i0 = GT[m0 * 16 + h], i1 = GT[(m0 + 1) * 16 + h];
              const float l0 = logsigmoidf_(GT[m0 * 16 + 8 + h]), l1 = logsigmoidf_(GT[(m0 + 1) * 16 + 8 + h]);
              float s = l0 + l1, inc = s;
#pragma unroll
              for (int o = 1; o < 64; o <<= 1) { const float t = __shfl_up(inc, o); if (F.lane >= o) inc += t; }
              const float b0 = (inc - s) + l0, b1 = inc;
              const float a0 = i0 - b0, a1 = i1 - b1;
              float mx = fmaxf(a0, a1), pm = mx;
#pragma unroll
              for (int o = 1; o < 64; o <<= 1) { const float t = __shfl_up(pm, o); if (F.lane >= o) pm = fmaxf(pm, t); }
              float ex = __shfl_up(pm, 1); if (F.lane == 0) ex = -INFINITY;
              const float cm0 = fmaxf(ex, a0), cm1 = fmaxf(cm0, a1);
              const size_t o0 = (size_t)bh * SEQ + c * LCH + 2 * F.lane;
              SA[o0] = a0; SA[o0 + 1] = a1; SB[o0] = b0; SB[o0 + 1] = b1; SMX[o0] = cm0; SMX[o0 + 1] = cm1;
              if (F.lane == 63) { sbl[c] = b1; sA[c] = cm1; }
          }
          __syncthreads();
          if (F.tid == 0) { float m = 0.f; for (int c = 0; c < NCH; ++c) { sm[c] = m; m = sbl[c] + fmaxf(m, sA[c]); } sm[NCH] = m; }
          VM_WAIT(); __syncthreads();
          for (int c = F.wave; c < NCH; c += NWAVES) {
              const float mc = sm[c], mn = sm[c + 1], bL = sbl[c];
              const size_t o0 = (size_t)bh * SEQ + c * LCH + 2 * F.lane;
              const float a0 = SA[o0], a1 = SA[o0 + 1], c0 = SMX[o0], c1 = SMX[o0 + 1];
              SMX[o0] = fmaxf(mc, c0); SMX[o0 + 1] = fmaxf(mc, c1);
              SW[o0] = __expf(bL + a0 - mn); SW[o0 + 1] = __expf(bL + a1 - mn);
              if (F.lane == 0) { DEC[bh * NCH + c] = __expf(bL + mc - mn); MC[bh * NCH + c] = mc; }
          }
      } }
}
__device__ __forceinline__ void p_prep(Frame& F, const Args& args) {
    const bf16* U = wsp<bf16>(F, WS_U);
    { bf16* QM = wsp<bf16>(F, WS_QM); bf16* KM = wsp<bf16>(F, WS_KM);
      BG_DECL(BGS_CONV, 4);
      const size_t cst = (size_t)F.G * NTHR, ctot = (size_t)(M / 4) * 128; const int cit = (int)((ctot + cst - 1) / cst), cq = (cit + 3) / 4;
      for (int sl = 0; sl < 4; ++sl) { BG_TOP();
      for (int kk = sl * cq; kk < (sl + 1) * cq && kk < cit; ++kk) { const size_t i = (size_t)F.bid * NTHR + F.tid + (size_t)kk * cst; if (i >= ctot) break;
          const int m0 = (int)(i >> 7) * 4, ch = (int)(i & 127) * 8, t0 = m0 & (SEQ - 1);
          float xin[7][8];
#pragma unroll
          for (int j = 0; j < 7; ++j) { v4u w = {0u, 0u, 0u, 0u}; if (t0 - 3 + j >= 0) w = *(const v4u*)(U + (size_t)(m0 - 3 + j) * NU + ch);
              xin[j][0] = bflo(w.x); xin[j][1] = bfhi(w.x); xin[j][2] = bflo(w.y); xin[j][3] = bfhi(w.y); xin[j][4] = bflo(w.z); xin[j][5] = bfhi(w.z); xin[j][6] = bflo(w.w); xin[j][7] = bfhi(w.w); }
          float cw[4][8], cb[8];
#pragma unroll
          for (int j = 0; j < 4; ++j) { const f32x4 c0 = *(const f32x4*)(args.in[4] + j * 1024 + ch), c1 = *(const f32x4*)(args.in[4] + j * 1024 + ch + 4);
              cw[j][0] = c0.x; cw[j][1] = c0.y; cw[j][2] = c0.z; cw[j][3] = c0.w; cw[j][4] = c1.x; cw[j][5] = c1.y; cw[j][6] = c1.z; cw[j][7] = c1.w; }
          { const f32x4 b0 = *(const f32x4*)(args.in[5] + ch), b1 = *(const f32x4*)(args.in[5] + ch + 4); cb[0] = b0.x; cb[1] = b0.y; cb[2] = b0.z; cb[3] = b0.w; cb[4] = b1.x; cb[5] = b1.y; cb[6] = b1.z; cb[7] = b1.w; }
          const float sc = ch < 512 ? 0.125f : 1.0f;
#pragma unroll
          for (int tt = 0; tt < 4; ++tt) { float y[8];
#pragma unroll
              for (int e = 0; e < 8; ++e) { float a = cb[e];
#pragma unroll
                  for (int j = 0; j < 4; ++j) a += xin[tt + j][e] * cw[j][e];
                  y[e] = a * sigmoidf_(a) * sc; }
              bf16* o = ch < 512 ? QM + (size_t)(m0 + tt) * WM + ch : KM + (size_t)(m0 + tt) * WM + (ch - 512);
              *(v4u*)o = (v4u){pk2(y[0], y[1]), pk2(y[2], y[3]), pk2(y[4], y[5]), pk2(y[6], y[7])}; } }
      BG_BOT(); } }
    { bf16* KN = wsp<bf16>(F, WS_KN); bf16* VT = wsp<bf16>(F, WS_VT); float* KMEAN = wsp<float>(F, WS_KMEAN);
      LAS float* red = (LAS float*)F.lds;
      LAS unsigned char* vtl = F.lds + 4096;
      BG_DECL(BGS_KPART, 2);
      for (int un = F.bid; un < NBH * NBK; un += F.G) { BG_TOP();
          const int bh = un / NBK, j = un % NBK, b = bh / NH, h = bh % NH;
          const int key = F.tid >> 1, hf = F.tid & 1; const size_t m = (size_t)b * SEQ + j * MBS + key;
          __syncthreads();
          float kv[32]; float ss = 0.f;
#pragma unroll
          for (int i = 0; i < 4; ++i) { const v4u w = *(const v4u*)(U + m * NU + UKB + h * HD + 32 * hf + 8 * i);
              kv[8 * i] = bflo(w.x); kv[8 * i + 1] = bfhi(w.x); kv[8 * i + 2] = bflo(w.y); kv[8 * i + 3] = bfhi(w.y); kv[8 * i + 4] = bflo(w.z); kv[8 * i + 5] = bfhi(w.z); kv[8 * i + 6] = bflo(w.w); kv[8 * i + 7] = bfhi(w.w); }
#pragma unroll
          for (int e = 0; e < 32; ++e) ss += kv[e] * kv[e];
          ss += __shfl_xor(ss, 1);
          const float rstd = 1.0f / sqrtf(ss * (1.0f / HD) + RMS_EPS);
#pragma unroll
          for (int e = 0; e < 32; ++e) kv[e] = kv[e] * rstd * args.in[10][32 * hf + e];
#pragma unroll
          for (int i = 0; i < 4; ++i) *(v4u*)(KN + m * WM + h * HD + 32 * hf + 8 * i) = (v4u){pk2(kv[8 * i], kv[8 * i + 1]), pk2(kv[8 * i + 2], kv[8 * i + 3]), pk2(kv[8 * i + 4], kv[8 * i + 5]), pk2(kv[8 * i + 6], kv[8 * i + 7])};
#pragma unroll
          for (int e = 0; e < 32; ++e) { float a = kv[e]; a += __shfl_xor(a, 2); a += __shfl_xor(a, 4); a += __shfl_xor(a, 8); a += __shfl_xor(a, 16); a += __shfl_xor(a, 32); kv[e] = a; }
          if (F.lane < 2) {
#pragma unroll
              for (int e = 0; e < 32; ++e) red[F.wave * 64 + 32 * hf + e] = kv[e]; }
#pragma unroll
          for (int i = 0; i < 4; ++i) { const v4u w = *(const v4u*)(U + m * NU + UVB + h * HD + 32 * hf + 8 * i); const unsigned ww[4] = {w.x, w.y, w.z, w.w};
#pragma unroll
              for (int e = 0; e < 4; ++e) { *(LAS unsigned short*)(vtl + (32 * hf + 8 * i + 2 * e) * 528 + 2 * key) = (unsigned short)(ww[e] & 0xffffu); *(LAS unsigned short*)(vtl + (32 * hf + 8 * i + 2 * e + 1) * 528 + 2 * key) = (unsigned short)(ww[e] >> 16); } }
          __syncthreads();
          if (F.wave == 0) { float sm = 0.f;
#pragma unroll
              for (int w = 0; w < NWAVES; ++w) sm += red[w * 64 + F.lane];
              KMEAN[(size_t)un * HD + F.lane] = sm * (1.0f / MBS); }
          { const int d = F.tid >> 3, pc = F.tid & 7;
#pragma unroll
            for (int i = 0; i < 4; ++i) *(v4u*)(VT + ((size_t)bh * HD + d) * SEQ + j * MBS + pc * 32 + 8 * i) = *(const LAS v4u*)(vtl + d * 528 + (pc * 32 + 8 * i) * 2); }
          BG_BOT();
      } }
    if (F.G != 256) gate_scans(F, F.bid, F.G);

}

__device__ __forceinline__ void mlstm_state(Frame& F, const Args& args);
__device__ __forceinline__ int pair_idx(int i, int j) { return i * (i - 1) / 2 + j; }
__device__ __forceinline__ void p_route(Frame& F, const Args& args) {
    const bf16* U = wsp<bf16>(F, WS_U); bf16* QN = wsp<bf16>(F, WS_QN); const float* KMEAN = wsp<float>(F, WS_KMEAN);
    int* MLIST = wsp<int>(F, WS_MLIST); int* MCNT = wsp<int>(F, WS_MCNT);
    LAS float* skm = (LAS float*)F.lds;
    LAS int* ssel = (LAS int*)(F.lds + 8192);
    LAS int* wtot = (LAS int*)(F.lds + 8192 + 3072);
    BG_DECL(BGS_ROUTE, 2);
    for (int un = F.bid; un < NBH * NBK; un += F.G) { BG_TOP();
        const int bh = un / NBK, i = un % NBK, b = bh / NH, h = bh % NH;
        __syncthreads();
        for (int e = F.tid; e < NBK * HD; e += NTHR) skm[e] = KMEAN[(size_t)bh * NBK * HD + e];
        __syncthreads();
        BG_BOT();
        int s0 = -1, s1 = -1, s2 = -1;
        if (F.tid < MBS) {
            const size_t m = (size_t)b * SEQ + i * MBS + F.tid;
            float q[HD]; float ss = 0.f;
#pragma unroll
            for (int d8 = 0; d8 < 8; ++d8) { const v4u w = *(const v4u*)(U + m * NU + UQB + h * HD + 8 * d8);
                q[8 * d8 + 0] = bflo(w.x); q[8 * d8 + 1] = bfhi(w.x); q[8 * d8 + 2] = bflo(w.y); q[8 * d8 + 3] = bfhi(w.y);
                q[8 * d8 + 4] = bflo(w.z); q[8 * d8 + 5] = bfhi(w.z); q[8 * d8 + 6] = bflo(w.w); q[8 * d8 + 7] = bfhi(w.w); }
#pragma unroll
            for (int d = 0; d < HD; ++d) ss += q[d] * q[d];
            const float rstd = 1.0f / sqrtf(ss * (1.0f / HD) + RMS_EPS);
#pragma unroll
            for (int d = 0; d < HD; ++d) q[d] = q[d] * rstd * args.in[9][d] * 0.125f;
#pragma unroll
            for (int d8 = 0; d8 < 8; ++d8) { v4u w; w.x = pk2(q[8 * d8] * LOG2E, q[8 * d8 + 1] * LOG2E); w.y = pk2(q[8 * d8 + 2] * LOG2E, q[8 * d8 + 3] * LOG2E); w.z = pk2(q[8 * d8 + 4] * LOG2E, q[8 * d8 + 5] * LOG2E); w.w = pk2(q[8 * d8 + 6] * LOG2E, q[8 * d8 + 7] * LOG2E);
                *(v4u*)(QN + m * WM + h * HD + 8 * d8) = w; }
            float v0 = -INFINITY, v1 = -INFINITY, v2 = -INFINITY;
            for (int j = 0; j < i; ++j) {
                float g = 0.f; const LAS f32x4* kp = (const LAS f32x4*)(skm + j * HD);
#pragma unroll
                for (int d4 = 0; d4 < HD / 4; ++d4) { const f32x4 w = kp[d4]; g += (q[4 * d4] * w.x + q[4 * d4 + 1] * w.y) + (q[4 * d4 + 2] * w.z + q[4 * d4 + 3] * w.w); }
                if (g > v0) { v2 = v1; s2 = s1; v1 = v0; s1 = s0; v0 = g; s0 = j; }
                else if (g > v1) { v2 = v1; s2 = s1; v1 = g; s1 = j; }
                else if (g > v2) { v2 = g; s2 = j; }
            }
            ssel[F.tid * 3 + 0] = s0; ssel[F.tid * 3 + 1] = s1; ssel[F.tid * 3 + 2] = s2;
        }
        if (F.wave < 4) { for (int j = 0; j < i; ++j) { const bool f = (s0 == j) || (s1 == j) || (s2 == j); const unsigned long long mk = __ballot(f); if (F.lane == 0) wtot[j * 4 + F.wave] = __popcll(mk); } }
        __syncthreads();
        if (F.wave < 4) { for (int j = 0; j < i; ++j) { const bool f = (s0 == j) || (s1 == j) || (s2 == j); const unsigned long long mk = __ballot(f);
                int base = 0; for (int w = 0; w < F.wave; ++w) base += wtot[j * 4 + w];
                if (f) { const int pos = base + __popcll(mk & ((1ull << F.lane) - 1ull)); const int slot = (s0 == j) ? 0 : ((s1 == j) ? 1 : 2);
                    MLIST[((size_t)bh * NPAIR + pair_idx(i, j)) * MBS + pos] = F.tid | (slot << 8); } } }
        if (F.tid < i) MCNT[bh * NPAIR + pair_idx(i, F.tid)] = wtot[F.tid * 4] + wtot[F.tid * 4 + 1] + wtot[F.tid * 4 + 2] + wtot[F.tid * 4 + 3];
    }
    __syncthreads();
    mlstm_state(F, args);
}

__device__ __forceinline__ float moba_m0(const Frame& F, const Args& args) { return 8.0f * wave_max(fabsf(args.in[9][F.lane])) * wave_max(fabsf(args.in[10][F.lane])); }


constexpr int MB_VOFF = 32768, MB_VSTR = 520, MB_MISC = MB_VOFF + 64 * MB_VSTR;
__device__ __forceinline__ void moba_kv_fetch(const Frame& F, int bh, int j, v4u (&kv)[8]) {
    const bf16* KN = wsp<bf16>(F, WS_KN); const bf16* VT = wsp<bf16>(F, WS_VT); const int b = bh / NH, head = bh % NH;
#pragma unroll
    for (int k = 0; k < 4; ++k) { const int p = F.tid + NTHR * k, key = p >> 3, c = p & 7; kv[k] = *(const v4u*)(KN + ((size_t)b * SEQ + j * MBS + key) * WM + head * HD + c * 8); }
#pragma unroll
    for (int k = 0; k < 4; ++k) { const int p = F.tid + NTHR * k, d = p >> 5, c = p & 31; kv[4 + k] = *(const v4u*)(VT + ((size_t)bh * HD + d) * SEQ + j * MBS + c * 8); }
}
__device__ __forceinline__ void moba_kv_put(const Frame& F, const v4u (&kv)[8]) {
#pragma unroll
    for (int k = 0; k < 4; ++k) { const int p = F.tid + NTHR * k, key = p >> 3, c = p & 7; *(LAS v4u*)(F.lds + key * 128 + ((c ^ ((key >> 1) & 7)) << 4)) = kv[k]; }
#pragma unroll
    for (int k = 0; k < 4; ++k) { const int p = F.tid + NTHR * k, d = p >> 5, c = p & 31; const v4u w = kv[4 + k];
        LAS v2u* dst = (LAS v2u*)(F.lds + MB_VOFF + d * MB_VSTR + c * 16); dst[0] = (v2u){w.x, w.y}; dst[1] = (v2u){w.z, w.w}; }
}
__device__ __forceinline__ void moba_load_kv(const Frame& F, int bh, int j) { v4u kv[8]; moba_kv_fetch(F, bh, j, kv); moba_kv_put(F, kv); }
template <bool MASK>
__device__ __forceinline__ void moba_core(LAS const unsigned char* lds, const bf16x8 (&qf)[4], f32x16 (&o)[2], float& l, int nkt, int dkey0, float slope2, float m0l, int q, int h) {
    float br[16];
#pragma unroll
    for (int r = 0; r < 16; ++r) br[r] = slope2 * (float)((r & 3) + 8 * (r >> 2)) - m0l;
#pragma unroll 1
    for (int kt = 0; kt < nkt; ++kt) {
        const float cb = slope2 * (float)(dkey0 + 32 * kt);
        f32x16 s;
#pragma unroll
        for (int r = 0; r < 16; ++r) s[r] = br[r] + cb;
        const int key = 32 * kt + q, sw = (key >> 1) & 7;
#pragma unroll
        for (int s4 = 0; s4 < 4; ++s4) { const bf16x8 kf = *(const LAS bf16x8*)(lds + key * 128 + (((2 * s4 + h) ^ sw) << 4)); s = __builtin_amdgcn_mfma_f32_32x32x16_bf16(kf, qf[s4], s, 0, 0, 0); }
        float p[16];
#pragma unroll
        for (int r = 0; r < 16; ++r) { p[r] = __builtin_amdgcn_exp2f(s[r]); if (MASK && kt == nkt - 1 && ((r & 3) + 8 * (r >> 2) + 4 * h > q)) p[r] = 0.f; l += p[r]; }
        bf16x8 pb[2];
#pragma unroll
        for (int s2 = 0; s2 < 2; ++s2) { v4u w; w.x = pk2(p[8 * s2], p[8 * s2 + 1]); w.y = pk2(p[8 * s2 + 2], p[8 * s2 + 3]); w.z = pk2(p[8 * s2 + 4], p[8 * s2 + 5]); w.w = pk2(p[8 * s2 + 6], p[8 * s2 + 7]); pb[s2] = __builtin_bit_cast(bf16x8, w); }
#pragma unroll
        for (int mt = 0; mt < 2; ++mt)
#pragma unroll
            for (int s2 = 0; s2 < 2; ++s2) { const LAS unsigned char* vp = lds + MB_VOFF + (32 * mt + q) * MB_VSTR + (32 * kt + 16 * s2 + 4 * h) * 2;
                const v2u lo = *(const LAS v2u*)vp, hi = *(const LAS v2u*)(vp + 16); const v4u w = {lo.x, lo.y, hi.x, hi.y};
                o[mt] = __builtin_amdgcn_mfma_f32_32x32x16_bf16(__builtin_bit_cast(bf16x8, w), pb[s2], o[mt], 0, 0, 0); }
    }
}
__device__ __forceinline__ void moba_routed(Frame& F, const Args& args) {
    const bf16* QN = wsp<bf16>(F, WS_QN); const int* MLIST = wsp<int>(F, WS_MLIST); const int* MCNT = wsp<int>(F, WS_MCNT);
    bf16* OP = wsp<bf16>(F, WS_OP); float* LP = wsp<float>(F, WS_LP);
    const float m0l = moba_m0(F, args) * LOG2E;
    LAS int* utot = (LAS int*)(F.lds + MB_MISC); LAS int* ustart = utot + 512; LAS int* cpre = ustart + 512;
    constexpr int NQ = NBH * (NBK - 1);
    __syncthreads();
    if (F.tid < NQ) { const int bh = F.tid / (NBK - 1), j = F.tid % (NBK - 1); int t = 0; for (int i = j + 1; i < NBK; ++i) t += MCNT[bh * NPAIR + pair_idx(i, j)]; utot[F.tid] = t; }
    __syncthreads();
    if (F.wave == 0) {
        int loc[8], sum = 0;
#pragma unroll
        for (int e = 0; e < 8; ++e) { const int qq = F.lane * 8 + e; loc[e] = qq < NQ ? (utot[qq] + 255) >> 8 : 0; sum += loc[e]; }
        int inc = sum;
#pragma unroll
        for (int o = 1; o < 64; o <<= 1) { const int t = __shfl_up(inc, o); if (F.lane >= o) inc += t; }
        int a = inc - sum;
#pragma unroll
        for (int e = 0; e < 8; ++e) { const int qq = F.lane * 8 + e; if (qq <= NQ) ustart[qq] = a; a += loc[e]; }
    }
    __syncthreads();
    const int nunits = ustart[NQ];
    const int q = F.lane & 31, h = F.lane >> 5;
    BG_DECL(BGS_MIXA, 8);
    v4u kv[8];
    if (F.bid < nunits) { int lo = 0, hi = NQ; while (hi - lo > 1) { const int mid = (lo + hi) >> 1; if (ustart[mid] <= F.bid) lo = mid; else hi = mid; }
        moba_kv_fetch(F, lo / (NBK - 1), lo % (NBK - 1), kv); }
    for (int un = F.bid; un < nunits; un += F.G) {
        int lo = 0, hi = NQ;
        while (hi - lo > 1) { const int mid = (lo + hi) >> 1; if (ustart[mid] <= un) lo = mid; else hi = mid; }
        const int qq = lo, chunk = un - ustart[qq], bh = qq / (NBK - 1), j = qq % (NBK - 1), b = bh / NH, head = bh % NH, tot = utot[qq];
        __syncthreads();
        if (F.wave == 0) { const int i = j + 1 + F.lane; const int cnt = i < NBK ? MCNT[bh * NPAIR + pair_idx(i, j)] : 0; int inc = cnt;
#pragma unroll
            for (int o = 1; o < 32; o <<= 1) { const int t = __shfl_up(inc, o); if (F.lane >= o) inc += t; }
            if (i <= NBK) cpre[i] = inc - cnt; }
        moba_kv_put(F, kv);
        __syncthreads();
        if (un + F.G < nunits) { int l2 = 0, h2 = NQ; while (h2 - l2 > 1) { const int mid = (l2 + h2) >> 1; if (ustart[mid] <= un + F.G) l2 = mid; else h2 = mid; }
            moba_kv_fetch(F, l2 / (NBK - 1), l2 % (NBK - 1), kv); }
        const int gr = chunk * 256 + F.wave * 32 + q; const bool valid = gr < tot; const bool act = __ballot(valid) != 0ull;
        int slot = 0, tq = 0; size_t mq = 0; bf16x8 qf[4];
        if (act) {
            const int grc = valid ? gr : chunk * 256;
            int i = j + 1; while (cpre[i + 1] <= grc) ++i;
            const int ent = MLIST[((size_t)bh * NPAIR + pair_idx(i, j)) * MBS + (grc - cpre[i])]; const int qo = ent & 255; slot = ent >> 8;
            tq = i * MBS + qo; mq = (size_t)b * SEQ + tq;
#pragma unroll
            for (int s4 = 0; s4 < 4; ++s4) qf[s4] = *(const bf16x8*)(QN + mq * WM + head * HD + 16 * s4 + 8 * h); }
        BG_TOP();
        if (act) {
            f32x16 o[2]; float l = 0.f;
#pragma unroll
            for (int r = 0; r < 16; ++r) { o[0][r] = 0.f; o[1][r] = 0.f; }
            const float slope2 = exp2f(-(float)(head + 1)) * LOG2E;
            moba_core<false>(F.lds, qf, o, l, 8, j * MBS + 4 * h - tq, slope2, m0l, q, h);
            l += __shfl_xor(l, 32);
            if (valid) { bf16* op = OP + ((mq * NH + head) * 3 + slot) * HD;
#pragma unroll
                for (int mt = 0; mt < 2; ++mt)
#pragma unroll
                    for (int g = 0; g < 4; ++g) *(v2u*)(op + 32 * mt + 8 * g + 4 * h) = (v2u){pk2(o[mt][4 * g], o[mt][4 * g + 1]), pk2(o[mt][4 * g + 2], o[mt][4 * g + 3])};
                if (h == 0) LP[(mq * NH + head) * 3 + slot] = l; }
        }
        BG_BOT();
    }
    BG_FLUSH();
}
__device__ __forceinline__ void moba_own(Frame& F, const Args& args) {
    const bf16* QN = wsp<bf16>(F, WS_QN); const bf16* OP = wsp<bf16>(F, WS_OP); const float* LP = wsp<float>(F, WS_LP); bf16* MIX = wsp<bf16>(F, WS_MIX);
    const float m0l = moba_m0(F, args) * LOG2E;
    const int q = F.lane & 31, h = F.lane >> 5;
    BG_DECL(BGS_MIXB, 2);
    v4u kv[8];
    if (F.bid < NBH * NBK) moba_kv_fetch(F, F.bid / NBK, F.bid % NBK, kv);
    for (int un = F.bid; un < NBH * NBK; un += F.G) {
        const int bh = un / NBK, i = un % NBK, b = bh / NH, head = bh % NH;
        const int qo = F.wave * 32 + q; const size_t mq = (size_t)b * SEQ + i * MBS + qo;
        f32x16 o[2]; float l = 0.f;
#pragma unroll
        for (int r = 0; r < 16; ++r) { o[0][r] = 0.f; o[1][r] = 0.f; }
        const int nsel = i < 3 ? i : 3;
        for (int sl = 0; sl < nsel; ++sl) { const bf16* op = OP + ((mq * NH + head) * 3 + sl) * HD; if (h == 0) l += LP[(mq * NH + head) * 3 + sl];
#pragma unroll
            for (int mt = 0; mt < 2; ++mt)
#pragma unroll
                for (int g = 0; g < 4; ++g) { const v2u v = *(const v2u*)(op + 32 * mt + 8 * g + 4 * h); o[mt][4 * g] += bflo(v.x); o[mt][4 * g + 1] += bfhi(v.x); o[mt][4 * g + 2] += bflo(v.y); o[mt][4 * g + 3] += bfhi(v.y); } }
        bf16x8 qf[4];
#pragma unroll
        for (int s4 = 0; s4 < 4; ++s4) qf[s4] = *(const bf16x8*)(QN + mq * WM + head * HD + 16 * s4 + 8 * h);
        __syncthreads();
        moba_kv_put(F, kv);
        __syncthreads();
        if (un + F.G < NBH * NBK) moba_kv_fetch(F, (un + F.G) / NBK, (un + F.G) % NBK, kv);
        BG_TOP();
        const float slope2 = exp2f(-(float)(head + 1)) * LOG2E;
        moba_core<true>(F.lds, qf, o, l, F.wave + 1, 4 * h - qo, slope2, m0l, q, h);
        l += __shfl_xor(l, 32);
        const float inv = 1.0f / l;
#pragma unroll
        for (int mt = 0; mt < 2; ++mt)
#pragma unroll
            for (int g = 0; g < 4; ++g) *(v2u*)(MIX + mq * D + WM + head * HD + 32 * mt + 8 * g + 4 * h) = (v2u){pk2(o[mt][4 * g] * inv, o[mt][4 * g + 1] * inv), pk2(o[mt][4 * g + 2] * inv, o[mt][4 * g + 3] * inv)};
        BG_BOT();
    }
}


constexpr int ML_STR = 272;
typedef LAS unsigned short* lds_u16p;
__device__ __forceinline__ void mlstm_state(Frame& F, const Args& args) {
    const bf16* U = wsp<bf16>(F, WS_U); const bf16* KM = wsp<bf16>(F, WS_KM); const float* SW = wsp<float>(F, WS_SW); float* DC = wsp<float>(F, WS_DC); float* DN = wsp<float>(F, WS_DN);
    LAS unsigned char* vt = F.lds; LAS unsigned char* kt = F.lds + 64 * ML_STR; LAS float* sw = (LAS float*)(F.lds + 128 * ML_STR);
    const int l15 = F.lane & 15, kq = F.lane >> 4;
    BG_DECL(BGS_STATE, 4);
    v4u pk_[2], pv_[2]; float pw_[2], psw = 0.f;
#define ST_FETCH(UN) do { const int bh_ = (UN) / NCH, c_ = (UN) % NCH, b_ = bh_ / NH, hd_ = bh_ % NH; const size_t m0_ = (size_t)b_ * SEQ + c_ * LCH; \
        if (F.tid < LCH) psw = SW[(size_t)bh_ * SEQ + c_ * LCH + F.tid]; \
        _Pragma("unroll") for (int k = 0; k < 2; ++k) { const int p = F.tid + NTHR * k, sidx = p >> 3, cc = p & 7; pw_[k] = SW[(size_t)bh_ * SEQ + c_ * LCH + sidx]; \
            pk_[k] = *(const v4u*)(KM + (m0_ + sidx) * WM + hd_ * HD + 8 * cc); pv_[k] = *(const v4u*)(U + (m0_ + sidx) * NU + UVM + hd_ * HD + 8 * cc); } } while (0)
    if (F.bid < NBH * NCH) ST_FETCH(F.bid);
    for (int un = F.bid; un < NBH * NCH; un += F.G) {
        __syncthreads();
        if (F.tid < LCH) sw[F.tid] = psw;
#pragma unroll
        for (int k = 0; k < 2; ++k) { const int p = F.tid + NTHR * k, sidx = p >> 3, cc = p & 7;
            const float w = pw_[k]; const v4u kv = pk_[k], vv = pv_[k];
            const unsigned kw[4] = {kv.x, kv.y, kv.z, kv.w}, vw[4] = {vv.x, vv.y, vv.z, vv.w};
#pragma unroll
            for (int e = 0; e < 4; ++e) {
                *(lds_u16p)(kt + (8 * cc + 2 * e) * ML_STR + 2 * sidx) = (unsigned short)(kw[e] & 0xffffu); *(lds_u16p)(kt + (8 * cc + 2 * e + 1) * ML_STR + 2 * sidx) = (unsigned short)(kw[e] >> 16);
                const unsigned pw = pk2(w * bflo(vw[e]), w * bfhi(vw[e]));
                *(lds_u16p)(vt + (8 * cc + 2 * e) * ML_STR + 2 * sidx) = (unsigned short)(pw & 0xffffu); *(lds_u16p)(vt + (8 * cc + 2 * e + 1) * ML_STR + 2 * sidx) = (unsigned short)(pw >> 16); } }
        if (un + F.G < NBH * NCH) ST_FETCH(un + F.G);
        BG_TOP();
        __syncthreads();
#pragma unroll
        for (int tt = 0; tt < 2; ++tt) { const int tile = 2 * F.wave + tt, mt = tile >> 2, nt = tile & 3; f32x4 acc = {0.f, 0.f, 0.f, 0.f};
#pragma unroll
            for (int ks = 0; ks < 4; ++ks) { const bf16x8 av = *(const LAS bf16x8*)(vt + (16 * mt + l15) * ML_STR + (32 * ks + 8 * kq) * 2), bv = *(const LAS bf16x8*)(kt + (16 * nt + l15) * ML_STR + (32 * ks + 8 * kq) * 2);
                acc = __builtin_amdgcn_mfma_f32_16x16x32_bf16(av, bv, acc, 0, 0, 0); }
#pragma unroll
            for (int r = 0; r < 4; ++r) DC[(size_t)un * 4096 + (16 * mt + 4 * kq + r) * HD + 16 * nt + l15] = acc[r]; }
        if (F.tid < HD) { float a = 0.f;
#pragma unroll 8
            for (int sidx = 0; sidx < LCH; ++sidx) a += sw[sidx] * bf2f(*(lds_u16p)(kt + F.tid * ML_STR + 2 * sidx));
            DN[(size_t)un * HD + F.tid] = a; }
        BG_BOT();
    }
#undef ST_FETCH
}
__device__ __forceinline__ void mlstm_out(Frame& F, const Args& args) {
    const bf16* U = wsp<bf16>(F, WS_U); const bf16* QM = wsp<bf16>(F, WS_QM); const bf16* KM = wsp<bf16>(F, WS_KM);
    const float* SA = wsp<float>(F, WS_SA); const float* SMX = wsp<float>(F, WS_SMX); const float* SB = wsp<float>(F, WS_SB);
    const float* CS = wsp<float>(F, WS_CS); const float* NS = wsp<float>(F, WS_NS); const float* MC = wsp<float>(F, WS_MC); bf16* MIX = wsp<bf16>(F, WS_MIX);
    LAS unsigned char* sp = F.lds; LAS unsigned char* vt = F.lds + LCH * ML_STR;
    const int l15 = F.lane & 15, kq = F.lane >> 4, w = F.wave, t0 = 16 * w;
    for (int un = F.bid; un < NBH * NCH; un += F.G) {
        const int bh = un / NCH, c = un % NCH, b = bh / NH, head = bh % NH; const size_t m0 = (size_t)b * SEQ + c * LCH; const size_t g0 = (size_t)bh * SEQ + c * LCH;
        __syncthreads();
#pragma unroll
        for (int k = 0; k < 2; ++k) { const int p = F.tid + NTHR * k, sidx = p >> 3, cc = p & 7;
            const v4u vv = *(const v4u*)(U + (m0 + sidx) * NU + UVM + head * HD + 8 * cc); const unsigned vw[4] = {vv.x, vv.y, vv.z, vv.w};
#pragma unroll
            for (int e = 0; e < 4; ++e) { *(lds_u16p)(vt + (8 * cc + 2 * e) * ML_STR + 2 * sidx) = (unsigned short)(vw[e] & 0xffffu); *(lds_u16p)(vt + (8 * cc + 2 * e + 1) * ML_STR + 2 * sidx) = (unsigned short)(vw[e] >> 16); } }
        for (int e = F.tid; e < 16 * LCH; e += NTHR) { const int r = e >> 7, sidx = e & 127; *(lds_u16p)(vt + (64 + r) * ML_STR + 2 * sidx) = (unsigned short)(r == 0 ? 0x3F80u : 0u); }
        bf16x8 qa[2];
#pragma unroll
        for (int ks = 0; ks < 2; ++ks) qa[ks] = *(const bf16x8*)(QM + (m0 + t0 + l15) * WM + head * HD + 32 * ks + 8 * kq);
        float mx[4], sbv[4]; unsigned ogv[4][2];
#pragma unroll
        for (int r = 0; r < 4; ++r) { mx[r] = SMX[g0 + t0 + 4 * kq + r]; sbv[r] = SB[g0 + t0 + 4 * kq + r];
            const bf16* up = U + (m0 + t0 + 4 * kq + r) * NU + UOM + head * HD + l15;
            ogv[r][0] = (unsigned)up[0] | ((unsigned)up[16] << 16); ogv[r][1] = (unsigned)up[32] | ((unsigned)up[48] << 16); }
        bf16x8 kb[4][2]; float as[4];
#pragma unroll
        for (int st = 0; st < 4; ++st) if (st <= w) {
#pragma unroll
            for (int ks = 0; ks < 2; ++ks) kb[st][ks] = *(const bf16x8*)(KM + (m0 + 16 * st + l15) * WM + head * HD + 32 * ks + 8 * kq);
            as[st] = SA[g0 + 16 * st + l15]; }
        bf16x8 cf[2][5];
#pragma unroll
        for (int ks = 0; ks < 2; ++ks)
#pragma unroll
            for (int nt = 0; nt < 5; ++nt) { f32x4 c0, c1;
                if (nt < 4) { const float* cp = CS + (size_t)un * 4096 + (16 * nt + l15) * HD + 32 * ks + 8 * kq; c0 = *(const f32x4*)cp; c1 = *(const f32x4*)(cp + 4); }
                else { const float* np = NS + (size_t)un * HD + 32 * ks + 8 * kq; c0 = *(const f32x4*)np; c1 = *(const f32x4*)(np + 4); if (l15 != 0) { c0 = (f32x4){0.f, 0.f, 0.f, 0.f}; c1 = c0; } }
                const v4u wv = {pk2(c0.x, c0.y), pk2(c0.z, c0.w), pk2(c1.x, c1.y), pk2(c1.z, c1.w)}; cf[ks][nt] = __builtin_bit_cast(bf16x8, wv); }
#pragma unroll
        for (int hf = 0; hf < 2; ++hf) {
            if (hf == 1) {
#pragma unroll
                for (int st = 0; st < 4; ++st) if (st + 4 <= w) {
#pragma unroll
                    for (int ks = 0; ks < 2; ++ks) kb[st][ks] = *(const bf16x8*)(KM + (m0 + 16 * (st + 4) + l15) * WM + head * HD + 32 * ks + 8 * kq);
                    as[st] = SA[g0 + 16 * (st + 4) + l15]; } }
#pragma unroll
            for (int s4 = 0; s4 < 4; ++s4) { const int st = 4 * hf + s4; if (st <= w) {
                f32x4 acc = {0.f, 0.f, 0.f, 0.f};
                acc = __builtin_amdgcn_mfma_f32_16x16x32_bf16(qa[0], kb[s4][0], acc, 0, 0, 0); acc = __builtin_amdgcn_mfma_f32_16x16x32_bf16(qa[1], kb[s4][1], acc, 0, 0, 0);
#pragma unroll
                for (int r = 0; r < 4; ++r) { float v = acc[r] * __expf(as[s4] - mx[r]); if (st == w && l15 > 4 * kq + r) v = 0.f;
                    *(lds_u16p)(sp + (t0 + 4 * kq + r) * ML_STR + 2 * (16 * st + l15)) = (unsigned short)f2bf(v); } } }
        }
        if ((w & 1) == 0) {
#pragma unroll
            for (int r = 0; r < 4; ++r) *(lds_u16p)(sp + (t0 + 4 * kq + r) * ML_STR + 2 * (16 * (w + 1) + l15)) = (unsigned short)0; }
        __syncthreads();
        f32x4 a1[5], a2[5];
#pragma unroll
        for (int nt = 0; nt < 5; ++nt) { a1[nt] = (f32x4){0.f, 0.f, 0.f, 0.f}; a2[nt] = (f32x4){0.f, 0.f, 0.f, 0.f}; }
        const int nks = (w + 2) >> 1;
        for (int ks = 0; ks < nks; ++ks) { const bf16x8 av = *(const LAS bf16x8*)(sp + (t0 + l15) * ML_STR + (32 * ks + 8 * kq) * 2);
#pragma unroll
            for (int nt = 0; nt < 5; ++nt) { const bf16x8 bv = *(const LAS bf16x8*)(vt + (16 * nt + l15) * ML_STR + (32 * ks + 8 * kq) * 2); a1[nt] = __builtin_amdgcn_mfma_f32_16x16x32_bf16(av, bv, a1[nt], 0, 0, 0); } }
#pragma unroll
        for (int ks = 0; ks < 2; ++ks)
#pragma unroll
            for (int nt = 0; nt < 5; ++nt) a2[nt] = __builtin_amdgcn_mfma_f32_16x16x32_bf16(qa[ks], cf[ks][nt], a2[nt], 0, 0, 0);
        const float mc = MC[un];
#pragma unroll
        for (int r = 0; r < 4; ++r) { const int t = t0 + 4 * kq + r; const float sc = __expf(mc - mx[r]);
            float den = a1[4][r] + sc * a2[4][r]; den = __shfl(den, F.lane & 48);
            const float dn = fmaxf(fabsf(den), __expf(-(sbv[r] + mx[r]))); const float inv = 1.0f / dn;
            float hv[4], ss = 0.f;
#pragma unroll
            for (int nt = 0; nt < 4; ++nt) { hv[nt] = (a1[nt][r] + sc * a2[nt][r]) * inv; ss += hv[nt] * hv[nt]; }
            ss += __shfl_xor(ss, 1); ss += __shfl_xor(ss, 2); ss += __shfl_xor(ss, 4); ss += __shfl_xor(ss, 8);
            const float rstd = 1.0f / sqrtf(ss * (1.0f / HD) + RMS_EPS);
#pragma unroll
            for (int nt = 0; nt < 4; ++nt) { const int v = 16 * nt + l15; const float og = (nt & 1) ? bfhi(ogv[r][nt >> 1]) : bflo(ogv[r][nt >> 1]);
                MIX[(m0 + t) * D + head * HD + v] = (bf16)f2bf(hv[nt] * rstd * args.in[8][head * HD + v] * sigmoidf_(og)); } }
    }
}

__device__ __forceinline__ void mlstm_scan(Frame& F) {
    const float* DC = wsp<float>(F, WS_DC); const float* DN = wsp<float>(F, WS_DN); float* CS = wsp<float>(F, WS_CS); float* NS = wsp<float>(F, WS_NS); const float* DEC = wsp<float>(F, WS_DEC);
    constexpr int TOT = NBH * (4096 + HD); const int per = (TOT + F.G - 1) / F.G;
    for (int q = F.tid; q < per; q += NTHR) { const int e = F.bid * per + q; if (e >= TOT) break;
        const int bh = e / (4096 + HD), r = e % (4096 + HD);
        const float* src = r < 4096 ? DC + (size_t)bh * NCH * 4096 + r : DN + (size_t)bh * NCH * HD + (r - 4096);
        float* dst = r < 4096 ? CS + (size_t)bh * NCH * 4096 + r : NS + (size_t)bh * NCH * HD + (r - 4096);
        const size_t str = r < 4096 ? 4096 : HD;
        float st = 0.f;
#pragma unroll 1
        for (int c0 = 0; c0 < NCH; c0 += 32) { float d[32], g[32];
#pragma unroll
            for (int i = 0; i < 32; ++i) { d[i] = src[(size_t)(c0 + i) * str]; g[i] = DEC[bh * NCH + c0 + i]; }
#pragma unroll
            for (int i = 0; i < 32; ++i) { dst[(size_t)(c0 + i) * str] = st; st = g[i] * st + d[i]; } }
    }
}

__device__ __forceinline__ void p_mix_a(Frame& F, const Args& args) {
    const bf16* U = wsp<bf16>(F, WS_U);
    moba_routed(F, args);
    mlstm_scan(F);
}

__device__ __forceinline__ void p_mix_b(Frame& F, const Args& args) {
    moba_own(F, args);
    __syncthreads();
    mlstm_out(F, args);
}

__device__ __forceinline__ void p_router(Frame& F, const Args& args) {
    const bf16* T1 = wsp<bf16>(F, WS_X1); const bf16* WR = wsp<bf16>(F, WS_WR); const float* SS = wsp<float>(F, WS_SS);
    int* SELE = wsp<int>(F, WS_SELE); float* SELW = wsp<float>(F, WS_SELW); float* RSTD = wsp<float>(F, WS_RSTD); int* HIST = wsp<int>(F, WS_HIST);
    LAS float* part = (LAS float*)F.lds;
    LAS int* sh = (LAS int*)(F.lds + 2 * 64 * 33 * 4);
    const int l15 = F.lane & 15, kq = F.lane >> 4, tile = F.wave & 3, kh = F.wave >> 2;
    for (int ch = F.bid; ch < 256; ch += F.G) {
        __syncthreads();
        if (F.tid < NE) sh[F.tid] = 0;
        f32x4 acc[2] = {{0.f, 0.f, 0.f, 0.f}, {0.f, 0.f, 0.f, 0.f}};
        const bf16* ap = T1 + ((size_t)ch * 64 + 16 * tile + l15) * D + 512 * kh + 8 * kq; const bf16* bp = WR + (size_t)l15 * D + 512 * kh + 8 * kq;
#pragma unroll 4
        for (int ks = 0; ks < 16; ++ks) { const bf16x8 av = *(const bf16x8*)(ap + 32 * ks), b0 = *(const bf16x8*)(bp + 32 * ks), b1 = *(const bf16x8*)(bp + 16 * D + 32 * ks);
            acc[0] = __builtin_amdgcn_mfma_f32_16x16x32_bf16(av, b0, acc[0], 0, 0, 0); acc[1] = __builtin_amdgcn_mfma_f32_16x16x32_bf16(av, b1, acc[1], 0, 0, 0); }
#pragma unroll
        for (int nt = 0; nt < 2; ++nt)
#pragma unroll
            for (int r = 0; r < 4; ++r) part[(kh * 64 + 16 * tile + 4 * kq + r) * 33 + 16 * nt + l15] = acc[nt][r];
        __syncthreads();
        if (F.tid < 64) {
            const size_t m = (size_t)ch * 64 + F.tid; float ss = 0.f;
#pragma unroll
            for (int q = 0; q < 16; ++q) ss += SS[m * 16 + q];
            const float rstd = 1.0f / sqrtf(ss * (1.0f / D) + RMS_EPS);
            float v0 = -INFINITY, v1 = -INFINITY, v2 = -INFINITY, v3 = -INFINITY; int s0 = 0, s1 = 0, s2 = 0, s3 = 0;
            for (int e = 0; e < NE; ++e) { const float g = (part[F.tid * 33 + e] + part[(64 + F.tid) * 33 + e]) * rstd + args.in[14][e];
                if (g > v0) { v3 = v2; s3 = s2; v2 = v1; s2 = s1; v1 = v0; s1 = s0; v0 = g; s0 = e; }
                else if (g > v1) { v3 = v2; s3 = s2; v2 = v1; s2 = s1; v1 = g; s1 = e; }
                else if (g > v2) { v3 = v2; s3 = s2; v2 = g; s2 = e; }
                else if (g > v3) { v3 = g; s3 = e; } }
            const float e1 = __expf(v1 - v0), e2 = __expf(v2 - v0), e3 = __expf(v3 - v0); const float inv = 1.0f / (1.0f + e1 + e2 + e3);
            *(int4*)(SELE + m * 4) = make_int4(s0, s1, s2, s3); *(f32x4*)(SELW + m * 4) = (f32x4){inv, e1 * inv, e2 * inv, e3 * inv}; RSTD[m] = rstd;
            atomicAdd((int*)&sh[s0], 1); atomicAdd((int*)&sh[s1], 1); atomicAdd((int*)&sh[s2], 1); atomicAdd((int*)&sh[s3], 1);
        }
        __syncthreads();
        if (F.tid < NE) HIST[ch * NE + F.tid] = sh[F.tid];
    }
}
__device__ __forceinline__ void p_lists(Frame& F, const Args& args) {
    const int* SELE = wsp<int>(F, WS_SELE); const float* SELW = wsp<float>(F, WS_SELW); const float* RSTD = wsp<float>(F, WS_RSTD); const int* HIST = wsp<int>(F, WS_HIST);
    int* POS = wsp<int>(F, WS_POS); int* ROWTOK = wsp<int>(F, WS_ROWTOK); float* ROWGATE = wsp<float>(F, WS_ROWGATE); float* ROWRSTD = wsp<float>(F, WS_ROWRSTD); int* TILEE = wsp<int>(F, WS_TILEE);
    LAS int* stot = (LAS int*)F.lds;
    LAS int* soff = stot + 32;
    LAS int* sbase = soff + 40;
    for (int ch = F.bid; ch < 256; ch += F.G) {
        __syncthreads();
        { LAS int* part = sbase + 32;
          const int e = F.tid & 31, pt = F.tid >> 5; int hv[16], tot = 0, before = 0;
#pragma unroll
          for (int i = 0; i < 16; ++i) hv[i] = HIST[(16 * pt + i) * NE + e];
#pragma unroll
          for (int i = 0; i < 16; ++i) { tot += hv[i]; if (16 * pt + i < ch) before += hv[i]; }
          part[(pt * 32 + e) * 2] = tot; part[(pt * 32 + e) * 2 + 1] = before;
          __syncthreads();
          if (F.tid < NE) { int t = 0, bsum = 0;
#pragma unroll
              for (int p = 0; p < 16; ++p) { t += part[(p * 32 + F.tid) * 2]; bsum += part[(p * 32 + F.tid) * 2 + 1]; }
              stot[F.tid] = t; sbase[F.tid] = bsum; } }
        __syncthreads();
        if (F.tid == 0) { int o = 0; for (int e = 0; e < NE; ++e) { soff[e] = o; o += (stot[e] + 255) & ~255; } soff[NE] = o; }
        __syncthreads();
        if (F.wave == 0) {
            const size_t m = (size_t)ch * 64 + F.lane; int se[4]; float sw[4];
#pragma unroll
            for (int k = 0; k < 4; ++k) { se[k] = SELE[m * 4 + k]; sw[k] = SELW[m * 4 + k]; }
            const float rs = RSTD[m]; int pos[4] = {0, 0, 0, 0};
            for (int e = 0; e < NE; ++e) { const unsigned long long mk = __ballot(se[0] == e || se[1] == e || se[2] == e || se[3] == e);
                const int rank = __popcll(mk & ((1ull << F.lane) - 1ull)); const int pp = soff[e] + sbase[e] + rank;
#pragma unroll
                for (int k = 0; k < 4; ++k) if (se[k] == e) pos[k] = pp; }
#pragma unroll
            for (int k = 0; k < 4; ++k) { POS[m * 4 + k] = pos[k]; ROWTOK[pos[k]] = (int)m; ROWGATE[pos[k]] = sw[k]; ROWRSTD[pos[k]] = rs; }
        }
        if (ch < NE) { const int e = ch; for (int r = soff[e] + stot[e] + F.tid; r < soff[e + 1]; r += NTHR) { ROWTOK[r] = 0; ROWGATE[r] = 0.f; ROWRSTD[r] = 0.f; } }
        if (ch == 0) { const int nt = soff[NE] >> 8; for (int t = F.tid; t < nt; t += NTHR) { int e = 0; while (soff[e + 1] <= t * 256) ++e; TILEE[t] = e; } if (F.tid == 0) TILEE[MAXTILES] = nt; }
    }
}
__device__ __forceinline__ void p_combine(Frame& F, const Args& args) {
    bf16* X1 = wsp<bf16>(F, WS_X1); const unsigned char* YS = wsp<unsigned char>(F, WS_YS); const int* POS = wsp<int>(F, WS_POS); float* RS2 = wsp<float>(F, WS_RSTD);
    const int gw = F.bid * NWAVES + F.wave, NGW = F.G * NWAVES, lane = F.lane;
    v2u xw[4]; int yw[4][4]; int4 psn = make_int4(0, 0, 0, 0);
    if (gw < M) { const int4 ps = *(const int4*)(POS + (size_t)gw * 4); const int pv[4] = {ps.x, ps.y, ps.z, ps.w};
#pragma unroll
        for (int j = 0; j < 4; ++j) { xw[j] = *(const v2u*)(X1 + (size_t)gw * D + 256 * j + 4 * lane);
#pragma unroll
            for (int k = 0; k < 4; ++k) yw[j][k] = __builtin_nontemporal_load((const int*)(YS + (size_t)pv[k] * D + 256 * j + 4 * lane)); }
        if (gw + NGW < M) psn = *(const int4*)(POS + (size_t)(gw + NGW) * 4); }
    for (int m = gw; m < M; m += NGW) {
        f32x4 v[4]; float s = 0.f;
#pragma unroll
        for (int j = 0; j < 4; ++j) { v[j] = (f32x4){bflo(xw[j].x), bfhi(xw[j].x), bflo(xw[j].y), bfhi(xw[j].y)};
#pragma unroll
            for (int k = 0; k < 4; ++k) { const f32x2_t lo = __builtin_amdgcn_cvt_pk_f32_fp8(yw[j][k], false), hi = __builtin_amdgcn_cvt_pk_f32_fp8(yw[j][k], true);
                v[j].x += lo.x; v[j].y += lo.y; v[j].z += hi.x; v[j].w += hi.y; } }
        if (m + NGW < M) { const int pv[4] = {psn.x, psn.y, psn.z, psn.w}; const size_t mn = (size_t)(m + NGW);
#pragma unroll
            for (int j = 0; j < 4; ++j) { xw[j] = *(const v2u*)(X1 + mn * D + 256 * j + 4 * lane);
#pragma unroll
                for (int k = 0; k < 4; ++k) yw[j][k] = __builtin_nontemporal_load((const int*)(YS + (size_t)pv[k] * D + 256 * j + 4 * lane)); }
            if (m + 2 * NGW < M) psn = *(const int4*)(POS + (size_t)(m + 2 * NGW) * 4); }
#pragma unroll
        for (int j = 0; j < 4; ++j) { s += (v[j].x * v[j].x + v[j].y * v[j].y) + (v[j].z * v[j].z + v[j].w * v[j].w);
            *(v2u*)(X1 + (size_t)m * D + 256 * j + 4 * lane) = (v2u){pk2(v[j].x, v[j].y), pk2(v[j].z, v[j].w)}; }
        const float rstd = 1.0f / sqrtf(wave_sum(s) * (1.0f / D) + RMS_EPS);
        if (lane == 0) RS2[m] = rstd;
    }
}

enum { PH_PRO = 0, PH_INPROJ, PH_PREP, PH_ROUTE, PH_MIXA, PH_MIXB, PH_OUTPROJ, PH_ROUTER, PH_LISTS, PH_GU, PH_DN, PH_COMB, PH_PLE, NPH };

__global__ void __launch_bounds__(NTHR, 2) fwd(Args args) {
    extern __shared__ __attribute__((aligned(16))) unsigned char lds[];
    Frame F;
    F.lds = (LAS unsigned char*)lds; F.MISC = (volatile LAS unsigned*)(F.lds + MISC_OFF);
    F.tid = threadIdx.x; F.lane = F.tid & 63; F.wave = __builtin_amdgcn_readfirstlane(F.tid >> 6); F.G = gridDim.x; F.bid = blockIdx.x;
    F.ws = args.ws; F.ctl = (gu32*)(args.ws + WS_CTL); F.out = args.out;

    for (int u = F.tid; u < (LDS_BYTES - RING_BYTES) / 4; u += NTHR) ((LAS unsigned*)(F.lds + RING_BYTES))[u] = 0u;
    __syncthreads();
    XcdBarrier bar; bar.bar = (unsigned*)(F.ctl + CW_BAR); bar.x = 0; bar.st = nullptr;
    if (!MK_PER_PHASE) bar = xcd_barrier_post((unsigned*)(F.ctl + CW_BAR), F.MISC + 8);
    const int lo = args.ph_lo, hi = args.ph_hi;
#ifdef ONLY
#define IN(k) ((k) == ONLY)
#else
#define IN(k) (lo <= (k) && (k) < hi)
#endif
#ifdef USE_SGEMM
#define GEMM(gather, A_, arow_, lda_, Bt_, K_, S_, E_) sgemm_phase(F, A_, arow_, lda_, Bt_, K_, S_, E_)
#else
#define GEMM(gather, A_, arow_, lda_, Bt_, K_, S_, E_) pg8::gemm_phase<decltype(E_), decltype(S_), gather, true, false>(F.lds, A_, arow_, Bt_, K_, S_, E_)
#define GEMM8(gather, A_, arow_, Bt_, K_, S_, E_) pg8::gemm_phase<decltype(E_), decltype(S_), gather, true, true>(F.lds, A_, arow_, Bt_, K_, S_, E_)
#endif
#ifndef DUP_PHASE
#define DUP_PHASE -1
#endif
#define NREP(k) ((k) == DUP_PHASE ? 2 : 1)
#ifndef PROBE_PHASE
#define PROBE_PHASE -1
#endif
#define PSTAMP(k, w) do { if (PROBE_PHASE == (k) && F.bid == 0 && F.tid == 0) F.MISC[20 + (w)] = (unsigned)__builtin_amdgcn_s_memrealtime(); } while (0)
#define SEAM(k) do { if (IN(k) && IN((k) + 1)) xcd_barrier(bar); } while (0)

    PSTAMP(PH_PRO, 0);
    if (IN(PH_PRO)) { for (int rep = 0; rep < NREP(PH_PRO); ++rep) { p0_prologue(F, args); __syncthreads(); } } SEAM(PH_PRO); PSTAMP(PH_PRO, 1);
    PSTAMP(PH_INPROJ, 0);
    if (IN(PH_INPROJ)) { constexpr int GG = 224;
        if (F.G == 256 && F.bid >= GG) { if (F.bid - GG < NBH) { gate_scans(F, F.bid - GG, NBH); __syncthreads(); }
            tr_run<false>(F, args, I_SMALL, NBG, (F.bid - GG) * NWAVES + F.wave, (256 - GG) * NWAVES); }
        else { StaticOrder S{M / 256, NU / 256, F.G == 256 ? GG : F.G, F.bid}; EpiStoreBf16 E{wsp<bf16>(F, WS_U), NU};
            GEMM(false, wsp<bf16>(F, WS_XN), nullptr, D, wsp<bf16>(F, WS_WIN), D, S, E);
        } } SEAM(PH_INPROJ); PSTAMP(PH_INPROJ, 1);
    PSTAMP(PH_PREP, 0);
    if (IN(PH_PREP)) { for (int rep = 0; rep < NREP(PH_PREP); ++rep) { p_prep(F, args); __syncthreads(); } } SEAM(PH_PREP); PSTAMP(PH_PREP, 1);
    PSTAMP(PH_ROUTE, 0);
    if (IN(PH_ROUTE)) { for (int rep = 0; rep < NREP(PH_ROUTE); ++rep) { p_route(F, args); __syncthreads(); } } SEAM(PH_ROUTE); PSTAMP(PH_ROUTE, 1);
    PSTAMP(PH_MIXA, 0);
    if (IN(PH_MIXA)) { for (int rep = 0; rep < NREP(PH_MIXA); ++rep) { p_mix_a(F, args); __syncthreads(); } } SEAM(PH_MIXA); PSTAMP(PH_MIXA, 1);
    PSTAMP(PH_MIXB, 0);
    if (IN(PH_MIXB)) { for (int rep = 0; rep < NREP(PH_MIXB); ++rep) { p_mix_b(F, args); __syncthreads(); } } SEAM(PH_MIXB); PSTAMP(PH_MIXB, 1);
    PSTAMP(PH_OUTPROJ, 0);
    if (IN(PH_OUTPROJ)) { for (int rep = 0; rep < NREP(PH_OUTPROJ); ++rep) { StaticOrder S{M / 256, D / 256, F.G, F.bid}; EpiOutProj E{args.in[0], wsp<bf16>(F, WS_X1), wsp<float>(F, WS_SS), wsp<unsigned char>(F, WS_T8)};
        GEMM(false, wsp<bf16>(F, WS_MIX), nullptr, D, wsp<bf16>(F, WS_WOUT), D, S, E); } } SEAM(PH_OUTPROJ); PSTAMP(PH_OUTPROJ, 1);
    PSTAMP(PH_ROUTER, 0);
    if (IN(PH_ROUTER)) {
        for (int rep = 0; rep < NREP(PH_ROUTER); ++rep) { p_router(F, args); __syncthreads(); } } SEAM(PH_ROUTER); PSTAMP(PH_ROUTER, 1);
    PSTAMP(PH_LISTS, 0);
    if (IN(PH_LISTS)) { for (int rep = 0; rep < NREP(PH_LISTS); ++rep) { p_lists(F, args); __syncthreads(); } } SEAM(PH_LISTS); PSTAMP(PH_LISTS, 1);
    PSTAMP(PH_GU, 0);
    if (IN(PH_GU)) { for (int rep = 0; rep < NREP(PH_GU); ++rep) { GroupedOrder S{wsp<int>(F, WS_TILEE), 8, F.G, F.bid}; EpiGateUp E{wsp<int>(F, WS_TILEE), wsp<float>(F, WS_ROWRSTD), args.in[16], wsp<unsigned char>(F, WS_ACT)};
        GEMM8(true, wsp<unsigned char>(F, WS_T8), wsp<int>(F, WS_ROWTOK), wsp<unsigned char>(F, WS_WGU), D, S, E); }
        {
            const int nun = wsp<int>(F, WS_TILEE)[MAXTILES] * 8, rem = nun % F.G; PeOrder S{F.bid, F.G};
            if (rem > 0) { S.first = F.bid >= rem ? F.bid - rem : -1; S.stride = F.G - rem; }
            int kple = PLE; asm volatile("" : "+s"(kple)); EpiStoreBf16 E{wsp<bf16>(F, WS_MIX), D}; GEMM(false, wsp<bf16>(F, WS_PB), nullptr, kple, wsp<bf16>(F, WS_WPP), kple, S, E); } } SEAM(PH_GU); PSTAMP(PH_GU, 1);
    PSTAMP(PH_DN, 0);
    if (IN(PH_DN)) { for (int rep = 0; rep < NREP(PH_DN); ++rep) { GroupedOrder S{wsp<int>(F, WS_TILEE), 4, F.G, F.bid}; EpiDown E{wsp<float>(F, WS_ROWGATE), args.in[18], wsp<unsigned char>(F, WS_YS)};
        GEMM8(false, wsp<unsigned char>(F, WS_ACT), nullptr, wsp<unsigned char>(F, WS_WDN), FF, S, E); }
} SEAM(PH_DN); PSTAMP(PH_DN, 1);
    PSTAMP(PH_COMB, 0);
    if (IN(PH_COMB)) { for (int rep = 0; rep < NREP(PH_COMB); ++rep) { p_combine(F, args); __syncthreads(); } } SEAM(PH_COMB); PSTAMP(PH_COMB, 1);
    PSTAMP(PH_PLE, 0);
    if (IN(PH_PLE)) { StaticOrder S{M / 256, D / 256, F.G, F.bid};
        { EpiPle E{wsp<bf16>(F, WS_MIX), wsp<bf16>(F, WS_X1), wsp<float>(F, WS_RSTD), F.out}; GEMM(false, wsp<bf16>(F, WS_X1), nullptr, D, wsp<bf16>(F, WS_WPG), D, S, E); } }
    if (PROBE_PHASE == PH_PLE) { __syncthreads(); PSTAMP(PH_PLE, 1); }
    if (PROBE_PHASE >= 0 && F.bid == 0 && F.tid == 0) { const unsigned dt = F.MISC[21] - F.MISC[20]; const unsigned long long t0 = __builtin_amdgcn_s_memrealtime(); while (__builtin_amdgcn_s_memrealtime() - t0 < 9ull * dt) __builtin_amdgcn_s_sleep(8); }
#undef IN
#undef SEAM
}

extern "C" void kernel_launch(void* const* d_in, const int* in_sizes, int n_in, void* d_out, int out_size, void* d_ws, size_t ws_size, hipStream_t stream) {
    static int grid = 0;
    if (grid == 0) {
        if (n_in != 22 || out_size != M * D || ws_size < WS_END) { fprintf(stderr, "kernel_launch: unexpected problem (n_in %d, out %d, ws %zu); nothing launched\n", n_in, out_size, ws_size); grid = -1; return; }
        int dev = 0, cus = 0, per_cu = 0;
        if (hipGetDevice(&dev) != hipSuccess || hipDeviceGetAttribute(&cus, hipDeviceAttributeMultiprocessorCount, dev) != hipSuccess) { grid = -1; return; }
        if (hipFuncSetAttribute((const void*)fwd, hipFuncAttributeMaxDynamicSharedMemorySize, LDS_BYTES) != hipSuccess) { fprintf(stderr, "kernel_launch: hipFuncSetAttribute failed\n"); grid = -1; return; }
        if (hipOccupancyMaxActiveBlocksPerMultiprocessor(&per_cu, (const void*)fwd, NTHR, LDS_BYTES) != hipSuccess || per_cu < 1) fprintf(stderr, "kernel_launch: occupancy query says %d\n", per_cu);
        (void)hipGetLastError();
        grid = cus;
    }
    if (grid < 0) return;
    if (hipMemsetAsync((char*)d_ws + WS_CTL, 0, CTL_ZERO_BYTES, stream) != hipSuccess) return;
    Args a{};
    for (int i = 0; i < 22; ++i) a.in[i] = (const float*)d_in[i];
    a.out = (float*)d_out; a.ws = (unsigned char*)d_ws; a.li = 0; a.pad = 0;
#if MK_PER_PHASE
    for (int ph = 0; ph < NPH; ++ph) { a.ph_lo = ph; a.ph_hi = ph + 1; hipLaunchKernelGGL(fwd, dim3(grid), dim3(NTHR), LDS_BYTES, stream, a); }
#else
    a.ph_lo = 0; a.ph_hi = NPH; hipLaunchKernelGGL(fwd, dim3(grid), dim3(NTHR), LDS_BYTES, stream, a);
#endif
}
```

```cpp
#include <hip/hip_runtime.h>
#include <cstdio>
#include <cstdint>

#ifndef MK_PER_PHASE
#define MK_PER_PHASE 0
#endif

#define GAS __attribute__((address_space(1)))
#define LAS __attribute__((address_space(3)))
typedef unsigned short bf16;
typedef unsigned v4u __attribute__((ext_vector_type(4)));
typedef unsigned v2u __attribute__((ext_vector_type(2)));
typedef float f32x4 __attribute__((ext_vector_type(4)));
typedef short bf16x8 __attribute__((ext_vector_type(8)));
typedef int v8i __attribute__((ext_vector_type(8)));
typedef GAS unsigned gu32;
#define RLX_AGENT __ATOMIC_RELAXED, __HIP_MEMORY_SCOPE_AGENT
#define LDS_WAIT() asm volatile("s_waitcnt lgkmcnt(0)" ::: "memory")
#define VM_WAIT() asm volatile("s_waitcnt vmcnt(0)" ::: "memory")

constexpr int BATCH = 2, SEQ = 8192, D = 1024, M = BATCH * SEQ;
constexpr int PROJ = 3600, NU = 3584;
constexpr int HD = 64, NH = 8, WM = 512;
constexpr int LCH = 128, NCH = SEQ / LCH;
constexpr int MBS = 256, NBK = SEQ / MBS;
constexpr int NPAIR = NBK * (NBK - 1) / 2;
constexpr int NE = 32, TOPK = 4, FF = 1024, PLE = 256;
constexpr int MAXROWS = M * TOPK + NE * 256, MAXTILES = MAXROWS / 256;
constexpr float RMS_EPS = 1e-6f;
constexpr float SW_LIMIT = 7.0f, SW_ALPHA = 1.702f;
constexpr float LOG2E = 1.4426950408889634f;
constexpr float W8_SCALE = 64.0f, W8_INV = 1.0f / 64.0f;
constexpr int UQM = 0, UKM = 512, UVM = 1024, UOM = 1536, UQB = 2048, UKB = 2560, UVB = 3072;
constexpr int NBH = BATCH * NH;

constexpr size_t MiB = 1u << 20;
constexpr size_t WS_CTL = 0, CTL_ZERO_BYTES = 32768;
constexpr size_t WS_WIN = 2 * MiB;
constexpr size_t WS_WOUT = 10 * MiB;
constexpr size_t WS_WPG = 12 * MiB;
constexpr size_t WS_WPP = 14 * MiB;
constexpr size_t WS_WR = 15 * MiB;
constexpr size_t WS_WGU = 16 * MiB;
constexpr size_t WS_WDN = 144 * MiB;
constexpr size_t WS_XN = 208 * MiB;
constexpr size_t WS_PB = 240 * MiB;
constexpr size_t WS_GATES = 248 * MiB;
constexpr size_t WS_SA = 249 * MiB;
constexpr size_t WS_SMX = WS_SA + 512 * 1024;
constexpr size_t WS_SB = WS_SMX + 512 * 1024;
constexpr size_t WS_SW = WS_SB + 512 * 1024;
constexpr size_t WS_SMALL = 251 * MiB;
constexpr size_t WS_DEC = WS_SMALL;
constexpr size_t WS_MC = WS_DEC + 4096;
constexpr size_t WS_KMEAN = WS_MC + 4096;
constexpr size_t WS_MCNT = WS_KMEAN + 131072;
constexpr size_t WS_SELE = 252 * MiB;
constexpr size_t WS_SELW = WS_SELE + 262144;
constexpr size_t WS_RSTD = WS_SELW + 262144;
constexpr size_t WS_HIST = WS_RSTD + 65536;
constexpr size_t WS_POS = WS_HIST + 32768;
constexpr size_t WS_ROWTOK = WS_POS + 262144;
constexpr size_t WS_ROWGATE = WS_ROWTOK + 294912;
constexpr size_t WS_ROWRSTD = WS_ROWGATE + 294912;
constexpr size_t WS_TILEE = WS_ROWRSTD + 294912;
constexpr size_t WS_SS = 254 * MiB;
constexpr size_t WS_DN = 255 * MiB;
constexpr size_t WS_NS = WS_DN + 262144;
constexpr size_t WS_U = 260 * MiB;
constexpr size_t WS_QM = 372 * MiB;
constexpr size_t WS_KM = 388 * MiB;
constexpr size_t WS_QN = 404 * MiB;
constexpr size_t WS_KN = 420 * MiB;
constexpr size_t WS_T8 = 404 * MiB;
constexpr size_t WS_VT = 436 * MiB;
constexpr size_t WS_MIX = 452 * MiB;
constexpr size_t WS_X1 = 484 * MiB;
constexpr size_t WS_MLIST = 548 * MiB;
constexpr size_t WS_OP = 556 * MiB;
constexpr size_t WS_LP = 652 * MiB;
constexpr size_t WS_DC = 654 * MiB;
constexpr size_t WS_CS = 670 * MiB;
constexpr size_t WS_ACT = 688 * MiB;
constexpr size_t WS_YS = 260 * MiB;
constexpr size_t WS_END = 832 * MiB;
static_assert(WS_ACT + (size_t)MAXROWS * 1024 * 2 <= WS_END && WS_YS + (size_t)MAXROWS * 1024 * 2 <= WS_QN, "ws map");
constexpr int CW_BAR = 4096;

constexpr int RING_BYTES = 131072;
constexpr int LDS_BYTES = 147456;
constexpr int MISC_OFF = LDS_BYTES - 256;
constexpr int BG_SCR = 77824;
constexpr int GSCR_OFF = RING_BYTES + 1024;
constexpr int NWAVES = 8, NTHR = 512;
static_assert(BG_SCR + NWAVES * 8448 <= MISC_OFF, "LDS map");

typedef float f32x2_t __attribute__((ext_vector_type(2)));
typedef __bf16 bf16x2_t __attribute__((ext_vector_type(2)));
typedef float f32x16 __attribute__((ext_vector_type(16)));
__device__ __forceinline__ unsigned pk2(float lo, float hi) { f32x2_t v = {lo, hi}; bf16x2_t b = __builtin_convertvector(v, bf16x2_t); return __builtin_bit_cast(unsigned, b); }
__device__ __forceinline__ unsigned f2bf(float f) { return pk2(f, 0.f) & 0xffffu; }
__device__ __forceinline__ unsigned pk4f8(float a, float b, float c, float d) { int w = 0; w = __builtin_amdgcn_cvt_pk_fp8_f32(a, b, w, false); w = __builtin_amdgcn_cvt_pk_fp8_f32(c, d, w, true); return (unsigned)w; }
__device__ __forceinline__ float bf2f(unsigned short b) { return __builtin_bit_cast(float, (unsigned)b << 16); }
__device__ __forceinline__ float bflo(unsigned w) { return __builtin_bit_cast(float, w << 16); }
__device__ __forceinline__ float bfhi(unsigned w) { return __builtin_bit_cast(float, w & 0xffff0000u); }
__device__ __forceinline__ float sigmoidf_(float x) { return 1.0f / (1.0f + __expf(-x)); }

#define XB_TMO      128
#define XB_XCNT(j)  (256  + 64 * (j))
#define XB_XSUB(j)  (1280 + 64 * (j))
#define XB_XGEN(j)  (2304 + 64 * (j))
#define XB_TOP      3328
#define XB_TOPGEN   3392
#define XCD_BAR_WORDS 3456
#define XB_SPIN_CAP (1u << 18)
__device__ __forceinline__ unsigned xb_ld(unsigned* p)              { return __hip_atomic_load(p, __ATOMIC_RELAXED, __HIP_MEMORY_SCOPE_AGENT); }
__device__ __forceinline__ unsigned xb_add(unsigned* p, unsigned v) { return __hip_atomic_fetch_add(p, v, __ATOMIC_RELAXED, __HIP_MEMORY_SCOPE_AGENT); }
__device__ __forceinline__ unsigned xb_xcc_id() { return (unsigned)__builtin_amdgcn_s_getreg((3 << 11) | 20) & 0xFu; }
#define XB_SPIN(cond, bar) do { unsigned _sp = 0; while (cond) { __builtin_amdgcn_s_sleep(1); \
    if ((++_sp & 255u) == 0u) { if (xb_ld(&(bar)[XB_TMO])) break; if (_sp > XB_SPIN_CAP) { atomicAdd(&(bar)[XB_TMO], 1u); break; } } } } while (0)
struct XcdBarrier { unsigned* bar; unsigned x; volatile LAS unsigned* st; };
__device__ __forceinline__ XcdBarrier xcd_barrier_post(unsigned* bar, volatile LAS unsigned* st) {
    XcdBarrier b; b.bar = bar; b.x = xb_xcc_id(); b.st = st;
    if (threadIdx.x == 0) (void)xb_add(&bar[XB_XCNT(b.x)], 1u);
    return b;
}
__device__ __forceinline__ void xcd_barrier_complete(unsigned* bar, unsigned x, unsigned& nloc, unsigned& nx) {
    const unsigned G = gridDim.x * gridDim.y * gridDim.z;
    unsigned sum, cnt, mine, sp = 0u;
    for (;;) {
        sum = 0u; cnt = 0u; mine = 0u;
#pragma unroll
        for (unsigned j = 0; j < 16; ++j) { const unsigned c = xb_ld(&bar[XB_XCNT(j)]); sum += c; cnt += (c > 0u) ? 1u : 0u; mine = (j == x) ? c : mine; }
        if (sum == G) break;
        __builtin_amdgcn_s_sleep(1);
        if ((++sp & 255u) == 0u) { if (xb_ld(&bar[XB_TMO])) break; if (sp > XB_SPIN_CAP) { atomicAdd(&bar[XB_TMO], 1u); break; } }
    }
    nloc = mine > 0u ? mine : 1u; nx = cnt > 0u ? cnt : 1u;
}
__device__ __forceinline__ void xcd_barrier(const XcdBarrier& b) {
    asm volatile("s_waitcnt vmcnt(0)" ::: "memory");
    __syncthreads();
    if (threadIdx.x == 0) {
        unsigned* bar = b.bar;
        __builtin_amdgcn_s_waitcnt(0);
        unsigned nloc = b.st[0], nx = b.st[1];
        if (nloc == 0u) { xcd_barrier_complete(bar, b.x, nloc, nx); b.st[0] = nloc; b.st[1] = nx; }
        const unsigned old = xb_add(&bar[XB_XSUB(b.x)], 1u);
        const unsigned gen = old / nloc;
        if (old + 1u == (gen + 1u) * nloc) {
            __builtin_amdgcn_fence(__ATOMIC_RELEASE, "agent");
            asm volatile("s_waitcnt vmcnt(0)" ::: "memory");
            const unsigned og = xb_add(&bar[XB_TOP], 1u);
            const unsigned tg = og / nx;
            if (og + 1u == (tg + 1u) * nx) xb_add(&bar[XB_TOPGEN], 1u);
            else XB_SPIN(xb_ld(&bar[XB_TOPGEN]) == tg, bar);
            __builtin_amdgcn_fence(__ATOMIC_ACQUIRE, "agent");
            xb_add(&bar[XB_XGEN(b.x)], 1u);
            asm volatile("s_waitcnt vmcnt(0)" ::: "memory");
        } else {
            XB_SPIN(xb_ld(&bar[XB_XGEN(b.x)]) == gen, bar);
            __builtin_amdgcn_fence(__ATOMIC_ACQUIRE, "agent");
            asm volatile("s_waitcnt vmcnt(0)" ::: "memory");
        }
    }
    __syncthreads();
}

struct Args { const float* in[22]; float* out; unsigned char* ws; int ph_lo, ph_hi, li, pad; };
struct Frame {
    LAS unsigned char* lds; volatile LAS unsigned* MISC; gu32* ctl;
    int tid, lane, wave, G, bid;
    float* out; unsigned char* ws;
};
template <class T> __device__ __forceinline__ T* wsp(const Frame& F, size_t off) { return (T*)(F.ws + off); }

__device__ __forceinline__ float wave_sum(float v) {
#pragma unroll
    for (int o = 1; o < 64; o <<= 1) v += __shfl_xor(v, o);
    return v;
}
__device__ __forceinline__ float wave_max(float v) {
#pragma unroll
    for (int o = 1; o < 64; o <<= 1) v = fmaxf(v, __shfl_xor(v, o));
    return v;
}

struct Unit { int pm, pn; };
struct StaticOrder {
    int nM, nN, G, c;
    __device__ __forceinline__ bool next(int i, Unit& u) const {
        const int nwg = nM * nN; const int L = i * G + c; if (L >= nwg) return false;
        int wgid = L; { const int q = nwg / 8, r = nwg % 8, xcd = wgid % 8, off = wgid / 8; wgid = (xcd < r ? xcd * (q + 1) : r * (q + 1) + (xcd - r) * q) + off; }
        const int nig = 8 * nN, gid = wgid / nig, fm = gid * 8, gsz = (nM - fm) < 8 ? (nM - fm) : 8;
        u.pm = fm + ((wgid % nig) % gsz); u.pn = (wgid % nig) / gsz; return true;
    }
};
struct GroupedOrder {
    const int* tile_e; int NT, G, c;
    __device__ __forceinline__ bool next(int i, Unit& u) const {
        const int nwg = tile_e[MAXTILES] * NT; const int L0 = i * G + c; if (L0 >= nwg) return false;
        const int q = nwg / 8, r = nwg % 8, xcd = L0 % 8, off = L0 / 8; const int L = (xcd < r ? xcd * (q + 1) : r * (q + 1) + (xcd - r) * q) + off;
        const int t = L / NT, n = L % NT; u.pm = t; u.pn = tile_e[t] * NT + n; return true;
    }
};
struct PeOrder {
    int first, stride;
    __device__ __forceinline__ bool next(int i, Unit& u) const { const int L = first + i * stride; if (first < 0 || L >= (M / 256) * (D / 256)) return false; u.pm = L >> 2; u.pn = L & 3; return true; }
};
__device__ __forceinline__ int perm32(int rho) { const int n = rho >> 4, i = rho & 15; return 8 * (i >> 2) + 4 * n + (i & 3); }

template <class Sched, class Epi>
__device__ __forceinline__ void sgemm_phase(const Frame& F, const bf16* A, const int* arow, int lda, const bf16* Bt, int K, const Sched& S, const Epi& E) {
    const int wid = F.wave, lane = F.lane, wr = wid >> 2, wc = wid & 3, fr = lane & 15, fq = lane >> 4;
    Unit u;
    for (int i = 0; S.next(i, u); ++i) {
        for (int ai = 0; ai < 2; ++ai) {
            f32x4 acc[2][4][2];
#pragma unroll
            for (int bj = 0; bj < 2; ++bj)
#pragma unroll
                for (int m = 0; m < 4; ++m)
#pragma unroll
                    for (int n = 0; n < 2; ++n) acc[bj][m][n] = (f32x4){0.f, 0.f, 0.f, 0.f};
            const bf16* ap[4]; const bf16* bp[2][2];
#pragma unroll
            for (int m = 0; m < 4; ++m) { const int r = u.pm * 256 + ai * 128 + wr * 64 + m * 16 + fr; const int src = arow ? arow[r] : r; ap[m] = A + (size_t)src * lda + fq * 8; }
#pragma unroll
            for (int bj = 0; bj < 2; ++bj)
#pragma unroll
                for (int n = 0; n < 2; ++n) bp[bj][n] = Bt + (size_t)(u.pn * 256 + bj * 128 + wc * 32 + perm32(16 * n + fr)) * K + fq * 8;
            for (int k = 0; k < K; k += 32) {
                bf16x8 af[4], bfr[2][2];
#pragma unroll
                for (int m = 0; m < 4; ++m) af[m] = *(const bf16x8*)(ap[m] + k);
#pragma unroll
                for (int bj = 0; bj < 2; ++bj)
#pragma unroll
                    for (int n = 0; n < 2; ++n) bfr[bj][n] = *(const bf16x8*)(bp[bj][n] + k);
#pragma unroll
                for (int bj = 0; bj < 2; ++bj)
#pragma unroll
                    for (int m = 0; m < 4; ++m)
#pragma unroll
                        for (int n = 0; n < 2; ++n) acc[bj][m][n] = __builtin_amdgcn_mfma_f32_16x16x32_bf16(bfr[bj][n], af[m], acc[bj][m][n], 0, 0, 0);
            }
#pragma unroll
            for (int m = 0; m < 4; ++m) {
                float lo[8], hi[8];
#pragma unroll
                for (int j = 0; j < 4; ++j) { lo[j] = acc[0][m][0][j]; lo[4 + j] = acc[0][m][1][j]; hi[j] = acc[1][m][0][j]; hi[4 + j] = acc[1][m][1][j]; }
                typename Epi::Pre pre; E.pre(u, wr * 64 + fr, wc * 32 + fq * 8, pre); { typename Epi::Ld ld; E.load(u, ai * 128 + wr * 64 + m * 16 + fr, wc * 32 + fq * 8, ld); E(u, ai * 128 + wr * 64 + m * 16 + fr, wc * 32 + fq * 8, lo, hi, pre, ai * 4 + m, ld); }
            }
        }
    }
}

namespace pg8 {
constexpr int BM = 256, BK = 64, HALF = 128, HTB = HALF * BK * 2, STAGE_BYTES = 8 * HTB;
__device__ __forceinline__ int lds_byte(int r, int c) { const int st = (r >> 4) * 2 + (c >> 5), rr = r & 15, cc = c & 31, ob = rr * 64 + cc * 2; return st * 1024 + (ob ^ (((ob >> 9) & 1) << 5)); }
__device__ __forceinline__ void stage_rc(int b, int& R, int& C) { const int st = b / 1024, sb = b % 1024, swz = sb ^ (((sb >> 9) & 1) << 5); R = (st >> 1) * 16 + swz / 64; C = (st & 1) * 32 + (swz % 64) / 2; }

template <bool FP8>
__device__ __forceinline__ void mma_block(f32x4 (&c)[4][2], const bf16x8 (&At)[4][2], const bf16x8 (&Bq)[2][2]) {
    if constexpr (FP8) {
#pragma unroll
        for (int m = 0; m < 4; ++m)
#pragma unroll
            for (int n = 0; n < 2; ++n) {
                const v4u b0 = __builtin_bit_cast(v4u, Bq[n][0]), b1 = __builtin_bit_cast(v4u, Bq[n][1]), a0 = __builtin_bit_cast(v4u, At[m][0]), a1 = __builtin_bit_cast(v4u, At[m][1]);
                const v8i bw = {(int)b0.x, (int)b0.y, (int)b0.z, (int)b0.w, (int)b1.x, (int)b1.y, (int)b1.z, (int)b1.w}, aw = {(int)a0.x, (int)a0.y, (int)a0.z, (int)a0.w, (int)a1.x, (int)a1.y, (int)a1.z, (int)a1.w};
                c[m][n] = __builtin_amdgcn_mfma_scale_f32_16x16x128_f8f6f4(bw, aw, c[m][n], 0, 0, 0, 0x7F7F7F7F, 0, 0x7F7F7F7F); }
    } else {
#pragma unroll
        for (int m = 0; m < 4; ++m)
#pragma unroll
            for (int n = 0; n < 2; ++n)
#pragma unroll
                for (int k = 0; k < 2; ++k) c[m][n] = __builtin_amdgcn_mfma_f32_16x16x32_bf16(Bq[n][k], At[m][k], c[m][n], 0, 0, 0);
    }
}
template <class Epi, class Sched, bool GATHER, bool ALIGN_EPI, bool FP8>
__device__ __forceinline__ void gemm_phase(LAS unsigned char* lds, const void* A, const int* arow, const void* Bt, const int K, const Sched& S, const Epi& E) {
    const int RB = FP8 ? K : 2 * K;
    const int tid = threadIdx.x, wid = __builtin_amdgcn_readfirstlane(tid >> 6), lane = tid & 63, wr = wid >> 2, wc = wid & 3, fr = lane & 15, fq = lane >> 4;
    const int nt = RB / 128;
    unsigned voffB[2], vA[2][2];
#pragma unroll
    for (int i = 0; i < 2; ++i) { int sR, sC; stage_rc(tid * 16 + i * 8192, sR, sC); const int Rb = (sR & ~31) + perm32(sR & 31);
        voffB[i] = (unsigned)(Rb * RB + sC * 2);
        vA[0][i] = (unsigned)(sR * RB + sC * 2); vA[1][i] = (unsigned)((sR + HALF) * RB + sC * 2); }
    const unsigned kstep = 128u;
    const unsigned hstep = (unsigned)HALF * RB;
    const unsigned r64 = 64u * RB;
    const unsigned tstep = 2 * hstep;
    const __amdgpu_buffer_rsrc_t rA = __builtin_amdgcn_make_buffer_rsrc((void*)A, 0, 0x7fffffff, 0x00020000), rB = __builtin_amdgcn_make_buffer_rsrc((void*)Bt, 0, 0x7fffffff, 0x00020000);
    const unsigned ldsw = (unsigned)wid * 1024u;
    const int aoff = lds_byte(wr * 64 + fr, fq * 8), boff = lds_byte(wc * 32 + fr, fq * 8);
#define PG8_SA(b, h) (((b) * 2 + (h)) * HTB)
#define PG8_SB(b, h) ((4 + (b) * 2 + (h)) * HTB)
#define PG8_STAGE_B(bufoff, so) do { _Pragma("unroll") for (int _i = 0; _i < 2; ++_i) \
        __builtin_amdgcn_raw_ptr_buffer_load_lds(rB, (LAS unsigned*)(lds + (bufoff) + ldsw + _i * 8192), 16, voffB[0], (int)((so) + _i * r64), 0, 0); } while (0)
#define PG8_STAGE_A(bufoff, so, h, nx) do { _Pragma("unroll") for (int _i = 0; _i < 2; ++_i) { if constexpr (GATHER) \
        __builtin_amdgcn_raw_ptr_buffer_load_lds(rA, (LAS unsigned*)(lds + (bufoff) + ldsw + _i * 8192), 16, vA[h][_i], (int)(so), 0, 0); else \
        __builtin_amdgcn_raw_ptr_buffer_load_lds(rA, (LAS unsigned*)(lds + (bufoff) + ldsw + _i * 8192), 16, vA[0][0], (int)((so) + (h) * hstep + _i * r64), 0, 0); } } while (0)
#define PG8_LDA(dst, b, h) do { _Pragma("unroll") for (int m = 0; m < 4; ++m) _Pragma("unroll") for (int k = 0; k < 2; ++k) dst[m][k] = *(const LAS bf16x8*)(lds + PG8_SA(b, h) + aoff + m * 2048 + k * 1024); } while (0)
#define PG8_LDB(dst, b, h) do { _Pragma("unroll") for (int n = 0; n < 2; ++n) _Pragma("unroll") for (int k = 0; k < 2; ++k) dst[n][k] = *(const LAS bf16x8*)(lds + PG8_SB(b, h) + boff + n * 2048 + k * 1024); } while (0)
#define PG8_MMA(ai, bj, At, Bq) do { __builtin_amdgcn_s_setprio(1); mma_block<FP8>(acc[ai][bj], At, Bq); __builtin_amdgcn_s_setprio(0); } while (0)
#define PG8_WAIT_V(n) asm volatile("s_waitcnt vmcnt(" #n ")" ::: "memory")
#define PG8_WAIT_L(n) asm volatile("s_waitcnt lgkmcnt(" #n ")" ::: "memory")
#define PG8_BAR __builtin_amdgcn_s_barrier()
#define PG8_SCHED __builtin_amdgcn_sched_barrier(0)
#define PG8_GOFF(dst, u) do { if (GATHER) { _Pragma("unroll") for (int _h = 0; _h < 2; ++_h) _Pragma("unroll") for (int _i = 0; _i < 2; ++_i) { int _R, _C; stage_rc(tid * 16 + _i * 8192, _R, _C); \
        dst[_h][_i] = (unsigned)(arow[(u).pm * BM + _h * HALF + _R] * RB + _C * 2); } } } while (0)
    LAS v4u* gscr = (LAS v4u*)(lds + GSCR_OFF) + tid;
    Unit cur, nxt; int ui = 0;
    if (!S.next(0, cur)) return;
    PG8_GOFF(vA, cur);
    f32x4 acc[2][2][4][2];
#pragma unroll
    for (int a = 0; a < 2; ++a)
#pragma unroll
        for (int b = 0; b < 2; ++b)
#pragma unroll
            for (int m = 0; m < 4; ++m)
#pragma unroll
                for (int n = 0; n < 2; ++n) acc[a][b][m][n] = (f32x4){0.f, 0.f, 0.f, 0.f};
    bf16x8 At[4][2], B0[2][2], B1[2][2];
    unsigned cA = GATHER ? 0u : (unsigned)cur.pm * tstep, cB = (unsigned)cur.pn * tstep;
    PG8_STAGE_B(PG8_SB(0, 0), cB); PG8_STAGE_B(PG8_SB(0, 1), cB + hstep); PG8_STAGE_A(PG8_SA(0, 0), cA, 0, false); PG8_STAGE_A(PG8_SA(0, 1), cA, 1, false);
    if (wr == 1) PG8_BAR;
    PG8_WAIT_V(2); PG8_BAR;
    PG8_STAGE_B(PG8_SB(1, 0), cB + kstep); PG8_STAGE_A(PG8_SA(1, 0), cA + kstep, 0, false); PG8_STAGE_B(PG8_SB(1, 1), cB + hstep + kstep);
    PG8_WAIT_V(6); PG8_BAR;
    for (;;) {
        const bool has_next = S.next(ui + 1, nxt);
        const unsigned nA = has_next ? (GATHER ? 0u : (unsigned)nxt.pm * tstep) : cA, nB = has_next ? (unsigned)nxt.pn * tstep : cB;
        if (GATHER) { if (has_next) { unsigned nv[2][2]; PG8_GOFF(nv, nxt); *gscr = (v4u){nv[0][0], nv[0][1], nv[1][0], nv[1][1]}; } else *gscr = (v4u){vA[0][0], vA[0][1], vA[1][0], vA[1][1]}; }
#pragma unroll 1
        for (int t = 0; t < nt; t += 2) {
            const bool last = (t == nt - 2);
            const unsigned a1 = cA + (unsigned)(t + 1) * kstep;
            const unsigned a2 = last ? nA : cA + (unsigned)(t + 2) * kstep, b2 = last ? nB : cB + (unsigned)(t + 2) * kstep;
            const unsigned a3 = a2 + kstep, b3 = b2 + kstep;
            PG8_LDB(B0, 0, 0); PG8_LDB(B1, 0, 1); PG8_SCHED; PG8_LDA(At, 0, 0); PG8_STAGE_A(PG8_SA(1, 1), a1, 1, false);
            if (GATHER) { if (last) { const v4u nv = *gscr; vA[0][0] = nv.x; vA[0][1] = nv.y; vA[1][0] = nv.z; vA[1][1] = nv.w; } }
            PG8_WAIT_V(8); PG8_WAIT_L(0); PG8_BAR; PG8_MMA(0, 0, At, B0); PG8_MMA(0, 1, At, B1); PG8_BAR; PG8_SCHED;
            PG8_LDA(At, 0, 1); PG8_STAGE_B(PG8_SB(0, 0), b2); PG8_STAGE_B(PG8_SB(0, 1), b2 + hstep); PG8_STAGE_A(PG8_SA(0, 0), a2, 0, last);
            PG8_WAIT_V(8); PG8_WAIT_L(0); PG8_BAR; PG8_MMA(1, 0, At, B0); PG8_MMA(1, 1, At, B1); PG8_BAR; PG8_SCHED;
            PG8_LDB(B0, 1, 0); PG8_LDB(B1, 1, 1); PG8_SCHED; PG8_LDA(At, 1, 0); PG8_STAGE_A(PG8_SA(0, 1), a2, 1, last);
            PG8_WAIT_V(8); PG8_WAIT_L(0); PG8_BAR; PG8_MMA(0, 0, At, B0); PG8_MMA(0, 1, At, B1); PG8_BAR; PG8_SCHED;
            PG8_LDA(At, 1, 1); PG8_STAGE_B(PG8_SB(1, 0), b3); PG8_STAGE_B(PG8_SB(1, 1), b3 + hstep); PG8_STAGE_A(PG8_SA(1, 0), a3, 0, last);
            PG8_WAIT_V(8); PG8_WAIT_L(0); PG8_BAR; PG8_MMA(1, 0, At, B0); PG8_MMA(1, 1, At, B1); PG8_BAR; PG8_SCHED;
        }
        if constexpr (ALIGN_EPI) { if (wr == 0) PG8_BAR; }
        {
            int fr2 = fr, fq2 = fq; asm volatile("" : "+v"(fr2), "+v"(fq2));
            typename Epi::Pre pre; E.pre(cur, wr * 64 + fr2, wc * 32 + fq2 * 8, pre);
            typename Epi::Ld ld; E.load(cur, wr * 64 + fr2, wc * 32 + fq2 * 8, ld);
#pragma unroll
            for (int ai = 0; ai < 2; ++ai)
#pragma unroll
                for (int m = 0; m < 4; ++m) { float lo[8], hi[8]; const int g = ai * 4 + m;
#pragma unroll
                    for (int j = 0; j < 4; ++j) { lo[j] = acc[ai][0][m][0][j]; lo[4 + j] = acc[ai][0][m][1][j]; hi[j] = acc[ai][1][m][0][j]; hi[4 + j] = acc[ai][1][m][1][j]; }
                    typename Epi::Ld nld; if (g < 7) E.load(cur, ((g + 1) >> 2) * HALF + wr * 64 + ((g + 1) & 3) * 16 + fr2, wc * 32 + fq2 * 8, nld);
                    E(cur, ai * HALF + wr * 64 + m * 16 + fr2, wc * 32 + fq2 * 8, lo, hi, pre, g, ld); if (Epi::FENCE) asm volatile("" ::: "memory"); ld = nld; }
        }
        if (!has_next) break;
#pragma unroll
        for (int a = 0; a < 2; ++a)
#pragma unroll
            for (int b = 0; b < 2; ++b)
#pragma unroll
                for (int m = 0; m < 4; ++m)
#pragma unroll
                    for (int n = 0; n < 2; ++n) acc[a][b][m][n] = (f32x4){0.f, 0.f, 0.f, 0.f};
        cur = nxt; cA = nA; cB = nB; ++ui;
        if constexpr (ALIGN_EPI) { if (wr == 1) PG8_BAR; }
    }
    PG8_WAIT_V(0);
    if constexpr (!ALIGN_EPI) { if (wr == 0) PG8_BAR; }
    PG8_BAR;
#undef PG8_SA
#undef PG8_SB
#undef PG8_STAGE_A
#undef PG8_STAGE_B
#undef PG8_LDA
#undef PG8_LDB
#undef PG8_MMA
#undef PG8_WAIT_V
#undef PG8_WAIT_L
#undef PG8_BAR
#undef PG8_SCHED
#undef PG8_GOFF
}
}
__device__ __forceinline__ void store8bf(bf16* p, const float (&v)[8]) { v4u w; w.x = pk2(v[0], v[1]); w.y = pk2(v[2], v[3]); w.z = pk2(v[4], v[5]); w.w = pk2(v[6], v[7]); *(v4u*)p = w; }

struct NoPre {};
struct EpiStoreBf16 { bf16* O; int ldc;
    typedef NoPre Pre; typedef NoPre Ld; static constexpr bool FENCE = false;
    __device__ __forceinline__ void pre(const Unit&, int, int, Pre&) const {}
    __device__ __forceinline__ void load(const Unit&, int, int, Ld&) const {}
    __device__ __forceinline__ void operator()(const Unit& u, int r, int c, const float (&lo)[8], const float (&hi)[8], const Pre&, int, const Ld&) const {
        bf16* o = O + (size_t)(u.pm * 256 + r) * ldc + u.pn * 256 + c; store8bf(o, lo); store8bf(o + 128, hi); } };
struct LdOut { f32x4 x[4]; };
struct EpiOutProj { const float* x; bf16* X1; float* SS; unsigned char* T8;
    typedef NoPre Pre; typedef LdOut Ld; static constexpr bool FENCE = true;
    __device__ __forceinline__ void pre(const Unit&, int, int, Pre&) const {}
    __device__ __forceinline__ void load(const Unit& u, int r, int c, Ld& l) const { const float* xp = x + ((size_t)u.pm * 256 + r) * D + u.pn * 256 + c;
        l.x[0] = __builtin_nontemporal_load((const f32x4*)xp); l.x[1] = __builtin_nontemporal_load((const f32x4*)(xp + 4)); l.x[2] = __builtin_nontemporal_load((const f32x4*)(xp + 128)); l.x[3] = __builtin_nontemporal_load((const f32x4*)(xp + 132)); }
    __device__ __forceinline__ void operator()(const Unit& u, int r, int c, const float (&lo)[8], const float (&hi)[8], const Pre&, int, const Ld& l) const {
        const size_t row = (size_t)u.pm * 256 + r; const int col = u.pn * 256 + c; float ss = 0.f;
#pragma unroll
        for (int h = 0; h < 2; ++h) { const float* v = h ? hi : lo; const int cc = col + h * 128; float o[8];
#pragma unroll
            for (int j = 0; j < 8; ++j) { o[j] = l.x[2 * h + (j >> 2)][j & 3] + v[j]; ss += o[j] * o[j]; }
            store8bf(X1 + row * D + cc, o); *(v2u*)(T8 + row * D + cc) = (v2u){pk4f8(o[0], o[1], o[2], o[3]), pk4f8(o[4], o[5], o[6], o[7])}; }
        ss += __shfl_xor(ss, 16); ss += __shfl_xor(ss, 32);
        if ((threadIdx.x & 63) < 16) SS[row * 16 + u.pn * 4 + (c >> 5)] = ss; } };
struct PreRow { float lo[8], hi[8], rw[8]; };
struct EpiGateUp { const int* tile_e; const float* rowrstd; const float* b_gu; unsigned char* ACT;
    typedef PreRow Pre; typedef NoPre Ld; static constexpr bool FENCE = false;
    __device__ __forceinline__ void load(const Unit&, int, int, Ld&) const {}
    __device__ __forceinline__ void pre(const Unit& u, int r0, int c, Pre& p) const {
        const int e = u.pn >> 3, nt = u.pn & 7; const float* bg = b_gu + (size_t)e * 2048 + nt * 128 + c;
        const f32x4 a0 = *(const f32x4*)bg, a1 = *(const f32x4*)(bg + 4), b0 = *(const f32x4*)(bg + 1024), b1 = *(const f32x4*)(bg + 1028);
        p.lo[0] = a0.x; p.lo[1] = a0.y; p.lo[2] = a0.z; p.lo[3] = a0.w; p.lo[4] = a1.x; p.lo[5] = a1.y; p.lo[6] = a1.z; p.lo[7] = a1.w;
        p.hi[0] = b0.x; p.hi[1] = b0.y; p.hi[2] = b0.z; p.hi[3] = b0.w; p.hi[4] = b1.x; p.hi[5] = b1.y; p.hi[6] = b1.z; p.hi[7] = b1.w;
#pragma unroll
        for (int g = 0; g < 8; ++g) p.rw[g] = rowrstd[(size_t)u.pm * 256 + r0 + 128 * (g >> 2) + 16 * (g & 3)] * W8_INV; }
    __device__ __forceinline__ void operator()(const Unit& u, int r, int c, const float (&lo)[8], const float (&hi)[8], const Pre& p, int g, const Ld&) const {
        const int nt = u.pn & 7; const size_t row = (size_t)u.pm * 256 + r; const float rs = p.rw[g]; float a[8];
#pragma unroll
        for (int j = 0; j < 8; ++j) { float glu = lo[j] * rs + p.lo[j], lin = hi[j] * rs + p.hi[j];
            glu = fminf(glu, SW_LIMIT); lin = fminf(fmaxf(lin, -SW_LIMIT), SW_LIMIT);
            a[j] = glu * sigmoidf_(SW_ALPHA * glu) * (lin + 1.0f); }
        *(v2u*)(ACT + row * FF + nt * 128 + c) = (v2u){pk4f8(a[0], a[1], a[2], a[3]), pk4f8(a[4], a[5], a[6], a[7])}; } };
struct EpiDown { const float* rowgate; const float* b_dn; unsigned char* YS;
    typedef PreRow Pre; typedef NoPre Ld; static constexpr bool FENCE = false;
    __device__ __forceinline__ void load(const Unit&, int, int, Ld&) const {}
    __device__ __forceinline__ void pre(const Unit& u, int r0, int c, Pre& p) const {
        const int e = u.pn >> 2, nt = u.pn & 3; const float* bd = b_dn + (size_t)e * 1024 + nt * 256 + c;
        const f32x4 a0 = *(const f32x4*)bd, a1 = *(const f32x4*)(bd + 4), b0 = *(const f32x4*)(bd + 128), b1 = *(const f32x4*)(bd + 132);
        p.lo[0] = a0.x; p.lo[1] = a0.y; p.lo[2] = a0.z; p.lo[3] = a0.w; p.lo[4] = a1.x; p.lo[5] = a1.y; p.lo[6] = a1.z; p.lo[7] = a1.w;
        p.hi[0] = b0.x; p.hi[1] = b0.y; p.hi[2] = b0.z; p.hi[3] = b0.w; p.hi[4] = b1.x; p.hi[5] = b1.y; p.hi[6] = b1.z; p.hi[7] = b1.w;
#pragma unroll
        for (int g = 0; g < 8; ++g) p.rw[g] = rowgate[(size_t)u.pm * 256 + r0 + 128 * (g >> 2) + 16 * (g & 3)]; }
    __device__ __forceinline__ void operator()(const Unit& u, int r, int c, const float (&lo)[8], const float (&hi)[8], const Pre& p, int g, const Ld&) const {
        const int nt = u.pn & 3; const size_t row = (size_t)u.pm * 256 + r; const float gt = p.rw[g]; float a[8], b[8];
#pragma unroll
        for (int j = 0; j < 8; ++j) { a[j] = (lo[j] * W8_INV + p.lo[j]) * gt; b[j] = (hi[j] * W8_INV + p.hi[j]) * gt; }
        unsigned char* o = YS + row * D + nt * 256 + c; *(v2u*)o = (v2u){pk4f8(a[0], a[1], a[2], a[3]), pk4f8(a[4], a[5], a[6], a[7])}; *(v2u*)(o + 128) = (v2u){pk4f8(b[0], b[1], b[2], b[3]), pk4f8(b[4], b[5], b[6], b[7])}; } };
struct LdPle { v4u pe[2], xw[2]; float rs; };
struct EpiPle { const bf16* PE; const bf16* X2; const float* RS; float* out;
    typedef NoPre Pre; typedef LdPle Ld; static constexpr bool FENCE = true;
    __device__ __forceinline__ void pre(const Unit&, int, int, Pre&) const {}
    __device__ __forceinline__ void load(const Unit& u, int r, int c, Ld& l) const { const size_t o = ((size_t)u.pm * 256 + r) * D + u.pn * 256 + c;
        l.pe[0] = __builtin_nontemporal_load((const v4u*)(PE + o)); l.pe[1] = __builtin_nontemporal_load((const v4u*)(PE + o + 128)); l.xw[0] = *(const v4u*)(X2 + o); l.xw[1] = *(const v4u*)(X2 + o + 128); l.rs = RS[(size_t)u.pm * 256 + r]; }
    __device__ __forceinline__ void operator()(const Unit& u, int r, int c, const float (&lo)[8], const float (&hi)[8], const Pre&, int, const Ld& l) const {
        const size_t row = (size_t)u.pm * 256 + r; const int col = u.pn * 256 + c;
#pragma unroll
        for (int h = 0; h < 2; ++h) { float v[8]; const int cc = col + h * 128; const v4u pe = l.pe[h], xw = l.xw[h];
#pragma unroll
            for (int j = 0; j < 8; ++j) v[j] = (h ? hi[j] : lo[j]) * l.rs;
            f32x4 x0, x1;
            x0[0] = bflo(xw.x) + sigmoidf_(v[0]) * bflo(pe.x); x0[1] = bfhi(xw.x) + sigmoidf_(v[1]) * bfhi(pe.x); x0[2] = bflo(xw.y) + sigmoidf_(v[2]) * bflo(pe.y); x0[3] = bfhi(xw.y) + sigmoidf_(v[3]) * bfhi(pe.y);
            x1[0] = bflo(xw.z) + sigmoidf_(v[4]) * bflo(pe.z); x1[1] = bfhi(xw.z) + sigmoidf_(v[5]) * bfhi(pe.z); x1[2] = bflo(xw.w) + sigmoidf_(v[6]) * bflo(pe.w); x1[3] = bfhi(xw.w) + sigmoidf_(v[7]) * bfhi(pe.w);
            *(f32x4*)(out + row * D + cc) = x0; *(f32x4*)(out + row * D + cc + 4) = x1; } } };

struct TrItem { const float* src; void* dst; const float* gk; int ldw, K, f8; };
__device__ __forceinline__ void tr_load(const TrItem& t, float (&v)[32], int lane) {
#pragma unroll
    for (int i = 0; i < 32; ++i) v[i] = __builtin_nontemporal_load(t.src + (size_t)(2 * i + (lane >> 5)) * t.ldw + (lane & 31));
}
__device__ __forceinline__ void tr_store(const TrItem& t, const float (&v)[32], LAS float* scr, int lane) {
#pragma unroll
    for (int i = 0; i < 32; ++i) scr[(2 * i + (lane >> 5)) * 33 + (lane & 31)] = v[i];
    LDS_WAIT(); asm volatile("" ::: "memory");
    if (t.f8) { const int n = lane >> 1, hf = lane & 1; const LAS float* s = scr + (32 * hf) * 33 + n; unsigned w[8];
#pragma unroll
        for (int q = 0; q < 8; ++q) { f32x4 g = {W8_SCALE, W8_SCALE, W8_SCALE, W8_SCALE}; if (t.gk) g = *(const f32x4*)(t.gk + 32 * hf + 4 * q) * W8_SCALE;
            w[q] = pk4f8(s[(4 * q) * 33] * g.x, s[(4 * q + 1) * 33] * g.y, s[(4 * q + 2) * 33] * g.z, s[(4 * q + 3) * 33] * g.w); }
        unsigned char* o = (unsigned char*)t.dst + (size_t)n * t.K + 32 * hf;
        *(v4u*)o = (v4u){w[0], w[1], w[2], w[3]}; *(v4u*)(o + 16) = (v4u){w[4], w[5], w[6], w[7]};
    } else { const int c = lane & 7;
        f32x4 g0 = {1.f, 1.f, 1.f, 1.f}, g1 = g0; if (t.gk) { g0 = *(const f32x4*)(t.gk + 8 * c); g1 = *(const f32x4*)(t.gk + 8 * c + 4); }
#pragma unroll
        for (int j = 0; j < 4; ++j) { const int n = (lane >> 3) + 8 * j; const LAS float* s = scr + (8 * c) * 33 + n;
            v4u o; o.x = pk2(s[0 * 33] * g0.x, s[1 * 33] * g0.y); o.y = pk2(s[2 * 33] * g0.z, s[3 * 33] * g0.w); o.z = pk2(s[4 * 33] * g1.x, s[5 * 33] * g1.y); o.w = pk2(s[6 * 33] * g1.z, s[7 * 33] * g1.w);
            *(v4u*)((bf16*)t.dst + (size_t)n * t.K + 8 * c) = o; } }
    LDS_WAIT(); asm volatile("" ::: "memory");
}
constexpr int I_IN = 16 * (NU / 32), I_SQ = 16 * 32, I_PP = 4 * 32, I_R = 16, I_GU = 16 * 64, I_DN = 16 * 32;
constexpr int NITEMS = I_IN + 2 * I_SQ + I_PP + I_R + NE * I_GU + NE * I_DN;
__device__ __forceinline__ TrItem tr_decode(const Frame& F, const Args& args, int r) {
    TrItem t; t.f8 = 0; t.gk = nullptr;
    if (r < I_IN) { const int kb = r / (NU / 32), nb = r % (NU / 32), n0 = 32 * nb, sc = n0 < 2048 ? n0 : n0 + 16;
        t.src = args.in[3] + (size_t)(64 * kb) * PROJ + sc; t.ldw = PROJ; t.dst = wsp<bf16>(F, WS_WIN) + (size_t)n0 * D + 64 * kb; t.K = D; }
    else if ((r -= I_IN) < I_SQ) { const int kb = r / 32, n0 = 32 * (r % 32); t.src = args.in[11] + (size_t)(64 * kb) * D + n0; t.ldw = D; t.dst = wsp<bf16>(F, WS_WOUT) + (size_t)n0 * D + 64 * kb; t.K = D; }
    else if ((r -= I_SQ) < I_SQ) { const int kb = r / 32, n0 = 32 * (r % 32); t.src = args.in[20] + (size_t)(64 * kb) * D + n0; t.ldw = D; t.dst = wsp<bf16>(F, WS_WPG) + (size_t)n0 * D + 64 * kb; t.K = D; t.gk = args.in[19] + 64 * kb; }
    else if ((r -= I_SQ) < I_PP) { const int kb = r / 32, n0 = 32 * (r % 32); t.src = args.in[21] + (size_t)(64 * kb) * D + n0; t.ldw = D; t.dst = wsp<bf16>(F, WS_WPP) + (size_t)n0 * PLE + 64 * kb; t.K = PLE; }
    else if ((r -= I_PP) < I_R) { const int kb = r; t.src = args.in[13] + (size_t)(64 * kb) * NE; t.ldw = NE; t.dst = wsp<bf16>(F, WS_WR) + 64 * kb; t.K = D; t.gk = args.in[12] + 64 * kb; }
    else if ((r -= I_R) < NE * I_GU) { const int e = r / I_GU, q = r % I_GU, kb = q / 64, n0 = 32 * (q % 64), pn = n0 >> 8, c = n0 & 255;
        const int sc = c < 128 ? pn * 128 + c : 1024 + pn * 128 + (c - 128);
        t.src = args.in[15] + ((size_t)e * D + 64 * kb) * 2048 + sc; t.ldw = 2048; t.dst = wsp<unsigned char>(F, WS_WGU) + ((size_t)e * 2048 + n0) * D + 64 * kb; t.K = D; t.f8 = 1; t.gk = args.in[12] + 64 * kb; }
    else { r -= NE * I_GU; const int e = r / I_DN, q = r % I_DN, kb = q / 32, n0 = 32 * (q % 32);
        t.src = args.in[17] + ((size_t)e * FF + 64 * kb) * D + n0; t.ldw = D; t.dst = wsp<unsigned char>(F, WS_WDN) + ((size_t)e * D + n0) * FF + 64 * kb; t.K = FF; t.f8 = 1; }
    return t;
}
constexpr int BGS_CONV = 0, BGS_KPART = 4, BGS_ROUTE = 6, BGS_STATE = 8, BGS_MIXA = 12, BGS_MIXB = 20, BGS_END = 22;
struct Bg { float v[32]; TrItem it; int live; };
constexpr int I_SMALL = I_IN + 2 * I_SQ + I_PP + I_R, NBG = 4096;
template <bool REMAP>
__device__ __forceinline__ void tr_run(Frame& F, const Args& args, int first, int count, int w, int nw) {
    LAS float* scr = (LAS float*)(F.lds + F.wave * 16384); const int lane = F.lane;
    float v[32], nv[32]; int q = w;
#define TR_ITEM(qq) (REMAP ? ((qq) < I_SMALL ? (qq) : (qq) + NBG) : first + (qq))
    TrItem cur = tr_decode(F, args, TR_ITEM(q < count ? q : 0));
    if (q < count) tr_load(cur, v, lane);
    while (q < count) { const int nq = q + nw; TrItem nx = tr_decode(F, args, TR_ITEM(nq < count ? nq : 0));
        if (nq < count) tr_load(nx, nv, lane);
        tr_store(cur, v, scr, lane);
#pragma unroll
        for (int i = 0; i < 32; ++i) v[i] = nv[i];
        cur = nx; q = nq; }
#undef TR_ITEM
}
__device__ __forceinline__ void bg_issue(const Frame& F, const Args& args, Bg& bg, int slot) {
    if (F.G != 256) { bg.live = 0; return; }
    int ln = F.lane; asm volatile("" : "+v"(ln));
    const int item = I_SMALL + NBG + (slot * 256 + F.bid) * NWAVES + F.wave; bg.live = item < NITEMS;
    bg.it = tr_decode(F, args, bg.live ? item : I_SMALL);
    if (bg.live) tr_load(bg.it, bg.v, ln);
}
__device__ __forceinline__ void bg_retire(const Frame& F, Bg& bg) { int ln = F.lane; asm volatile("" : "+v"(ln)); if (bg.live) tr_store(bg.it, bg.v, (LAS float*)(F.lds + BG_SCR + F.wave * 8448), ln); }
#define BG_DECL(base, n) Bg bg; int bg_s = (base); const int bg_e = (base) + (n); bg.live = 0
#define BG_TOP() do { if (bg_s < bg_e) bg_issue(F, args, bg, bg_s); } while (0)
#define BG_BOT() do { if (bg_s < bg_e) { bg_retire(F, bg); ++bg_s; } } while (0)
#define BG_FLUSH() do { while (bg_s < bg_e) { bg_issue(F, args, bg, bg_s); bg_retire(F, bg); ++bg_s; } } while (0)
__device__ __forceinline__ void p0_prologue(Frame& F, const Args& args) {
    const int gw = F.bid * NWAVES + F.wave, NGW = F.G * NWAVES, lane = F.lane;
    tr_run<false>(F, args, 0, F.G == 256 ? I_SMALL : NITEMS, gw, NGW);
    __syncthreads();
    { LAS float* slab = (LAS float*)F.lds;
      f32x4 w[8];
#pragma unroll
      for (int q = 0; q < 8; ++q) { const int e = F.tid + NTHR * q; w[q] = *(const f32x4*)(args.in[3] + (size_t)(e >> 2) * PROJ + 2048 + (e & 3) * 4); }
#pragma unroll
      for (int q = 0; q < 8; ++q) { const int e = F.tid + NTHR * q, k = e >> 2, c4 = (e & 3) * 4;
          slab[(c4 + 0) * D + k] = w[q].x; slab[(c4 + 1) * D + k] = w[q].y; slab[(c4 + 2) * D + k] = w[q].z; slab[(c4 + 3) * D + k] = w[q].w; } }
    __syncthreads();
    bf16* XN = wsp<bf16>(F, WS_XN); float* GT = wsp<float>(F, WS_GATES);
    f32x4 nv[2][4];
#pragma unroll
    for (int r = 0; r < 2; ++r) if (gw + r * NGW < M) {
#pragma unroll
        for (int j = 0; j < 4; ++j) nv[r][j] = __builtin_nontemporal_load((const f32x4*)(args.in[0] + (size_t)(gw + r * NGW) * D) + lane + 64 * j); }
    for (int m = gw; m < M; m += 2 * NGW) {
        const f32x4* gr = (const f32x4*)args.in[2] + lane;
        f32x4 v[2][4]; const bool two = m + NGW < M;
#pragma unroll
        for (int r = 0; r < 2; ++r)
#pragma unroll
            for (int j = 0; j < 4; ++j) v[r][j] = (r == 0 || two) ? nv[r][j] : (f32x4){0.f, 0.f, 0.f, 0.f};
#pragma unroll
        for (int r = 0; r < 2; ++r) if (m + (2 + r) * NGW < M) {
#pragma unroll
            for (int j = 0; j < 4; ++j) nv[r][j] = __builtin_nontemporal_load((const f32x4*)(args.in[0] + (size_t)(m + (2 + r) * NGW) * D) + lane + 64 * j); }
        asm volatile("" ::: "memory");
#pragma unroll
        for (int r = 0; r < 2; ++r) { float s = 0.f;
#pragma unroll
            for (int j = 0; j < 4; ++j) s += (v[r][j].x * v[r][j].x + v[r][j].y * v[r][j].y) + (v[r][j].z * v[r][j].z + v[r][j].w * v[r][j].w);
            const float rstd = 1.0f / sqrtf(wave_sum(s) * (1.0f / D) + RMS_EPS);
#pragma unroll
            for (int j = 0; j < 4; ++j) { const f32x4 g = gr[64 * j]; v[r][j] = v[r][j] * rstd * g;
                if (r == 0 || two) *(v2u*)(XN + (size_t)(m + r * NGW) * D + 256 * j + 4 * lane) = (v2u){pk2(v[r][j].x, v[r][j].y), pk2(v[r][j].z, v[r][j].w)}; } }
        float ga[32];
#pragma unroll
        for (int c = 0; c < 16; ++c) { float a0 = 0.f, a1 = 0.f;
#pragma unroll
            for (int j = 0; j < 4; ++j) { const f32x4 w = *(const LAS f32x4*)((LAS float*)F.lds + c * D + 256 * j + 4 * lane);
                a0 += (v[0][j].x * w.x + v[0][j].y * w.y) + (v[0][j].z * w.z + v[0][j].w * w.w); a1 += (v[1][j].x * w.x + v[1][j].y * w.y) + (v[1][j].z * w.z + v[1][j].w * w.w); }
            ga[c] = a0; ga[16 + c] = a1; }
#define BFLY(HALF, BIT) { const bool up = lane & (BIT); _Pragma("unroll") for (int c = 0; c < (HALF); ++c) { const float mine = up ? ga[c + (HALF)] : ga[c], oth = up ? ga[c] : ga[c + (HALF)]; ga[c] = mine + __shfl_xor(oth, (BIT)); } }
        BFLY(16, 1) BFLY(8, 2) BFLY(4, 4) BFLY(2, 8) BFLY(1, 16)
#undef BFLY
        ga[0] += __shfl_xor(ga[0], 32);
        if (lane < 32) { const int idx = 16 * (lane & 1) + 8 * ((lane >> 1) & 1) + 4 * ((lane >> 2) & 1) + 2 * ((lane >> 3) & 1) + ((lane >> 4) & 1); const int r = idx >> 4, col = idx & 15;
            if (r == 0 || two) GT[(size_t)(m + r * NGW) * 16 + col] = ga[0] + (col < 8 ? args.in[6][col] : args.in[7][col - 8]); }
    }
    bf16* PB = wsp<bf16>(F, WS_PB);
    { const size_t n4 = (size_t)M * PLE / 4, st = (size_t)F.G * NTHR;
      for (size_t i0 = (size_t)F.bid * NTHR + F.tid; i0 < n4; i0 += 4 * st) { f32x4 t[4];
#pragma unroll
          for (int q = 0; q < 4; ++q) if (i0 + q * st < n4) t[q] = ((const f32x4*)args.in[1])[i0 + q * st];
#pragma unroll
          for (int q = 0; q < 4; ++q) if (i0 + q * st < n4) *(v2u*)(PB + 4 * (i0 + q * st)) = (v2u){pk2(t[q].x, t[q].y), pk2(t[q].z, t[q].w)}; } }
}

__device__ __forceinline__ float logsigmoidf_(float f) { return f >= 0.f ? -log1pf(__expf(-f)) : f - log1pf(__expf(f)); }
__device__ __forceinline__ void gate_scans(Frame& F, int first, int stride) {
    { const float* GT = wsp<float>(F, WS_GATES); float* SA = wsp<float>(F, WS_SA); float* SMX = wsp<float>(F, WS_SMX); float* SB = wsp<float>(F, WS_SB); float* SW = wsp<float>(F, WS_SW);
      float* DEC = wsp<float>(F, WS_DEC); float* MC = wsp<float>(F, WS_MC);
      LAS float* sbl = (LAS float*)(F.lds + 4096); LAS float* sA = sbl + 64; LAS float* sm = sA + 64;
      for (int bh = first; bh < NBH; bh += stride) {
          const int b = bh / NH, h = bh % NH;
          __syncthreads();
          for (int c = F.wave; c < NCH; c += NWAVES) {
              const size_t m0 = (size_t)b * SEQ + c * LCH + 2 * F.lane;
              const float i0 = GT[m0 * 16 + h], i1 = GT[(m0 + 1) * 16 + h];
              const float l0 = logsigmoidf_(GT[m0 * 16 + 8 + h]), l1 = logsigmoidf_(GT[(m0 + 1) * 16 + 8 + h]);
              float s = l0 + l1, inc = s;
#pragma unroll
              for (int o = 1; o < 64; o <<= 1) { const float t = __shfl_up(inc, o); if (F.lane >= o) inc += t; }
              const float b0 = (inc - s) + l0, b1 = inc;
              const float a0 = i0 - b0, a1 = i1 - b1;
              float mx = fmaxf(a0, a1), pm = mx;
#pragma unroll
              for (int o = 1; o < 64; o <<= 1) { const float t = __shfl_up(pm, o); if (F.lane >= o) pm = fmaxf(pm, t); }
              float ex = __shfl_up(pm, 1); if (F.lane == 0) ex = -INFINITY;
              const float cm0 = fmaxf(ex, a0), cm1 = fmaxf(cm0, a1);
              const size_t o0 = (size_t)bh * SEQ + c * LCH + 2 * F.lane;
              SA[o0] = a0; SA[o0 + 1] = a1; SB[o0] = b0; SB[o0 + 1] = b1; SMX[o0] = cm0; SMX[o0 + 1] = cm1;
              if (F.lane == 63) { sbl[c] = b1; sA[c] = cm1; }
          }
          __syncthreads();
          if (F.tid == 0) { float m = 0.f; for (int c = 0; c < NCH; ++c) { sm[c] = m; m = sbl[c] + fmaxf(m, sA[c]); } sm[NCH] = m; }
          VM_WAIT(); __syncthreads();
          for (int c = F.wave; c < NCH; c += NWAVES) {
              const float mc = sm[c], mn = sm[c + 1], bL = sbl[c];
              const size_t o0 = (size_t)bh * SEQ + c * LCH + 2 * F.lane;
              const float a0 = SA[o0], a1 = SA[o0 + 1], c0 = SMX[o0], c1 = SMX[o0 + 1];
              SMX[o0] = fmaxf(mc, c0); SMX[o0 + 1] = fmaxf(mc, c1);
              SW[o0] = __expf(bL + a0 - mn); SW[o0 + 1] = __expf(bL + a1 - mn);
              if (F.lane == 0) { DEC[bh * NCH + c] = __expf(bL + mc - mn); MC[bh * NCH + c] = mc; }
          }
      } }
}
__device__ __forceinline__ void p_prep(Frame& F, const Args& args) {
    const bf16* U = wsp<bf16>(F, WS_U);
    { bf16* QM = wsp<bf16>(F, WS_QM); bf16* KM = wsp<bf16>(F, WS_KM);
      BG_DECL(BGS_CONV, 4);
      const size_t cst = (size_t)F.G * NTHR, ctot = (size_t)(M / 4) * 128; const int cit = (int)((ctot + cst - 1) / cst), cq = (cit + 3) / 4;
      for (int sl = 0; sl < 4; ++sl) { BG_TOP();
      for (int kk = sl * cq; kk < (sl + 1) * cq && kk < cit; ++kk) { const size_t i = (size_t)F.bid * NTHR + F.tid + (size_t)kk * cst; if (i >= ctot) break;
          const int m0 = (int)(i >> 7) * 4, ch = (int)(i & 127) * 8, t0 = m0 & (SEQ - 1);
          float xin[7][8];
#pragma unroll
          for (int j = 0; j < 7; ++j) { v4u w = {0u, 0u, 0u, 0u}; if (t0 - 3 + j >= 0) w = *(const v4u*)(U + (size_t)(m0 - 3 + j) * NU + ch);
              xin[j][0] = bflo(w.x); xin[j][1] = bfhi(w.x); xin[j][2] = bflo(w.y); xin[j][3] = bfhi(w.y); xin[j][4] = bflo(w.z); xin[j][5] = bfhi(w.z); xin[j][6] = bflo(w.w); xin[j][7] = bfhi(w.w); }
          float cw[4][8], cb[8];
#pragma unroll
          for (int j = 0; j < 4; ++j) { const f32x4 c0 = *(const f32x4*)(args.in[4] + j * 1024 + ch), c1 = *(const f32x4*)(args.in[4] + j * 1024 + ch + 4);
              cw[j][0] = c0.x; cw[j][1] = c0.y; cw[j][2] = c0.z; cw[j][3] = c0.w; cw[j][4] = c1.x; cw[j][5] = c1.y; cw[j][6] = c1.z; cw[j][7] = c1.w; }
          { const f32x4 b0 = *(const f32x4*)(args.in[5] + ch), b1 = *(const f32x4*)(args.in[5] + ch + 4); cb[0] = b0.x; cb[1] = b0.y; cb[2] = b0.z; cb[3] = b0.w; cb[4] = b1.x; cb[5] = b1.y; cb[6] = b1.z; cb[7] = b1.w; }
          const float sc = ch < 512 ? 0.125f : 1.0f;
#pragma unroll
          for (int tt = 0; tt < 4; ++tt) { float y[8];
#pragma unroll
              for (int e = 0; e < 8; ++e) { float a = cb[e];
#pragma unroll
                  for (int j = 0; j < 4; ++j) a += xin[tt + j][e] * cw[j][e];
                  y[e] = a * sigmoidf_(a) * sc; }
              bf16* o = ch < 512 ? QM + (size_t)(m0 + tt) * WM + ch : KM + (size_t)(m0 + tt) * WM + (ch - 512);
              *(v4u*)o = (v4u){pk2(y[0], y[1]), pk2(y[2], y[3]), pk2(y[4], y[5]), pk2(y[6], y[7])}; } }
      BG_BOT(); } }
    { bf16* KN = wsp<bf16>(F, WS_KN); bf16* VT = wsp<bf16>(F, WS_VT); float* KMEAN = wsp<float>(F, WS_KMEAN);
      LAS float* red = (LAS float*)F.lds;
      LAS unsigned char* vtl = F.lds + 4096;
      BG_DECL(BGS_KPART, 2);
      for (int un = F.bid; un < NBH * NBK; un += F.G) { BG_TOP();
          const int bh = un / NBK, j = un % NBK, b = bh / NH, h = bh % NH;
          const int key = F.tid >> 1, hf = F.tid & 1; const size_t m = (size_t)b * SEQ + j * MBS + key;
          __syncthreads();
          float kv[32]; float ss = 0.f;
#pragma unroll
          for (int i = 0; i < 4; ++i) { const v4u w = *(const v4u*)(U + m * NU + UKB + h * HD + 32 * hf + 8 * i);
              kv[8 * i] = bflo(w.x); kv[8 * i + 1] = bfhi(w.x); kv[8 * i + 2] = bflo(w.y); kv[8 * i + 3] = bfhi(w.y); kv[8 * i + 4] = bflo(w.z); kv[8 * i + 5] = bfhi(w.z); kv[8 * i + 6] = bflo(w.w); kv[8 * i + 7] = bfhi(w.w); }
#pragma unroll
          for (int e = 0; e < 32; ++e) ss += kv[e] * kv[e];
          ss += __shfl_xor(ss, 1);
          const float rstd = 1.0f / sqrtf(ss * (1.0f / HD) + RMS_EPS);
#pragma unroll
          for (int e = 0; e < 32; ++e) kv[e] = kv[e] * rstd * args.in[10][32 * hf + e];
#pragma unroll
          for (int i = 0; i < 4; ++i) *(v4u*)(KN + m * WM + h * HD + 32 * hf + 8 * i) = (v4u){pk2(kv[8 * i], kv[8 * i + 1]), pk2(kv[8 * i + 2], kv[8 * i + 3]), pk2(kv[8 * i + 4], kv[8 * i + 5]), pk2(kv[8 * i + 6], kv[8 * i + 7])};
#pragma unroll
          for (int e = 0; e < 32; ++e) { float a = kv[e]; a += __shfl_xor(a, 2); a += __shfl_xor(a, 4); a += __shfl_xor(a, 8); a += __shfl_xor(a, 16); a += __shfl_xor(a, 32); kv[e] = a; }
          if (F.lane < 2) {
#pragma unroll
              for (int e = 0; e < 32; ++e) red[F.wave * 64 + 32 * hf + e] = kv[e]; }
#pragma unroll
          for (int i = 0; i < 4; ++i) { const v4u w = *(const v4u*)(U + m * NU + UVB + h * HD + 32 * hf + 8 * i); const unsigned ww[4] = {w.x, w.y, w.z, w.w};
#pragma unroll
              for (int e = 0; e < 4; ++e) { *(LAS unsigned short*)(vtl + (32 * hf + 8 * i + 2 * e) * 528 + 2 * key) = (unsigned short)(ww[e] & 0xffffu); *(LAS unsigned short*)(vtl + (32 * hf + 8 * i + 2 * e + 1) * 528 + 2 * key) = (unsigned short)(ww[e] >> 16); } }
          __syncthreads();
          if (F.wave == 0) { float sm = 0.f;
#pragma unroll
              for (int w = 0; w < NWAVES; ++w) sm += red[w * 64 + F.lane];
              KMEAN[(size_t)un * HD + F.lane] = sm * (1.0f / MBS); }
          { const int d = F.tid >> 3, pc = F.tid & 7;
#pragma unroll
            for (int i = 0; i < 4; ++i) *(v4u*)(VT + ((size_t)bh * HD + d) * SEQ + j * MBS + pc * 32 + 8 * i) = *(const LAS v4u*)(vtl + d * 528 + (pc * 32 + 8 * i) * 2); }
          BG_BOT();
      } }
    if (F.G != 256) gate_scans(F, F.bid, F.G);

}

__device__ __forceinline__ void mlstm_state(Frame& F, const Args& args);
__device__ __forceinline__ int pair_idx(int i, int j) { return i * (i - 1) / 2 + j; }
__device__ __forceinline__ void p_route(Frame& F, const Args& args) {
    const bf16* U = wsp<bf16>(F, WS_U); bf16* QN = wsp<bf16>(F, WS_QN); const float* KMEAN = wsp<float>(F, WS_KMEAN);
    int* MLIST = wsp<int>(F, WS_MLIST); int* MCNT = wsp<int>(F, WS_MCNT);
    LAS float* skm = (LAS float*)F.lds;
    LAS int* ssel = (LAS int*)(F.lds + 8192);
    LAS int* wtot = (LAS int*)(F.lds + 8192 + 3072);
    BG_DECL(BGS_ROUTE, 2);
    for (int un = F.bid; un < NBH * NBK; un += F.G) { BG_TOP();
        const int bh = un / NBK, i = un % NBK, b = bh / NH, h = bh % NH;
        __syncthreads();
        for (int e = F.tid; e < NBK * HD; e += NTHR) skm[e] = KMEAN[(size_t)bh * NBK * HD + e];
        __syncthreads();
        BG_BOT();
        int s0 = -1, s1 = -1, s2 = -1;
        if (F.tid < MBS) {
            const size_t m = (size_t)b * SEQ + i * MBS + F.tid;
            float q[HD]; float ss = 0.f;
#pragma unroll
            for (int d8 = 0; d8 < 8; ++d8) { const v4u w = *(const v4u*)(U + m * NU + UQB + h * HD + 8 * d8);
                q[8 * d8 + 0] = bflo(w.x); q[8 * d8 + 1] = bfhi(w.x); q[8 * d8 + 2] = bflo(w.y); q[8 * d8 + 3] = bfhi(w.y);
                q[8 * d8 + 4] = bflo(w.z); q[8 * d8 + 5] = bfhi(w.z); q[8 * d8 + 6] = bflo(w.w); q[8 * d8 + 7] = bfhi(w.w); }
#pragma unroll
            for (int d = 0; d < HD; ++d) ss += q[d] * q[d];
            const float rstd = 1.0f / sqrtf(ss * (1.0f / HD) + RMS_EPS);
#pragma unroll
            for (int d = 0; d < HD; ++d) q[d] = q[d] * rstd * args.in[9][d] * 0.125f;
#pragma unroll
            for (int d8 = 0; d8 < 8; ++d8) { v4u w; w.x = pk2(q[8 * d8] * LOG2E, q[8 * d8 + 1] * LOG2E); w.y = pk2(q[8 * d8 + 2] * LOG2E, q[8 * d8 + 3] * LOG2E); w.z = pk2(q[8 * d8 + 4] * LOG2E, q[8 * d8 + 5] * LOG2E); w.w = pk2(q[8 * d8 + 6] * LOG2E, q[8 * d8 + 7] * LOG2E);
                *(v4u*)(QN + m * WM + h * HD + 8 * d8) = w; }
            float v0 = -INFINITY, v1 = -INFINITY, v2 = -INFINITY;
            for (int j = 0; j < i; ++j) {
                float g = 0.f; const LAS f32x4* kp = (const LAS f32x4*)(skm + j * HD);
#pragma unroll
                for (int d4 = 0; d4 < HD / 4; ++d4) { const f32x4 w = kp[d4]; g += (q[4 * d4] * w.x + q[4 * d4 + 1] * w.y) + (q[4 * d4 + 2] * w.z + q[4 * d4 + 3] * w.w); }
                if (g > v0) { v2 = v1; s2 = s1; v1 = v0; s1 = s0; v0 = g; s0 = j; }
                else if (g > v1) { v2 = v1; s2 = s1; v1 = g; s1 = j; }
                else if (g > v2) { v2 = g; s2 = j; }
            }
            ssel[F.tid * 3 + 0] = s0; ssel[F.tid * 3 + 1] = s1; ssel[F.tid * 3 + 2] = s2;
        }
        if (F.wave < 4) { for (int j = 0; j < i; ++j) { const bool f = (s0 == j) || (s1 == j) || (s2 == j); const unsigned long long mk = __ballot(f); if (F.lane == 0) wtot[j * 4 + F.wave] = __popcll(mk); } }
        __syncthreads();
        if (F.wave < 4) { for (int j = 0; j < i; ++j) { const bool f = (s0 == j) || (s1 == j) || (s2 == j); const unsigned long long mk = __ballot(f);
                int base = 0; for (int w = 0; w < F.wave; ++w) base += wtot[j * 4 + w];
                if (f) { const int pos = base + __popcll(mk & ((1ull << F.lane) - 1ull)); const int slot = (s0 == j) ? 0 : ((s1 == j) ? 1 : 2);
                    MLIST[((size_t)bh * NPAIR + pair_idx(i, j)) * MBS + pos] = F.tid | (slot << 8); } } }
        if (F.tid < i) MCNT[bh * NPAIR + pair_idx(i, F.tid)] = wtot[F.tid * 4] + wtot[F.tid * 4 + 1] + wtot[F.tid * 4 + 2] + wtot[F.tid * 4 + 3];
    }
    __syncthreads();
    mlstm_state(F, args);
}

__device__ __forceinline__ float moba_m0(const Frame& F, const Args& args) { return 8.0f * wave_max(fabsf(args.in[9][F.lane])) * wave_max(fabsf(args.in[10][F.lane])); }


constexpr int MB_VOFF = 32768, MB_VSTR = 520, MB_MISC = MB_VOFF + 64 * MB_VSTR;
__device__ __forceinline__ void moba_kv_fetch(const Frame& F, int bh, int j, v4u (&kv)[8]) {
    const bf16* KN = wsp<bf16>(F, WS_KN); const bf16* VT = wsp<bf16>(F, WS_VT); const int b = bh / NH, head = bh % NH;
#pragma unroll
    for (int k = 0; k < 4; ++k) { const int p = F.tid + NTHR * k, key = p >> 3, c = p & 7; kv[k] = *(const v4u*)(KN + ((size_t)b * SEQ + j * MBS + key) * WM + head * HD + c * 8); }
#pragma unroll
    for (int k = 0; k < 4; ++k) { const int p = F.tid + NTHR * k, d = p >> 5, c = p & 31; kv[4 + k] = *(const v4u*)(VT + ((size_t)bh * HD + d) * SEQ + j * MBS + c * 8); }
}
__device__ __forceinline__ void moba_kv_put(const Frame& F, const v4u (&kv)[8]) {
#pragma unroll
    for (int k = 0; k < 4; ++k) { const int p = F.tid + NTHR * k, key = p >> 3, c = p & 7; *(LAS v4u*)(F.lds + key * 128 + ((c ^ ((key >> 1) & 7)) << 4)) = kv[k]; }
#pragma unroll
    for (int k = 0; k < 4; ++k) { const int p = F.tid + NTHR * k, d = p >> 5, c = p & 31; const v4u w = kv[4 + k];
        LAS v2u* dst = (LAS v2u*)(F.lds + MB_VOFF + d * MB_VSTR + c * 16); dst[0] = (v2u){w.x, w.y}; dst[1] = (v2u){w.z, w.w}; }
}
__device__ __forceinline__ void moba_load_kv(const Frame& F, int bh, int j) { v4u kv[8]; moba_kv_fetch(F, bh, j, kv); moba_kv_put(F, kv); }
template <bool MASK>
__device__ __forceinline__ void moba_core(LAS const unsigned char* lds, const bf16x8 (&qf)[4], f32x16 (&o)[2], float& l, int nkt, int dkey0, float slope2, float m0l, int q, int h) {
    float br[16];
#pragma unroll
    for (int r = 0; r < 16; ++r) br[r] = slope2 * (float)((r & 3) + 8 * (r >> 2)) - m0l;
#pragma unroll 1
    for (int kt = 0; kt < nkt; ++kt) {
        const float cb = slope2 * (float)(dkey0 + 32 * kt);
        f32x16 s;
#pragma unroll
        for (int r = 0; r < 16; ++r) s[r] = br[r] + cb;
        const int key = 32 * kt + q, sw = (key >> 1) & 7;
#pragma unroll
        for (int s4 = 0; s4 < 4; ++s4) { const bf16x8 kf = *(const LAS bf16x8*)(lds + key * 128 + (((2 * s4 + h) ^ sw) << 4)); s = __builtin_amdgcn_mfma_f32_32x32x16_bf16(kf, qf[s4], s, 0, 0, 0); }
        float p[16];
#pragma unroll
        for (int r = 0; r < 16; ++r) { p[r] = __builtin_amdgcn_exp2f(s[r]); if (MASK && kt == nkt - 1 && ((r & 3) + 8 * (r >> 2) + 4 * h > q)) p[r] = 0.f; l += p[r]; }
        bf16x8 pb[2];
#pragma unroll
        for (int s2 = 0; s2 < 2; ++s2) { v4u w; w.x = pk2(p[8 * s2], p[8 * s2 + 1]); w.y = pk2(p[8 * s2 + 2], p[8 * s2 + 3]); w.z = pk2(p[8 * s2 + 4], p[8 * s2 + 5]); w.w = pk2(p[8 * s2 + 6], p[8 * s2 + 7]); pb[s2] = __builtin_bit_cast(bf16x8, w); }
#pragma unroll
        for (int mt = 0; mt < 2; ++mt)
#pragma unroll
            for (int s2 = 0; s2 < 2; ++s2) { const LAS unsigned char* vp = lds + MB_VOFF + (32 * mt + q) * MB_VSTR + (32 * kt + 16 * s2 + 4 * h) * 2;
                const v2u lo = *(const LAS v2u*)vp, hi = *(const LAS v2u*)(vp + 16); const v4u w = {lo.x, lo.y, hi.x, hi.y};
                o[mt] = __builtin_amdgcn_mfma_f32_32x32x16_bf16(__builtin_bit_cast(bf16x8, w), pb[s2], o[mt], 0, 0, 0); }
    }
}
__device__ __forceinline__ void moba_routed(Frame& F, const Args& args) {
    const bf16* QN = wsp<bf16>(F, WS_QN); const int* MLIST = wsp<int>(F, WS_MLIST); const int* MCNT = wsp<int>(F, WS_MCNT);
    bf16* OP = wsp<bf16>(F, WS_OP); float* LP = wsp<float>(F, WS_LP);
    const float m0l = moba_m0(F, args) * LOG2E;
    LAS int* utot = (LAS int*)(F.lds + MB_MISC); LAS int* ustart = utot + 512; LAS int* cpre = ustart + 512;
    constexpr int NQ = NBH * (NBK - 1);
    __syncthreads();
    if (F.tid < NQ) { const int bh = F.tid / (NBK - 1), j = F.tid % (NBK - 1); int t = 0; for (int i = j + 1; i < NBK; ++i) t += MCNT[bh * NPAIR + pair_idx(i, j)]; utot[F.tid] = t; }
    __syncthreads();
    if (F.wave == 0) {
        int loc[8], sum = 0;
#pragma unroll
        for (int e = 0; e < 8; ++e) { const int qq = F.lane * 8 + e; loc[e] = qq < NQ ? (utot[qq] + 255) >> 8 : 0; sum += loc[e]; }
        int inc = sum;
#pragma unroll
        for (int o = 1; o < 64; o <<= 1) { const int t = __shfl_up(inc, o); if (F.lane >= o) inc += t; }
        int a = inc - sum;
#pragma unroll
        for (int e = 0; e < 8; ++e) { const int qq = F.lane * 8 + e; if (qq <= NQ) ustart[qq] = a; a += loc[e]; }
    }
    __syncthreads();
    const int nunits = ustart[NQ];
    const int q = F.lane & 31, h = F.lane >> 5;
    BG_DECL(BGS_MIXA, 8);
    v4u kv[8];
    if (F.bid < nunits) { int lo = 0, hi = NQ; while (hi - lo > 1) { const int mid = (lo + hi) >> 1; if (ustart[mid] <= F.bid) lo = mid; else hi = mid; }
        moba_kv_fetch(F, lo / (NBK - 1), lo % (NBK - 1), kv); }
    for (int un = F.bid; un < nunits; un += F.G) {
        int lo = 0, hi = NQ;
        while (hi - lo > 1) { const int mid = (lo + hi) >> 1; if (ustart[mid] <= un) lo = mid; else hi = mid; }
        const int qq = lo, chunk = un - ustart[qq], bh = qq / (NBK - 1), j = qq % (NBK - 1), b = bh / NH, head = bh % NH, tot = utot[qq];
        __syncthreads();
        if (F.wave == 0) { const int i = j + 1 + F.lane; const int cnt = i < NBK ? MCNT[bh * NPAIR + pair_idx(i, j)] : 0; int inc = cnt;
#pragma unroll
            for (int o = 1; o < 32; o <<= 1) { const int t = __shfl_up(inc, o); if (F.lane >= o) inc += t; }
            if (i <= NBK) cpre[i] = inc - cnt; }
        moba_kv_put(F, kv);
        __syncthreads();
        if (un + F.G < nunits) { int l2 = 0, h2 = NQ; while (h2 - l2 > 1) { const int mid = (l2 + h2) >> 1; if (ustart[mid] <= un + F.G) l2 = mid; else h2 = mid; }
            moba_kv_fetch(F, l2 / (NBK - 1), l2 % (NBK - 1), kv); }
        const int gr = chunk * 256 + F.wave * 32 + q; const bool valid = gr < tot; const bool act = __ballot(valid) != 0ull;
        int slot = 0, tq = 0; size_t mq = 0; bf16x8 qf[4];
        if (act) {
            const int grc = valid ? gr : chunk * 256;
            int i = j + 1; while (cpre[i + 1] <= grc) ++i;
            const int ent = MLIST[((size_t)bh * NPAIR + pair_idx(i, j)) * MBS + (grc - cpre[i])]; const int qo = ent & 255; slot = ent >> 8;
            tq = i * MBS + qo; mq = (size_t)b * SEQ + tq;
#pragma unroll
            for (int s4 = 0; s4 < 4; ++s4) qf[s4] = *(const bf16x8*)(QN + mq * WM + head * HD + 16 * s4 + 8 * h); }
        BG_TOP();
        if (act) {
            f32x16 o[2]; float l = 0.f;
#pragma unroll
            for (int r = 0; r < 16; ++r) { o[0][r] = 0.f; o[1][r] = 0.f; }
            const float slope2 = exp2f(-(float)(head + 1)) * LOG2E;
            moba_core<false>(F.lds, qf, o, l, 8, j * MBS + 4 * h - tq, slope2, m0l, q, h);
            l += __shfl_xor(l, 32);
            if (valid) { bf16* op = OP + ((mq * NH + head) * 3 + slot) * HD;
#pragma unroll
                for (int mt = 0; mt < 2; ++mt)
#pragma unroll
                    for (int g = 0; g < 4; ++g) *(v2u*)(op + 32 * mt + 8 * g + 4 * h) = (v2u){pk2(o[mt][4 * g], o[mt][4 * g + 1]), pk2(o[mt][4 * g + 2], o[mt][4 * g + 3])};
                if (h == 0) LP[(mq * NH + head) * 3 + slot] = l; }
        }
        BG_BOT();
    }
    BG_FLUSH();
}
__device__ __forceinline__ void moba_own(Frame& F, const Args& args) {
    const bf16* QN = wsp<bf16>(F, WS_QN); const bf16* OP = wsp<bf16>(F, WS_OP); const float* LP = wsp<float>(F, WS_LP); bf16* MIX = wsp<bf16>(F, WS_MIX);
    const float m0l = moba_m0(F, args) * LOG2E;
    const int q = F.lane & 31, h = F.lane >> 5;
    BG_DECL(BGS_MIXB, 2);
    v4u kv[8];
    if (F.bid < NBH * NBK) moba_kv_fetch(F, F.bid / NBK, F.bid % NBK, kv);
    for (int un = F.bid; un < NBH * NBK; un += F.G) {
        const int bh = un / NBK, i = un % NBK, b = bh / NH, head = bh % NH;
        const int qo = F.wave * 32 + q; const size_t mq = (size_t)b * SEQ + i * MBS + qo;
        f32x16 o[2]; float l = 0.f;
#pragma unroll
        for (int r = 0; r < 16; ++r) { o[0][r] = 0.f; o[1][r] = 0.f; }
        const int nsel = i < 3 ? i : 3;
        for (int sl = 0; sl < nsel; ++sl) { const bf16* op = OP + ((mq * NH + head) * 3 + sl) * HD; if (h == 0) l += LP[(mq * NH + head) * 3 + sl];
#pragma unroll
            for (int mt = 0; mt < 2; ++mt)
#pragma unroll
                for (int g = 0; g < 4; ++g) { const v2u v = *(const v2u*)(op + 32 * mt + 8 * g + 4 * h); o[mt][4 * g] += bflo(v.x); o[mt][4 * g + 1] += bfhi(v.x); o[mt][4 * g + 2] += bflo(v.y); o[mt][4 * g + 3] += bfhi(v.y); } }
        bf16x8 qf[4];
#pragma unroll
        for (int s4 = 0; s4 < 4; ++s4) qf[s4] = *(const bf16x8*)(QN + mq * WM + head * HD + 16 * s4 + 8 * h);
        __syncthreads();
        moba_kv_put(F, kv);
        __syncthreads();
        if (un + F.G < NBH * NBK) moba_kv_fetch(F, (un + F.G) / NBK, (un + F.G) % NBK, kv);
        BG_TOP();
        const float slope2 = exp2f(-(float)(head + 1)) * LOG2E;
        moba_core<true>(F.lds, qf, o, l, F.wave + 1, 4 * h - qo, slope2, m0l, q, h);
        l += __shfl_xor(l, 32);
        const float inv = 1.0f / l;
#pragma unroll
        for (int mt = 0; mt < 2; ++mt)
#pragma unroll
            for (int g = 0; g < 4; ++g) *(v2u*)(MIX + mq * D + WM + head * HD + 32 * mt + 8 * g + 4 * h) = (v2u){pk2(o[mt][4 * g] * inv, o[mt][4 * g + 1] * inv), pk2(o[mt][4 * g + 2] * inv, o[mt][4 * g + 3] * inv)};
        BG_BOT();
    }
}


constexpr int ML_STR = 272;
typedef LAS unsigned short* lds_u16p;
__device__ __forceinline__ void mlstm_state(Frame& F, const Args& args) {
    const bf16* U = wsp<bf16>(F, WS_U); const bf16* KM = wsp<bf16>(F, WS_KM); const float* SW = wsp<float>(F, WS_SW); float* DC = wsp<float>(F, WS_DC); float* DN = wsp<float>(F, WS_DN);
    LAS unsigned char* vt = F.lds; LAS unsigned char* kt = F.lds + 64 * ML_STR; LAS float* sw = (LAS float*)(F.lds + 128 * ML_STR);
    const int l15 = F.lane & 15, kq = F.lane >> 4;
    BG_DECL(BGS_STATE, 4);
    v4u pk_[2], pv_[2]; float pw_[2], psw = 0.f;
#define ST_FETCH(UN) do { const int bh_ = (UN) / NCH, c_ = (UN) % NCH, b_ = bh_ / NH, hd_ = bh_ % NH; const size_t m0_ = (size_t)b_ * SEQ + c_ * LCH; \
        if (F.tid < LCH) psw = SW[(size_t)bh_ * SEQ + c_ * LCH + F.tid]; \
        _Pragma("unroll") for (int k = 0; k < 2; ++k) { const int p = F.tid + NTHR * k, sidx = p >> 3, cc = p & 7; pw_[k] = SW[(size_t)bh_ * SEQ + c_ * LCH + sidx]; \
            pk_[k] = *(const v4u*)(KM + (m0_ + sidx) * WM + hd_ * HD + 8 * cc); pv_[k] = *(const v4u*)(U + (m0_ + sidx) * NU + UVM + hd_ * HD + 8 * cc); } } while (0)
    if (F.bid < NBH * NCH) ST_FETCH(F.bid);
    for (int un = F.bid; un < NBH * NCH; un += F.G) {
        __syncthreads();
        if (F.tid < LCH) sw[F.tid] = psw;
#pragma unroll
        for (int k = 0; k < 2; ++k) { const int p = F.tid + NTHR * k, sidx = p >> 3, cc = p & 7;
            const float w = pw_[k]; const v4u kv = pk_[k], vv = pv_[k];
            const unsigned kw[4] = {kv.x, kv.y, kv.z, kv.w}, vw[4] = {vv.x, vv.y, vv.z, vv.w};
#pragma unroll
            for (int e = 0; e < 4; ++e) {
                *(lds_u16p)(kt + (8 * cc + 2 * e) * ML_STR + 2 * sidx) = (unsigned short)(kw[e] & 0xffffu); *(lds_u16p)(kt + (8 * cc + 2 * e + 1) * ML_STR + 2 * sidx) = (unsigned short)(kw[e] >> 16);
                const unsigned pw = pk2(w * bflo(vw[e]), w * bfhi(vw[e]));
                *(lds_u16p)(vt + (8 * cc + 2 * e) * ML_STR + 2 * sidx) = (unsigned short)(pw & 0xffffu); *(lds_u16p)(vt + (8 * cc + 2 * e + 1) * ML_STR + 2 * sidx) = (unsigned short)(pw >> 16); } }
        if (un + F.G < NBH * NCH) ST_FETCH(un + F.G);
        BG_TOP();
        __syncthreads();
#pragma unroll
        for (int tt = 0; tt < 2; ++tt) { const int tile = 2 * F.wave + tt, mt = tile >> 2, nt = tile & 3; f32x4 acc = {0.f, 0.f, 0.f, 0.f};
#pragma unroll
            for (int ks = 0; ks < 4; ++ks) { const bf16x8 av = *(const LAS bf16x8*)(vt + (16 * mt + l15) * ML_STR + (32 * ks + 8 * kq) * 2), bv = *(const LAS bf16x8*)(kt + (16 * nt + l15) * ML_STR + (32 * ks + 8 * kq) * 2);
                acc = __builtin_amdgcn_mfma_f32_16x16x32_bf16(av, bv, acc, 0, 0, 0); }
#pragma unroll
            for (int r = 0; r < 4; ++r) DC[(size_t)un * 4096 + (16 * mt + 4 * kq + r) * HD + 16 * nt + l15] = acc[r]; }
        if (F.tid < HD) { float a = 0.f;
#pragma unroll 8
            for (int sidx = 0; sidx < LCH; ++sidx) a += sw[sidx] * bf2f(*(lds_u16p)(kt + F.tid * ML_STR + 2 * sidx));
            DN[(size_t)un * HD + F.tid] = a; }
        BG_BOT();
    }
#undef ST_FETCH
}
__device__ __forceinline__ void mlstm_out(Frame& F, const Args& args) {
    const bf16* U = wsp<bf16>(F, WS_U); const bf16* QM = wsp<bf16>(F, WS_QM); const bf16* KM = wsp<bf16>(F, WS_KM);
    const float* SA = wsp<float>(F, WS_SA); const float* SMX = wsp<float>(F, WS_SMX); const float* SB = wsp<float>(F, WS_SB);
    const float* CS = wsp<float>(F, WS_CS); const float* NS = wsp<float>(F, WS_NS); const float* MC = wsp<float>(F, WS_MC); bf16* MIX = wsp<bf16>(F, WS_MIX);
    LAS unsigned char* sp = F.lds; LAS unsigned char* vt = F.lds + LCH * ML_STR;
    const int l15 = F.lane & 15, kq = F.lane >> 4, w = F.wave, t0 = 16 * w;
    for (int un = F.bid; un < NBH * NCH; un += F.G) {
        const int bh = un / NCH, c = un % NCH, b = bh / NH, head = bh % NH; const size_t m0 = (size_t)b * SEQ + c * LCH; const size_t g0 = (size_t)bh * SEQ + c * LCH;
        __syncthreads();
#pragma unroll
        for (int k = 0; k < 2; ++k) { const int p = F.tid + NTHR * k, sidx = p >> 3, cc = p & 7;
            const v4u vv = *(const v4u*)(U + (m0 + sidx) * NU + UVM + head * HD + 8 * cc); const unsigned vw[4] = {vv.x, vv.y, vv.z, vv.w};
#pragma unroll
            for (int e = 0; e < 4; ++e) { *(lds_u16p)(vt + (8 * cc + 2 * e) * ML_STR + 2 * sidx) = (unsigned short)(vw[e] & 0xffffu); *(lds_u16p)(vt + (8 * cc + 2 * e + 1) * ML_STR + 2 * sidx) = (unsigned short)(vw[e] >> 16); } }
        for (int e = F.tid; e < 16 * LCH; e += NTHR) { const int r = e >> 7, sidx = e & 127; *(lds_u16p)(vt + (64 + r) * ML_STR + 2 * sidx) = (unsigned short)(r == 0 ? 0x3F80u : 0u); }
        bf16x8 qa[2];
#pragma unroll
        for (int ks = 0; ks < 2; ++ks) qa[ks] = *(const bf16x8*)(QM + (m0 + t0 + l15) * WM + head * HD + 32 * ks + 8 * kq);
        float mx[4], sbv[4]; unsigned ogv[4][2];
#pragma unroll
        for (int r = 0; r < 4; ++r) { mx[r] = SMX[g0 + t0 + 4 * kq + r]; sbv[r] = SB[g0 + t0 + 4 * kq + r];
            const bf16* up = U + (m0 + t0 + 4 * kq + r) * NU + UOM + head * HD + l15;
            ogv[r][0] = (unsigned)up[0] | ((unsigned)up[16] << 16); ogv[r][1] = (unsigned)up[32] | ((unsigned)up[48] << 16); }
        bf16x8 kb[4][2]; float as[4];
#pragma unroll
        for (int st = 0; st < 4; ++st) if (st <= w) {
#pragma unroll
            for (int ks = 0; ks < 2; ++ks) kb[st][ks] = *(const bf16x8*)(KM + (m0 + 16 * st + l15) * WM + head * HD + 32 * ks + 8 * kq);
            as[st] = SA[g0 + 16 * st + l15]; }
        bf16x8 cf[2][5];
#pragma unroll
        for (int ks = 0; ks < 2; ++ks)
#pragma unroll
            for (int nt = 0; nt < 5; ++nt) { f32x4 c0, c1;
                if (nt < 4) { const float* cp = CS + (size_t)un * 4096 + (16 * nt + l15) * HD + 32 * ks + 8 * kq; c0 = *(const f32x4*)cp; c1 = *(const f32x4*)(cp + 4); }
                else { const float* np = NS + (size_t)un * HD + 32 * ks + 8 * kq; c0 = *(const f32x4*)np; c1 = *(const f32x4*)(np + 4); if (l15 != 0) { c0 = (f32x4){0.f, 0.f, 0.f, 0.f}; c1 = c0; } }
                const v4u wv = {pk2(c0.x, c0.y), pk2(c0.z, c0.w), pk2(c1.x, c1.y), pk2(c1.z, c1.w)}; cf[ks][nt] = __builtin_bit_cast(bf16x8, wv); }
#pragma unroll
        for (int hf = 0; hf < 2; ++hf) {
            if (hf == 1) {
#pragma unroll
                for (int st = 0; st < 4; ++st) if (st + 4 <= w) {
#pragma unroll
                    for (int ks = 0; ks < 2; ++ks) kb[st][ks] = *(const bf16x8*)(KM + (m0 + 16 * (st + 4) + l15) * WM + head * HD + 32 * ks + 8 * kq);
                    as[st] = SA[g0 + 16 * (st + 4) + l15]; } }
#pragma unroll
            for (int s4 = 0; s4 < 4; ++s4) { const int st = 4 * hf + s4; if (st <= w) {
                f32x4 acc = {0.f, 0.f, 0.f, 0.f};
                acc = __builtin_amdgcn_mfma_f32_16x16x32_bf16(qa[0], kb[s4][0], acc, 0, 0, 0); acc = __builtin_amdgcn_mfma_f32_16x16x32_bf16(qa[1], kb[s4][1], acc, 0, 0, 0);
#pragma unroll
                for (int r = 0; r < 4; ++r) { float v = acc[r] * __expf(as[s4] - mx[r]); if (st == w && l15 > 4 * kq + r) v = 0.f;
                    *(lds_u16p)(sp + (t0 + 4 * kq + r) * ML_STR + 2 * (16 * st + l15)) = (unsigned short)f2bf(v); } } }
        }
        if ((w & 1) == 0) {
#pragma unroll
            for (int r = 0; r < 4; ++r) *(lds_u16p)(sp + (t0 + 4 * kq + r) * ML_STR + 2 * (16 * (w + 1) + l15)) = (unsigned short)0; }
        __syncthreads();
        f32x4 a1[5], a2[5];
#pragma unroll
        for (int nt = 0; nt < 5; ++nt) { a1[nt] = (f32x4){0.f, 0.f, 0.f, 0.f}; a2[nt] = (f32x4){0.f, 0.f, 0.f, 0.f}; }
        const int nks = (w + 2) >> 1;
        for (int ks = 0; ks < nks; ++ks) { const bf16x8 av = *(const LAS bf16x8*)(sp + (t0 + l15) * ML_STR + (32 * ks + 8 * kq) * 2);
#pragma unroll
            for (int nt = 0; nt < 5; ++nt) { const bf16x8 bv = *(const LAS bf16x8*)(vt + (16 * nt + l15) * ML_STR + (32 * ks + 8 * kq) * 2); a1[nt] = __builtin_amdgcn_mfma_f32_16x16x32_bf16(av, bv, a1[nt], 0, 0, 0); } }
#pragma unroll
        for (int ks = 0; ks < 2; ++ks)
#pragma unroll
            for (int nt = 0; nt < 5; ++nt) a2[nt] = __builtin_amdgcn_mfma_f32_16x16x32_bf16(qa[ks], cf[ks][nt], a2[nt], 0, 0, 0);
        const float mc = MC[un];
#pragma unroll
        for (int r = 0; r < 4; ++r) { const int t = t0 + 4 * kq + r; const float sc = __expf(mc - mx[r]);
            float den = a1[4][r] + sc * a2[4][r]; den = __shfl(den, F.lane & 48);
            const float dn = fmaxf(fabsf(den), __expf(-(sbv[r] + mx[r]))); const float inv = 1.0f / dn;
            float hv[4], ss = 0.f;
#pragma unroll
            for (int nt = 0; nt < 4; ++nt) { hv[nt] = (a1[nt][r] + sc * a2[nt][r]) * inv; ss += hv[nt] * hv[nt]; }
            ss += __shfl_xor(ss, 1); ss += __shfl_xor(ss, 2); ss += __shfl_xor(ss, 4); ss += __shfl_xor(ss, 8);
            const float rstd = 1.0f / sqrtf(ss * (1.0f / HD) + RMS_EPS);
#pragma unroll
            for (int nt = 0; nt < 4; ++nt) { const int v = 16 * nt + l15; const float og = (nt & 1) ? bfhi(ogv[r][nt >> 1]) : bflo(ogv[r][nt >> 1]);
                MIX[(m0 + t) * D + head * HD + v] = (bf16)f2bf(hv[nt] * rstd * args.in[8][head * HD + v] * sigmoidf_(og)); } }
    }
}

__device__ __forceinline__ void mlstm_scan(Frame& F) {
    const float* DC = wsp<float>(F, WS_DC); const float* DN = wsp<float>(F, WS_DN); float* CS = wsp<float>(F, WS_CS); float* NS = wsp<float>(F, WS_NS); const float* DEC = wsp<float>(F, WS_DEC);
    constexpr int TOT = NBH * (4096 + HD); const int per = (TOT + F.G - 1) / F.G;
    for (int q = F.tid; q < per; q += NTHR) { const int e = F.bid * per + q; if (e >= TOT) break;
        const int bh = e / (4096 + HD), r = e % (4096 + HD);
        const float* src = r < 4096 ? DC + (size_t)bh * NCH * 4096 + r : DN + (size_t)bh * NCH * HD + (r - 4096);
        float* dst = r < 4096 ? CS + (size_t)bh * NCH * 4096 + r : NS + (size_t)bh * NCH * HD + (r - 4096);
        const size_t str = r < 4096 ? 4096 : HD;
        float st = 0.f;
#pragma unroll 1
        for (int c0 = 0; c0 < NCH; c0 += 32) { float d[32], g[32];
#pragma unroll
            for (int i = 0; i < 32; ++i) { d[i] = src[(size_t)(c0 + i) * str]; g[i] = DEC[bh * NCH + c0 + i]; }
#pragma unroll
            for (int i = 0; i < 32; ++i) { dst[(size_t)(c0 + i) * str] = st; st = g[i] * st + d[i]; } }
    }
}


__device__ __forceinline__ void mlstm_out2(Frame& F, const Args& args) {
    const bf16* U = wsp<bf16>(F, WS_U); const bf16* QM = wsp<bf16>(F, WS_QM); const bf16* KM = wsp<bf16>(F, WS_KM);
    const float* SA = wsp<float>(F, WS_SA); const float* SMX = wsp<float>(F, WS_SMX); const float* SB = wsp<float>(F, WS_SB);
    const float* CS = wsp<float>(F, WS_CS); const float* NS = wsp<float>(F, WS_NS); const float* MC = wsp<float>(F, WS_MC); bf16* MIX = wsp<bf16>(F, WS_MIX);
    LAS float* sa = (LAS float*)(F.lds + MB_MISC);
    const int q = F.lane & 31, h = F.lane >> 5, ci = F.wave >> 2, qt = F.wave & 3;
    constexpr int NUN = NBH * NCH / 2;
    v4u pk[4], pv[4]; float pa = 0.f;
#define MO_FETCH(UN) do { const int bh_ = (UN) / (NCH / 2), cp_ = (UN) % (NCH / 2), hd_ = bh_ % NH; const size_t m0_ = (size_t)(bh_ / NH) * SEQ + cp_ * 256; \
        if (F.tid < 256) pa = SA[(size_t)bh_ * SEQ + cp_ * 256 + F.tid]; \
        _Pragma("unroll") for (int k = 0; k < 4; ++k) { const int p = F.tid + NTHR * k, key = p >> 3, c = p & 7; \
            pk[k] = *(const v4u*)(KM + (m0_ + key) * WM + hd_ * HD + c * 8); pv[k] = *(const v4u*)(U + (m0_ + key) * NU + UVM + hd_ * HD + c * 8); } } while (0)
    for (int un = F.bid; un < NUN; un += F.G) { MO_FETCH(un);
        const int bh = un / (NCH / 2), cp = un % (NCH / 2), b = bh / NH, head = bh % NH; const size_t m0 = (size_t)b * SEQ + cp * 256, g0 = (size_t)bh * SEQ + cp * 256;
        const int unc = bh * NCH + 2 * cp + ci; const int t = 128 * ci + 32 * qt + q; const size_t m = m0 + t;
        bf16x8 qf[4];
#pragma unroll
        for (int s4 = 0; s4 < 4; ++s4) qf[s4] = *(const bf16x8*)(QM + m * WM + head * HD + 16 * s4 + 8 * h);
        const float mx = SMX[g0 + t], sbv = SB[g0 + t], mc = MC[unc];
        __syncthreads();
        if (F.tid < 256) sa[F.tid] = pa;
#pragma unroll
        for (int k = 0; k < 4; ++k) { const int p = F.tid + NTHR * k, key = p >> 3, c = p & 7;
            *(LAS v4u*)(F.lds + key * 128 + ((c ^ ((key >> 1) & 7)) << 4)) = pk[k];
            const unsigned vw[4] = {pv[k].x, pv[k].y, pv[k].z, pv[k].w};
#pragma unroll
            for (int e = 0; e < 4; ++e) { *(LAS unsigned short*)(F.lds + MB_VOFF + (8 * c + 2 * e) * MB_VSTR + 2 * key) = (unsigned short)(vw[e] & 0xffffu);
                *(LAS unsigned short*)(F.lds + MB_VOFF + (8 * c + 2 * e + 1) * MB_VSTR + 2 * key) = (unsigned short)(vw[e] >> 16); } }
        __syncthreads();
        const float sc = __expf(mc - mx);
        f32x16 o[2]; float l = 0.f;
#pragma unroll
        for (int r = 0; r < 16; ++r) { o[0][r] = 0.f; o[1][r] = 0.f; }
        bf16x8 qs[4]; float qn = 0.f;
#pragma unroll
        for (int s4 = 0; s4 < 4; ++s4) { const v4u w = __builtin_bit_cast(v4u, qf[s4]); const float* np = NS + (size_t)unc * HD + 16 * s4 + 8 * h;
            const f32x4 n0 = *(const f32x4*)np, n1 = *(const f32x4*)(np + 4);
            const float f0 = bflo(w.x), f1 = bfhi(w.x), f2 = bflo(w.y), f3 = bfhi(w.y), f4 = bflo(w.z), f5 = bfhi(w.z), f6 = bflo(w.w), f7 = bfhi(w.w);
            qn += (f0 * n0.x + f1 * n0.y) + (f2 * n0.z + f3 * n0.w) + (f4 * n1.x + f5 * n1.y) + (f6 * n1.z + f7 * n1.w);
            const v4u ws = {pk2(f0 * sc, f1 * sc), pk2(f2 * sc, f3 * sc), pk2(f4 * sc, f5 * sc), pk2(f6 * sc, f7 * sc)}; qs[s4] = __builtin_bit_cast(bf16x8, ws); }
        qn += __shfl_xor(qn, 32);
#pragma unroll
        for (int mt = 0; mt < 2; ++mt) { asm volatile("" ::: "memory");
#pragma unroll
            for (int s4 = 0; s4 < 4; ++s4) { const float* cpn = CS + (size_t)unc * 4096 + (32 * mt + q) * HD + 16 * s4 + 8 * h; const f32x4 c0 = *(const f32x4*)cpn, c1 = *(const f32x4*)(cpn + 4);
                const v4u cw = {pk2(c0.x, c0.y), pk2(c0.z, c0.w), pk2(c1.x, c1.y), pk2(c1.z, c1.w)};
                o[mt] = __builtin_amdgcn_mfma_f32_32x32x16_bf16(__builtin_bit_cast(bf16x8, cw), qs[s4], o[mt], 0, 0, 0); } }
#pragma unroll 1
        for (int ktl = 0; ktl <= qt; ++ktl) { const int kt = 4 * ci + ktl;
            f32x16 sacc;
#pragma unroll
            for (int r = 0; r < 16; ++r) sacc[r] = 0.f;
            const int key = 32 * kt + q, sw = (key >> 1) & 7;
#pragma unroll
            for (int s4 = 0; s4 < 4; ++s4) { const bf16x8 kf = *(const LAS bf16x8*)(F.lds + key * 128 + (((2 * s4 + h) ^ sw) << 4)); sacc = __builtin_amdgcn_mfma_f32_32x32x16_bf16(kf, qf[s4], sacc, 0, 0, 0); }
            float p[16];
#pragma unroll
            for (int r = 0; r < 16; ++r) { const int kr = (r & 3) + 8 * (r >> 2) + 4 * h; const float e = __expf(sa[32 * kt + kr] - mx);
                p[r] = (ktl == qt && kr > q) ? 0.f : sacc[r] * e; l += p[r]; }
            bf16x8 pb[2];
#pragma unroll
            for (int s2 = 0; s2 < 2; ++s2) { v4u w; w.x = pk2(p[8 * s2], p[8 * s2 + 1]); w.y = pk2(p[8 * s2 + 2], p[8 * s2 + 3]); w.z = pk2(p[8 * s2 + 4], p[8 * s2 + 5]); w.w = pk2(p[8 * s2 + 6], p[8 * s2 + 7]); pb[s2] = __builtin_bit_cast(bf16x8, w); }
#pragma unroll
            for (int mt = 0; mt < 2; ++mt)
#pragma unroll
                for (int s2 = 0; s2 < 2; ++s2) { const LAS unsigned char* vp = F.lds + MB_VOFF + (32 * mt + q) * MB_VSTR + (32 * kt + 16 * s2 + 4 * h) * 2;
                    const v2u lo = *(const LAS v2u*)vp, hi = *(const LAS v2u*)(vp + 16); const v4u w = {lo.x, lo.y, hi.x, hi.y};
                    o[mt] = __builtin_amdgcn_mfma_f32_32x32x16_bf16(__builtin_bit_cast(bf16x8, w), pb[s2], o[mt], 0, 0, 0); }
        }
        l += __shfl_xor(l, 32);
        const float den = l + sc * qn; const float inv = 1.0f / fmaxf(fabsf(den), __expf(-(sbv + mx)));
        float ss = 0.f;
#pragma unroll
        for (int mt = 0; mt < 2; ++mt)
#pragma unroll
            for (int r = 0; r < 16; ++r) { o[mt][r] *= inv; ss += o[mt][r] * o[mt][r]; }
        ss += __shfl_xor(ss, 32);
        const float rstd = 1.0f / sqrtf(ss * (1.0f / HD) + RMS_EPS);
#pragma unroll
        for (int mt = 0; mt < 2; ++mt)
#pragma unroll
            for (int g = 0; g < 4; ++g) { const int v0 = 32 * mt + 8 * g + 4 * h; const v2u ow = *(const v2u*)(U + m * NU + UOM + head * HD + v0); const f32x4 hg = *(const f32x4*)(args.in[8] + head * HD + v0);
                *(v2u*)(MIX + m * D + head * HD + v0) = (v2u){pk2(o[mt][4 * g] * rstd * hg.x * sigmoidf_(bflo(ow.x)), o[mt][4 * g + 1] * rstd * hg.y * sigmoidf_(bfhi(ow.x))),
                                                             pk2(o[mt][4 * g + 2] * rstd * hg.z * sigmoidf_(bflo(ow.y)), o[mt][4 * g + 3] * rstd * hg.w * sigmoidf_(bfhi(ow.y)))}; }
    }
#undef MO_FETCH
}

__device__ __forceinline__ void p_mix_a(Frame& F, const Args& args) {
    const bf16* U = wsp<bf16>(F, WS_U);
    moba_routed(F, args);
    mlstm_scan(F);
}

__device__ __forceinline__ void p_mix_b(Frame& F, const Args& args) {
    moba_own(F, args);
    __syncthreads();
    mlstm_out2(F, args);
}

__device__ __forceinline__ void p_router(Frame& F, const Args& args) {
    const bf16* T1 = wsp<bf16>(F, WS_X1); const bf16* WR = wsp<bf16>(F, WS_WR); const float* SS = wsp<float>(F, WS_SS);
    int* SELE = wsp<int>(F, WS_SELE); float* SELW = wsp<float>(F, WS_SELW); float* RSTD = wsp<float>(F, WS_RSTD); int* HIST = wsp<int>(F, WS_HIST);
    LAS float* part = (LAS float*)F.lds;
    LAS int* sh = (LAS int*)(F.lds + 2 * 64 * 33 * 4);
    const int l15 = F.lane & 15, kq = F.lane >> 4, tile = F.wave & 3, kh = F.wave >> 2;
    for (int ch = F.bid; ch < 256; ch += F.G) {
        __syncthreads();
        if (F.tid < NE) sh[F.tid] = 0;
        f32x4 acc[2] = {{0.f, 0.f, 0.f, 0.f}, {0.f, 0.f, 0.f, 0.f}};
        const bf16* ap = T1 + ((size_t)ch * 64 + 16 * tile + l15) * D + 512 * kh + 8 * kq; const bf16* bp = WR + (size_t)l15 * D + 512 * kh + 8 * kq;
#pragma unroll 4
        for (int ks = 0; ks < 16; ++ks) { const bf16x8 av = *(const bf16x8*)(ap + 32 * ks), b0 = *(const bf16x8*)(bp + 32 * ks), b1 = *(const bf16x8*)(bp + 16 * D + 32 * ks);
            acc[0] = __builtin_amdgcn_mfma_f32_16x16x32_bf16(av, b0, acc[0], 0, 0, 0); acc[1] = __builtin_amdgcn_mfma_f32_16x16x32_bf16(av, b1, acc[1], 0, 0, 0); }
#pragma unroll
        for (int nt = 0; nt < 2; ++nt)
#pragma unroll
            for (int r = 0; r < 4; ++r) part[(kh * 64 + 16 * tile + 4 * kq + r) * 33 + 16 * nt + l15] = acc[nt][r];
        __syncthreads();
        if (F.tid < 64) {
            const size_t m = (size_t)ch * 64 + F.tid; float ss = 0.f;
#pragma unroll
            for (int q = 0; q < 16; ++q) ss += SS[m * 16 + q];
            const float rstd = 1.0f / sqrtf(ss * (1.0f / D) + RMS_EPS);
            float v0 = -INFINITY, v1 = -INFINITY, v2 = -INFINITY, v3 = -INFINITY; int s0 = 0, s1 = 0, s2 = 0, s3 = 0;
            for (int e = 0; e < NE; ++e) { const float g = (part[F.tid * 33 + e] + part[(64 + F.tid) * 33 + e]) * rstd + args.in[14][e];
                if (g > v0) { v3 = v2; s3 = s2; v2 = v1; s2 = s1; v1 = v0; s1 = s0; v0 = g; s0 = e; }
                else if (g > v1) { v3 = v2; s3 = s2; v2 = v1; s2 = s1; v1 = g; s1 = e; }
                else if (g > v2) { v3 = v2; s3 = s2; v2 = g; s2 = e; }
                else if (g > v3) { v3 = g; s3 = e; } }
            const float e1 = __expf(v1 - v0), e2 = __expf(v2 - v0), e3 = __expf(v3 - v0); const float inv = 1.0f / (1.0f + e1 + e2 + e3);
            *(int4*)(SELE + m * 4) = make_int4(s0, s1, s2, s3); *(f32x4*)(SELW + m * 4) = (f32x4){inv, e1 * inv, e2 * inv, e3 * inv}; RSTD[m] = rstd;
            atomicAdd((int*)&sh[s0], 1); atomicAdd((int*)&sh[s1], 1); atomicAdd((int*)&sh[s2], 1); atomicAdd((int*)&sh[s3], 1);
        }
        __syncthreads();
        if (F.tid < NE) HIST[ch * NE + F.tid] = sh[F.tid];
    }
}
__device__ __forceinline__ void p_lists(Frame& F, const Args& args) {
    const int* SELE = wsp<int>(F, WS_SELE); const float* SELW = wsp<float>(F, WS_SELW); const float* RSTD = wsp<float>(F, WS_RSTD); const int* HIST = wsp<int>(F, WS_HIST);
    int* POS = wsp<int>(F, WS_POS); int* ROWTOK = wsp<int>(F, WS_ROWTOK); float* ROWGATE = wsp<float>(F, WS_ROWGATE); float* ROWRSTD = wsp<float>(F, WS_ROWRSTD); int* TILEE = wsp<int>(F, WS_TILEE);
    LAS int* stot = (LAS int*)F.lds;
    LAS int* soff = stot + 32;
    LAS int* sbase = soff + 40;
    for (int ch = F.bid; ch < 256; ch += F.G) {
        __syncthreads();
        { LAS int* part = sbase + 32;
          const int e = F.tid & 31, pt = F.tid >> 5; int hv[16], tot = 0, before = 0;
#pragma unroll
          for (int i = 0; i < 16; ++i) hv[i] = HIST[(16 * pt + i) * NE + e];
#pragma unroll
          for (int i = 0; i < 16; ++i) { tot += hv[i]; if (16 * pt + i < ch) before += hv[i]; }
          part[(pt * 32 + e) * 2] = tot; part[(pt * 32 + e) * 2 + 1] = before;
          __syncthreads();
          if (F.tid < NE) { int t = 0, bsum = 0;
#pragma unroll
              for (int p = 0; p < 16; ++p) { t += part[(p * 32 + F.tid) * 2]; bsum += part[(p * 32 + F.tid) * 2 + 1]; }
              stot[F.tid] = t; sbase[F.tid] = bsum; } }
        __syncthreads();
        if (F.tid == 0) { int o = 0; for (int e = 0; e < NE; ++e) { soff[e] = o; o += (stot[e] + 255) & ~255; } soff[NE] = o; }
        __syncthreads();
        if (F.wave == 0) {
            const size_t m = (size_t)ch * 64 + F.lane; int se[4]; float sw[4];
#pragma unroll
            for (int k = 0; k < 4; ++k) { se[k] = SELE[m * 4 + k]; sw[k] = SELW[m * 4 + k]; }
            const float rs = RSTD[m]; int pos[4] = {0, 0, 0, 0};
            for (int e = 0; e < NE; ++e) { const unsigned long long mk = __ballot(se[0] == e || se[1] == e || se[2] == e || se[3] == e);
                const int rank = __popcll(mk & ((1ull << F.lane) - 1ull)); const int pp = soff[e] + sbase[e] + rank;
#pragma unroll
                for (int k = 0; k < 4; ++k) if (se[k] == e) pos[k] = pp; }
#pragma unroll
            for (int k = 0; k < 4; ++k) { POS[m * 4 + k] = pos[k]; ROWTOK[pos[k]] = (int)m; ROWGATE[pos[k]] = sw[k]; ROWRSTD[pos[k]] = rs; }
        }
        if (ch < NE) { const int e = ch; for (int r = soff[e] + stot[e] + F.tid; r < soff[e + 1]; r += NTHR) { ROWTOK[r] = 0; ROWGATE[r] = 0.f; ROWRSTD[r] = 0.f; } }
        if (ch == 0) { const int nt = soff[NE] >> 8; for (int t = F.tid; t < nt; t += NTHR) { int e = 0; while (soff[e + 1] <= t * 256) ++e; TILEE[t] = e; } if (F.tid == 0) TILEE[MAXTILES] = nt; }
    }
}
__device__ __forceinline__ void p_combine(Frame& F, const Args& args) {
    bf16* X1 = wsp<bf16>(F, WS_X1); const unsigned char* YS = wsp<unsigned char>(F, WS_YS); const int* POS = wsp<int>(F, WS_POS); float* RS2 = wsp<float>(F, WS_RSTD);
    const int gw = F.bid * NWAVES + F.wave, NGW = F.G * NWAVES, lane = F.lane;
    v2u xw[4]; int yw[4][4]; int4 psn = make_int4(0, 0, 0, 0);
    if (gw < M) { const int4 ps = *(const int4*)(POS + (size_t)gw * 4); const int pv[4] = {ps.x, ps.y, ps.z, ps.w};
#pragma unroll
        for (int j = 0; j < 4; ++j) { xw[j] = *(const v2u*)(X1 + (size_t)gw * D + 256 * j + 4 * lane);
#pragma unroll
            for (int k = 0; k < 4; ++k) yw[j][k] = __builtin_nontemporal_load((const int*)(YS + (size_t)pv[k] * D + 256 * j + 4 * lane)); }
        if (gw + NGW < M) psn = *(const int4*)(POS + (size_t)(gw + NGW) * 4); }
    for (int m = gw; m < M; m += NGW) {
        f32x4 v[4]; float s = 0.f;
#pragma unroll
        for (int j = 0; j < 4; ++j) { v[j] = (f32x4){bflo(xw[j].x), bfhi(xw[j].x), bflo(xw[j].y), bfhi(xw[j].y)};
#pragma unroll
            for (int k = 0; k < 4; ++k) { const f32x2_t lo = __builtin_amdgcn_cvt_pk_f32_fp8(yw[j][k], false), hi = __builtin_amdgcn_cvt_pk_f32_fp8(yw[j][k], true);
                v[j].x += lo.x; v[j].y += lo.y; v[j].z += hi.x; v[j].w += hi.y; } }
        if (m + NGW < M) { const int pv[4] = {psn.x, psn.y, psn.z, psn.w}; const size_t mn = (size_t)(m + NGW);
#pragma unroll
            for (int j = 0; j < 4; ++j) { xw[j] = *(const v2u*)(X1 + mn * D + 256 * j + 4 * lane);
#pragma unroll
                for (int k = 0; k < 4; ++k) yw[j][k] = __builtin_nontemporal_load((const int*)(YS + (size_t)pv[k] * D + 256 * j + 4 * lane)); }
            if (m + 2 * NGW < M) psn = *(const int4*)(POS + (size_t)(m + 2 * NGW) * 4); }
#pragma unroll
        for (int j = 0; j < 4; ++j) { s += (v[j].x * v[j].x + v[j].y * v[j].y) + (v[j].z * v[j].z + v[j].w * v[j].w);
            *(v2u*)(X1 + (size_t)m * D + 256 * j + 4 * lane) = (v2u){pk2(v[j].x, v[j].y), pk2(v[j].z, v[j].w)}; }
        const float rstd = 1.0f / sqrtf(wave_sum(s) * (1.0f / D) + RMS_EPS);
        if (lane == 0) RS2[m] = rstd;
    }
}

enum { PH_PRO = 0, PH_INPROJ, PH_PREP, PH_ROUTE, PH_MIXA, PH_MIXB, PH_OUTPROJ, PH_ROUTER, PH_LISTS, PH_GU, PH_DN, PH_COMB, PH_PLE, NPH };

__global__ void __launch_bounds__(NTHR, 2) fwd(Args args) {
    extern __shared__ __attribute__((aligned(16))) unsigned char lds[];
    Frame F;
    F.lds = (LAS unsigned char*)lds; F.MISC = (volatile LAS unsigned*)(F.lds + MISC_OFF);
    F.tid = threadIdx.x; F.lane = F.tid & 63; F.wave = __builtin_amdgcn_readfirstlane(F.tid >> 6); F.G = gridDim.x; F.bid = blockIdx.x;
    F.ws = args.ws; F.ctl = (gu32*)(args.ws + WS_CTL); F.out = args.out;

    for (int u = F.tid; u < (LDS_BYTES - RING_BYTES) / 4; u += NTHR) ((LAS unsigned*)(F.lds + RING_BYTES))[u] = 0u;
    __syncthreads();
    XcdBarrier bar; bar.bar = (unsigned*)(F.ctl + CW_BAR); bar.x = 0; bar.st = nullptr;
    if (!MK_PER_PHASE) bar = xcd_barrier_post((unsigned*)(F.ctl + CW_BAR), F.MISC + 8);
    const int lo = args.ph_lo, hi = args.ph_hi;
#ifdef ONLY
#define IN(k) ((k) == ONLY)
#else
#define IN(k) (lo <= (k) && (k) < hi)
#endif
#ifdef USE_SGEMM
#define GEMM(gather, A_, arow_, lda_, Bt_, K_, S_, E_) sgemm_phase(F, A_, arow_, lda_, Bt_, K_, S_, E_)
#else
#define GEMM(gather, A_, arow_, lda_, Bt_, K_, S_, E_) pg8::gemm_phase<decltype(E_), decltype(S_), gather, true, false>(F.lds, A_, arow_, Bt_, K_, S_, E_)
#define GEMM8(gather, A_, arow_, Bt_, K_, S_, E_) pg8::gemm_phase<decltype(E_), decltype(S_), gather, true, true>(F.lds, A_, arow_, Bt_, K_, S_, E_)
#endif
#ifndef DUP_PHASE
#define DUP_PHASE -1
#endif
#define NREP(k) ((k) == DUP_PHASE ? 2 : 1)
#ifndef PROBE_PHASE
#define PROBE_PHASE -1
#endif
#define PSTAMP(k, w) do { if (PROBE_PHASE == (k) && F.bid == 0 && F.tid == 0) F.MISC[20 + (w)] = (unsigned)__builtin_amdgcn_s_memrealtime(); } while (0)
#define SEAM(k) do { if (IN(k) && IN((k) + 1)) xcd_barrier(bar); } while (0)

    PSTAMP(PH_PRO, 0);
    if (IN(PH_PRO)) { for (int rep = 0; rep < NREP(PH_PRO); ++rep) { p0_prologue(F, args); __syncthreads(); } } SEAM(PH_PRO); PSTAMP(PH_PRO, 1);
    PSTAMP(PH_INPROJ, 0);
    if (IN(PH_INPROJ)) { constexpr int GG = 224;
        if (F.G == 256 && F.bid >= GG) { if (F.bid - GG < NBH) { gate_scans(F, F.bid - GG, NBH); __syncthreads(); }
            tr_run<false>(F, args, I_SMALL, NBG, (F.bid - GG) * NWAVES + F.wave, (256 - GG) * NWAVES); }
        else { StaticOrder S{M / 256, NU / 256, F.G == 256 ? GG : F.G, F.bid}; EpiStoreBf16 E{wsp<bf16>(F, WS_U), NU};
            GEMM(false, wsp<bf16>(F, WS_XN), nullptr, D, wsp<bf16>(F, WS_WIN), D, S, E);
        } } SEAM(PH_INPROJ); PSTAMP(PH_INPROJ, 1);
    PSTAMP(PH_PREP, 0);
    if (IN(PH_PREP)) { for (int rep = 0; rep < NREP(PH_PREP); ++rep) { p_prep(F, args); __syncthreads(); } } SEAM(PH_PREP); PSTAMP(PH_PREP, 1);
    PSTAMP(PH_ROUTE, 0);
    if (IN(PH_ROUTE)) { for (int rep = 0; rep < NREP(PH_ROUTE); ++rep) { p_route(F, args); __syncthreads(); } } SEAM(PH_ROUTE); PSTAMP(PH_ROUTE, 1);
    PSTAMP(PH_MIXA, 0);
    if (IN(PH_MIXA)) { for (int rep = 0; rep < NREP(PH_MIXA); ++rep) { p_mix_a(F, args); __syncthreads(); } } SEAM(PH_MIXA); PSTAMP(PH_MIXA, 1);
    PSTAMP(PH_MIXB, 0);
    if (IN(PH_MIXB)) { for (int rep = 0; rep < NREP(PH_MIXB); ++rep) { p_mix_b(F, args); __syncthreads(); } } SEAM(PH_MIXB); PSTAMP(PH_MIXB, 1);
    PSTAMP(PH_OUTPROJ, 0);
    if (IN(PH_OUTPROJ)) { for (int rep = 0; rep < NREP(PH_OUTPROJ); ++rep) { StaticOrder S{M / 256, D / 256, F.G, F.bid}; EpiOutProj E{args.in[0], wsp<bf16>(F, WS_X1), wsp<float>(F, WS_SS), wsp<unsigned char>(F, WS_T8)};
        GEMM(false, wsp<bf16>(F, WS_MIX), nullptr, D, wsp<bf16>(F, WS_WOUT), D, S, E); } } SEAM(PH_OUTPROJ); PSTAMP(PH_OUTPROJ, 1);
    PSTAMP(PH_ROUTER, 0);
    if (IN(PH_ROUTER)) {
        for (int rep = 0; rep < NREP(PH_ROUTER); ++rep) { p_router(F, args); __syncthreads(); } } SEAM(PH_ROUTER); PSTAMP(PH_ROUTER, 1);
    PSTAMP(PH_LISTS, 0);
    if (IN(PH_LISTS)) { for (int rep = 0; rep < NREP(PH_LISTS); ++rep) { p_lists(F, args); __syncthreads(); } } SEAM(PH_LISTS); PSTAMP(PH_LISTS, 1);
    PSTAMP(PH_GU, 0);
    if (IN(PH_GU)) { for (int rep = 0; rep < NREP(PH_GU); ++rep) { GroupedOrder S{wsp<int>(F, WS_TILEE), 8, F.G, F.bid}; EpiGateUp E{wsp<int>(F, WS_TILEE), wsp<float>(F, WS_ROWRSTD), args.in[16], wsp<unsigned char>(F, WS_ACT)};
        GEMM8(true, wsp<unsigned char>(F, WS_T8), wsp<int>(F, WS_ROWTOK), wsp<unsigned char>(F, WS_WGU), D, S, E); }
        {
            const int nun = wsp<int>(F, WS_TILEE)[MAXTILES] * 8, rem = nun % F.G; PeOrder S{F.bid, F.G};
            if (rem > 0) { S.first = F.bid >= rem ? F.bid - rem : -1; S.stride = F.G - rem; }
            int kple = PLE; asm volatile("" : "+s"(kple)); EpiStoreBf16 E{wsp<bf16>(F, WS_MIX), D}; GEMM(false, wsp<bf16>(F, WS_PB), nullptr, kple, wsp<bf16>(F, WS_WPP), kple, S, E); } } SEAM(PH_GU); PSTAMP(PH_GU, 1);
    PSTAMP(PH_DN, 0);
    if (IN(PH_DN)) { for (int rep = 0; rep < NREP(PH_DN); ++rep) { GroupedOrder S{wsp<int>(F, WS_TILEE), 4, F.G, F.bid}; EpiDown E{wsp<float>(F, WS_ROWGATE), args.in[18], wsp<unsigned char>(F, WS_YS)};
        GEMM8(false, wsp<unsigned char>(F, WS_ACT), nullptr, wsp<unsigned char>(F, WS_WDN), FF, S, E); }
} SEAM(PH_DN); PSTAMP(PH_DN, 1);
    PSTAMP(PH_COMB, 0);
    if (IN(PH_COMB)) { for (int rep = 0; rep < NREP(PH_COMB); ++rep) { p_combine(F, args); __syncthreads(); } } SEAM(PH_COMB); PSTAMP(PH_COMB, 1);
    PSTAMP(PH_PLE, 0);
    if (IN(PH_PLE)) { StaticOrder S{M / 256, D / 256, F.G, F.bid};
        { EpiPle E{wsp<bf16>(F, WS_MIX), wsp<bf16>(F, WS_X1), wsp<float>(F, WS_RSTD), F.out}; GEMM(false, wsp<bf16>(F, WS_X1), nullptr, D, wsp<bf16>(F, WS_WPG), D, S, E); } }
    if (PROBE_PHASE == PH_PLE) { __syncthreads(); PSTAMP(PH_PLE, 1); }
    if (PROBE_PHASE >= 0 && F.bid == 0 && F.tid == 0) { const unsigned dt = F.MISC[21] - F.MISC[20]; const unsigned long long t0 = __builtin_amdgcn_s_memrealtime(); while (__builtin_amdgcn_s_memrealtime() - t0 < 9ull * dt) __builtin_amdgcn_s_sleep(8); }
#undef IN
#undef SEAM
}

extern "C" void kernel_launch(void* const* d_in, const int* in_sizes, int n_in, void* d_out, int out_size, void* d_ws, size_t ws_size, hipStream_t stream) {
    static int grid = 0;
    if (grid == 0) {
        if (n_in != 22 || out_size != M * D || ws_size < WS_END) { fprintf(stderr, "kernel_launch: unexpected problem (n_in %d, out %d, ws %zu); nothing launched\n", n_in, out_size, ws_size); grid = -1; return; }
        int dev = 0, cus = 0, per_cu = 0;
        if (hipGetDevice(&dev) != hipSuccess || hipDeviceGetAttribute(&cus, hipDeviceAttributeMultiprocessorCount, dev) != hipSuccess) { grid = -1; return; }
        if (hipFuncSetAttribute((const void*)fwd, hipFuncAttributeMaxDynamicSharedMemorySize, LDS_BYTES) != hipSuccess) { fprintf(stderr, "kernel_launch: hipFuncSetAttribute failed\n"); grid = -1; return; }
        if (hipOccupancyMaxActiveBlocksPerMultiprocessor(&per_cu, (const void*)fwd, NTHR, LDS_BYTES) != hipSuccess || per_cu < 1) fprintf(stderr, "kernel_launch: occupancy query says %d\n", per_cu);
        (void)hipGetLastError();
        grid = cus;
    }
    if (grid < 0) return;
    if (hipMemsetAsync((char*)d_ws + WS_CTL, 0, CTL_ZERO_BYTES, stream) != hipSuccess) return;
    Args a{};
    for (int i = 0; i < 22; ++i) a.in[i] = (const float*)d_in[i];
    a.out = (float*)d_out; a.ws = (unsigned char*)d_ws; a.li = 0; a.pad = 0;
#if MK_PER_PHASE
    for (int ph = 0; ph < NPH; ++ph) { a.ph_lo = ph; a.ph_hi = ph + 1; hipLaunchKernelGGL(fwd, dim3(grid), dim3(NTHR), LDS_BYTES, stream, a); }
#else
    a.ph_lo = 0; a.ph_hi = NPH; hipLaunchKernelGGL(fwd, dim3(grid), dim3(NTHR), LDS_BYTES, stream, a);
#endif
}
```
